# Optimizing an MI355X kernel written in HIP

```python
import jax
import jax.numpy as jnp
from jax import lax
import numpy as np

D_MODEL = 1024
BATCH = 16
SEQ = 256
DEPTH = 4
DEC_BATCH = 2
DEC_SEQ = 2048
PAST_LEN = 512

GRID_W = 64
HEAD_DIM = 64
A_HEADS = 8
A_KV = 2
A_GROUP = A_HEADS // A_KV
WINDOW = 128
Q_BLOCK = 128
B_HEADS = 8
B_WIDTH = B_HEADS * HEAD_DIM
LORA_W = 64
LORA_A = 64
LORA_G = 128
GN_EPS = 64e-5
C_HEADS = 8
NA_ROWS = 8
NA_COLS = 16
N_BRANCH = 3
A_COLS = (A_HEADS + 2 * A_KV) * HEAD_DIM
B_COLS = 3 * B_WIDTH + 2 * LORA_W + 2 * LORA_A + LORA_G
C_COLS = 3 * C_HEADS * HEAD_DIM
IN_COLS = A_COLS + B_COLS + C_COLS + N_BRANCH * D_MODEL
PEER_HEADS = 8
N_KEYS = 128
N_EXPERTS = N_KEYS * N_KEYS
PEER_KEY_DIM = 256
PEER_TOPK = 16
PEER_CHUNK = 128
ROPE_BASE = 10000.0
RMS_EPS = 1e-6
N_MOD = 6

kernel_name = "hybrid_diffusion_prefix_trunk_step"


def _rmsnorm(x, g):
    xf = x.astype(jnp.float32)
    y = xf * lax.rsqrt(jnp.mean(xf * xf, axis=-1, keepdims=True) + RMS_EPS)
    return (y * g.astype(jnp.float32)).astype(x.dtype)


def _modulate(x, shift, scale):
    return x * (1 + scale) + shift


def _axial_rope(x):
    T = x.shape[1]
    quarter = x.shape[-1] // 4
    t = jnp.arange(T)
    pos = jnp.stack([t // GRID_W, t % GRID_W], axis=-1).astype(jnp.float32)
    freqs = ROPE_BASE ** (-jnp.arange(quarter, dtype=jnp.float32) / quarter)
    ang = pos[:, :, None] * freqs
    bshape = (T,) + (1,) * (x.ndim - 3) + (2, quarter)
    cos = jnp.cos(ang).reshape(bshape).astype(x.dtype)
    sin = jnp.sin(ang).reshape(bshape).astype(x.dtype)
    xr = x.reshape(x.shape[:-1] + (2, 2, quarter))
    x1 = xr[..., 0, :]
    x2 = xr[..., 1, :]
    out = jnp.stack([x1 * cos - x2 * sin, x2 * cos + x1 * sin], axis=-2)
    return out.reshape(x.shape)


def _dense_attention(q, k, v, sink):
    B, S, KV, G, D = q.shape
    nb = S // Q_BLOCK
    scale = D ** -0.5
    vf = v.astype(jnp.float32)
    qb = jnp.moveaxis(q.reshape(B, nb, Q_BLOCK, KV, G, D), 1, 0)

    def block(qi):
        s = jnp.einsum("bqkgd,bskd->bkgqs", qi, k).astype(jnp.float32) * scale
        m = jnp.max(s, axis=-1)
        if sink is not None:
            sk = sink.astype(jnp.float32)[None, :, :, None]
            m = jnp.maximum(m, sk)
        p = jnp.exp(s - m[..., None])
        den = jnp.sum(p, axis=-1)
        if sink is not None:
            den = den + jnp.exp(sk - m)
        o = jnp.einsum("bkgqs,bskd->bqkgd", p, vf)
        return o / jnp.moveaxis(den, -1, 1)[..., None]

    o = lax.map(block, qb)
    return jnp.moveaxis(o, 0, 1).reshape(B, S, KV * G * D).astype(q.dtype)


def _window_attention(q, k, v, ck, cv, sink):
    B, T, KV, G, D = q.shape
    nb = T // Q_BLOCK
    span = Q_BLOCK + 2 * WINDOW
    scale = D ** -0.5
    pad = ((0, 0), (WINDOW, WINDOW), (0, 0), (0, 0))
    kp = jnp.pad(k, pad)
    vp = jnp.pad(v, pad)
    idx = jnp.arange(nb)[:, None] * Q_BLOCK + jnp.arange(span)[None, :]
    kb = kp[:, idx]
    vb = vp[:, idx].astype(jnp.float32)
    qb = q.reshape(B, nb, Q_BLOCK, KV, G, D)
    s = jnp.einsum("bnqkgd,bnskd->bnkgqs", qb, kb).astype(jnp.float32) * scale
    qpos = jnp.arange(nb)[:, None] * Q_BLOCK + jnp.arange(Q_BLOCK)[None, :]
    kpos = idx - WINDOW
    valid = ((jnp.abs(qpos[:, :, None] - kpos[:, None, :]) <= WINDOW)
             & (kpos >= 0)[:, None, :] & (kpos < T)[:, None, :])
    s = jnp.where(valid[None, :, None, None], s, -jnp.inf)
    sc = jnp.einsum("bnqkgd,bpkd->bnkgqp", qb, ck).astype(jnp.float32) * scale
    sk = sink.astype(jnp.float32)[None, None, :, :, None]
    m = jnp.maximum(jnp.maximum(jnp.max(s, axis=-1), jnp.max(sc, axis=-1)), sk)
    ps = jnp.exp(s - m[..., None])
    pc = jnp.exp(sc - m[..., None])
    den = jnp.sum(ps, axis=-1) + jnp.sum(pc, axis=-1) + jnp.exp(sk - m)
    o = (jnp.einsum("bnkgqs,bnskd->bnqkgd", ps, vb)
         + jnp.einsum("bnkgqp,bpkd->bnqkgd", pc, cv.astype(jnp.float32)))
    o = o / jnp.moveaxis(den, -1, 2)[..., None]
    return o.reshape(B, T, KV * G * D).astype(q.dtype)


def _neighbourhood_attention(q, k, v, ck, cv, rpb):
    B, T, H, D = q.shape
    rows = T // GRID_W
    wr = min(NA_ROWS, rows)
    scale = D ** -0.5
    qg = q.reshape(B, rows, GRID_W, H, D)
    kg = k.reshape(B, rows, GRID_W, H, D)
    vg = v.reshape(B, rows, GRID_W, H, D)
    r = jnp.arange(rows)
    rs = jnp.clip(r - wr // 2, 0, rows - wr)
    row_idx = rs[:, None] + jnp.arange(wr)[None, :]
    k_rows = kg[:, row_idx]
    v_rows = vg[:, row_idx].astype(jnp.float32)
    col = jnp.arange(GRID_W)
    cs = jnp.clip(col - NA_COLS // 2, 0, GRID_W - NA_COLS)
    col_ok = (col[None, :] >= cs[:, None]) & (col[None, :] < cs[:, None] + NA_COLS)
    dr = row_idx - r[:, None] + NA_ROWS - 1
    dc = jnp.clip(col[None, :] - col[:, None], -(NA_COLS - 1), NA_COLS - 1) + NA_COLS - 1
    bias = rpb[:, dr[:, None, :, None], dc[None, :, None, :]].astype(jnp.float32)
    s = jnp.einsum("brchd,brawhd->bhrcaw", qg, k_rows).astype(jnp.float32) * scale + bias[None]
    s = jnp.where(col_ok[None, None, None, :, None, :], s, -jnp.inf)
    sc = jnp.einsum("brchd,bphd->bhrcp", qg, ck).astype(jnp.float32) * scale
    m = jnp.maximum(jnp.max(s, axis=(-2, -1)), jnp.max(sc, axis=-1))
    pn = jnp.exp(s - m[..., None, None])
    pc = jnp.exp(sc - m[..., None])
    den = jnp.sum(pn, axis=(-2, -1)) + jnp.sum(pc, axis=-1)
    o = (jnp.einsum("bhrcaw,brawhd->brchd", pn, v_rows)
         + jnp.einsum("bhrcp,bphd->brchd", pc, cv.astype(jnp.float32)))
    o = o / jnp.transpose(den, (0, 2, 3, 1))[..., None]
    return o.reshape(B, T, H * D).astype(q.dtype)


def _heads(z):
    return z.reshape(z.shape[:2] + (B_HEADS, HEAD_DIM))


def _rwkv7_scan(s0, r, w, k, v, kk, a, reverse):
    xs = tuple(jnp.moveaxis(z, 1, 0) for z in (r, w, k, v, kk, a))

    def step(S, xt):
        rt, wt, kt, vt, kkt, at = xt
        sa = jnp.einsum("bhij,bhj->bhi", S, -kkt)
        S = (S * wt[:, :, None, :] + sa[..., None] * (kkt * at)[:, :, None, :]
             + vt[..., None] * kt[:, :, None, :])
        return S, jnp.einsum("bhij,bhj->bhi", S, rt)

    S, ys = lax.scan(step, s0.astype(jnp.float32), xs, reverse=reverse)
    return jnp.moveaxis(ys, 0, 1), S


def _rwkv7_bidir(pb, lp, s0_f, s0_b):
    B, T, _ = pb.shape
    prev = jnp.pad(pb[:, :-1], ((0, 0), (1, 0), (0, 0)))
    nxt = jnp.pad(pb[:, 1:], ((0, 0), (0, 1), (0, 0)))
    xb = pb + lp["rw_mu"] * (0.5 * (prev + nxt) - pb)
    r, k, v, wd, ad, gd = jnp.split(
        xb, [B_WIDTH, 2 * B_WIDTH, 3 * B_WIDTH, 3 * B_WIDTH + 2 * LORA_W,
             3 * B_WIDTH + 2 * LORA_W + 2 * LORA_A], axis=-1)
    wd = wd.reshape(B, T, 2, LORA_W)
    ad = ad.reshape(B, T, 2, LORA_A)
    wlog = -jax.nn.softplus(-(lp["rw_w0"] + jnp.einsum("btzl,zlc->btzc", jnp.tanh(wd), lp["rw_w2"]))) - 0.5
    decay = jnp.exp(-jnp.exp(wlog.astype(jnp.float32)))
    a = jax.nn.sigmoid(lp["rw_a0"] + jnp.einsum("btzl,zlc->btzc", ad, lp["rw_a2"])).astype(jnp.float32)
    g = (jax.nn.sigmoid(gd) @ lp["rw_g2"]).astype(jnp.float32)
    rf = r.astype(jnp.float32)
    kf = k.astype(jnp.float32)
    vf = v.astype(jnp.float32)
    kk = _heads(kf * lp["rw_kk"])
    kk = kk * lax.rsqrt(jnp.sum(kk * kk, axis=-1, keepdims=True) + 1e-12)
    kd = kf[:, :, None, :] * (1 + (a - 1) * lp["rw_ka"])
    y_f, s_f = _rwkv7_scan(s0_f, _heads(rf), _heads(decay[:, :, 0]), _heads(kd[:, :, 0]),
                           _heads(vf), kk, _heads(a[:, :, 0]), False)
    y_b, s_b = _rwkv7_scan(s0_b, _heads(rf), _heads(decay[:, :, 1]), _heads(kd[:, :, 1]),
                           _heads(vf), kk, _heads(a[:, :, 1]), True)
    y = y_f + y_b
    mu = jnp.mean(y, axis=-1, keepdims=True)
    var = jnp.mean(jnp.square(y - mu), axis=-1, keepdims=True)
    y = ((y - mu) * lax.rsqrt(var + GN_EPS)).reshape(B, T, B_WIDTH) * lp["rw_lnx_g"] + lp["rw_lnx_b"]
    bonus = jnp.sum(_heads(rf * (kd[:, :, 0] + kd[:, :, 1])) * lp["rw_rk"], axis=-1, keepdims=True) * _heads(vf)
    y = (y + bonus.reshape(B, T, B_WIDTH)) * g
    return y.astype(pb.dtype), s_f, s_b


def _mixer(h, lp, ctx):
    B, T, _ = h.shape
    p = h @ lp["w_in"]
    pa, pb, pc, pg = jnp.split(p, [A_COLS, A_COLS + B_COLS, A_COLS + B_COLS + C_COLS], axis=-1)
    qa, ka, va = jnp.split(pa, [A_HEADS * HEAD_DIM, (A_HEADS + A_KV) * HEAD_DIM], axis=-1)
    qa = qa.reshape(B, T, A_KV, A_GROUP, HEAD_DIM)
    ka = ka.reshape(B, T, A_KV, HEAD_DIM)
    va = va.reshape(B, T, A_KV, HEAD_DIM)
    qc, kc, vc = jnp.split(pc, 3, axis=-1)
    qc = qc.reshape(B, T, C_HEADS, HEAD_DIM)
    kc = kc.reshape(B, T, C_HEADS, HEAD_DIM)
    vc = vc.reshape(B, T, C_HEADS, HEAD_DIM)
    sink = lp["a_sink"].reshape(A_KV, A_GROUP)
    if ctx is None:
        ya = _dense_attention(qa, ka, va, sink)
        yc = _dense_attention(qc[:, :, :, None, :], kc, vc, None)
        s0_f = jnp.zeros((B, B_HEADS, HEAD_DIM, HEAD_DIM), jnp.float32)
        s0_b = s0_f
    else:
        ctx_ak, ctx_av, ctx_ck, ctx_cv, s0 = ctx
        ya = _window_attention(_axial_rope(qa), _axial_rope(ka), va, ctx_ak, ctx_av, sink)
        yc = _neighbourhood_attention(qc, kc, vc, ctx_ck, ctx_cv, lp["na_rpb"])
        s0_f = s0[:, 0]
        s0_b = s0[:, 1]
    yb, s_f, s_b = _rwkv7_bidir(pb, lp, s0_f, s0_b)
    gates = jax.nn.sigmoid(pg.reshape(B, T, N_BRANCH, D_MODEL))
    merged = (gates[:, :, 0] * (ya @ lp["a_out"]) + gates[:, :, 1] * (yb @ lp["rw_out"])
              + gates[:, :, 2] * (yc @ lp["na_out"]))
    out = merged @ lp["w_o"]
    if ctx is None:
        return out, (ka, va, kc, vc, jnp.stack([s_f, s_b], axis=1).astype(h.dtype))
    return out, None


def _peer(h, q_w, subkeys, u_tab, v_tab):
    B, T, D = h.shape
    hc_all = h.reshape((B * T) // PEER_CHUNK, PEER_CHUNK, D)

    def chunk(hc):
        q = (hc @ q_w).reshape(PEER_CHUNK, PEER_HEADS, 2, PEER_KEY_DIM // 2)
        s = jnp.einsum("chzk,hznk->chzn", q, subkeys).astype(jnp.float32)
        v1, i1 = lax.top_k(s[:, :, 0], PEER_TOPK)
        v2, i2 = lax.top_k(s[:, :, 1], PEER_TOPK)
        cand = (v1[..., :, None] + v2[..., None, :]).reshape(PEER_CHUNK, PEER_HEADS, PEER_TOPK * PEER_TOPK)
        sv, si = lax.top_k(cand, PEER_TOPK)
        e = (jnp.take_along_axis(i1, si // PEER_TOPK, axis=-1) * N_KEYS
             + jnp.take_along_axis(i2, si % PEER_TOPK, axis=-1))
        gate = jax.nn.softmax(sv, axis=-1)
        u = jnp.take(u_tab, e, axis=0)
        act = jax.nn.gelu(jnp.einsum("cd,chkd->chk", hc, u).astype(jnp.float32))
        vv = jnp.take(v_tab, e, axis=0)
        return jnp.einsum("chk,chkd->cd", (gate * act).astype(hc.dtype), vv)

    return lax.map(chunk, hc_all).reshape(B, T, D)


def setup_inputs(seed: int = 0) -> dict:
    key = jax.random.key(seed)
    ks = iter(jax.random.split(key, 48))

    def nrm(shape, s):
        return jax.random.normal(next(ks), shape, jnp.float32) * s

    L, D = DEPTH, D_MODEL
    return {
        "x_prompt": nrm((BATCH, SEQ, D), 1.0),
        "x_sample": nrm((DEC_BATCH, DEC_SEQ, D), 1.0),
        "cache_a_k": nrm((DEC_BATCH, L, PAST_LEN, A_KV, HEAD_DIM), 1.0),
        "cache_a_v": nrm((DEC_BATCH, L, PAST_LEN, A_KV, HEAD_DIM), 1.0),
        "cache_c_k": nrm((DEC_BATCH, L, PAST_LEN, C_HEADS, HEAD_DIM), 1.0),
        "cache_c_v": nrm((DEC_BATCH, L, PAST_LEN, C_HEADS, HEAD_DIM), 1.0),
        "state_rwkv": nrm((DEC_BATCH, L, 2, B_HEADS, HEAD_DIM, HEAD_DIM), 0.5),
        "c": nrm((DEC_BATCH, D), 1.0),
        "c_ctx": nrm((D,), 1.0),
        "ln1_g": 1.0 + nrm((L, D), 0.02),
        "ln2_g": 1.0 + nrm((L, D), 0.02),
        "lnf_g": 1.0 + nrm((D,), 0.02),
        "ada_w": nrm((L, D, N_MOD * D), 0.5 * D ** -0.5),
        "ada_b": nrm((L, N_MOD * D), 0.02),
        "w_in": nrm((L, D, IN_COLS), D ** -0.5),
        "a_sink": nrm((L, A_HEADS), 1.0),
        "a_out": nrm((L, A_HEADS * HEAD_DIM, D), (A_HEADS * HEAD_DIM) ** -0.5),
        "rw_mu": jax.random.uniform(next(ks), (L, B_COLS), jnp.float32),
        "rw_w0": nrm((L, 2, B_WIDTH), 0.5),
        "rw_w2": nrm((L, 2, LORA_W, B_WIDTH), 0.5 * LORA_W ** -0.5),
        "rw_a0": nrm((L, 2, B_WIDTH), 0.5),
        "rw_a2": nrm((L, 2, LORA_A, B_WIDTH), 0.5 * LORA_A ** -0.5),
        "rw_g2": nrm((L, LORA_G, B_WIDTH), LORA_G ** -0.5),
        "rw_kk": 1.0 + nrm((L, B_WIDTH), 0.1),
        "rw_ka": 1.0 + nrm((L, B_WIDTH), 0.1),
        "rw_rk": nrm((L, B_HEADS, HEAD_DIM), 0.1),
        "rw_lnx_g": 1.0 + nrm((L, B_WIDTH), 0.02),
        "rw_lnx_b": nrm((L, B_WIDTH), 0.02),
        "rw_out": nrm((L, B_WIDTH, D), B_WIDTH ** -0.5),
        "na_rpb": nrm((L, C_HEADS, 2 * NA_ROWS - 1, 2 * NA_COLS - 1), 0.5),
        "na_out": nrm((L, C_HEADS * HEAD_DIM, D), (C_HEADS * HEAD_DIM) ** -0.5),
        "w_o": nrm((L, D, D), D ** -0.5),
        "pe_q": nrm((L, D, PEER_HEADS * PEER_KEY_DIM), D ** -0.5),
        "pe_subkeys": nrm((L, PEER_HEADS, 2, N_KEYS, PEER_KEY_DIM // 2), (PEER_KEY_DIM // 2) ** -0.5),
        "pe_u": nrm((L, N_EXPERTS, D), D ** -0.5),
        "pe_v": nrm((L, N_EXPERTS, D), (PEER_HEADS * PEER_TOPK) ** -0.5),
    }


def reference(x_prompt, x_sample, cache_a_k, cache_a_v, cache_c_k, cache_c_v, state_rwkv,
              c, c_ctx, ln1_g, ln2_g, lnf_g, ada_w, ada_b, w_in, a_sink, a_out,
              rw_mu, rw_w0, rw_w2, rw_a0, rw_a2, rw_g2, rw_kk, rw_ka, rw_rk,
              rw_lnx_g, rw_lnx_b, rw_out, na_rpb, na_out, w_o,
              pe_q, pe_subkeys, pe_u, pe_v):
    xp = x_prompt
    xs = x_sample
    silu_ctx = jax.nn.silu(c_ctx)[None, :]
    silu_lat = jax.nn.silu(c)
    list_ak, list_av, list_ck, list_cv, list_st = [], [], [], [], []
    for l in range(DEPTH):
        lp = {
            "w_in": w_in[l], "a_sink": a_sink[l], "a_out": a_out[l],
            "rw_mu": rw_mu[l], "rw_w0": rw_w0[l], "rw_w2": rw_w2[l], "rw_a0": rw_a0[l],
            "rw_a2": rw_a2[l], "rw_g2": rw_g2[l], "rw_kk": rw_kk[l], "rw_ka": rw_ka[l],
            "rw_rk": rw_rk[l], "rw_lnx_g": rw_lnx_g[l], "rw_lnx_b": rw_lnx_b[l],
            "rw_out": rw_out[l], "na_rpb": na_rpb[l], "na_out": na_out[l], "w_o": w_o[l],
        }
        mod_p = (silu_ctx @ ada_w[l] + ada_b[l]).reshape(1, 1, N_MOD, D_MODEL)
        mod_s = (silu_lat @ ada_w[l] + ada_b[l]).reshape(-1, 1, N_MOD, D_MODEL)

        h = _modulate(_rmsnorm(xp, ln1_g[l]), mod_p[:, :, 0], mod_p[:, :, 1])
        o, (ak, av, ck, cv, st) = _mixer(h, lp, None)
        xp = xp + mod_p[:, :, 2] * o
        h = _modulate(_rmsnorm(xp, ln2_g[l]), mod_p[:, :, 3], mod_p[:, :, 4])
        xp = xp + mod_p[:, :, 5] * _peer(h, pe_q[l], pe_subkeys[l], pe_u[l], pe_v[l])
        list_ak.append(ak)
        list_av.append(av)
        list_ck.append(ck)
        list_cv.append(cv)
        list_st.append(st)

        ctx = (cache_a_k[:, l], cache_a_v[:, l], cache_c_k[:, l], cache_c_v[:, l], state_rwkv[:, l])
        h = _modulate(_rmsnorm(xs, ln1_g[l]), mod_s[:, :, 0], mod_s[:, :, 1])
        o, _ = _mixer(h, lp, ctx)
        xs = xs + mod_s[:, :, 2] * o
        h = _modulate(_rmsnorm(xs, ln2_g[l]), mod_s[:, :, 3], mod_s[:, :, 4])
        xs = xs + mod_s[:, :, 5] * _peer(h, pe_q[l], pe_subkeys[l], pe_u[l], pe_v[l])

    y_prompt = _rmsnorm(xp, lnf_g)
    y_sample = _rmsnorm(xs, lnf_g)
    new_a_k = jnp.stack(list_ak, axis=1)
    new_a_v = jnp.stack(list_av, axis=1)
    new_c_k = jnp.stack(list_ck, axis=1)
    new_c_v = jnp.stack(list_cv, axis=1)
    new_state_rwkv = jnp.stack(list_st, axis=1)
    return (y_prompt, y_sample, new_a_k, new_a_v, new_c_k, new_c_v, new_state_rwkv)
```

```cpp
#include <hip/hip_runtime.h>
#include <hip/hip_cooperative_groups.h>
#include <cstdio>
namespace cg = cooperative_groups;

#define DI __device__ __forceinline__
typedef unsigned short u16;
using bf16x8 = __attribute__((ext_vector_type(8))) short;
using bf16x4 = __attribute__((ext_vector_type(4))) short;
using f32x4 = __attribute__((ext_vector_type(4))) float;
using u32x2 = __attribute__((ext_vector_type(2))) unsigned;
using u32x4 = __attribute__((ext_vector_type(4))) unsigned;

constexpr int NT = 8192, NCTX = 4096, DM = 1024, INC = 7296, NL = 4;

constexpr size_t AL(size_t x) { return (x + 255) / 256 * 256; }
constexpr size_t O_WIN = 0;
constexpr size_t O_AOUT = O_WIN + AL(4ull * 7296 * 1024 * 2);
constexpr size_t O_RWOUT = O_AOUT + AL(4ull * 1024 * 512 * 2);
constexpr size_t O_NAOUT = O_RWOUT + AL(4ull * 1024 * 512 * 2);
constexpr size_t O_WO = O_NAOUT + AL(4ull * 1024 * 512 * 2);
constexpr size_t O_PEQ = O_WO + AL(4ull * 1024 * 1024 * 2);
constexpr size_t O_SUBK = O_PEQ + AL(4ull * 2048 * 1024 * 2);
constexpr size_t O_W2 = O_SUBK + AL(4ull * 8 * 2 * 128 * 128 * 2);
constexpr size_t O_A2 = O_W2 + AL(8ull * 512 * 64 * 2);
constexpr size_t O_G2 = O_A2 + AL(8ull * 512 * 64 * 2);
constexpr size_t O_PEU = O_G2 + AL(4ull * 512 * 128 * 2);
constexpr size_t O_PEV = O_PEU + AL(4ull * 16384 * 1024 * 2);
constexpr size_t O_CAK = O_PEV + AL(4ull * 16384 * 1024 * 2);
constexpr size_t O_CAVT = O_CAK + AL(8ull * 512 * 128 * 2);
constexpr size_t O_CCK = O_CAVT + AL(8ull * 128 * 512 * 2);
constexpr size_t O_CCVT = O_CCK + AL(8ull * 512 * 512 * 2);
constexpr size_t O_MOD = O_CCVT + AL(8ull * 512 * 512 * 2);
constexpr size_t O_ROPE = O_MOD + AL(4ull * 3 * 6144 * 4);
constexpr size_t O_CNT = O_ROPE + AL(64 * 16 * 2 * 4);
constexpr size_t O_X = O_CNT + 256;
constexpr size_t O_H = O_X + AL(8192ull * 1024 * 4);
constexpr size_t O_QA = O_H + AL(8192ull * 1024 * 2);
constexpr size_t O_KA = O_QA + AL(8192ull * 512 * 2);
constexpr size_t O_VAT = O_KA + AL(8192ull * 128 * 2);
constexpr size_t O_QC = O_VAT + AL(8192ull * 128 * 2);
constexpr size_t O_KC = O_QC + AL(8192ull * 512 * 2);
constexpr size_t O_VCT = O_KC + AL(8192ull * 512 * 2);
constexpr size_t O_PB = O_VCT + AL(8192ull * 512 * 2);
constexpr size_t O_GATE = O_PB + AL(8192ull * 1920 * 4);
constexpr size_t O_XRKV = O_GATE + AL(8192ull * 3072 * 2);
constexpr size_t O_KK = O_XRKV + AL(8192ull * 1536 * 4);
constexpr size_t O_TW = O_KK + AL(8192ull * 512 * 4);
constexpr size_t O_AD = O_TW + AL(8192ull * 128 * 2);
constexpr size_t O_SG = O_AD + AL(8192ull * 128 * 2);
constexpr size_t O_DEC = O_SG + AL(8192ull * 128 * 2);
constexpr size_t O_KD = O_DEC + AL(2ull * 8192 * 512 * 4);
constexpr size_t O_KKA = O_KD + AL(2ull * 8192 * 512 * 4);
constexpr size_t O_GG = O_KKA + AL(2ull * 8192 * 512 * 4);
constexpr size_t O_YS = O_GG + AL(8192ull * 512 * 4);
constexpr size_t O_YABC = O_YS + AL(2ull * 8192 * 512 * 4);
constexpr size_t O_MERG = O_YABC + AL(3ull * 8192 * 512 * 2);
constexpr size_t O_PQ = O_MERG + AL(8192ull * 1024 * 2);
constexpr size_t O_EIDX = O_PQ + AL(8192ull * 2048 * 2);
constexpr size_t O_EGATE = O_EIDX + AL(8192ull * 128 * 4);
constexpr size_t O_SCU = O_EGATE + AL(8192ull * 128 * 4);
constexpr size_t O_SCV = O_SCU + AL(4ull * 16384 * 4);
constexpr size_t O_BAR = O_SCV + AL(4ull * 16384 * 4);
constexpr size_t WS_TOTAL = O_BAR + AL(3456 * 4);
static_assert(WS_TOTAL < 1020ull * 1024 * 1024, "workspace too large");

constexpr size_t OUT_Y = 0;
constexpr size_t OUT_AK = 8388608;
constexpr size_t OUT_AV = 10485760;
constexpr size_t OUT_CK = 12582912;
constexpr size_t OUT_CV = 20971520;
constexpr size_t OUT_ST = 29360128;

struct Params {
  const float* in[36];
  float* out;
  char* ws;
};

__shared__ __attribute__((aligned(16))) char g_smem[65536];

DI u16 f2bf(float x) { unsigned u = __float_as_uint(x); u += 0x7fffu + ((u >> 16) & 1u); return (u16)(u >> 16); }
DI float bf2f(u16 h) { return __uint_as_float(((unsigned)h) << 16); }
DI unsigned pack2(float a, float b) { return (unsigned)f2bf(a) | ((unsigned)f2bf(b) << 16); }
DI float sigmoidf_(float x) { return 1.f / (1.f + __expf(-x)); }
template <int CTRL> DI float dppf(float v) {
  return __builtin_bit_cast(float, __builtin_amdgcn_update_dpp(0, __builtin_bit_cast(int, v), CTRL, 0xf, 0xf, true));
}
template <int CTRL> DI int dppi(int v) { return __builtin_amdgcn_update_dpp(0, v, CTRL, 0xf, 0xf, true); }
DI float row_sum16(float v) { v += dppf<0xB1>(v); v += dppf<0x4E>(v); v += dppf<0x141>(v); v += dppf<0x140>(v); return v; }
DI float row_max16(float v) { v = fmaxf(v, dppf<0xB1>(v)); v = fmaxf(v, dppf<0x4E>(v)); v = fmaxf(v, dppf<0x141>(v)); v = fmaxf(v, dppf<0x140>(v)); return v; }
DI int row_max16i(int v) { v = max(v, dppi<0xB1>(v)); v = max(v, dppi<0x4E>(v)); v = max(v, dppi<0x141>(v)); v = max(v, dppi<0x140>(v)); return v; }
DI float wave_sum(float v) { v = row_sum16(v); v += __shfl_xor(v, 16); v += __shfl_xor(v, 32); return v; }

DI int opaque_tid() { int t = threadIdx.x; asm volatile("" : "+v"(t)); return t; }
DI char* opaque_ptr(char* q) { size_t z = 0; asm volatile("" : "+s"(z)); return q + z; }
DI f32x4 mfma16(bf16x8 a, bf16x8 b, f32x4 c) { return __builtin_amdgcn_mfma_f32_16x16x32_bf16(a, b, c, 0, 0, 0); }

DI int lds_byte(int r, int c) {
  int st = (r >> 4) * 2 + (c >> 5), rr = r & 15, cc = c & 31, ob = rr * 64 + cc * 2;
  return st * 1024 + (ob ^ (((ob >> 9) & 1) << 5));
}
DI void stage_rc(int b, int& R, int& C) {
  int st = b >> 10, sb = b & 1023, swz = sb ^ (((sb >> 9) & 1) << 5);
  R = (st >> 1) * 16 + (swz >> 6);
  C = (st & 1) * 32 + ((swz & 63) >> 1);
}
DI void gemm_main(int tid, const u16* __restrict__ g0, int ld0, const u16* __restrict__ g1, int ld1, int K, f32x4 (&acc)[4][4], int koff = 0) {
  const int wid = tid >> 6, lane = tid & 63, wr = wid >> 1, wc = wid & 1, fr = lane & 15, fq = lane >> 4;
  const int nk = K >> 6;
  int R0, C0;
  stage_rc(tid * 16, R0, C0);
  const unsigned v0 = (unsigned)(R0 * ld0 + C0), v1 = (unsigned)(R0 * ld1 + C0);
  const int fa0 = lds_byte(wr * 64 + fr, fq * 8), fa1 = 16384 + lds_byte(wc * 64 + fr, fq * 8);
  const int sb = tid * 16;
#define GSTAGE(kt, buf)                                                                                          \
  do {                                                                                                           \
    _Pragma("unroll") for (int i = 0; i < 4; ++i) {                                                              \
      const u16* u0 = g0 + (size_t)(kt) * 64 + (size_t)i * 32 * ld0;                                             \
      const u16* u1 = g1 + (size_t)(kt) * 64 + (size_t)i * 32 * ld1;                                             \
      __builtin_amdgcn_global_load_lds((const unsigned*)(u0 + v0), (unsigned*)(g_smem + (buf) + i * 4096 + sb), 16, 0, 0);          \
      __builtin_amdgcn_global_load_lds((const unsigned*)(u1 + v1), (unsigned*)(g_smem + (buf) + 16384 + i * 4096 + sb), 16, 0, 0);  \
    }                                                                                                            \
  } while (0)
  int kt = koff;
  GSTAGE(kt, 0);
  for (int t = 0; t < nk; ++t) {
    asm volatile("s_waitcnt vmcnt(0)" ::: "memory");
    __syncthreads();
    const int cur = (t & 1) * 32768;
    kt = kt + 1 == nk ? 0 : kt + 1;
    if (t + 1 < nk) GSTAGE(kt, 32768 - cur);
#pragma unroll
    for (int ks = 0; ks < 2; ++ks) {
      bf16x8 f0[4], f1[4];
#pragma unroll
      for (int m = 0; m < 4; ++m) f0[m] = *(const bf16x8*)(g_smem + cur + fa0 + m * 2048 + ks * 1024);
#pragma unroll
      for (int n = 0; n < 4; ++n) f1[n] = *(const bf16x8*)(g_smem + cur + fa1 + n * 2048 + ks * 1024);
#pragma unroll
      for (int m = 0; m < 4; ++m)
#pragma unroll
        for (int n = 0; n < 4; ++n) acc[m][n] = mfma16(f1[n], f0[m], acc[m][n]);
    }
  }
#undef GSTAGE
  __syncthreads();
}
DI void zero_acc(f32x4 (&acc)[4][4]) {
#pragma unroll
  for (int m = 0; m < 4; ++m)
#pragma unroll
    for (int n = 0; n < 4; ++n) acc[m][n] = f32x4{0.f, 0.f, 0.f, 0.f};
}

struct TJob { const float* src; u16* dst; int K, N, nb; };

DI void transpose_tile(int tid, const float* __restrict__ src, u16* __restrict__ dst, int K, int N, int k0, int n0) {
  float* tile = (float*)g_smem;
  {
    const int tr = tid >> 4, tc = tid & 15;
#pragma unroll
    for (int p = 0; p < 4; ++p) {
      int r = tr + 16 * p;
      f32x4 v = *(const f32x4*)(src + (size_t)(k0 + r) * N + n0 + tc * 4);
      tile[r * 65 + tc * 4 + 0] = v[0]; tile[r * 65 + tc * 4 + 1] = v[1];
      tile[r * 65 + tc * 4 + 2] = v[2]; tile[r * 65 + tc * 4 + 3] = v[3];
    }
  }
  __syncthreads();
  {
    const int tn = tid >> 3, tk = tid & 7;
#pragma unroll
    for (int p = 0; p < 2; ++p) {
      int n = tn + 32 * p;
      u32x4 o;
#pragma unroll
      for (int q = 0; q < 4; ++q) o[q] = pack2(tile[(tk * 8 + 2 * q) * 65 + n], tile[(tk * 8 + 2 * q + 1) * 65 + n]);
      *(u32x4*)(dst + (size_t)(n0 + n) * K + k0 + tk * 8) = o;
    }
  }
  __syncthreads();
}

DI void convert_chunks(int tid, const float* __restrict__ src, u16* __restrict__ dst, size_t n) {
  const size_t nch = n / 8192;
  for (size_t c = blockIdx.x; c < nch; c += gridDim.x) {
    size_t e = c * 8192 + tid * 8;
    f32x4 a[4], b[4];
#pragma unroll
    for (int q = 0; q < 4; ++q) { a[q] = __builtin_nontemporal_load((const f32x4*)(src + e + q * 2048)); b[q] = __builtin_nontemporal_load((const f32x4*)(src + e + q * 2048 + 4)); }
#pragma unroll
    for (int q = 0; q < 4; ++q) {
      u32x4 o;
      o[0] = pack2(a[q][0], a[q][1]); o[1] = pack2(a[q][2], a[q][3]); o[2] = pack2(b[q][0], b[q][1]); o[3] = pack2(b[q][2], b[q][3]);
      *(u32x4*)(dst + e + q * 2048) = o;
    }
  }
}

typedef float f32x2 __attribute__((ext_vector_type(2)));
DI void convert_rows_fp8(int tid, const float* __restrict__ src, unsigned char* __restrict__ dst, float* __restrict__ inv_scale, int nrows) {
  const int lane = tid & 63;
  const int gw = blockIdx.x * 4 + (tid >> 6), GW = gridDim.x * 4;
  for (int r0 = gw; r0 < nrows; r0 += 2 * GW) {
    int rws[2] = {r0, r0 + GW < nrows ? r0 + GW : r0};
    f32x4 v[2][4];
#pragma unroll
    for (int u = 0; u < 2; ++u)
#pragma unroll
      for (int q = 0; q < 4; ++q) v[u][q] = __builtin_nontemporal_load((const f32x4*)(src + (size_t)rws[u] * 1024 + lane * 16 + q * 4));
#pragma unroll
    for (int u = 0; u < 2; ++u) {
      float am = 0.f;
#pragma unroll
      for (int q = 0; q < 4; ++q)
#pragma unroll
        for (int j = 0; j < 4; ++j) am = fmaxf(am, fabsf(v[u][q][j]));
      am = row_max16(am);
      am = fmaxf(am, __shfl_xor(am, 16));
      am = fmaxf(am, __shfl_xor(am, 32));
      int ex = (int)((__float_as_uint(am) >> 23) & 0xff) - 127;
      int k = am > 0.f ? 7 - ex : 0;
      k = min(max(k, -100), 100);
      float sc = __uint_as_float((unsigned)(127 + k) << 23), isc = __uint_as_float((unsigned)(127 - k) << 23);
      u32x4 o;
#pragma unroll
      for (int q = 0; q < 4; ++q) {
        int w = __builtin_amdgcn_cvt_pk_fp8_f32(v[u][q][0] * sc, v[u][q][1] * sc, 0, false);
        w = __builtin_amdgcn_cvt_pk_fp8_f32(v[u][q][2] * sc, v[u][q][3] * sc, w, true);
        o[q] = (unsigned)w;
      }
      *(u32x4*)(dst + (size_t)rws[u] * 1024 + lane * 16) = o;
      if (lane == 0) inv_scale[rws[u]] = isc;
    }
  }
}

DI void convert_rows_fp8_wave(int lane, const float* __restrict__ src, unsigned char* __restrict__ dst, float* __restrict__ inv_scale, int r0, int r1) {
  for (int r = r0; r < r1; r += 2) {
    f32x4 v[2][4];
#pragma unroll
    for (int u = 0; u < 2; ++u)
#pragma unroll
      for (int q = 0; q < 4; ++q) v[u][q] = __builtin_nontemporal_load((const f32x4*)(src + (size_t)(r + u) * 1024 + lane * 16 + q * 4));
#pragma unroll
    for (int u = 0; u < 2; ++u) {
      float am = 0.f;
#pragma unroll
      for (int q = 0; q < 4; ++q)
#pragma unroll
        for (int j = 0; j < 4; ++j) am = fmaxf(am, fabsf(v[u][q][j]));
      am = row_max16(am);
      am = fmaxf(am, __shfl_xor(am, 16));
      am = fmaxf(am, __shfl_xor(am, 32));
      int ex = (int)((__float_as_uint(am) >> 23) & 0xff) - 127;
      int k = am > 0.f ? 7 - ex : 0;
      k = min(max(k, -100), 100);
      float sc = __uint_as_float((unsigned)(127 + k) << 23), isc = __uint_as_float((unsigned)(127 - k) << 23);
      u32x4 o;
#pragma unroll
      for (int q = 0; q < 4; ++q) {
        int w = __builtin_amdgcn_cvt_pk_fp8_f32(v[u][q][0] * sc, v[u][q][1] * sc, 0, false);
        w = __builtin_amdgcn_cvt_pk_fp8_f32(v[u][q][2] * sc, v[u][q][3] * sc, w, true);
        o[q] = (unsigned)w;
      }
      *(u32x4*)(dst + (size_t)(r + u) * 1024 + lane * 16) = o;
      if (lane == 0) inv_scale[r + u] = isc;
    }
  }
}

__device__ void phase_prep(const Params& p) {
  char* ws = opaque_ptr(p.ws);
  const int tid = opaque_tid(), wid = tid >> 6, lane = tid & 63;
  if (blockIdx.x == 0 && tid < 64) ((int*)(ws + O_CNT))[tid] = 0;
  if (blockIdx.x < 4) {
    int e = blockIdx.x * 256 + tid;
    int pos = e >> 4, f = e & 15;
    const float fr4[4] = {1.0f, 0.56234132519f, 0.316227766017f, 0.177827941004f};
    float sc = (f >> 2) == 0 ? 1.0f : (f >> 2) == 1 ? 0.1f : (f >> 2) == 2 ? 0.01f : 0.001f;
    float fsel = (f & 3) == 0 ? fr4[0] : (f & 3) == 1 ? fr4[1] : (f & 3) == 2 ? fr4[2] : fr4[3];
    float freq = fsel * sc;
    float ang = (float)pos * freq;
    double a = (double)ang;
    double k = rint(a * 0.15915494309189535);
    double r = a - k * 6.283185307179586;
    double r2 = r * r, ts = r, tc = 1.0, s = r, c = 1.0;
    for (int i = 1; i <= 14; ++i) {
      tc = -tc * r2 / (double)((2 * i - 1) * (2 * i));
      ts = -ts * r2 / (double)((2 * i) * (2 * i + 1));
      c += tc; s += ts;
    }
    float* rope = (float*)(ws + O_ROPE);
    rope[e * 2] = (float)c; rope[e * 2 + 1] = (float)s;
  }
  {
    float* sil = (float*)g_smem;
    float* part = (float*)(g_smem + 16384);
    const float* cvec = p.in[7];
    const float* cctx = p.in[8];
    bool have_sil = false;
    for (int it = blockIdx.x; it < 4 * 96; it += gridDim.x) {
      if (!have_sil) {
        for (int k = tid; k < 1024; k += 256) {
          float a = cctx[k], b = cvec[k], c2 = cvec[1024 + k];
          sil[k] = a * sigmoidf_(a); sil[1024 + k] = b * sigmoidf_(b); sil[2048 + k] = c2 * sigmoidf_(c2);
        }
        have_sil = true;
        __syncthreads();
      }
      int l = it / 96, n = (it % 96) * 64 + lane;
      const float* W = p.in[12] + (size_t)l * 1024 * 6144 + n;
      float a0 = 0.f, a1 = 0.f, a2 = 0.f;
      int kb = wid * 256;
#pragma unroll 8
      for (int k = 0; k < 256; ++k) {
        float w = W[(size_t)(kb + k) * 6144];
        a0 += w * sil[kb + k]; a1 += w * sil[1024 + kb + k]; a2 += w * sil[2048 + kb + k];
      }
      part[(wid * 3 + 0) * 64 + lane] = a0; part[(wid * 3 + 1) * 64 + lane] = a1; part[(wid * 3 + 2) * 64 + lane] = a2;
      __syncthreads();
      if (tid < 192) {
        int c = tid >> 6, ln = tid & 63;
        float s = part[(0 * 3 + c) * 64 + ln] + part[(1 * 3 + c) * 64 + ln] + part[(2 * 3 + c) * 64 + ln] + part[(3 * 3 + c) * 64 + ln];
        int nn = (it % 96) * 64 + ln;
        ((float*)(ws + O_MOD))[((size_t)l * 3 + c) * 6144 + nn] = s + p.in[13][(size_t)l * 6144 + nn];
      }
      __syncthreads();
    }
    __syncthreads();
  }
  {
    TJob jobs[11] = {
        {p.in[14], (u16*)(ws + O_WIN), 1024, 7296, 4},
        {p.in[16], (u16*)(ws + O_AOUT), 512, 1024, 4},
        {p.in[28], (u16*)(ws + O_RWOUT), 512, 1024, 4},
        {p.in[30], (u16*)(ws + O_NAOUT), 512, 1024, 4},
        {p.in[31], (u16*)(ws + O_WO), 1024, 1024, 4},
        {p.in[32], (u16*)(ws + O_PEQ), 1024, 2048, 4},
        {p.in[19], (u16*)(ws + O_W2), 64, 512, 8},
        {p.in[21], (u16*)(ws + O_A2), 64, 512, 8},
        {p.in[22], (u16*)(ws + O_G2), 128, 512, 4},
        {p.in[3], (u16*)(ws + O_CAVT), 512, 128, 8},
        {p.in[5], (u16*)(ws + O_CCVT), 512, 512, 8},
    };
#pragma unroll
    for (int j = 0; j < 11; ++j) {
      const int tk = jobs[j].K / 64, tn = jobs[j].N / 64, per = tk * tn, tot = per * jobs[j].nb;
      for (int t = blockIdx.x; t < tot; t += gridDim.x) {
        int b = t / per, r = t % per;
        int kt = r / tn, ntile = r % tn;
        size_t off = (size_t)b * jobs[j].K * jobs[j].N;
        transpose_tile(tid, jobs[j].src + off, jobs[j].dst + off, jobs[j].K, jobs[j].N, kt * 64, ntile * 64);
      }
    }
  }
  convert_chunks(tid, p.in[33], (u16*)(ws + O_SUBK), 4ull * 8 * 2 * 128 * 128);
  convert_chunks(tid, p.in[2], (u16*)(ws + O_CAK), 8ull * 512 * 128);
  convert_chunks(tid, p.in[4], (u16*)(ws + O_CCK), 8ull * 512 * 512);
  {
    float* X = (float*)(ws + O_X);
    const size_t nch = (size_t)NT * DM / 1024;
    for (size_t c = blockIdx.x; c < nch; c += gridDim.x) {
      size_t e = c * 1024 + tid * 4;
      const float* src = e < (size_t)NCTX * DM ? p.in[0] + e : p.in[1] + (e - (size_t)NCTX * DM);
      *(f32x4*)(X + e) = *(const f32x4*)src;
    }
  }
}

DI int tok_cond(int tok) { return tok < NCTX ? 0 : 1 + ((tok - NCTX) >> 11); }

DI void norm_row_store(const float (&x)[16], const float* __restrict__ g, const float* __restrict__ shift, const float* __restrict__ scale,
                       u16* __restrict__ hrow, int lane) {
  float ss = 0.f;
#pragma unroll
  for (int i = 0; i < 16; ++i) ss += x[i] * x[i];
  ss = wave_sum(ss);
  float rstd = rsqrtf(ss * (1.f / 1024.f) + 1e-6f);
#pragma unroll
  for (int hh = 0; hh < 2; ++hh) {
    int e0 = hh * 512 + lane * 8;
    float y[8];
#pragma unroll
    for (int i = 0; i < 8; ++i) {
      float v = x[hh * 8 + i] * rstd * g[e0 + i];
      y[i] = v * (1.f + scale[e0 + i]) + shift[e0 + i];
    }
    u32x4 o;
    o[0] = pack2(y[0], y[1]); o[1] = pack2(y[2], y[3]); o[2] = pack2(y[4], y[5]); o[3] = pack2(y[6], y[7]);
    *(u32x4*)(hrow + e0) = o;
  }
}

__device__ void phase_norm(const Params& p, int l, int which) {
  char* ws = opaque_ptr(p.ws);
  const int tid = opaque_tid();
  const int lane = tid & 63;
  const int gw = blockIdx.x * 4 + (tid >> 6), GW = gridDim.x * 4;
  const float* X = (const float*)(ws + O_X);
  const float* g = (which == 0 ? p.in[9] : p.in[10]) + l * 1024;
  for (int tok = gw; tok < NT; tok += GW) {
    const float* mod = (const float*)(ws + O_MOD) + ((size_t)l * 3 + tok_cond(tok)) * 6144 + which * 3 * 1024;
    float x[16];
#pragma unroll
    for (int hh = 0; hh < 2; ++hh) {
      f32x4 a = *(const f32x4*)(X + (size_t)tok * 1024 + hh * 512 + lane * 8);
      f32x4 b = *(const f32x4*)(X + (size_t)tok * 1024 + hh * 512 + lane * 8 + 4);
#pragma unroll
      for (int i = 0; i < 4; ++i) { x[hh * 8 + i] = a[i]; x[hh * 8 + 4 + i] = b[i]; }
    }
    norm_row_store(x, g, mod, mod + 1024, (u16*)(ws + O_H) + (size_t)tok * 1024, lane);
  }
}

__device__ void phase_gemm_in(const Params& p, int l) {
  char* ws = opaque_ptr(p.ws);
  const int tid = opaque_tid();
  const int wid = tid >> 6, lane = tid & 63, wr = wid >> 1, wc = wid & 1, fr = lane & 15, fq = lane >> 4;
  const u16* H = (const u16*)(ws + O_H);
  const u16* W = (const u16*)(ws + O_WIN) + (size_t)l * INC * 1024;
  const float* rope = (const float*)(ws + O_ROPE);
  float* out = p.out;
  for (int t = blockIdx.x; t < 64 * 57; t += gridDim.x) {
    const int tm = t & 63, tn = t >> 6;
    const int brow = tm * 128, bcol = tn * 128;
    const bool swapped = (tn == 5) || (tn >= 29 && tn < 33);
    const bool ctx = brow < NCTX;
    f32x4 acc[4][4];
    zero_acc(acc);
    const int koff = (((tm >> 3) + (tn & 7)) * 2) & 15;
    if (!swapped) gemm_main(tid, H + (size_t)brow * 1024, 1024, W + (size_t)bcol * 1024, 1024, 1024, acc, koff);
    else gemm_main(tid, W + (size_t)bcol * 1024, 1024, H + (size_t)brow * 1024, 1024, 1024, acc, koff);
    if (!swapped) {
#pragma unroll
      for (int m = 0; m < 4; ++m) {
        const int tok = brow + wr * 64 + m * 16 + fr;
        const int cb = bcol + wc * 64 + fq * 4;
        if (tn < 5) {
          if (!ctx) {
            int tt = (tok - NCTX) & 2047;
            int pos0 = tt >> 6, pos1 = tt & 63;
#pragma unroll
            for (int ax = 0; ax < 2; ++ax) {
              int pos = ax == 0 ? pos0 : pos1;
#pragma unroll
              for (int j = 0; j < 4; ++j) {
                float c = rope[(pos * 16 + fq * 4 + j) * 2], s = rope[(pos * 16 + fq * 4 + j) * 2 + 1];
                float x1 = acc[m][2 * ax][j], x2 = acc[m][2 * ax + 1][j];
                acc[m][2 * ax][j] = x1 * c - x2 * s;
                acc[m][2 * ax + 1][j] = x2 * c + x1 * s;
              }
            }
          }
          if (tn < 4) {
#pragma unroll
            for (int n = 0; n < 4; ++n) {
              u32x2 o; o[0] = pack2(acc[m][n][0] * 0.125f, acc[m][n][1] * 0.125f); o[1] = pack2(acc[m][n][2] * 0.125f, acc[m][n][3] * 0.125f);
              *(u32x2*)((u16*)(ws + O_QA) + (size_t)tok * 512 + cb + n * 16) = o;
            }
          } else {
#pragma unroll
            for (int n = 0; n < 4; ++n) {
              int c = cb + n * 16 - 512;
              u32x2 o; o[0] = pack2(acc[m][n][0], acc[m][n][1]); o[1] = pack2(acc[m][n][2], acc[m][n][3]);
              *(u32x2*)((u16*)(ws + O_KA) + (size_t)tok * 128 + c) = o;
              if (ctx) *(f32x4*)(out + OUT_AK + ((size_t)((tok >> 8) * 4 + l) * 256 + (tok & 255)) * 128 + c) = acc[m][n];
            }
          }
        } else if (tn < 21) {
#pragma unroll
          for (int n = 0; n < 4; ++n) *(f32x4*)((float*)(ws + O_PB) + (size_t)tok * 1920 + cb + n * 16 - 768) = acc[m][n];
        } else if (tn < 25) {
#pragma unroll
          for (int n = 0; n < 4; ++n) {
            u32x2 o; o[0] = pack2(acc[m][n][0] * 0.125f, acc[m][n][1] * 0.125f); o[1] = pack2(acc[m][n][2] * 0.125f, acc[m][n][3] * 0.125f);
            *(u32x2*)((u16*)(ws + O_QC) + (size_t)tok * 512 + cb + n * 16 - 2688) = o;
          }
        } else if (tn < 29) {
#pragma unroll
          for (int n = 0; n < 4; ++n) {
            int c = cb + n * 16 - 3200;
            u32x2 o; o[0] = pack2(acc[m][n][0], acc[m][n][1]); o[1] = pack2(acc[m][n][2], acc[m][n][3]);
            *(u32x2*)((u16*)(ws + O_KC) + (size_t)tok * 512 + c) = o;
            if (ctx) *(f32x4*)(out + OUT_CK + ((size_t)((tok >> 8) * 4 + l) * 256 + (tok & 255)) * 512 + c) = acc[m][n];
          }
        } else {
#pragma unroll
          for (int n = 0; n < 4; ++n) {
            u32x2 o; o[0] = pack2(sigmoidf_(acc[m][n][0]), sigmoidf_(acc[m][n][1])); o[1] = pack2(sigmoidf_(acc[m][n][2]), sigmoidf_(acc[m][n][3]));
            *(u32x2*)((u16*)(ws + O_GATE) + (size_t)tok * 3072 + cb + n * 16 - 4224) = o;
          }
        }
      }
    } else {
      const bool isA = (tn == 5);
      u16* VT = isA ? (u16*)(ws + O_VAT) : (u16*)(ws + O_VCT);
      const int ncols = isA ? 128 : 512;
      const size_t obase = isA ? OUT_AV : OUT_CV;
#pragma unroll
      for (int m = 0; m < 4; ++m) {
        const int c = (isA ? 0 : (tn - 29) * 128) + wr * 64 + m * 16 + fr;
#pragma unroll
        for (int n = 0; n < 4; ++n) {
          const int tk = brow + wc * 64 + n * 16 + fq * 4;
          u32x2 o; o[0] = pack2(acc[m][n][0], acc[m][n][1]); o[1] = pack2(acc[m][n][2], acc[m][n][3]);
          *(u32x2*)(VT + (size_t)c * NT + tk) = o;
          if (ctx) {
#pragma unroll
            for (int j = 0; j < 4; ++j) {
              int tok = tk + j;
              out[obase + ((size_t)((tok >> 8) * 4 + l) * 256 + (tok & 255)) * ncols + c] = acc[m][n][j];
            }
          }
        }
      }
    }
  }
}

__device__ void phase_rwkv_prep(const Params& p, int l) {
  char* ws = opaque_ptr(p.ws);
  const int tid = opaque_tid();
  const int lane = tid & 63;
  const int gw = blockIdx.x * 4 + (tid >> 6), GW = gridDim.x * 4;
  const float* PB = (const float*)(ws + O_PB);
  const float* mu = p.in[17] + l * 1920;
  const float* kkw = p.in[23] + l * 512;
  for (int tok = gw; tok < NT; tok += GW) {
    int pos, len;
    if (tok < NCTX) { pos = tok & 255; len = 256; } else { pos = (tok - NCTX) & 2047; len = 2048; }
    const bool hp = pos > 0, hn = pos < len - 1;
    const float* row = PB + (size_t)tok * 1920;
#pragma unroll
    for (int i = 0; i < 8; ++i) {
      int q = lane + 64 * i;
      if (q < 480) {
        int c = q * 4;
        f32x4 cur = *(const f32x4*)(row + c);
        f32x4 pv = hp ? *(const f32x4*)(row - 1920 + c) : f32x4{0.f, 0.f, 0.f, 0.f};
        f32x4 nv = hn ? *(const f32x4*)(row + 1920 + c) : f32x4{0.f, 0.f, 0.f, 0.f};
        f32x4 m4 = *(const f32x4*)(mu + c);
        f32x4 xb;
#pragma unroll
        for (int j = 0; j < 4; ++j) xb[j] = cur[j] + m4[j] * (0.5f * (pv[j] + nv[j]) - cur[j]);
        if (i < 6) {
          *(f32x4*)((float*)(ws + O_XRKV) + (size_t)tok * 1536 + c) = xb;
          if (i == 2 || i == 3) {
            int ck = c - 512;
            f32x4 kw = *(const f32x4*)(kkw + ck);
            f32x4 kv;
            float ss = 0.f;
#pragma unroll
            for (int j = 0; j < 4; ++j) { kv[j] = xb[j] * kw[j]; ss += kv[j] * kv[j]; }
            ss = row_sum16(ss);
            float rn = rsqrtf(ss + 1e-12f);
#pragma unroll
            for (int j = 0; j < 4; ++j) kv[j] *= rn;
            *(f32x4*)((float*)(ws + O_KK) + (size_t)tok * 512 + ck) = kv;
          }
        } else {
          u16* dst;
          int cc;
          float v[4];
          if (c < 1664) { dst = (u16*)(ws + O_TW); cc = c - 1536; for (int j = 0; j < 4; ++j) v[j] = tanhf(xb[j]); }
          else if (c < 1792) { dst = (u16*)(ws + O_AD); cc = c - 1664; for (int j = 0; j < 4; ++j) v[j] = xb[j]; }
          else { dst = (u16*)(ws + O_SG); cc = c - 1792; for (int j = 0; j < 4; ++j) v[j] = sigmoidf_(xb[j]); }
          u32x2 o; o[0] = pack2(v[0], v[1]); o[1] = pack2(v[2], v[3]);
          *(u32x2*)(dst + (size_t)tok * 128 + cc) = o;
        }
      }
    }
  }
}

__device__ void phase_rwkv_lora(const Params& p, int l) {
  char* ws = opaque_ptr(p.ws);
  const int tid = opaque_tid();
  const int wid = tid >> 6, lane = tid & 63, wr = wid >> 1, wc = wid & 1, fr = lane & 15, fq = lane >> 4;
  for (int t = blockIdx.x; t < 5 * 256; t += gridDim.x) {
    const int job = t >> 8, r = t & 255, tm = r & 63, tn = r >> 6;
    const int brow = tm * 128, bcol = tn * 128;
    f32x4 acc[4][4];
    zero_acc(acc);
    const int z = job & 1;
    if (job < 2) gemm_main(tid, (const u16*)(ws + O_TW) + (size_t)brow * 128 + z * 64, 128, (const u16*)(ws + O_W2) + ((size_t)(l * 2 + z) * 512 + bcol) * 64, 64, 64, acc);
    else if (job < 4) gemm_main(tid, (const u16*)(ws + O_AD) + (size_t)brow * 128 + z * 64, 128, (const u16*)(ws + O_A2) + ((size_t)(l * 2 + z) * 512 + bcol) * 64, 64, 64, acc);
    else gemm_main(tid, (const u16*)(ws + O_SG) + (size_t)brow * 128, 128, (const u16*)(ws + O_G2) + ((size_t)l * 512 + bcol) * 128, 128, 128, acc);
#pragma unroll
    for (int m = 0; m < 4; ++m) {
      const int tok = brow + wr * 64 + m * 16 + fr;
#pragma unroll
      for (int n = 0; n < 4; ++n) {
        const int c = bcol + wc * 64 + n * 16 + fq * 4;
        if (job < 2) {
          f32x4 w0 = *(const f32x4*)(p.in[18] + (size_t)(l * 2 + z) * 512 + c);
          f32x4 o;
#pragma unroll
          for (int j = 0; j < 4; ++j) {
            float val = w0[j] + acc[m][n][j];
            float y = -val;
            float sp = fmaxf(y, 0.f) + log1pf(__expf(-fabsf(y)));
            float wlog = -sp - 0.5f;
            o[j] = __expf(-__expf(wlog));
          }
          *(f32x4*)((float*)(ws + O_DEC) + ((size_t)z * NT + tok) * 512 + c) = o;
        } else if (job < 4) {
          f32x4 a0 = *(const f32x4*)(p.in[20] + (size_t)(l * 2 + z) * 512 + c);
          f32x4 ka = *(const f32x4*)(p.in[24] + (size_t)l * 512 + c);
          f32x4 kx = *(const f32x4*)((const float*)(ws + O_XRKV) + (size_t)tok * 1536 + 512 + c);
          f32x4 kk = *(const f32x4*)((const float*)(ws + O_KK) + (size_t)tok * 512 + c);
          f32x4 okd, okka;
#pragma unroll
          for (int j = 0; j < 4; ++j) {
            float a = sigmoidf_(a0[j] + acc[m][n][j]);
            okd[j] = kx[j] * (1.f + (a - 1.f) * ka[j]);
            okka[j] = kk[j] * a;
          }
          *(f32x4*)((float*)(ws + O_KD) + ((size_t)z * NT + tok) * 512 + c) = okd;
          *(f32x4*)((float*)(ws + O_KKA) + ((size_t)z * NT + tok) * 512 + c) = okka;
        } else {
          *(f32x4*)((float*)(ws + O_GG) + (size_t)tok * 512 + c) = acc[m][n];
        }
      }
    }
  }
}

template <int JPL> struct ScanOps { float w[JPL], kd[JPL], kk[JPL], kka[JPL], r[JPL]; float v; };

template <int JPL>
DI void scan_load(ScanOps<JPL>& o, const float* __restrict__ dec, const float* __restrict__ kd, const float* __restrict__ kk,
                  const float* __restrict__ kka, const float* __restrict__ rr, const float* __restrict__ vv, int tok, int cj, int ci) {
  const size_t e = (size_t)tok * 512 + cj;
#pragma unroll
  for (int q = 0; q < JPL / 4; ++q) {
    f32x4 a = *(const f32x4*)(dec + e + q * 4), b = *(const f32x4*)(kd + e + q * 4), c = *(const f32x4*)(kk + e + q * 4),
          d = *(const f32x4*)(kka + e + q * 4), f = *(const f32x4*)(rr + (size_t)tok * 1536 + cj + q * 4);
#pragma unroll
    for (int j = 0; j < 4; ++j) { o.w[q * 4 + j] = a[j]; o.kd[q * 4 + j] = b[j]; o.kk[q * 4 + j] = c[j]; o.kka[q * 4 + j] = d[j]; o.r[q * 4 + j] = f[j]; }
  }
  o.v = vv[(size_t)tok * 1536 + 1024 + ci];
}

template <int JPL> DI float scan_red(float v) {
  v += dppf<0xB1>(v);
  v += dppf<0x4E>(v);
  if (JPL <= 8) v += dppf<0x141>(v);
  if (JPL <= 4) v += dppf<0x140>(v);
  return v;
}

template <int JPL>
DI void scan_step(float (&S)[JPL], const ScanOps<JPL>& o, float* __restrict__ y, int tok, int ci, bool wr) {
  float sa0 = 0.f, sa1 = 0.f;
#pragma unroll
  for (int j = 0; j < JPL; j += 2) { sa0 += S[j] * o.kk[j]; sa1 += S[j + 1] * o.kk[j + 1]; }
  float sa = -scan_red<JPL>(sa0 + sa1);
  float y0 = 0.f, y1 = 0.f;
#pragma unroll
  for (int j = 0; j < JPL; j += 2) {
    S[j] = S[j] * o.w[j] + (sa * o.kka[j] + o.v * o.kd[j]);
    S[j + 1] = S[j + 1] * o.w[j + 1] + (sa * o.kka[j + 1] + o.v * o.kd[j + 1]);
    y0 += S[j] * o.r[j]; y1 += S[j + 1] * o.r[j + 1];
  }
  float yv = scan_red<JPL>(y0 + y1);
  if (wr) y[(size_t)tok * 512 + ci] = yv;
}

template <int JPL, int D>
DI void scan_wave(char* ws, int lane, int z, int h, int tok0, int T, int rowbase, const float* __restrict__ s0, float* __restrict__ sout) {
  constexpr int LPR = 64 / JPL;
  const int rr = lane / LPR, pp = lane % LPR;
  const int i = rowbase + rr, j0 = pp * JPL;
  const int cj = h * 64 + j0, ci = h * 64 + i;
  const float* dec = (const float*)(ws + O_DEC) + (size_t)z * NT * 512;
  const float* kd = (const float*)(ws + O_KD) + (size_t)z * NT * 512;
  const float* kka = (const float*)(ws + O_KKA) + (size_t)z * NT * 512;
  const float* kk = (const float*)(ws + O_KK);
  const float* xr = (const float*)(ws + O_XRKV);
  float* y = (float*)(ws + O_YS) + (size_t)z * NT * 512;
  float S[JPL];
#pragma unroll
  for (int j = 0; j < JPL; ++j) S[j] = s0 ? s0[i * 64 + j0 + j] : 0.f;
  const int dir = z == 0 ? 1 : -1;
  const int first = z == 0 ? tok0 : tok0 + T - 1;
  const bool wr = pp == 0;
  ScanOps<JPL> R[D];
#pragma unroll
  for (int d = 0; d < D; ++d) scan_load<JPL>(R[d], dec, kd, kk, kka, xr, xr, first + dir * d, cj, ci);
  for (int n = 0; n < T; n += D) {
#pragma unroll
    for (int d = 0; d < D; ++d) {
      scan_step<JPL>(S, R[d], y, first + dir * (n + d), ci, wr);
      int nn = n + d + D;
      nn = nn < T ? nn : T - 1;
      scan_load<JPL>(R[d], dec, kd, kk, kka, xr, xr, first + dir * nn, cj, ci);
    }
  }
  if (sout) {
#pragma unroll
    for (int j = 0; j < JPL; ++j) sout[i * 64 + j0 + j] = S[j];
  }
}

DI void dma16(const char* gptr, unsigned ldsaddr) {
  asm volatile("s_mov_b32 m0, %0\n\ts_nop 0\n\tglobal_load_lds_dwordx4 %1, off" ::"s"(ldsaddr), "v"(gptr) : "memory");
}
template <int N> DI void wait_vm() { asm volatile("s_waitcnt vmcnt(%0)" ::"n"(N) : "memory"); }

template <int JPL> struct ScanRegs { float w[JPL], kd[JPL], kk[JPL], kka[JPL], r[JPL]; float v; };
template <int JPL> DI void scan_lds_read(ScanRegs<JPL>& o, const char* slot, int pp, int rr) {
#pragma unroll
  for (int q = 0; q < JPL / 4; ++q) {
    f32x4 a = *(const f32x4*)(slot + 0 + pp * JPL * 4 + q * 16), b = *(const f32x4*)(slot + 256 + pp * JPL * 4 + q * 16),
          c = *(const f32x4*)(slot + 512 + pp * JPL * 4 + q * 16), d = *(const f32x4*)(slot + 768 + pp * JPL * 4 + q * 16),
          f = *(const f32x4*)(slot + 1024 + pp * JPL * 4 + q * 16);
#pragma unroll
    for (int j = 0; j < 4; ++j) { o.w[q * 4 + j] = a[j]; o.kd[q * 4 + j] = b[j]; o.kk[q * 4 + j] = c[j]; o.kka[q * 4 + j] = d[j]; o.r[q * 4 + j] = f[j]; }
  }
  o.v = *(const float*)(slot + 1280 + rr * 4);
}
template <int JPL>
DI void scan_step2(float (&S)[JPL], const ScanRegs<JPL>& o, float* __restrict__ yp, bool wr) {
  float sa0 = 0.f, sa1 = 0.f;
#pragma unroll
  for (int j = 0; j < JPL; j += 2) { sa0 += S[j] * o.kk[j]; sa1 += S[j + 1] * o.kk[j + 1]; }
  float sa = -scan_red<JPL>(sa0 + sa1);
  float y0 = 0.f, y1 = 0.f;
#pragma unroll
  for (int j = 0; j < JPL; j += 2) {
    S[j] = sa * o.kka[j] + (S[j] * o.w[j] + o.v * o.kd[j]);
    S[j + 1] = sa * o.kka[j + 1] + (S[j + 1] * o.w[j + 1] + o.v * o.kd[j + 1]);
    y0 += S[j] * o.r[j]; y1 += S[j + 1] * o.r[j + 1];
  }
  float yv = scan_red<JPL>(y0 + y1);
  if (wr) *yp = yv;
}

template <int JPL, int NS>
DI void scan_wave_dma(char* ws, int lane, int ringoff, int z, int h, int tok0, int T, int rowbase, const float* __restrict__ s0,
                      float* __restrict__ sout) {
  constexpr int LPR = 64 / JPL, PD = NS - 1, WN = 3 * PD - 3;
  static_assert(WN <= 63, "vmcnt range");
  const int rr = lane / LPR, pp = lane % LPR;
  const int i = rowbase + rr, j0 = pp * JPL;
  const int dir = z == 0 ? 1 : -1;
  const int first = z == 0 ? tok0 : tok0 + T - 1;
  const bool wr = pp == 0;
  float S[JPL];
#pragma unroll
  for (int j = 0; j < JPL; ++j) S[j] = s0 ? s0[i * 64 + j0 + j] : 0.f;
  const int a = lane >> 4, c16 = lane & 15;
  const float* arr = a == 0 ? (const float*)(ws + O_DEC) + (size_t)z * NT * 512
                   : a == 1 ? (const float*)(ws + O_KD) + (size_t)z * NT * 512
                   : a == 2 ? (const float*)(ws + O_KK)
                            : (const float*)(ws + O_KKA) + (size_t)z * NT * 512;
  const char* gA = (const char*)(arr + (size_t)first * 512 + h * 64 + c16 * 4);
  const char* gB = (const char*)((const float*)(ws + O_XRKV) + (size_t)first * 1536 + (lane < 16 ? h * 64 + c16 * 4 : 1024 + h * 64 + rowbase + (lane - 16) * 4));
  const long stA = (long)dir * 2048, stB = (long)dir * 6144;
  const bool bact = lane < 16 + JPL / 4;
  ringoff = __builtin_amdgcn_readfirstlane(ringoff);
  const unsigned ring = (unsigned)(size_t)g_smem + (unsigned)ringoff;
  const char* ringp = g_smem + ringoff;
  float* yp = (float*)(ws + O_YS) + (size_t)z * NT * 512 + (size_t)first * 512 + h * 64 + i;
  const long sty = (long)dir * 512;
  float* dummy = (float*)(ws + O_MERG) + lane;
#pragma unroll 1
  for (int s = 0; s < PD; ++s) {
    unsigned slot = ring + (unsigned)(s & (NS - 1)) * 1536u;
    dma16(gA, slot);
    if (bact) dma16(gB, slot + 1024u);
    gA += stA; gB += stB;
    if (wr) dummy[s * 64] = 0.f;
  }
  ScanRegs<JPL> A, B;
  wait_vm<3 * PD - 3>();
  wait_vm<3 * (PD - 1)>();
  scan_lds_read<JPL>(A, ringp, pp, rr);
  for (int n = 0; n < T; n += 2) {
    {
      unsigned sl = (unsigned)((n + PD) & (NS - 1)) * 1536u;
      dma16(gA, ring + sl);
      if (bact) dma16(gB, ring + sl + 1024u);
      gA += stA; gB += stB;
      wait_vm<WN>();
      scan_lds_read<JPL>(B, ringp + ((n + 1) & (NS - 1)) * 1536, pp, rr);
      scan_step2<JPL>(S, A, yp, wr);
      yp += sty;
    }
    {
      unsigned sl = (unsigned)((n + 1 + PD) & (NS - 1)) * 1536u;
      dma16(gA, ring + sl);
      if (bact) dma16(gB, ring + sl + 1024u);
      gA += stA; gB += stB;
      wait_vm<WN>();
      scan_lds_read<JPL>(A, ringp + ((n + 2) & (NS - 1)) * 1536, pp, rr);
      scan_step2<JPL>(S, B, yp, wr);
      yp += sty;
    }
  }
  wait_vm<0>();
  if (sout) {
#pragma unroll
    for (int j = 0; j < JPL; ++j) sout[i * 64 + j0 + j] = S[j];
  }
}

template <int JPL>
DI void scan_dots(const float (&S)[JPL], const ScanRegs<JPL>& cur, const ScanRegs<JPL>& prv, float& d1, float& d2) {
  float a0 = 0.f, a1 = 0.f, b0 = 0.f, b1 = 0.f;
#pragma unroll
  for (int j = 0; j < JPL; j += 2) {
    a0 += S[j] * cur.kk[j]; b0 += S[j] * prv.r[j];
    a1 += S[j + 1] * cur.kk[j + 1]; b1 += S[j + 1] * prv.r[j + 1];
  }
  d1 = a0 + a1; d2 = b0 + b1;
}
template <int JPL> DI void scan_red2(float& a, float& b) {
  a += dppf<0xB1>(a); b += dppf<0xB1>(b);
  a += dppf<0x4E>(a); b += dppf<0x4E>(b);
  if (JPL <= 8) { a += dppf<0x141>(a); b += dppf<0x141>(b); }
  if (JPL <= 4) { a += dppf<0x140>(a); b += dppf<0x140>(b); }
}
template <int JPL> DI void scan_pre(float (&Tm)[JPL], const float (&S)[JPL], const ScanRegs<JPL>& o) {
#pragma unroll
  for (int j = 0; j < JPL; ++j) Tm[j] = S[j] * o.w[j] + o.v * o.kd[j];
}
template <int JPL> DI void scan_update(float (&S)[JPL], const float (&Tm)[JPL], const ScanRegs<JPL>& o, float sa) {
#pragma unroll
  for (int j = 0; j < JPL; ++j) S[j] = sa * o.kka[j] + Tm[j];
}

template <int JPL>
DI void scan_latent_block(char* ws, int tid, int z, int h, int tok0, int rowblock, const float* __restrict__ s0) {
  constexpr int LPR = 64 / JPL, G = 7, T = 2048, WNV = 6 * G - 2;
  const int wid = __builtin_amdgcn_readfirstlane(tid >> 6), lane = tid & 63;
  const int rr = lane / LPR, pp = lane % LPR;
  const int rloc = wid * JPL + rr;
  const int i = rowblock + rloc, j0 = pp * JPL;
  const int dir = z == 0 ? 1 : -1;
  const int first = z == 0 ? tok0 : tok0 + T - 1;
  const bool wr = pp == 0;
  float S[JPL];
#pragma unroll
  for (int j = 0; j < JPL; ++j) S[j] = s0[i * 64 + j0 + j];
  const int a = lane >> 4, c16 = lane & 15;
  const float* arr = a == 0 ? (const float*)(ws + O_DEC) + (size_t)z * NT * 512
                   : a == 1 ? (const float*)(ws + O_KD) + (size_t)z * NT * 512
                   : a == 2 ? (const float*)(ws + O_KK)
                            : (const float*)(ws + O_KKA) + (size_t)z * NT * 512;
  const int fw = first + dir * wid;
  const char* gA = (const char*)(arr + (size_t)fw * 512 + h * 64 + c16 * 4);
  const char* gB = (const char*)((const float*)(ws + O_XRKV) + (size_t)fw * 1536 + (lane < 16 ? h * 64 + c16 * 4 : 1024 + h * 64 + rowblock + (lane - 16) * 4));
  const long stA = (long)dir * 4 * 2048, stB = (long)dir * 4 * 6144;
  const bool bact = lane < 16 + JPL;
  const unsigned ring = (unsigned)(size_t)g_smem;
  const char* ringp = g_smem;
  float* yp = (float*)(ws + O_YS) + (size_t)z * NT * 512 + (size_t)first * 512 + h * 64 + i;
  const long sty = (long)dir * 512;
  float* dummy = (float*)(ws + O_MERG) + tid;
#pragma unroll 1
  for (int g = 0; g < G; ++g) {
    unsigned slot = ring + (unsigned)((4 * g + wid) & 31) * 1536u;
    dma16(gA, slot);
    if (bact) dma16(gB, slot + 1024u);
    gA += stA; gB += stB;
    if (wr) { dummy[(g * 4 + 0) * 256] = 0.f; }
    if (wr) { dummy[(g * 4 + 1) * 256] = 0.f; }
    if (wr) { dummy[(g * 4 + 2) * 256] = 0.f; }
    if (wr) { dummy[(g * 4 + 3) * 256] = 0.f; }
    asm volatile("" ::: "memory");
  }
  ScanRegs<JPL> A, B;
#pragma unroll
  for (int j = 0; j < JPL; ++j) B.r[j] = 0.f;
  float* ypv = dummy + 28 * 256;
  wait_vm<WNV>();
  asm volatile("" ::: "memory");
  __builtin_amdgcn_s_barrier();
  asm volatile("" ::: "memory");
  scan_lds_read<JPL>(A, ringp, pp, rloc);
#pragma unroll 1
  for (int g = 0; g < T / 4; ++g) {
    wait_vm<WNV - 6>();

    asm volatile("" ::: "memory");
    __builtin_amdgcn_s_barrier();
    asm volatile("" ::: "memory");
    {
      unsigned slot = ring + (unsigned)((4 * (g + G) + wid) & 31) * 1536u;
      dma16(gA, slot);
      if (bact) dma16(gB, slot + 1024u);
      gA += stA; gB += stB;
    }
    const char* gp = ringp + ((4 * g) & 31) * 1536;
    float d1, y0, y1, y2, y3;
    float Tm[JPL];
    scan_dots<JPL>(S, A, B, d1, y0);
    scan_pre<JPL>(Tm, S, A);
    scan_lds_read<JPL>(B, gp + 1536, pp, rloc);
    scan_red2<JPL>(d1, y0);
    scan_update<JPL>(S, Tm, A, -d1);
    scan_dots<JPL>(S, B, A, d1, y1);
    scan_pre<JPL>(Tm, S, B);
    scan_lds_read<JPL>(A, gp + 2 * 1536, pp, rloc);
    scan_red2<JPL>(d1, y1);
    scan_update<JPL>(S, Tm, B, -d1);
    scan_dots<JPL>(S, A, B, d1, y2);
    scan_pre<JPL>(Tm, S, A);
    scan_lds_read<JPL>(B, gp + 3 * 1536, pp, rloc);
    scan_red2<JPL>(d1, y2);
    scan_update<JPL>(S, Tm, A, -d1);
    scan_dots<JPL>(S, B, A, d1, y3);
    scan_pre<JPL>(Tm, S, B);
    scan_lds_read<JPL>(A, ringp + ((4 * g + 4) & 31) * 1536, pp, rloc);
    scan_red2<JPL>(d1, y3);
    scan_update<JPL>(S, Tm, B, -d1);
    if (wr) {
      *ypv = y0;
      yp[0] = y1;
      yp[sty] = y2;
      yp[2 * sty] = y3;
    }
    ypv = yp + 3 * sty;
    yp += 4 * sty;
    asm volatile("" ::: "memory");
  }
  {
    float e0 = 0.f, e1 = 0.f;
#pragma unroll
    for (int j = 0; j < JPL; j += 2) { e0 += S[j] * B.r[j]; e1 += S[j + 1] * B.r[j + 1]; }
    float yv = scan_red<JPL>(e0 + e1);
    if (wr) *ypv = yv;
  }
  wait_vm<0>();
  asm volatile("" ::: "memory");
  __builtin_amdgcn_s_barrier();
  asm volatile("" ::: "memory");
}

struct AttnSt { float m, l; f32x4 o[4]; };

struct AttnKVF { bf16x8 k[2][2]; bf16x4 vlo[4], vhi[4]; };
DI void attn_kvload(AttnKVF& f, const u16* __restrict__ kp, int ldk, const u16* __restrict__ vtp, int ldv, int fr, int fq) {
#pragma unroll
  for (int kt = 0; kt < 2; ++kt)
#pragma unroll
    for (int ks = 0; ks < 2; ++ks) f.k[kt][ks] = *(const bf16x8*)(kp + (size_t)(kt * 16 + fr) * ldk + ks * 32 + fq * 8);
#pragma unroll
  for (int dt = 0; dt < 4; ++dt) {
    f.vlo[dt] = *(const bf16x4*)(vtp + (size_t)(dt * 16 + fr) * ldv + fq * 4);
    f.vhi[dt] = *(const bf16x4*)(vtp + (size_t)(dt * 16 + fr) * ldv + 16 + fq * 4);
  }
}
template <int MODE>
DI void attn_core(AttnSt& st, const bf16x8 (&qf)[2], const AttnKVF& f, int fr, int fq, int qpos, int kpos0, const float* __restrict__ rpbrow) {
  f32x4 s[2];
#pragma unroll
  for (int kt = 0; kt < 2; ++kt) {
    s[kt] = f32x4{0.f, 0.f, 0.f, 0.f};
#pragma unroll
    for (int ks = 0; ks < 2; ++ks) s[kt] = mfma16(f.k[kt][ks], qf[ks], s[kt]);
  }
  if (MODE != 0) {
#pragma unroll
    for (int kt = 0; kt < 2; ++kt)
#pragma unroll
      for (int j = 0; j < 4; ++j) {
        int kpos = kpos0 + kt * 16 + fq * 4 + j;
        if (MODE == 1) {
          int d = qpos - kpos;
          if (d > 128 || d < -128) s[kt][j] = -1e30f;
        } else {
          int cs = min(max(qpos - 8, 0), 48);
          int dc = min(max(kpos - qpos, -15), 15) + 15;
          float b = rpbrow[dc];
          s[kt][j] = (kpos >= cs && kpos < cs + 16) ? s[kt][j] + b : -1e30f;
        }
      }
  }
  float mx = fmaxf(fmaxf(fmaxf(s[0][0], s[0][1]), fmaxf(s[0][2], s[0][3])), fmaxf(fmaxf(s[1][0], s[1][1]), fmaxf(s[1][2], s[1][3])));
  mx = fmaxf(mx, __shfl_xor(mx, 16));
  mx = fmaxf(mx, __shfl_xor(mx, 32));
  float mn = fmaxf(st.m, mx);
  float alpha = __expf(st.m - mn);
  st.m = mn;
  float ps = 0.f;
  float pv[8];
#pragma unroll
  for (int kt = 0; kt < 2; ++kt)
#pragma unroll
    for (int j = 0; j < 4; ++j) { float e = __expf(s[kt][j] - mn); pv[kt * 4 + j] = e; ps += e; }
  st.l = st.l * alpha + ps;
  u32x4 pk;
  pk[0] = pack2(pv[0], pv[1]); pk[1] = pack2(pv[2], pv[3]); pk[2] = pack2(pv[4], pv[5]); pk[3] = pack2(pv[6], pv[7]);
  bf16x8 pf = __builtin_bit_cast(bf16x8, pk);
#pragma unroll
  for (int dt = 0; dt < 4; ++dt) {
    bf16x8 vf = __builtin_shufflevector(f.vlo[dt], f.vhi[dt], 0, 1, 2, 3, 4, 5, 6, 7);
#pragma unroll
    for (int j = 0; j < 4; ++j) st.o[dt][j] *= alpha;
    st.o[dt] = mfma16(vf, pf, st.o[dt]);
  }
}

DI void attn_item(const Params& p, char* ws, int lane, int l, int item) {
  const int fr = lane & 15, fq = lane >> 4;
  const int type = item >> 10, r = item & 1023;
  const int h = r & 7, qp = r >> 3;
  AttnSt st[2];
  const u16* Q;
  u16* Y;
  if (type == 0 || type == 2) { Q = (const u16*)(ws + O_QA); Y = (u16*)(ws + O_YABC); }
  else { Q = (const u16*)(ws + O_QC); Y = (u16*)(ws + O_YABC) + 2ull * NT * 512; }
  const int tok0 = (type < 2 ? NCTX : 0) + qp * 32;
  bf16x8 qf[2][2];
  const bool hasSink = (type == 0 || type == 2);
#pragma unroll
  for (int i = 0; i < 2; ++i) {
#pragma unroll
    for (int dt = 0; dt < 4; ++dt) st[i].o[dt] = f32x4{0.f, 0.f, 0.f, 0.f};
#pragma unroll
    for (int ks = 0; ks < 2; ++ks) qf[i][ks] = *(const bf16x8*)(Q + (size_t)(tok0 + i * 16 + fr) * 512 + h * 64 + ks * 32 + fq * 8);
    if (hasSink) { st[i].m = p.in[15][l * 8 + h]; st[i].l = fq == 0 ? 1.f : 0.f; }
    else { st[i].m = -1e30f; st[i].l = 0.f; }
  }
  AttnKVF f;
  if (type == 0) {
    const int qt = qp * 2;
    const int b = qt >> 7, kv = h >> 2;
    const u16* ck = (const u16*)(ws + O_CAK) + ((size_t)(b * 4 + l) * 512) * 128 + kv * 64;
    const u16* cvt = (const u16*)(ws + O_CAVT) + ((size_t)(b * 4 + l) * 128 + kv * 64) * 512;
    for (int p0 = 0; p0 < 512; p0 += 32) {
      attn_kvload(f, ck + (size_t)p0 * 128, 128, cvt + p0, 512, fr, fq);
      attn_core<0>(st[0], qf[0], f, fr, fq, 0, 0, nullptr);
      attn_core<0>(st[1], qf[1], f, fr, fq, 0, 0, nullptr);
    }
    const u16* K = (const u16*)(ws + O_KA) + (size_t)(NCTX + b * 2048) * 128 + kv * 64;
    const u16* VT = (const u16*)(ws + O_VAT) + (size_t)(kv * 64) * NT + NCTX + b * 2048;
    const int ta = (qt & 127) * 16;
    const int kb0 = max(0, ((ta - 128) >> 5) << 5), kb1 = min(2048, ta + 32 + 128);
    for (int k0 = kb0; k0 < kb1; k0 += 32) {
      attn_kvload(f, K + (size_t)k0 * 128, 128, VT + k0, NT, fr, fq);
      attn_core<1>(st[0], qf[0], f, fr, fq, ta + fr, k0, nullptr);
      attn_core<1>(st[1], qf[1], f, fr, fq, ta + 16 + fr, k0, nullptr);
    }
  } else if (type == 1) {
    const int qt = qp * 2;
    const int b = qt >> 7;
    const u16* ck = (const u16*)(ws + O_CCK) + ((size_t)(b * 4 + l) * 512) * 512 + h * 64;
    const u16* cvt = (const u16*)(ws + O_CCVT) + ((size_t)(b * 4 + l) * 512 + h * 64) * 512;
    for (int p0 = 0; p0 < 512; p0 += 32) {
      attn_kvload(f, ck + (size_t)p0 * 512, 512, cvt + p0, 512, fr, fq);
      attn_core<0>(st[0], qf[0], f, fr, fq, 0, 0, nullptr);
      attn_core<0>(st[1], qf[1], f, fr, fq, 0, 0, nullptr);
    }
    const u16* K = (const u16*)(ws + O_KC) + (size_t)(NCTX + b * 2048) * 512 + h * 64;
    const u16* VT = (const u16*)(ws + O_VCT) + (size_t)(h * 64) * NT + NCTX + b * 2048;
    const float* rpb = p.in[29] + (size_t)(l * 8 + h) * 15 * 31;
#pragma unroll
    for (int i = 0; i < 2; ++i) {
      const int t0 = ((qt + i) & 127) * 16;
      const int qrow = t0 >> 6, c0 = t0 & 63;
      const int rs = min(max(qrow - 4, 0), 24);
      const int cstart = min(max(c0 - 8, 0), 32);
      for (int a = 0; a < 8; ++a) {
        int krow = rs + a;
        int k0 = krow * 64 + cstart;
        attn_kvload(f, K + (size_t)k0 * 512, 512, VT + k0, NT, fr, fq);
        attn_core<2>(st[i], qf[i], f, fr, fq, c0 + fr, cstart, rpb + (krow - qrow + 7) * 31);
      }
    }
  } else if (type == 2) {
    const int b = (qp * 2) >> 4, kv = h >> 2;
    const u16* K = (const u16*)(ws + O_KA) + (size_t)(b * 256) * 128 + kv * 64;
    const u16* VT = (const u16*)(ws + O_VAT) + (size_t)(kv * 64) * NT + b * 256;
    for (int k0 = 0; k0 < 256; k0 += 32) {
      attn_kvload(f, K + (size_t)k0 * 128, 128, VT + k0, NT, fr, fq);
      attn_core<0>(st[0], qf[0], f, fr, fq, 0, 0, nullptr);
      attn_core<0>(st[1], qf[1], f, fr, fq, 0, 0, nullptr);
    }
  } else {
    const int b = (qp * 2) >> 4;
    const u16* K = (const u16*)(ws + O_KC) + (size_t)(b * 256) * 512 + h * 64;
    const u16* VT = (const u16*)(ws + O_VCT) + (size_t)(h * 64) * NT + b * 256;
    for (int k0 = 0; k0 < 256; k0 += 32) {
      attn_kvload(f, K + (size_t)k0 * 512, 512, VT + k0, NT, fr, fq);
      attn_core<0>(st[0], qf[0], f, fr, fq, 0, 0, nullptr);
      attn_core<0>(st[1], qf[1], f, fr, fq, 0, 0, nullptr);
    }
  }
#pragma unroll
  for (int i = 0; i < 2; ++i) {
    float lt = st[i].l;
    lt += __shfl_xor(lt, 16);
    lt += __shfl_xor(lt, 32);
    float inv = 1.f / lt;
#pragma unroll
    for (int dt = 0; dt < 4; ++dt) {
      u32x2 o; o[0] = pack2(st[i].o[dt][0] * inv, st[i].o[dt][1] * inv); o[1] = pack2(st[i].o[dt][2] * inv, st[i].o[dt][3] * inv);
      *(u32x2*)(Y + (size_t)(tok0 + i * 16 + fr) * 512 + h * 64 + dt * 16 + fq * 4) = o;
    }
  }
}


__device__ void phase_mix(const Params& p, int l) {
  char* ws = opaque_ptr(p.ws);
  const int tid = opaque_tid();
  const int wid = tid >> 6, lane = tid & 63;
  constexpr int LJPL = 4;
  constexpr int BPS = 64 / (4 * LJPL);
  const int NLB = (int)gridDim.x >= 2 * 32 * BPS ? 32 * BPS : 0;
  if ((int)blockIdx.x < NLB) {
    __builtin_amdgcn_s_setprio(3);
    const int it = blockIdx.x;
    const int sc = it / BPS, hf = it % BPS;
    const int z = sc & 1, h = (sc >> 1) & 7, b = sc >> 4;
    const float* s0 = p.in[6] + ((size_t)((b * 4 + l) * 2 + z) * 8 + h) * 4096;
    scan_latent_block<LJPL>(ws, tid, z, h, NCTX + b * 2048, hf * 4 * LJPL, s0);
  } else {
    __builtin_amdgcn_s_setprio(1);
    if (NLB == 0) {
      for (int it = blockIdx.x * 4 + wid; it < 256; it += gridDim.x * 4) {
        int sc = it >> 3, part = it & 7;
        int z = sc & 1, h = (sc >> 1) & 7, b = sc >> 4;
        const float* s0 = p.in[6] + ((size_t)((b * 4 + l) * 2 + z) * 8 + h) * 4096;
        scan_wave_dma<8, 8>(ws, lane, wid * 12288, z, h, NCTX + b * 2048, 2048, part * 8, s0, nullptr);
      }
    }
    const int nw = (gridDim.x - NLB) * 4;
    for (int it = ((int)blockIdx.x - NLB) * 4 + wid; it < 2048; it += nw) {
      int sc = it >> 3, part = it & 7;
      int z = sc & 1, h = (sc >> 1) & 7, b = sc >> 4;
      float* so = p.out + OUT_ST + ((size_t)((b * 4 + l) * 2 + z) * 8 + h) * 4096;
      scan_wave_dma<8, 8>(ws, lane, wid * 12288, z, h, b * 256, 256, part * 8, nullptr, so);
    }
  }
  __builtin_amdgcn_s_setprio(0);
  int* cnt = (int*)(ws + O_CNT) + l;
  while (true) {
    int it = 0;
    if (lane == 0) it = atomicAdd(cnt, 1);
    it = __builtin_amdgcn_readfirstlane(it);
    if (it >= 4096) break;
    attn_item(p, ws, lane, l, it);
  }
  if (l == 0) {
    int* cnt2 = (int*)(ws + O_CNT) + 8;
    while (true) {
      int it = 0;
      if (lane == 0) it = atomicAdd(cnt2, 1);
      it = __builtin_amdgcn_readfirstlane(it);
      if (it >= 4096) break;
      const int tab = it >> 11, rb = (it & 2047) * 32;
      if (tab == 0) convert_rows_fp8_wave(lane, p.in[34], (unsigned char*)(ws + O_PEU), (float*)(ws + O_SCU), rb, rb + 32);
      else convert_rows_fp8_wave(lane, p.in[35], (unsigned char*)(ws + O_PEV), (float*)(ws + O_SCV), rb, rb + 32);
    }
  }
}

__device__ void phase_rwkv_post(const Params& p, int l) {
  char* ws = opaque_ptr(p.ws);
  const int tid = opaque_tid();
  const int lane = tid & 63;
  const int gw = blockIdx.x * 4 + (tid >> 6), GW = gridDim.x * 4;
  const float* Y0 = (const float*)(ws + O_YS);
  const float* Y1 = Y0 + (size_t)NT * 512;
  const float* KD0 = (const float*)(ws + O_KD);
  const float* KD1 = KD0 + (size_t)NT * 512;
  for (int tok = gw; tok < NT; tok += GW) {
#pragma unroll
    for (int i = 0; i < 2; ++i) {
      int c = (lane + 64 * i) * 4;
      size_t e = (size_t)tok * 512 + c;
      f32x4 a = *(const f32x4*)(Y0 + e), b = *(const f32x4*)(Y1 + e);
      f32x4 y;
      float s = 0.f;
#pragma unroll
      for (int j = 0; j < 4; ++j) { y[j] = a[j] + b[j]; s += y[j]; }
      float mu = row_sum16(s) * (1.f / 64.f);
      float vs = 0.f;
#pragma unroll
      for (int j = 0; j < 4; ++j) { y[j] -= mu; vs += y[j] * y[j]; }
      float var = row_sum16(vs) * (1.f / 64.f);
      float rstd = rsqrtf(var + 64e-5f);
      f32x4 g = *(const f32x4*)(p.in[26] + l * 512 + c), bb = *(const f32x4*)(p.in[27] + l * 512 + c);
      f32x4 r = *(const f32x4*)((const float*)(ws + O_XRKV) + (size_t)tok * 1536 + c);
      f32x4 v = *(const f32x4*)((const float*)(ws + O_XRKV) + (size_t)tok * 1536 + 1024 + c);
      f32x4 k0 = *(const f32x4*)(KD0 + e), k1 = *(const f32x4*)(KD1 + e);
      f32x4 rk = *(const f32x4*)(p.in[25] + l * 512 + c);
      float bs = 0.f;
#pragma unroll
      for (int j = 0; j < 4; ++j) bs += r[j] * (k0[j] + k1[j]) * rk[j];
      bs = row_sum16(bs);
      f32x4 gg = *(const f32x4*)((const float*)(ws + O_GG) + e);
      float o[4];
#pragma unroll
      for (int j = 0; j < 4; ++j) o[j] = (y[j] * rstd * g[j] + bb[j] + bs * v[j]) * gg[j];
      u32x2 ov; ov[0] = pack2(o[0], o[1]); ov[1] = pack2(o[2], o[3]);
      *(u32x2*)((u16*)(ws + O_YABC) + (size_t)NT * 512 + e) = ov;
    }
  }
}

__device__ void phase_branch(const Params& p, int l) {
  char* ws = opaque_ptr(p.ws);
  const int tid = opaque_tid();
  const int wid = tid >> 6, lane = tid & 63, wr = wid >> 1, wc = wid & 1, fr = lane & 15, fq = lane >> 4;
  const u16* G = (const u16*)(ws + O_GATE);
  for (int t = blockIdx.x; t < 64 * 8; t += gridDim.x) {
    const int tm = t & 63, tn = t >> 6;
    const int brow = tm * 128, bcol = tn * 128;
    f32x4 tot[4][4];
    zero_acc(tot);
#pragma unroll 1
    for (int br = 0; br < 3; ++br) {
      f32x4 acc[4][4];
      zero_acc(acc);
      const u16* Wb = (const u16*)(ws + (br == 0 ? O_AOUT : br == 1 ? O_RWOUT : O_NAOUT)) + ((size_t)l * 1024 + bcol) * 512;
      gemm_main(tid, (const u16*)(ws + O_YABC) + (size_t)br * NT * 512 + (size_t)brow * 512, 512, Wb, 512, 512, acc, ((tm >> 3) + (tn & 7)) & 7);
#pragma unroll
      for (int m = 0; m < 4; ++m) {
        const int tok = brow + wr * 64 + m * 16 + fr;
#pragma unroll
        for (int n = 0; n < 4; ++n) {
          const int c = bcol + wc * 64 + n * 16 + fq * 4;
          u32x2 gv = *(const u32x2*)(G + (size_t)tok * 3072 + br * 1024 + c);
          tot[m][n][0] += acc[m][n][0] * __uint_as_float(gv[0] << 16);
          tot[m][n][1] += acc[m][n][1] * __uint_as_float(gv[0] & 0xffff0000u);
          tot[m][n][2] += acc[m][n][2] * __uint_as_float(gv[1] << 16);
          tot[m][n][3] += acc[m][n][3] * __uint_as_float(gv[1] & 0xffff0000u);
        }
      }
    }
#pragma unroll
    for (int m = 0; m < 4; ++m) {
      const int tok = brow + wr * 64 + m * 16 + fr;
#pragma unroll
      for (int n = 0; n < 4; ++n) {
        const int c = bcol + wc * 64 + n * 16 + fq * 4;
        u32x2 o; o[0] = pack2(tot[m][n][0], tot[m][n][1]); o[1] = pack2(tot[m][n][2], tot[m][n][3]);
        *(u32x2*)((u16*)(ws + O_MERG) + (size_t)tok * 1024 + c) = o;
      }
    }
  }
}

__device__ void phase_wo(const Params& p, int l) {
  char* ws = opaque_ptr(p.ws);
  const int tid = opaque_tid();
  const int wid = tid >> 6, lane = tid & 63, wr = wid >> 1, wc = wid & 1, fr = lane & 15, fq = lane >> 4;
  float* X = (float*)(ws + O_X);
  for (int t = blockIdx.x; t < 64 * 8; t += gridDim.x) {
    const int tm = t & 63, tn = t >> 6;
    const int brow = tm * 128, bcol = tn * 128;
    f32x4 acc[4][4];
    zero_acc(acc);
    gemm_main(tid, (const u16*)(ws + O_MERG) + (size_t)brow * 1024, 1024, (const u16*)(ws + O_WO) + ((size_t)l * 1024 + bcol) * 1024, 1024, 1024, acc, (((tm >> 3) + (tn & 7)) * 2) & 15);
#pragma unroll
    for (int m = 0; m < 4; ++m) {
      const int tok = brow + wr * 64 + m * 16 + fr;
      const float* gate = (const float*)(ws + O_MOD) + ((size_t)l * 3 + tok_cond(tok)) * 6144 + 2 * 1024;
#pragma unroll
      for (int n = 0; n < 4; ++n) {
        const int c = bcol + wc * 64 + n * 16 + fq * 4;
        f32x4 x = *(f32x4*)(X + (size_t)tok * 1024 + c);
        f32x4 g = *(const f32x4*)(gate + c);
#pragma unroll
        for (int j = 0; j < 4; ++j) x[j] += g[j] * acc[m][n][j];
        *(f32x4*)(X + (size_t)tok * 1024 + c) = x;
      }
    }
  }
}

__device__ void phase_peq(const Params& p, int l) {
  char* ws = opaque_ptr(p.ws);
  const int tid = opaque_tid();
  const int wid = tid >> 6, lane = tid & 63, wr = wid >> 1, wc = wid & 1, fr = lane & 15, fq = lane >> 4;
  for (int t = blockIdx.x; t < 64 * 16; t += gridDim.x) {
    const int tm = t & 63, tn = t >> 6;
    const int brow = tm * 128, bcol = tn * 128;
    f32x4 acc[4][4];
    zero_acc(acc);
    gemm_main(tid, (const u16*)(ws + O_H) + (size_t)brow * 1024, 1024, (const u16*)(ws + O_PEQ) + ((size_t)l * 2048 + bcol) * 1024, 1024, 1024, acc, (((tm >> 3) + (tn & 7)) * 2) & 15);
#pragma unroll
    for (int m = 0; m < 4; ++m) {
      const int tok = brow + wr * 64 + m * 16 + fr;
#pragma unroll
      for (int n = 0; n < 4; ++n) {
        const int c = bcol + wc * 64 + n * 16 + fq * 4;
        u32x2 o; o[0] = pack2(acc[m][n][0], acc[m][n][1]); o[1] = pack2(acc[m][n][2], acc[m][n][3]);
        *(u32x2*)((u16*)(ws + O_PQ) + (size_t)tok * 2048 + c) = o;
      }
    }
  }
}

__device__ const unsigned char kCand[64] = {
    0x00, 0x01, 0x02, 0x03, 0x04, 0x05, 0x06, 0x07, 0x08, 0x09, 0x0a, 0x0b, 0x0c, 0x0d, 0x0e, 0x0f,
    0x10, 0x11, 0x12, 0x13, 0x14, 0x15, 0x16, 0x17, 0x20, 0x21, 0x22, 0x23, 0x24, 0x30, 0x31, 0x32,
    0x33, 0x40, 0x41, 0x42, 0x50, 0x51, 0x60, 0x61, 0x70, 0x71, 0x80, 0x90, 0xa0, 0xb0, 0xc0, 0xd0,
    0xe0, 0xf0, 0xff, 0xff, 0xff, 0xff, 0xff, 0xff, 0xff, 0xff, 0xff, 0xff, 0xff, 0xff, 0xff, 0xff};

DI unsigned f2key(float f) { unsigned u = __float_as_uint(f); return (u & 0x80000000u) ? ~u : (u | 0x80000000u); }
DI float key2f(unsigned k) { unsigned u = (k & 0x80000000u) ? (k & 0x7fffffffu) : ~k; return __uint_as_float(u); }
template <int CTRL> DI unsigned dppu(unsigned v) { return (unsigned)__builtin_amdgcn_update_dpp(0, (int)v, CTRL, 0xf, 0xf, true); }
DI unsigned row_max16u(unsigned v) { v = max(v, dppu<0xB1>(v)); v = max(v, dppu<0x4E>(v)); v = max(v, dppu<0x141>(v)); v = max(v, dppu<0x140>(v)); return v; }

__device__ void phase_peer_sel(const Params& p, int l) {
  char* ws = opaque_ptr(p.ws);
  const int tid = opaque_tid();
  const int wid = tid >> 6, lane = tid & 63, fr = lane & 15, fq = lane >> 4;
  const int gw = blockIdx.x * 4 + wid, GW = gridDim.x * 4;
  float* lv = (float*)(g_smem + wid * 4096);
  int* li = (int*)(g_smem + wid * 4096 + 2048);
  const u16* PQ = (const u16*)(ws + O_PQ);
  int ca[4], cb[4];
  bool cvld[4];
#pragma unroll
  for (int c = 0; c < 4; ++c) { int code = kCand[c * 16 + fr]; cvld[c] = code != 0xff; ca[c] = (code >> 4) & 15; cb[c] = code & 15; }
  for (int it = gw; it < 512 * 8; it += GW) {
    const int h = it >> 9, tg = it & 511;
    const u16* SK = (const u16*)(ws + O_SUBK) + ((size_t)(l * 8 + h) * 2) * 128 * 128;
    f32x4 sc[2][8];
#pragma unroll
    for (int z = 0; z < 2; ++z) {
      bf16x8 qf[4];
#pragma unroll
      for (int ks = 0; ks < 4; ++ks) qf[ks] = *(const bf16x8*)(PQ + (size_t)(tg * 16 + fr) * 2048 + (h * 2 + z) * 128 + ks * 32 + fq * 8);
#pragma unroll
      for (int nt = 0; nt < 8; ++nt) {
        sc[z][nt] = f32x4{0.f, 0.f, 0.f, 0.f};
#pragma unroll
        for (int ks = 0; ks < 4; ++ks) {
          bf16x8 kf = *(const bf16x8*)(SK + ((size_t)z * 128 + nt * 16 + fr) * 128 + ks * 32 + fq * 8);
          sc[z][nt] = mfma16(qf[ks], kf, sc[z][nt]);
        }
      }
    }
#pragma unroll
    for (int z = 0; z < 2; ++z) {
#pragma unroll
      for (int j = 0; j < 4; ++j) {
        unsigned key[8];
#pragma unroll
        for (int nt = 0; nt < 8; ++nt) key[nt] = (f2key(sc[z][nt][j]) & ~127u) | (unsigned)(127 - (nt * 16 + fr));
        unsigned tk = 0u;
#pragma unroll 1
        for (int k = 0; k < 16; ++k) {
          unsigned m = key[0];
#pragma unroll
          for (int nt = 1; nt < 8; ++nt) m = max(m, key[nt]);
          unsigned M = row_max16u(m);
#pragma unroll
          for (int nt = 0; nt < 8; ++nt) key[nt] = key[nt] == M ? 0u : key[nt];
          if (fr == k) tk = M;
        }
        lv[((fq * 4 + j) * 2 + z) * 16 + fr] = key2f(tk & ~127u);
        li[((fq * 4 + j) * 2 + z) * 16 + fr] = 127 - (int)(tk & 127u);
      }
    }
    __builtin_amdgcn_s_waitcnt(0xc07f);
    __builtin_amdgcn_wave_barrier();
#pragma unroll 1
    for (int j = 0; j < 4; ++j) {
      const int tl = fq * 4 + j;
      float cand[4];
#pragma unroll
      for (int c = 0; c < 4; ++c) cand[c] = cvld[c] ? lv[(tl * 2 + 0) * 16 + ca[c]] + lv[(tl * 2 + 1) * 16 + cb[c]] : -3e38f;
      unsigned ck[4];
#pragma unroll
      for (int c = 0; c < 4; ++c) ck[c] = cvld[c] ? ((f2key(cand[c]) & ~63u) | (unsigned)(63 - (c * 16 + fr))) : 0u;
      unsigned sk = 0u;
#pragma unroll 1
      for (int k = 0; k < 16; ++k) {
        unsigned m = max(max(ck[0], ck[1]), max(ck[2], ck[3]));
        unsigned M = row_max16u(m);
#pragma unroll
        for (int c = 0; c < 4; ++c) ck[c] = ck[c] == M ? 0u : ck[c];
        if (fr == k) sk = M;
      }
      const float sv = key2f(sk & ~63u);
      const int scode = 63 - (int)(sk & 63u);
      int ab = kCand[scode];
      int e = li[(tl * 2 + 0) * 16 + ((ab >> 4) & 15)] * 128 + li[(tl * 2 + 1) * 16 + (ab & 15)];
      float mx = row_max16(sv);
      float ex = __expf(sv - mx);
      float sum = row_sum16(ex);
      int tok = tg * 16 + tl;
      ((int*)(ws + O_EIDX))[(size_t)tok * 128 + h * 16 + fr] = e;
      ((float*)(ws + O_EGATE))[(size_t)tok * 128 + h * 16 + fr] = ex / sum;
    }
    __builtin_amdgcn_s_waitcnt(0xc07f);
    __builtin_amdgcn_wave_barrier();
  }
}

DI void cvt8(const bf16x8& v, float (&f)[8]) {
  u32x4 u = __builtin_bit_cast(u32x4, v);
#pragma unroll
  for (int q = 0; q < 4; ++q) { f[2 * q] = __uint_as_float(u[q] << 16); f[2 * q + 1] = __uint_as_float(u[q] & 0xffff0000u); }
}
DI void cvt16(const u32x4& q, float (&f)[16]) {
#pragma unroll
  for (int i = 0; i < 4; ++i) {
    f32x2 a = __builtin_amdgcn_cvt_pk_f32_fp8((int)q[i], false), b = __builtin_amdgcn_cvt_pk_f32_fp8((int)q[i], true);
    f[4 * i] = a[0]; f[4 * i + 1] = a[1]; f[4 * i + 2] = b[0]; f[4 * i + 3] = b[1];
  }
}

__device__ void phase_peer_gather(const Params& p, int l, bool dry = false) {
  char* ws = opaque_ptr(p.ws);
  const int tid = opaque_tid();
  const int lane = tid & 63;
  const int gw = blockIdx.x * 4 + (tid >> 6), GW = gridDim.x * 4;
  const unsigned char* U = (const unsigned char*)(ws + O_PEU) + (size_t)l * 16384 * 1024;
  const unsigned char* V = (const unsigned char*)(ws + O_PEV) + (size_t)l * 16384 * 1024;
  const float* SU = (const float*)(ws + O_SCU) + l * 16384;
  const float* SV = (const float*)(ws + O_SCV) + l * 16384;
  float* X = (float*)(ws + O_X);
  float* XW = dry ? (float*)(ws + O_YS) : X;
  u16* HW = dry ? (u16*)(ws + O_MERG) : (u16*)(ws + O_H);
  float* OW = dry ? (float*)(ws + O_PB) : p.out + OUT_Y;
  for (int tok = gw; tok < NT; tok += GW) {
    float hf[16];
    {
      const u16* hr = (const u16*)(ws + O_H) + (size_t)tok * 1024 + lane * 16;
      bf16x8 h0 = *(const bf16x8*)(hr), h1 = *(const bf16x8*)(hr + 8);
      float t0[8], t1[8];
      cvt8(h0, t0); cvt8(h1, t1);
#pragma unroll
      for (int i = 0; i < 8; ++i) { hf[i] = t0[i]; hf[8 + i] = t1[i]; }
    }
    float acc[16];
#pragma unroll
    for (int i = 0; i < 16; ++i) acc[i] = 0.f;
    const int id0 = ((const int*)(ws + O_EIDX))[(size_t)tok * 128 + lane], id1 = ((const int*)(ws + O_EIDX))[(size_t)tok * 128 + 64 + lane];
    const float g0 = ((const float*)(ws + O_EGATE))[(size_t)tok * 128 + lane], g1 = ((const float*)(ws + O_EGATE))[(size_t)tok * 128 + 64 + lane];
#define PG_LOAD(G, ids, gts, su, sv, uq, vq)                                                                      \
  do {                                                                                                            \
    _Pragma("unroll") for (int e = 0; e < 4; ++e) {                                                               \
      int k = (G) * 4 + e;                                                                                        \
      int sel = k & 63;                                                                                           \
      int a_ = __builtin_amdgcn_readlane(id0, sel), b_ = __builtin_amdgcn_readlane(id1, sel);                     \
      float ga_ = __builtin_bit_cast(float, __builtin_amdgcn_readlane(__builtin_bit_cast(int, g0), sel));         \
      float gb_ = __builtin_bit_cast(float, __builtin_amdgcn_readlane(__builtin_bit_cast(int, g1), sel));         \
      ids[e] = (G) < 16 ? a_ : b_;                                                                                 \
      gts[e] = (G) < 16 ? ga_ : gb_;                                                                               \
    }                                                                                                             \
    _Pragma("unroll") for (int e = 0; e < 4; ++e) uq[e] = *(const u32x4*)(U + (size_t)ids[e] * 1024 + lane * 16); \
    _Pragma("unroll") for (int e = 0; e < 4; ++e) vq[e] = *(const u32x4*)(V + (size_t)ids[e] * 1024 + lane * 16); \
    _Pragma("unroll") for (int e = 0; e < 4; ++e) { su[e] = SU[ids[e]]; sv[e] = SV[ids[e]]; }                     \
  } while (0)
#define PG_COMP(gts, su, sv, uq, vq)                                                                              \
  do {                                                                                                            \
    float cf[4];                                                                                                  \
    _Pragma("unroll") for (int e = 0; e < 4; ++e) {                                                               \
      float a[16];                                                                                                \
      cvt16(uq[e], a);                                                                                            \
      float d0 = 0.f, d1 = 0.f;                                                                                   \
      _Pragma("unroll") for (int i = 0; i < 16; i += 2) { d0 += a[i] * hf[i]; d1 += a[i + 1] * hf[i + 1]; }       \
      float d = wave_sum(d0 + d1) * su[e];                                                                        \
      float u3 = 0.7978845608028654f * (d + 0.044715f * d * d * d);                                               \
      float th = 1.f - 2.f / (__expf(2.f * u3) + 1.f);                                                            \
      cf[e] = gts[e] * 0.5f * d * (1.f + th) * sv[e];                                                             \
    }                                                                                                             \
    _Pragma("unroll") for (int e = 0; e < 4; ++e) {                                                               \
      float a[16];                                                                                                \
      cvt16(vq[e], a);                                                                                            \
      _Pragma("unroll") for (int i = 0; i < 16; ++i) acc[i] += cf[e] * a[i];                                      \
    }                                                                                                             \
  } while (0)
    {
      int idA[4], idB[4];
      float gtA[4], gtB[4], suA[4], svA[4], suB[4], svB[4];
      u32x4 uqA[4], vqA[4], uqB[4], vqB[4];
      PG_LOAD(0, idA, gtA, suA, svA, uqA, vqA);
#pragma unroll 1
      for (int g = 0; g < 32; g += 2) {
        PG_LOAD(g + 1, idB, gtB, suB, svB, uqB, vqB);
        PG_COMP(gtA, suA, svA, uqA, vqA);
        if (g + 2 < 32) PG_LOAD(g + 2, idA, gtA, suA, svA, uqA, vqA);
        PG_COMP(gtB, suB, svB, uqB, vqB);
      }
    }
#undef PG_LOAD
#undef PG_COMP
    const float* mod = (const float*)(ws + O_MOD) + ((size_t)l * 3 + tok_cond(tok)) * 6144;
    float x[16];
    const int e0 = lane * 16;
#pragma unroll
    for (int q = 0; q < 4; ++q) {
      f32x4 a = *(const f32x4*)(X + (size_t)tok * 1024 + e0 + q * 4);
      f32x4 ga = *(const f32x4*)(mod + 5 * 1024 + e0 + q * 4);
#pragma unroll
      for (int i = 0; i < 4; ++i) { a[i] += ga[i] * acc[q * 4 + i]; x[q * 4 + i] = a[i]; }
      *(f32x4*)(XW + (size_t)tok * 1024 + e0 + q * 4) = a;
    }
    float ss = 0.f;
#pragma unroll
    for (int i = 0; i < 16; ++i) ss += x[i] * x[i];
    ss = wave_sum(ss);
    const float rstd = rsqrtf(ss * (1.f / 1024.f) + 1e-6f);
    if (l < NL - 1) {
      const float* mod2 = (const float*)(ws + O_MOD) + ((size_t)(l + 1) * 3 + tok_cond(tok)) * 6144;
      const float* g = p.in[9] + (l + 1) * 1024;
      float y[16];
#pragma unroll
      for (int q = 0; q < 4; ++q) {
        f32x4 gg = *(const f32x4*)(g + e0 + q * 4), sh = *(const f32x4*)(mod2 + e0 + q * 4), sc = *(const f32x4*)(mod2 + 1024 + e0 + q * 4);
#pragma unroll
        for (int i = 0; i < 4; ++i) y[q * 4 + i] = x[q * 4 + i] * rstd * gg[i] * (1.f + sc[i]) + sh[i];
      }
      u32x4 o0, o1;
      o0[0] = pack2(y[0], y[1]); o0[1] = pack2(y[2], y[3]); o0[2] = pack2(y[4], y[5]); o0[3] = pack2(y[6], y[7]);
      o1[0] = pack2(y[8], y[9]); o1[1] = pack2(y[10], y[11]); o1[2] = pack2(y[12], y[13]); o1[3] = pack2(y[14], y[15]);
      *(u32x4*)(HW + (size_t)tok * 1024 + e0) = o0;
      *(u32x4*)(HW + (size_t)tok * 1024 + e0 + 8) = o1;
    } else {
      const float* g = p.in[11];
#pragma unroll
      for (int q = 0; q < 4; ++q) {
        f32x4 gg = *(const f32x4*)(g + e0 + q * 4), a;
#pragma unroll
        for (int i = 0; i < 4; ++i) a[i] = x[q * 4 + i] * rstd * gg[i];
        *(f32x4*)(OW + (size_t)tok * 1024 + e0 + q * 4) = a;
      }
    }
  }
}

#define XB_TMO 128
#define XB_XCNT(j) (256 + 64 * (j))
#define XB_XSUB(j) (1280 + 64 * (j))
#define XB_XGEN(j) (2304 + 64 * (j))
#define XB_TOP 3328
#define XB_TOPGEN 3392
#define XCD_BAR_WORDS 3456
#define XB_SPIN_CAP (1u << 18)
DI unsigned xb_ld(unsigned* q) { return __hip_atomic_load(q, __ATOMIC_RELAXED, __HIP_MEMORY_SCOPE_AGENT); }
DI unsigned xb_add(unsigned* q, unsigned v) { return __hip_atomic_fetch_add(q, v, __ATOMIC_RELAXED, __HIP_MEMORY_SCOPE_AGENT); }
DI unsigned xb_xcc_id() { return (unsigned)__builtin_amdgcn_s_getreg((3 << 11) | 20) & 0xFu; }
#define XB_SPIN(cond, bar)                                                                   \
  do {                                                                                       \
    unsigned _sp = 0;                                                                        \
    while (cond) {                                                                           \
      __builtin_amdgcn_s_sleep(1);                                                           \
      if ((++_sp & 255u) == 0u) {                                                            \
        if (xb_ld(&(bar)[XB_TMO])) break;                                                    \
        if (_sp > XB_SPIN_CAP) { atomicAdd(&(bar)[XB_TMO], 1u); break; }                     \
      }                                                                                      \
    }                                                                                        \
  } while (0)
struct XB { unsigned* bar; unsigned x, nloc, nx; };
DI void xcd_barrier(const XB& b) {
  asm volatile("s_waitcnt vmcnt(0)" ::: "memory");
  __syncthreads();
  if (threadIdx.x == 0) {
    unsigned* bar = b.bar;
    __builtin_amdgcn_s_waitcnt(0);
    const unsigned nloc = b.nloc, nx = b.nx;
    const unsigned old = xb_add(&bar[XB_XSUB(b.x)], 1u);
    const unsigned gen = old / nloc;
    if (old + 1u == (gen + 1u) * nloc) {
      __builtin_amdgcn_fence(__ATOMIC_RELEASE, "agent");
      asm volatile("s_waitcnt vmcnt(0)" ::: "memory");
      const unsigned og = xb_add(&bar[XB_TOP], 1u);
      const unsigned tg = og / nx;
      if (og + 1u == (tg + 1u) * nx) xb_add(&bar[XB_TOPGEN], 1u);
      else XB_SPIN(xb_ld(&bar[XB_TOPGEN]) == tg, bar);
      __builtin_amdgcn_fence(__ATOMIC_ACQUIRE, "agent");
      xb_add(&bar[XB_XGEN(b.x)], 1u);
      asm volatile("s_waitcnt vmcnt(0)" ::: "memory");
    } else {
      XB_SPIN(xb_ld(&bar[XB_XGEN(b.x)]) == gen, bar);
      __builtin_amdgcn_fence(__ATOMIC_ACQUIRE, "agent");
      asm volatile("s_waitcnt vmcnt(0)" ::: "memory");
    }
  }
  __syncthreads();
}

__global__ void __launch_bounds__(256, 2) fwd_megakernel(Params p) {
  cg::grid_group grid = cg::this_grid();
  XB xb;
  xb.bar = (unsigned*)(p.ws + O_BAR);
  xb.x = xb_xcc_id();
  if (threadIdx.x == 0) (void)xb_add(&xb.bar[XB_XCNT(xb.x)], 1u);
  phase_prep(p);
  if (p.ws == nullptr) grid.sync();
  {
    unsigned mine = 0u, cnt = 0u, sum = 0u, sp = 0u;
    for (;;) {
      sum = 0u; cnt = 0u; mine = 0u;
#pragma unroll
      for (unsigned j = 0; j < 16; ++j) { const unsigned c = xb_ld(&xb.bar[XB_XCNT(j)]); sum += c; cnt += (c > 0u) ? 1u : 0u; mine = (j == xb.x) ? c : mine; }
      if (sum == gridDim.x) break;
      __builtin_amdgcn_s_sleep(1);
      if (++sp > XB_SPIN_CAP) break;
    }
    xb.nloc = __builtin_amdgcn_readfirstlane(mine > 0u ? mine : 1u);
    xb.nx = __builtin_amdgcn_readfirstlane(cnt > 0u ? cnt : 1u);
  }
  xcd_barrier(xb);
  phase_norm(p, 0, 0);
  xcd_barrier(xb);
  for (int l = 0; l < NL; ++l) {
    phase_gemm_in(p, l);
    xcd_barrier(xb);
    phase_rwkv_prep(p, l);
    xcd_barrier(xb);
    phase_rwkv_lora(p, l);
    xcd_barrier(xb);
    phase_mix(p, l);
    xcd_barrier(xb);
    phase_rwkv_post(p, l);
    xcd_barrier(xb);
    phase_branch(p, l);
    xcd_barrier(xb);
    phase_wo(p, l);
    xcd_barrier(xb);
    phase_norm(p, l, 1);
    xcd_barrier(xb);
    phase_peq(p, l);
    xcd_barrier(xb);
    phase_peer_sel(p, l);
    xcd_barrier(xb);
    phase_peer_gather(p, l);
    if (l + 1 < NL) xcd_barrier(xb);
  }
}

extern "C" void kernel_launch(void* const* d_in, const int* in_sizes, int n_in, void* d_out, int out_size, void* d_ws, size_t ws_size,
                              hipStream_t stream) {
  static int grid_blocks = 0;
  if (!grid_blocks) {
    int dev = 0, cus = 0, per_cu = 0;
    hipGetDevice(&dev);
    hipDeviceGetAttribute(&cus, hipDeviceAttributeMultiprocessorCount, dev);
    hipOccupancyMaxActiveBlocksPerMultiprocessor(&per_cu, fwd_megakernel, 256, 0);
    if (per_cu > 2) per_cu = 2;
    if (per_cu < 1) per_cu = 1;
    grid_blocks = cus * per_cu;
  }
  Params p{};
  for (int i = 0; i < 36; ++i) p.in[i] = (const float*)d_in[i];
  p.out = (float*)d_out;
  p.ws = (char*)d_ws;
  (void)hipMemsetAsync((char*)d_ws + O_BAR, 0, 3456 * 4, stream);
  void* args[] = {&p};
  hipError_t e = hipLaunchCooperativeKernel((void*)fwd_megakernel, dim3(grid_blocks), dim3(256), args, 0, stream);
  if (e != hipSuccess) fprintf(stderr, "cooperative launch failed: %s (grid %d)\n", hipGetErrorString(e), grid_blocks);
}
```

```cpp
#include <hip/hip_runtime.h>
#include <hip/hip_cooperative_groups.h>
#include <cstdio>
namespace cg = cooperative_groups;

#define DI __device__ __forceinline__
typedef unsigned short u16;
using bf16x8 = __attribute__((ext_vector_type(8))) short;
using bf16x4 = __attribute__((ext_vector_type(4))) short;
using f32x4 = __attribute__((ext_vector_type(4))) float;
using u32x2 = __attribute__((ext_vector_type(2))) unsigned;
using u32x4 = __attribute__((ext_vector_type(4))) unsigned;

constexpr int NT = 8192, NCTX = 4096, DM = 1024, INC = 7296, NL = 4;

constexpr size_t AL(size_t x) { return (x + 255) / 256 * 256; }
constexpr size_t O_WIN = 0;
constexpr size_t O_AOUT = O_WIN + AL(4ull * 7296 * 1024 * 2);
constexpr size_t O_RWOUT = O_AOUT + AL(4ull * 1024 * 512 * 2);
constexpr size_t O_NAOUT = O_RWOUT + AL(4ull * 1024 * 512 * 2);
constexpr size_t O_WO = O_NAOUT + AL(4ull * 1024 * 512 * 2);
constexpr size_t O_PEQ = O_WO + AL(4ull * 1024 * 1024 * 2);
constexpr size_t O_SUBK = O_PEQ + AL(4ull * 2048 * 1024 * 2);
constexpr size_t O_W2 = O_SUBK + AL(4ull * 8 * 2 * 128 * 128 * 2);
constexpr size_t O_A2 = O_W2 + AL(8ull * 512 * 64 * 2);
constexpr size_t O_G2 = O_A2 + AL(8ull * 512 * 64 * 2);
constexpr size_t O_PEU = O_G2 + AL(4ull * 512 * 128 * 2);
constexpr size_t O_PEV = O_PEU + AL(4ull * 16384 * 1024 * 2);
constexpr size_t O_CAK = O_PEV + AL(4ull * 16384 * 1024 * 2);
constexpr size_t O_CAVT = O_CAK + AL(8ull * 512 * 128 * 2);
constexpr size_t O_CCK = O_CAVT + AL(8ull * 128 * 512 * 2);
constexpr size_t O_CCVT = O_CCK + AL(8ull * 512 * 512 * 2);
constexpr size_t O_MOD = O_CCVT + AL(8ull * 512 * 512 * 2);
constexpr size_t O_ROPE = O_MOD + AL(4ull * 3 * 6144 * 4);
constexpr size_t O_CNT = O_ROPE + AL(64 * 16 * 2 * 4);
constexpr size_t O_X = O_CNT + 256;
constexpr size_t O_H = O_X + AL(8192ull * 1024 * 4);
constexpr size_t O_QA = O_H + AL(8192ull * 1024 * 2);
constexpr size_t O_KA = O_QA + AL(8192ull * 512 * 2);
constexpr size_t O_VAT = O_KA + AL(8192ull * 128 * 2);
constexpr size_t O_QC = O_VAT + AL(8192ull * 128 * 2);
constexpr size_t O_KC = O_QC + AL(8192ull * 512 * 2);
constexpr size_t O_VCT = O_KC + AL(8192ull * 512 * 2);
constexpr size_t O_PB = O_VCT + AL(8192ull * 512 * 2);
constexpr size_t O_GATE = O_PB + AL(8192ull * 1920 * 4);
constexpr size_t O_XRKV = O_GATE + AL(8192ull * 3072 * 2);
constexpr size_t O_KK = O_XRKV + AL(8192ull * 1536 * 4);
constexpr size_t O_TW = O_KK + AL(8192ull * 512 * 4);
constexpr size_t O_AD = O_TW + AL(8192ull * 128 * 2);
constexpr size_t O_SG = O_AD + AL(8192ull * 128 * 2);
constexpr size_t O_DEC = O_SG + AL(8192ull * 128 * 2);
constexpr size_t O_KD = O_DEC + AL(2ull * 8192 * 512 * 4);
constexpr size_t O_KKA = O_KD + AL(2ull * 8192 * 512 * 4);
constexpr size_t O_GG = O_KKA + AL(2ull * 8192 * 512 * 4);
constexpr size_t O_YS = O_GG + AL(8192ull * 512 * 4);
constexpr size_t O_YABC = O_YS + AL(2ull * 8192 * 512 * 4);
constexpr size_t O_MERG = O_YABC + AL(3ull * 8192 * 512 * 2);
constexpr size_t O_PQ = O_MERG + AL(8192ull * 1024 * 2);
constexpr size_t O_EIDX = O_PQ + AL(8192ull * 2048 * 2);
constexpr size_t O_EGATE = O_EIDX + AL(8192ull * 128 * 4);
constexpr size_t O_SCU = O_EGATE + AL(8192ull * 128 * 4);
constexpr size_t O_SCV = O_SCU + AL(4ull * 16384 * 4);
constexpr size_t O_BAR = O_SCV + AL(4ull * 16384 * 4);
constexpr size_t WS_TOTAL = O_BAR + AL(3456 * 4);
static_assert(WS_TOTAL < 1020ull * 1024 * 1024, "workspace too large");

constexpr size_t OUT_Y = 0;
constexpr size_t OUT_AK = 8388608;
constexpr size_t OUT_AV = 10485760;
constexpr size_t OUT_CK = 12582912;
constexpr size_t OUT_CV = 20971520;
constexpr size_t OUT_ST = 29360128;

struct Params {
  const float* in[36];
  float* out;
  char* ws;
};

__shared__ __attribute__((aligned(16))) char g_smem[65536];

DI u16 f2bf(float x) { unsigned u = __float_as_uint(x); u += 0x7fffu + ((u >> 16) & 1u); return (u16)(u >> 16); }
DI float bf2f(u16 h) { return __uint_as_float(((unsigned)h) << 16); }
DI unsigned pack2(float a, float b) { return (unsigned)f2bf(a) | ((unsigned)f2bf(b) << 16); }
DI float sigmoidf_(float x) { return 1.f / (1.f + __expf(-x)); }
template <int CTRL> DI float dppf(float v) {
  return __builtin_bit_cast(float, __builtin_amdgcn_update_dpp(0, __builtin_bit_cast(int, v), CTRL, 0xf, 0xf, true));
}
template <int CTRL> DI int dppi(int v) { return __builtin_amdgcn_update_dpp(0, v, CTRL, 0xf, 0xf, true); }
DI float row_sum16(float v) { v += dppf<0xB1>(v); v += dppf<0x4E>(v); v += dppf<0x141>(v); v += dppf<0x140>(v); return v; }
DI float row_max16(float v) { v = fmaxf(v, dppf<0xB1>(v)); v = fmaxf(v, dppf<0x4E>(v)); v = fmaxf(v, dppf<0x141>(v)); v = fmaxf(v, dppf<0x140>(v)); return v; }
DI int row_max16i(int v) { v = max(v, dppi<0xB1>(v)); v = max(v, dppi<0x4E>(v)); v = max(v, dppi<0x141>(v)); v = max(v, dppi<0x140>(v)); return v; }
DI float wave_sum(float v) { v = row_sum16(v); v += __shfl_xor(v, 16); v += __shfl_xor(v, 32); return v; }

DI int opaque_tid() { int t = threadIdx.x; asm volatile("" : "+v"(t)); return t; }
DI char* opaque_ptr(char* q) { size_t z = 0; asm volatile("" : "+s"(z)); return q + z; }
DI f32x4 mfma16(bf16x8 a, bf16x8 b, f32x4 c) { return __builtin_amdgcn_mfma_f32_16x16x32_bf16(a, b, c, 0, 0, 0); }

DI int lds_byte(int r, int c) {
  int st = (r >> 4) * 2 + (c >> 5), rr = r & 15, cc = c & 31, ob = rr * 64 + cc * 2;
  return st * 1024 + (ob ^ (((ob >> 9) & 1) << 5));
}
DI void stage_rc(int b, int& R, int& C) {
  int st = b >> 10, sb = b & 1023, swz = sb ^ (((sb >> 9) & 1) << 5);
  R = (st >> 1) * 16 + (swz >> 6);
  C = (st & 1) * 32 + ((swz & 63) >> 1);
}
DI void gemm_main(int tid, const u16* __restrict__ g0, int ld0, const u16* __restrict__ g1, int ld1, int K, f32x4 (&acc)[4][4], int koff = 0) {
  const int wid = tid >> 6, lane = tid & 63, wr = wid >> 1, wc = wid & 1, fr = lane & 15, fq = lane >> 4;
  const int nk = K >> 6;
  int R0, C0;
  stage_rc(tid * 16, R0, C0);
  const unsigned v0 = (unsigned)(R0 * ld0 + C0), v1 = (unsigned)(R0 * ld1 + C0);
  const int fa0 = lds_byte(wr * 64 + fr, fq * 8), fa1 = 16384 + lds_byte(wc * 64 + fr, fq * 8);
  const int sb = tid * 16;
#define GSTAGE(kt, buf)                                                                                          \
  do {                                                                                                           \
    _Pragma("unroll") for (int i = 0; i < 4; ++i) {                                                              \
      const u16* u0 = g0 + (size_t)(kt) * 64 + (size_t)i * 32 * ld0;                                             \
      const u16* u1 = g1 + (size_t)(kt) * 64 + (size_t)i * 32 * ld1;                                             \
      __builtin_amdgcn_global_load_lds((const unsigned*)(u0 + v0), (unsigned*)(g_smem + (buf) + i * 4096 + sb), 16, 0, 0);          \
      __builtin_amdgcn_global_load_lds((const unsigned*)(u1 + v1), (unsigned*)(g_smem + (buf) + 16384 + i * 4096 + sb), 16, 0, 0);  \
    }                                                                                                            \
  } while (0)
  int kt = koff;
  GSTAGE(kt, 0);
  for (int t = 0; t < nk; ++t) {
    asm volatile("s_waitcnt vmcnt(0)" ::: "memory");
    __syncthreads();
    const int cur = (t & 1) * 32768;
    kt = kt + 1 == nk ? 0 : kt + 1;
    if (t + 1 < nk) GSTAGE(kt, 32768 - cur);
#pragma unroll
    for (int ks = 0; ks < 2; ++ks) {
      bf16x8 f0[4], f1[4];
#pragma unroll
      for (int m = 0; m < 4; ++m) f0[m] = *(const bf16x8*)(g_smem + cur + fa0 + m * 2048 + ks * 1024);
#pragma unroll
      for (int n = 0; n < 4; ++n) f1[n] = *(const bf16x8*)(g_smem + cur + fa1 + n * 2048 + ks * 1024);
#pragma unroll
      for (int m = 0; m < 4; ++m)
#pragma unroll
        for (int n = 0; n < 4; ++n) acc[m][n] = mfma16(f1[n], f0[m], acc[m][n]);
    }
  }
#undef GSTAGE
  __syncthreads();
}
DI void zero_acc(f32x4 (&acc)[4][4]) {
#pragma unroll
  for (int m = 0; m < 4; ++m)
#pragma unroll
    for (int n = 0; n < 4; ++n) acc[m][n] = f32x4{0.f, 0.f, 0.f, 0.f};
}

struct TJob { const float* src; u16* dst; int K, N, nb; };

DI void transpose_tile(int tid, const float* __restrict__ src, u16* __restrict__ dst, int K, int N, int k0, int n0) {
  float* tile = (float*)g_smem;
  {
    const int tr = tid >> 4, tc = tid & 15;
#pragma unroll
    for (int p = 0; p < 4; ++p) {
      int r = tr + 16 * p;
      f32x4 v = *(const f32x4*)(src + (size_t)(k0 + r) * N + n0 + tc * 4);
      tile[r * 65 + tc * 4 + 0] = v[0]; tile[r * 65 + tc * 4 + 1] = v[1];
      tile[r * 65 + tc * 4 + 2] = v[2]; tile[r * 65 + tc * 4 + 3] = v[3];
    }
  }
  __syncthreads();
  {
    const int tn = tid >> 3, tk = tid & 7;
#pragma unroll
    for (int p = 0; p < 2; ++p) {
      int n = tn + 32 * p;
      u32x4 o;
#pragma unroll
      for (int q = 0; q < 4; ++q) o[q] = pack2(tile[(tk * 8 + 2 * q) * 65 + n], tile[(tk * 8 + 2 * q + 1) * 65 + n]);
      *(u32x4*)(dst + (size_t)(n0 + n) * K + k0 + tk * 8) = o;
    }
  }
  __syncthreads();
}

DI void convert_chunks(int tid, const float* __restrict__ src, u16* __restrict__ dst, size_t n) {
  const size_t nch = n / 8192;
  for (size_t c = blockIdx.x; c < nch; c += gridDim.x) {
    size_t e = c * 8192 + tid * 8;
    f32x4 a[4], b[4];
#pragma unroll
    for (int q = 0; q < 4; ++q) { a[q] = __builtin_nontemporal_load((const f32x4*)(src + e + q * 2048)); b[q] = __builtin_nontemporal_load((const f32x4*)(src + e + q * 2048 + 4)); }
#pragma unroll
    for (int q = 0; q < 4; ++q) {
      u32x4 o;
      o[0] = pack2(a[q][0], a[q][1]); o[1] = pack2(a[q][2], a[q][3]); o[2] = pack2(b[q][0], b[q][1]); o[3] = pack2(b[q][2], b[q][3]);
      *(u32x4*)(dst + e + q * 2048) = o;
    }
  }
}

typedef float f32x2 __attribute__((ext_vector_type(2)));
DI void convert_rows_fp8(int tid, const float* __restrict__ src, unsigned char* __restrict__ dst, float* __restrict__ inv_scale, int nrows) {
  const int lane = tid & 63;
  const int gw = blockIdx.x * 4 + (tid >> 6), GW = gridDim.x * 4;
  for (int r0 = gw; r0 < nrows; r0 += 2 * GW) {
    int rws[2] = {r0, r0 + GW < nrows ? r0 + GW : r0};
    f32x4 v[2][4];
#pragma unroll
    for (int u = 0; u < 2; ++u)
#pragma unroll
      for (int q = 0; q < 4; ++q) v[u][q] = __builtin_nontemporal_load((const f32x4*)(src + (size_t)rws[u] * 1024 + lane * 16 + q * 4));
#pragma unroll
    for (int u = 0; u < 2; ++u) {
      float am = 0.f;
#pragma unroll
      for (int q = 0; q < 4; ++q)
#pragma unroll
        for (int j = 0; j < 4; ++j) am = fmaxf(am, fabsf(v[u][q][j]));
      am = row_max16(am);
      am = fmaxf(am, __shfl_xor(am, 16));
      am = fmaxf(am, __shfl_xor(am, 32));
      int ex = (int)((__float_as_uint(am) >> 23) & 0xff) - 127;
      int k = am > 0.f ? 7 - ex : 0;
      k = min(max(k, -100), 100);
      float sc = __uint_as_float((unsigned)(127 + k) << 23), isc = __uint_as_float((unsigned)(127 - k) << 23);
      u32x4 o;
#pragma unroll
      for (int q = 0; q < 4; ++q) {
        int w = __builtin_amdgcn_cvt_pk_fp8_f32(v[u][q][0] * sc, v[u][q][1] * sc, 0, false);
        w = __builtin_amdgcn_cvt_pk_fp8_f32(v[u][q][2] * sc, v[u][q][3] * sc, w, true);
        o[q] = (unsigned)w;
      }
      *(u32x4*)(dst + (size_t)rws[u] * 1024 + lane * 16) = o;
      if (lane == 0) inv_scale[rws[u]] = isc;
    }
  }
}

DI void convert_rows_fp8_wave(int lane, const float* __restrict__ src, unsigned char* __restrict__ dst, float* __restrict__ inv_scale, int r0, int r1) {
  for (int r = r0; r < r1; r += 2) {
    f32x4 v[2][4];
#pragma unroll
    for (int u = 0; u < 2; ++u)
#pragma unroll
      for (int q = 0; q < 4; ++q) v[u][q] = __builtin_nontemporal_load((const f32x4*)(src + (size_t)(r + u) * 1024 + lane * 16 + q * 4));
#pragma unroll
    for (int u = 0; u < 2; ++u) {
      float am = 0.f;
#pragma unroll
      for (int q = 0; q < 4; ++q)
#pragma unroll
        for (int j = 0; j < 4; ++j) am = fmaxf(am, fabsf(v[u][q][j]));
      am = row_max16(am);
      am = fmaxf(am, __shfl_xor(am, 16));
      am = fmaxf(am, __shfl_xor(am, 32));
      int ex = (int)((__float_as_uint(am) >> 23) & 0xff) - 127;
      int k = am > 0.f ? 7 - ex : 0;
      k = min(max(k, -100), 100);
      float sc = __uint_as_float((unsigned)(127 + k) << 23), isc = __uint_as_float((unsigned)(127 - k) << 23);
      u32x4 o;
#pragma unroll
      for (int q = 0; q < 4; ++q) {
        int w = __builtin_amdgcn_cvt_pk_fp8_f32(v[u][q][0] * sc, v[u][q][1] * sc, 0, false);
        w = __builtin_amdgcn_cvt_pk_fp8_f32(v[u][q][2] * sc, v[u][q][3] * sc, w, true);
        o[q] = (unsigned)w;
      }
      *(u32x4*)(dst + (size_t)(r + u) * 1024 + lane * 16) = o;
      if (lane == 0) inv_scale[r + u] = isc;
    }
  }
}

__device__ void phase_prep(const Params& p) {
  char* ws = opaque_ptr(p.ws);
  const int tid = opaque_tid(), wid = tid >> 6, lane = tid & 63;
  if (blockIdx.x == 0 && tid < 64) ((int*)(ws + O_CNT))[tid] = 0;
  if (blockIdx.x < 4) {
    int e = blockIdx.x * 256 + tid;
    int pos = e >> 4, f = e & 15;
    const float fr4[4] = {1.0f, 0.56234132519f, 0.316227766017f, 0.177827941004f};
    float sc = (f >> 2) == 0 ? 1.0f : (f >> 2) == 1 ? 0.1f : (f >> 2) == 2 ? 0.01f : 0.001f;
    float fsel = (f & 3) == 0 ? fr4[0] : (f & 3) == 1 ? fr4[1] : (f & 3) == 2 ? fr4[2] : fr4[3];
    float freq = fsel * sc;
    float ang = (float)pos * freq;
    double a = (double)ang;
    double k = rint(a * 0.15915494309189535);
    double r = a - k * 6.283185307179586;
    double r2 = r * r, ts = r, tc = 1.0, s = r, c = 1.0;
    for (int i = 1; i <= 14; ++i) {
      tc = -tc * r2 / (double)((2 * i - 1) * (2 * i));
      ts = -ts * r2 / (double)((2 * i) * (2 * i + 1));
      c += tc; s += ts;
    }
    float* rope = (float*)(ws + O_ROPE);
    rope[e * 2] = (float)c; rope[e * 2 + 1] = (float)s;
  }
  {
    float* sil = (float*)g_smem;
    float* part = (float*)(g_smem + 16384);
    const float* cvec = p.in[7];
    const float* cctx = p.in[8];
    bool have_sil = false;
    for (int it = blockIdx.x; it < 4 * 96; it += gridDim.x) {
      if (!have_sil) {
        for (int k = tid; k < 1024; k += 256) {
          float a = cctx[k], b = cvec[k], c2 = cvec[1024 + k];
          sil[k] = a * sigmoidf_(a); sil[1024 + k] = b * sigmoidf_(b); sil[2048 + k] = c2 * sigmoidf_(c2);
        }
        have_sil = true;
        __syncthreads();
      }
      int l = it / 96, n = (it % 96) * 64 + lane;
      const float* W = p.in[12] + (size_t)l * 1024 * 6144 + n;
      float a0 = 0.f, a1 = 0.f, a2 = 0.f;
      int kb = wid * 256;
#pragma unroll 8
      for (int k = 0; k < 256; ++k) {
        float w = W[(size_t)(kb + k) * 6144];
        a0 += w * sil[kb + k]; a1 += w * sil[1024 + kb + k]; a2 += w * sil[2048 + kb + k];
      }
      part[(wid * 3 + 0) * 64 + lane] = a0; part[(wid * 3 + 1) * 64 + lane] = a1; part[(wid * 3 + 2) * 64 + lane] = a2;
      __syncthreads();
      if (tid < 192) {
        int c = tid >> 6, ln = tid & 63;
        float s = part[(0 * 3 + c) * 64 + ln] + part[(1 * 3 + c) * 64 + ln] + part[(2 * 3 + c) * 64 + ln] + part[(3 * 3 + c) * 64 + ln];
        int nn = (it % 96) * 64 + ln;
        ((float*)(ws + O_MOD))[((size_t)l * 3 + c) * 6144 + nn] = s + p.in[13][(size_t)l * 6144 + nn];
      }
      __syncthreads();
    }
    __syncthreads();
  }
  {
    TJob jobs[11] = {
        {p.in[14], (u16*)(ws + O_WIN), 1024, 7296, 4},
        {p.in[16], (u16*)(ws + O_AOUT), 512, 1024, 4},
        {p.in[28], (u16*)(ws + O_RWOUT), 512, 1024, 4},
        {p.in[30], (u16*)(ws + O_NAOUT), 512, 1024, 4},
        {p.in[31], (u16*)(ws + O_WO), 1024, 1024, 4},
        {p.in[32], (u16*)(ws + O_PEQ), 1024, 2048, 4},
        {p.in[19], (u16*)(ws + O_W2), 64, 512, 8},
        {p.in[21], (u16*)(ws + O_A2), 64, 512, 8},
        {p.in[22], (u16*)(ws + O_G2), 128, 512, 4},
        {p.in[3], (u16*)(ws + O_CAVT), 512, 128, 8},
        {p.in[5], (u16*)(ws + O_CCVT), 512, 512, 8},
    };
#pragma unroll
    for (int j = 0; j < 11; ++j) {
      const int tk = jobs[j].K / 64, tn = jobs[j].N / 64, per = tk * tn, tot = per * jobs[j].nb;
      for (int t = blockIdx.x; t < tot; t += gridDim.x) {
        int b = t / per, r = t % per;
        int kt = r / tn, ntile = r % tn;
        size_t off = (size_t)b * jobs[j].K * jobs[j].N;
        transpose_tile(tid, jobs[j].src + off, jobs[j].dst + off, jobs[j].K, jobs[j].N, kt * 64, ntile * 64);
      }
    }
  }
  convert_chunks(tid, p.in[33], (u16*)(ws + O_SUBK), 4ull * 8 * 2 * 128 * 128);
  convert_chunks(tid, p.in[2], (u16*)(ws + O_CAK), 8ull * 512 * 128);
  convert_chunks(tid, p.in[4], (u16*)(ws + O_CCK), 8ull * 512 * 512);
  {
    float* X = (float*)(ws + O_X);
    const size_t nch = (size_t)NT * DM / 1024;
    for (size_t c = blockIdx.x; c < nch; c += gridDim.x) {
      size_t e = c * 1024 + tid * 4;
      const float* src = e < (size_t)NCTX * DM ? p.in[0] + e : p.in[1] + (e - (size_t)NCTX * DM);
      *(f32x4*)(X + e) = *(const f32x4*)src;
    }
  }
}

DI int tok_cond(int tok) { return tok < NCTX ? 0 : 1 + ((tok - NCTX) >> 11); }

DI void norm_row_store(const float (&x)[16], const float* __restrict__ g, const float* __restrict__ shift, const float* __restrict__ scale,
                       u16* __restrict__ hrow, int lane) {
  float ss = 0.f;
#pragma unroll
  for (int i = 0; i < 16; ++i) ss += x[i] * x[i];
  ss = wave_sum(ss);
  float rstd = rsqrtf(ss * (1.f / 1024.f) + 1e-6f);
#pragma unroll
  for (int hh = 0; hh < 2; ++hh) {
    int e0 = hh * 512 + lane * 8;
    float y[8];
#pragma unroll
    for (int i = 0; i < 8; ++i) {
      float v = x[hh * 8 + i] * rstd * g[e0 + i];
      y[i] = v * (1.f + scale[e0 + i]) + shift[e0 + i];
    }
    u32x4 o;
    o[0] = pack2(y[0], y[1]); o[1] = pack2(y[2], y[3]); o[2] = pack2(y[4], y[5]); o[3] = pack2(y[6], y[7]);
    *(u32x4*)(hrow + e0) = o;
  }
}

__device__ void phase_norm(const Params& p, int l, int which) {
  char* ws = opaque_ptr(p.ws);
  const int tid = opaque_tid();
  const int lane = tid & 63;
  const int gw = blockIdx.x * 4 + (tid >> 6), GW = gridDim.x * 4;
  const float* X = (const float*)(ws + O_X);
  const float* g = (which == 0 ? p.in[9] : p.in[10]) + l * 1024;
  for (int tok = gw; tok < NT; tok += GW) {
    const float* mod = (const float*)(ws + O_MOD) + ((size_t)l * 3 + tok_cond(tok)) * 6144 + which * 3 * 1024;
    float x[16];
#pragma unroll
    for (int hh = 0; hh < 2; ++hh) {
      f32x4 a = *(const f32x4*)(X + (size_t)tok * 1024 + hh * 512 + lane * 8);
      f32x4 b = *(const f32x4*)(X + (size_t)tok * 1024 + hh * 512 + lane * 8 + 4);
#pragma unroll
      for (int i = 0; i < 4; ++i) { x[hh * 8 + i] = a[i]; x[hh * 8 + 4 + i] = b[i]; }
    }
    norm_row_store(x, g, mod, mod + 1024, (u16*)(ws + O_H) + (size_t)tok * 1024, lane);
  }
}

__device__ void phase_gemm_in(const Params& p, int l) {
  char* ws = opaque_ptr(p.ws);
  const int tid = opaque_tid();
  const int wid = tid >> 6, lane = tid & 63, wr = wid >> 1, wc = wid & 1, fr = lane & 15, fq = lane >> 4;
  const u16* H = (const u16*)(ws + O_H);
  const u16* W = (const u16*)(ws + O_WIN) + (size_t)l * INC * 1024;
  const float* rope = (const float*)(ws + O_ROPE);
  float* out = p.out;
  for (int t = blockIdx.x; t < 64 * 57; t += gridDim.x) {
    const int tm = t & 63, tn = t >> 6;
    const int brow = tm * 128, bcol = tn * 128;
    const bool swapped = (tn == 5) || (tn >= 29 && tn < 33);
    const bool ctx = brow < NCTX;
    f32x4 acc[4][4];
    zero_acc(acc);
    const int koff = (((tm >> 3) + (tn & 7)) * 2) & 15;
    if (!swapped) gemm_main(tid, H + (size_t)brow * 1024, 1024, W + (size_t)bcol * 1024, 1024, 1024, acc, koff);
    else gemm_main(tid, W + (size_t)bcol * 1024, 1024, H + (size_t)brow * 1024, 1024, 1024, acc, koff);
    if (!swapped) {
#pragma unroll
      for (int m = 0; m < 4; ++m) {
        const int tok = brow + wr * 64 + m * 16 + fr;
        const int cb = bcol + wc * 64 + fq * 4;
        if (tn < 5) {
          if (!ctx) {
            int tt = (tok - NCTX) & 2047;
            int pos0 = tt >> 6, pos1 = tt & 63;
#pragma unroll
            for (int ax = 0; ax < 2; ++ax) {
              int pos = ax == 0 ? pos0 : pos1;
#pragma unroll
              for (int j = 0; j < 4; ++j) {
                float c = rope[(pos * 16 + fq * 4 + j) * 2], s = rope[(pos * 16 + fq * 4 + j) * 2 + 1];
                float x1 = acc[m][2 * ax][j], x2 = acc[m][2 * ax + 1][j];
                acc[m][2 * ax][j] = x1 * c - x2 * s;
                acc[m][2 * ax + 1][j] = x2 * c + x1 * s;
              }
            }
          }
          if (tn < 4) {
#pragma unroll
            for (int n = 0; n < 4; ++n) {
              u32x2 o; o[0] = pack2(acc[m][n][0] * 0.125f, acc[m][n][1] * 0.125f); o[1] = pack2(acc[m][n][2] * 0.125f, acc[m][n][3] * 0.125f);
              *(u32x2*)((u16*)(ws + O_QA) + (size_t)tok * 512 + cb + n * 16) = o;
            }
          } else {
#pragma unroll
            for (int n = 0; n < 4; ++n) {
              int c = cb + n * 16 - 512;
              u32x2 o; o[0] = pack2(acc[m][n][0], acc[m][n][1]); o[1] = pack2(acc[m][n][2], acc[m][n][3]);
              *(u32x2*)((u16*)(ws + O_KA) + (size_t)tok * 128 + c) = o;
              if (ctx) *(f32x4*)(out + OUT_AK + ((size_t)((tok >> 8) * 4 + l) * 256 + (tok & 255)) * 128 + c) = acc[m][n];
            }
          }
        } else if (tn < 21) {
#pragma unroll
          for (int n = 0; n < 4; ++n) *(f32x4*)((float*)(ws + O_PB) + (size_t)tok * 1920 + cb + n * 16 - 768) = acc[m][n];
        } else if (tn < 25) {
#pragma unroll
          for (int n = 0; n < 4; ++n) {
            u32x2 o; o[0] = pack2(acc[m][n][0] * 0.125f, acc[m][n][1] * 0.125f); o[1] = pack2(acc[m][n][2] * 0.125f, acc[m][n][3] * 0.125f);
            *(u32x2*)((u16*)(ws + O_QC) + (size_t)tok * 512 + cb + n * 16 - 2688) = o;
          }
        } else if (tn < 29) {
#pragma unroll
          for (int n = 0; n < 4; ++n) {
            int c = cb + n * 16 - 3200;
            u32x2 o; o[0] = pack2(acc[m][n][0], acc[m][n][1]); o[1] = pack2(acc[m][n][2], acc[m][n][3]);
            *(u32x2*)((u16*)(ws + O_KC) + (size_t)tok * 512 + c) = o;
            if (ctx) *(f32x4*)(out + OUT_CK + ((size_t)((tok >> 8) * 4 + l) * 256 + (tok & 255)) * 512 + c) = acc[m][n];
          }
        } else {
#pragma unroll
          for (int n = 0; n < 4; ++n) {
            u32x2 o; o[0] = pack2(sigmoidf_(acc[m][n][0]), sigmoidf_(acc[m][n][1])); o[1] = pack2(sigmoidf_(acc[m][n][2]), sigmoidf_(acc[m][n][3]));
            *(u32x2*)((u16*)(ws + O_GATE) + (size_t)tok * 3072 + cb + n * 16 - 4224) = o;
          }
        }
      }
    } else {
      const bool isA = (tn == 5);
      u16* VT = isA ? (u16*)(ws + O_VAT) : (u16*)(ws + O_VCT);
      const int ncols = isA ? 128 : 512;
      const size_t obase = isA ? OUT_AV : OUT_CV;
#pragma unroll
      for (int m = 0; m < 4; ++m) {
        const int c = (isA ? 0 : (tn - 29) * 128) + wr * 64 + m * 16 + fr;
#pragma unroll
        for (int n = 0; n < 4; ++n) {
          const int tk = brow + wc * 64 + n * 16 + fq * 4;
          u32x2 o; o[0] = pack2(acc[m][n][0], acc[m][n][1]); o[1] = pack2(acc[m][n][2], acc[m][n][3]);
          *(u32x2*)(VT + (size_t)c * NT + tk) = o;
          if (ctx) {
#pragma unroll
            for (int j = 0; j < 4; ++j) {
              int tok = tk + j;
              out[obase + ((size_t)((tok >> 8) * 4 + l) * 256 + (tok & 255)) * ncols + c] = acc[m][n][j];
            }
          }
        }
      }
    }
  }
}

__device__ void phase_rwkv_prep(const Params& p, int l) {
  char* ws = opaque_ptr(p.ws);
  const int tid = opaque_tid();
  const int lane = tid & 63;
  const int gw = blockIdx.x * 4 + (tid >> 6), GW = gridDim.x * 4;
  const float* PB = (const float*)(ws + O_PB);
  const float* mu = p.in[17] + l * 1920;
  const float* kkw = p.in[23] + l * 512;
  for (int tok = gw; tok < NT; tok += GW) {
    int pos, len;
    if (tok < NCTX) { pos = tok & 255; len = 256; } else { pos = (tok - NCTX) & 2047; len = 2048; }
    const bool hp = pos > 0, hn = pos < len - 1;
    const float* row = PB + (size_t)tok * 1920;
#pragma unroll
    for (int i = 0; i < 8; ++i) {
      int q = lane + 64 * i;
      if (q < 480) {
        int c = q * 4;
        f32x4 cur = *(const f32x4*)(row + c);
        f32x4 pv = hp ? *(const f32x4*)(row - 1920 + c) : f32x4{0.f, 0.f, 0.f, 0.f};
        f32x4 nv = hn ? *(const f32x4*)(row + 1920 + c) : f32x4{0.f, 0.f, 0.f, 0.f};
        f32x4 m4 = *(const f32x4*)(mu + c);
        f32x4 xb;
#pragma unroll
        for (int j = 0; j < 4; ++j) xb[j] = cur[j] + m4[j] * (0.5f * (pv[j] + nv[j]) - cur[j]);
        if (i < 6) {
          *(f32x4*)((float*)(ws + O_XRKV) + (size_t)tok * 1536 + c) = xb;
          if (i == 2 || i == 3) {
            int ck = c - 512;
            f32x4 kw = *(const f32x4*)(kkw + ck);
            f32x4 kv;
            float ss = 0.f;
#pragma unroll
            for (int j = 0; j < 4; ++j) { kv[j] = xb[j] * kw[j]; ss += kv[j] * kv[j]; }
            ss = row_sum16(ss);
            float rn = rsqrtf(ss + 1e-12f);
#pragma unroll
            for (int j = 0; j < 4; ++j) kv[j] *= rn;
            *(f32x4*)((float*)(ws + O_KK) + (size_t)tok * 512 + ck) = kv;
          }
        } else {
          u16* dst;
          int cc;
          float v[4];
          if (c < 1664) { dst = (u16*)(ws + O_TW); cc = c - 1536; for (int j = 0; j < 4; ++j) v[j] = tanhf(xb[j]); }
          else if (c < 1792) { dst = (u16*)(ws + O_AD); cc = c - 1664; for (int j = 0; j < 4; ++j) v[j] = xb[j]; }
          else { dst = (u16*)(ws + O_SG); cc = c - 1792; for (int j = 0; j < 4; ++j) v[j] = sigmoidf_(xb[j]); }
          u32x2 o; o[0] = pack2(v[0], v[1]); o[1] = pack2(v[2], v[3]);
          *(u32x2*)(dst + (size_t)tok * 128 + cc) = o;
        }
      }
    }
  }
}

__device__ void phase_rwkv_lora(const Params& p, int l) {
  char* ws = opaque_ptr(p.ws);
  const int tid = opaque_tid();
  const int wid = tid >> 6, lane = tid & 63, wr = wid >> 1, wc = wid & 1, fr = lane & 15, fq = lane >> 4;
  for (int t = blockIdx.x; t < 5 * 256; t += gridDim.x) {
    const int job = t >> 8, r = t & 255, tm = r & 63, tn = r >> 6;
    const int brow = tm * 128, bcol = tn * 128;
    f32x4 acc[4][4];
    zero_acc(acc);
    const int z = job & 1;
    if (job < 2) gemm_main(tid, (const u16*)(ws + O_TW) + (size_t)brow * 128 + z * 64, 128, (const u16*)(ws + O_W2) + ((size_t)(l * 2 + z) * 512 + bcol) * 64, 64, 64, acc);
    else if (job < 4) gemm_main(tid, (const u16*)(ws + O_AD) + (size_t)brow * 128 + z * 64, 128, (const u16*)(ws + O_A2) + ((size_t)(l * 2 + z) * 512 + bcol) * 64, 64, 64, acc);
    else gemm_main(tid, (const u16*)(ws + O_SG) + (size_t)brow * 128, 128, (const u16*)(ws + O_G2) + ((size_t)l * 512 + bcol) * 128, 128, 128, acc);
#pragma unroll
    for (int m = 0; m < 4; ++m) {
      const int tok = brow + wr * 64 + m * 16 + fr;
#pragma unroll
      for (int n = 0; n < 4; ++n) {
        const int c = bcol + wc * 64 + n * 16 + fq * 4;
        if (job < 2) {
          f32x4 w0 = *(const f32x4*)(p.in[18] + (size_t)(l * 2 + z) * 512 + c);
          f32x4 o;
#pragma unroll
          for (int j = 0; j < 4; ++j) {
            float val = w0[j] + acc[m][n][j];
            float y = -val;
            float sp = fmaxf(y, 0.f) + log1pf(__expf(-fabsf(y)));
            float wlog = -sp - 0.5f;
            o[j] = __expf(-__expf(wlog));
          }
          *(f32x4*)((float*)(ws + O_DEC) + ((size_t)z * NT + tok) * 512 + c) = o;
        } else if (job < 4) {
          f32x4 a0 = *(const f32x4*)(p.in[20] + (size_t)(l * 2 + z) * 512 + c);
          f32x4 ka = *(const f32x4*)(p.in[24] + (size_t)l * 512 + c);
          f32x4 kx = *(const f32x4*)((const float*)(ws + O_XRKV) + (size_t)tok * 1536 + 512 + c);
          f32x4 kk = *(const f32x4*)((const float*)(ws + O_KK) + (size_t)tok * 512 + c);
          f32x4 okd, okka;
#pragma unroll
          for (int j = 0; j < 4; ++j) {
            float a = sigmoidf_(a0[j] + acc[m][n][j]);
            okd[j] = kx[j] * (1.f + (a - 1.f) * ka[j]);
            okka[j] = kk[j] * a;
          }
          *(f32x4*)((float*)(ws + O_KD) + ((size_t)z * NT + tok) * 512 + c) = okd;
          *(f32x4*)((float*)(ws + O_KKA) + ((size_t)z * NT + tok) * 512 + c) = okka;
        } else {
          *(f32x4*)((float*)(ws + O_GG) + (size_t)tok * 512 + c) = acc[m][n];
        }
      }
    }
  }
}

template <int JPL> struct ScanOps { float w[JPL], kd[JPL], kk[JPL], kka[JPL], r[JPL]; float v; };

template <int JPL>
DI void scan_load(ScanOps<JPL>& o, const float* __restrict__ dec, const float* __restrict__ kd, const float* __restrict__ kk,
                  const float* __restrict__ kka, const float* __restrict__ rr, const float* __restrict__ vv, int tok, int cj, int ci) {
  const size_t e = (size_t)tok * 512 + cj;
#pragma unroll
  for (int q = 0; q < JPL / 4; ++q) {
    f32x4 a = *(const f32x4*)(dec + e + q * 4), b = *(const f32x4*)(kd + e + q * 4), c = *(const f32x4*)(kk + e + q * 4),
          d = *(const f32x4*)(kka + e + q * 4), f = *(const f32x4*)(rr + (size_t)tok * 1536 + cj + q * 4);
#pragma unroll
    for (int j = 0; j < 4; ++j) { o.w[q * 4 + j] = a[j]; o.kd[q * 4 + j] = b[j]; o.kk[q * 4 + j] = c[j]; o.kka[q * 4 + j] = d[j]; o.r[q * 4 + j] = f[j]; }
  }
  o.v = vv[(size_t)tok * 1536 + 1024 + ci];
}

template <int JPL> DI float scan_red(float v) {
  v += dppf<0xB1>(v);
  v += dppf<0x4E>(v);
  if (JPL <= 8) v += dppf<0x141>(v);
  if (JPL <= 4) v += dppf<0x140>(v);
  return v;
}

template <int JPL>
DI void scan_step(float (&S)[JPL], const ScanOps<JPL>& o, float* __restrict__ y, int tok, int ci, bool wr) {
  float sa0 = 0.f, sa1 = 0.f;
#pragma unroll
  for (int j = 0; j < JPL; j += 2) { sa0 += S[j] * o.kk[j]; sa1 += S[j + 1] * o.kk[j + 1]; }
  float sa = -scan_red<JPL>(sa0 + sa1);
  float y0 = 0.f, y1 = 0.f;
#pragma unroll
  for (int j = 0; j < JPL; j += 2) {
    S[j] = S[j] * o.w[j] + (sa * o.kka[j] + o.v * o.kd[j]);
    S[j + 1] = S[j + 1] * o.w[j + 1] + (sa * o.kka[j + 1] + o.v * o.kd[j + 1]);
    y0 += S[j] * o.r[j]; y1 += S[j + 1] * o.r[j + 1];
  }
  float yv = scan_red<JPL>(y0 + y1);
  if (wr) y[(size_t)tok * 512 + ci] = yv;
}

template <int JPL, int D>
DI void scan_wave(char* ws, int lane, int z, int h, int tok0, int T, int rowbase, const float* __restrict__ s0, float* __restrict__ sout) {
  constexpr int LPR = 64 / JPL;
  const int rr = lane / LPR, pp = lane % LPR;
  const int i = rowbase + rr, j0 = pp * JPL;
  const int cj = h * 64 + j0, ci = h * 64 + i;
  const float* dec = (const float*)(ws + O_DEC) + (size_t)z * NT * 512;
  const float* kd = (const float*)(ws + O_KD) + (size_t)z * NT * 512;
  const float* kka = (const float*)(ws + O_KKA) + (size_t)z * NT * 512;
  const float* kk = (const float*)(ws + O_KK);
  const float* xr = (const float*)(ws + O_XRKV);
  float* y = (float*)(ws + O_YS) + (size_t)z * NT * 512;
  float S[JPL];
#pragma unroll
  for (int j = 0; j < JPL; ++j) S[j] = s0 ? s0[i * 64 + j0 + j] : 0.f;
  const int dir = z == 0 ? 1 : -1;
  const int first = z == 0 ? tok0 : tok0 + T - 1;
  const bool wr = pp == 0;
  ScanOps<JPL> R[D];
#pragma unroll
  for (int d = 0; d < D; ++d) scan_load<JPL>(R[d], dec, kd, kk, kka, xr, xr, first + dir * d, cj, ci);
  for (int n = 0; n < T; n += D) {
#pragma unroll
    for (int d = 0; d < D; ++d) {
      scan_step<JPL>(S, R[d], y, first + dir * (n + d), ci, wr);
      int nn = n + d + D;
      nn = nn < T ? nn : T - 1;
      scan_load<JPL>(R[d], dec, kd, kk, kka, xr, xr, first + dir * nn, cj, ci);
    }
  }
  if (sout) {
#pragma unroll
    for (int j = 0; j < JPL; ++j) sout[i * 64 + j0 + j] = S[j];
  }
}

DI void dma16(const char* gptr, unsigned ldsaddr) {
  asm volatile("s_mov_b32 m0, %0\n\ts_nop 0\n\tglobal_load_lds_dwordx4 %1, off" ::"s"(ldsaddr), "v"(gptr) : "memory");
}
template <int N> DI void wait_vm() { asm volatile("s_waitcnt vmcnt(%0)" ::"n"(N) : "memory"); }

template <int JPL> struct ScanRegs { float w[JPL], kd[JPL], kk[JPL], kka[JPL], r[JPL]; float v; };
template <int JPL> DI void scan_lds_read(ScanRegs<JPL>& o, const char* slot, int pp, int rr) {
#pragma unroll
  for (int q = 0; q < JPL / 4; ++q) {
    f32x4 a = *(const f32x4*)(slot + 0 + pp * JPL * 4 + q * 16), b = *(const f32x4*)(slot + 256 + pp * JPL * 4 + q * 16),
          c = *(const f32x4*)(slot + 512 + pp * JPL * 4 + q * 16), d = *(const f32x4*)(slot + 768 + pp * JPL * 4 + q * 16),
          f = *(const f32x4*)(slot + 1024 + pp * JPL * 4 + q * 16);
#pragma unroll
    for (int j = 0; j < 4; ++j) { o.w[q * 4 + j] = a[j]; o.kd[q * 4 + j] = b[j]; o.kk[q * 4 + j] = c[j]; o.kka[q * 4 + j] = d[j]; o.r[q * 4 + j] = f[j]; }
  }
  o.v = *(const float*)(slot + 1280 + rr * 4);
}
template <int JPL>
DI void scan_step2(float (&S)[JPL], const ScanRegs<JPL>& o, float* __restrict__ yp, bool wr) {
  float sa0 = 0.f, sa1 = 0.f;
#pragma unroll
  for (int j = 0; j < JPL; j += 2) { sa0 += S[j] * o.kk[j]; sa1 += S[j + 1] * o.kk[j + 1]; }
  float sa = -scan_red<JPL>(sa0 + sa1);
  float y0 = 0.f, y1 = 0.f;
#pragma unroll
  for (int j = 0; j < JPL; j += 2) {
    S[j] = sa * o.kka[j] + (S[j] * o.w[j] + o.v * o.kd[j]);
    S[j + 1] = sa * o.kka[j + 1] + (S[j + 1] * o.w[j + 1] + o.v * o.kd[j + 1]);
    y0 += S[j] * o.r[j]; y1 += S[j + 1] * o.r[j + 1];
  }
  float yv = scan_red<JPL>(y0 + y1);
  if (wr) *yp = yv;
}

template <int JPL, int NS>
DI void scan_wave_dma(char* ws, int lane, int ringoff, int z, int h, int tok0, int T, int rowbase, const float* __restrict__ s0,
                      float* __restrict__ sout) {
  constexpr int LPR = 64 / JPL, PD = NS - 1, WN = 3 * PD - 3;
  static_assert(WN <= 63, "vmcnt range");
  const int rr = lane / LPR, pp = lane % LPR;
  const int i = rowbase + rr, j0 = pp * JPL;
  const int dir = z == 0 ? 1 : -1;
  const int first = z == 0 ? tok0 : tok0 + T - 1;
  const bool wr = pp == 0;
  float S[JPL];
#pragma unroll
  for (int j = 0; j < JPL; ++j) S[j] = s0 ? s0[i * 64 + j0 + j] : 0.f;
  const int a = lane >> 4, c16 = lane & 15;
  const float* arr = a == 0 ? (const float*)(ws + O_DEC) + (size_t)z * NT * 512
                   : a == 1 ? (const float*)(ws + O_KD) + (size_t)z * NT * 512
                   : a == 2 ? (const float*)(ws + O_KK)
                            : (const float*)(ws + O_KKA) + (size_t)z * NT * 512;
  const char* gA = (const char*)(arr + (size_t)first * 512 + h * 64 + c16 * 4);
  const char* gB = (const char*)((const float*)(ws + O_XRKV) + (size_t)first * 1536 + (lane < 16 ? h * 64 + c16 * 4 : 1024 + h * 64 + rowbase + (lane - 16) * 4));
  const long stA = (long)dir * 2048, stB = (long)dir * 6144;
  const bool bact = lane < 16 + JPL / 4;
  ringoff = __builtin_amdgcn_readfirstlane(ringoff);
  const unsigned ring = (unsigned)(size_t)g_smem + (unsigned)ringoff;
  const char* ringp = g_smem + ringoff;
  float* yp = (float*)(ws + O_YS) + (size_t)z * NT * 512 + (size_t)first * 512 + h * 64 + i;
  const long sty = (long)dir * 512;
  float* dummy = (float*)(ws + O_MERG) + lane;
#pragma unroll 1
  for (int s = 0; s < PD; ++s) {
    unsigned slot = ring + (unsigned)(s & (NS - 1)) * 1536u;
    dma16(gA, slot);
    if (bact) dma16(gB, slot + 1024u);
    gA += stA; gB += stB;
    if (wr) dummy[s * 64] = 0.f;
  }
  ScanRegs<JPL> A, B;
  wait_vm<3 * PD - 3>();
  wait_vm<3 * (PD - 1)>();
  scan_lds_read<JPL>(A, ringp, pp, rr);
  for (int n = 0; n < T; n += 2) {
    {
      unsigned sl = (unsigned)((n + PD) & (NS - 1)) * 1536u;
      dma16(gA, ring + sl);
      if (bact) dma16(gB, ring + sl + 1024u);
      gA += stA; gB += stB;
      wait_vm<WN>();
      scan_lds_read<JPL>(B, ringp + ((n + 1) & (NS - 1)) * 1536, pp, rr);
      scan_step2<JPL>(S, A, yp, wr);
      yp += sty;
    }
    {
      unsigned sl = (unsigned)((n + 1 + PD) & (NS - 1)) * 1536u;
      dma16(gA, ring + sl);
      if (bact) dma16(gB, ring + sl + 1024u);
      gA += stA; gB += stB;
      wait_vm<WN>();
      scan_lds_read<JPL>(A, ringp + ((n + 2) & (NS - 1)) * 1536, pp, rr);
      scan_step2<JPL>(S, B, yp, wr);
      yp += sty;
    }
  }
  wait_vm<0>();
  if (sout) {
#pragma unroll
    for (int j = 0; j < JPL; ++j) sout[i * 64 + j0 + j] = S[j];
  }
}

template <int JPL>
DI void scan_dots(const float (&S)[JPL], const ScanRegs<JPL>& cur, const ScanRegs<JPL>& prv, float& d1, float& d2) {
  float a0 = 0.f, a1 = 0.f, b0 = 0.f, b1 = 0.f;
#pragma unroll
  for (int j = 0; j < JPL; j += 2) {
    a0 += S[j] * cur.kk[j]; b0 += S[j] * prv.r[j];
    a1 += S[j + 1] * cur.kk[j + 1]; b1 += S[j + 1] * prv.r[j + 1];
  }
  d1 = a0 + a1; d2 = b0 + b1;
}
template <int JPL> DI void scan_red2(float& a, float& b) {
  a += dppf<0xB1>(a); b += dppf<0xB1>(b);
  a += dppf<0x4E>(a); b += dppf<0x4E>(b);
  if (JPL <= 8) { a += dppf<0x141>(a); b += dppf<0x141>(b); }
  if (JPL <= 4) { a += dppf<0x140>(a); b += dppf<0x140>(b); }
}
template <int JPL> DI void scan_pre(float (&Tm)[JPL], const float (&S)[JPL], const ScanRegs<JPL>& o) {
#pragma unroll
  for (int j = 0; j < JPL; ++j) Tm[j] = S[j] * o.w[j] + o.v * o.kd[j];
}
template <int JPL> DI void scan_update(float (&S)[JPL], const float (&Tm)[JPL], const ScanRegs<JPL>& o, float sa) {
#pragma unroll
  for (int j = 0; j < JPL; ++j) S[j] = sa * o.kka[j] + Tm[j];
}

template <int JPL>
DI void scan_latent_block(char* ws, int tid, int z, int h, int tok0, int rowblock, const float* __restrict__ s0) {
  constexpr int LPR = 64 / JPL, G = 7, T = 2048, WNV = 6 * G - 2;
  const int wid = __builtin_amdgcn_readfirstlane(tid >> 6), lane = tid & 63;
  const int rr = lane / LPR, pp = lane % LPR;
  const int rloc = wid * JPL + rr;
  const int i = rowblock + rloc, j0 = pp * JPL;
  const int dir = z == 0 ? 1 : -1;
  const int first = z == 0 ? tok0 : tok0 + T - 1;
  const bool wr = pp == 0;
  float S[JPL];
#pragma unroll
  for (int j = 0; j < JPL; ++j) S[j] = s0[i * 64 + j0 + j];
  const int a = lane >> 4, c16 = lane & 15;
  const float* arr = a == 0 ? (const float*)(ws + O_DEC) + (size_t)z * NT * 512
                   : a == 1 ? (const float*)(ws + O_KD) + (size_t)z * NT * 512
                   : a == 2 ? (const float*)(ws + O_KK)
                            : (const float*)(ws + O_KKA) + (size_t)z * NT * 512;
  const int fw = first + dir * wid;
  const char* gA = (const char*)(arr + (size_t)fw * 512 + h * 64 + c16 * 4);
  const char* gB = (const char*)((const float*)(ws + O_XRKV) + (size_t)fw * 1536 + (lane < 16 ? h * 64 + c16 * 4 : 1024 + h * 64 + rowblock + (lane - 16) * 4));
  const long stA = (long)dir * 4 * 2048, stB = (long)dir * 4 * 6144;
  const bool bact = lane < 16 + JPL;
  const unsigned ring = (unsigned)(size_t)g_smem;
  const char* ringp = g_smem;
  float* yp = (float*)(ws + O_YS) + (size_t)z * NT * 512 + (size_t)first * 512 + h * 64 + i;
  const long sty = (long)dir * 512;
  float* dummy = (float*)(ws + O_MERG) + tid;
#pragma unroll 1
  for (int g = 0; g < G; ++g) {
    unsigned slot = ring + (unsigned)((4 * g + wid) & 31) * 1536u;
    dma16(gA, slot);
    if (bact) dma16(gB, slot + 1024u);
    gA += stA; gB += stB;
    if (wr) { dummy[(g * 4 + 0) * 256] = 0.f; }
    if (wr) { dummy[(g * 4 + 1) * 256] = 0.f; }
    if (wr) { dummy[(g * 4 + 2) * 256] = 0.f; }
    if (wr) { dummy[(g * 4 + 3) * 256] = 0.f; }
    asm volatile("" ::: "memory");
  }
  ScanRegs<JPL> A, B;
#pragma unroll
  for (int j = 0; j < JPL; ++j) B.r[j] = 0.f;
  float* ypv = dummy + 28 * 256;
  wait_vm<WNV>();
  asm volatile("" ::: "memory");
  __builtin_amdgcn_s_barrier();
  asm volatile("" ::: "memory");
  scan_lds_read<JPL>(A, ringp, pp, rloc);
#pragma unroll 1
  for (int g = 0; g < T / 4; ++g) {
    wait_vm<WNV - 6>();

    asm volatile("" ::: "memory");
    __builtin_amdgcn_s_barrier();
    asm volatile("" ::: "memory");
    {
      unsigned slot = ring + (unsigned)((4 * (g + G) + wid) & 31) * 1536u;
      dma16(gA, slot);
      if (bact) dma16(gB, slot + 1024u);
      gA += stA; gB += stB;
    }
    const char* gp = ringp + ((4 * g) & 31) * 1536;
    float d1, y0, y1, y2, y3;
    float Tm[JPL];
    scan_dots<JPL>(S, A, B, d1, y0);
    scan_pre<JPL>(Tm, S, A);
    scan_lds_read<JPL>(B, gp + 1536, pp, rloc);
    scan_red2<JPL>(d1, y0);
    scan_update<JPL>(S, Tm, A, -d1);
    scan_dots<JPL>(S, B, A, d1, y1);
    scan_pre<JPL>(Tm, S, B);
    scan_lds_read<JPL>(A, gp + 2 * 1536, pp, rloc);
    scan_red2<JPL>(d1, y1);
    scan_update<JPL>(S, Tm, B, -d1);
    scan_dots<JPL>(S, A, B, d1, y2);
    scan_pre<JPL>(Tm, S, A);
    scan_lds_read<JPL>(B, gp + 3 * 1536, pp, rloc);
    scan_red2<JPL>(d1, y2);
    scan_update<JPL>(S, Tm, A, -d1);
    scan_dots<JPL>(S, B, A, d1, y3);
    scan_pre<JPL>(Tm, S, B);
    scan_lds_read<JPL>(A, ringp + ((4 * g + 4) & 31) * 1536, pp, rloc);
    scan_red2<JPL>(d1, y3);
    scan_update<JPL>(S, Tm, B, -d1);
    if (wr) {
      *ypv = y0;
      yp[0] = y1;
      yp[sty] = y2;
      yp[2 * sty] = y3;
    }
    ypv = yp + 3 * sty;
    yp += 4 * sty;
    asm volatile("" ::: "memory");
  }
  {
    float e0 = 0.f, e1 = 0.f;
#pragma unroll
    for (int j = 0; j < JPL; j += 2) { e0 += S[j] * B.r[j]; e1 += S[j + 1] * B.r[j + 1]; }
    float yv = scan_red<JPL>(e0 + e1);
    if (wr) *ypv = yv;
  }
  wait_vm<0>();
  asm volatile("" ::: "memory");
  __builtin_amdgcn_s_barrier();
  asm volatile("" ::: "memory");
}

struct AttnSt { float m, l; f32x4 o[4]; };

struct AttnKVF { bf16x8 k[2][2]; bf16x8 v[4]; };
DI void attn_kvload(AttnKVF& f, const u16* __restrict__ kp, int ldk, const u16* __restrict__ vtp, int ldv, int fr, int fq) {
#pragma unroll
  for (int kt = 0; kt < 2; ++kt)
#pragma unroll
    for (int ks = 0; ks < 2; ++ks) f.k[kt][ks] = *(const bf16x8*)(kp + (size_t)(8 * (fr >> 2) + 4 * kt + (fr & 3)) * ldk + ks * 32 + fq * 8);
#pragma unroll
  for (int dt = 0; dt < 4; ++dt) f.v[dt] = *(const bf16x8*)(vtp + (size_t)(dt * 16 + fr) * ldv + fq * 8);
}
template <int MODE>
DI void attn_core(AttnSt& st, const bf16x8 (&qf)[2], const AttnKVF& f, int fr, int fq, int qpos, int kpos0, const float* __restrict__ rpbrow) {
  f32x4 s[2];
#pragma unroll
  for (int kt = 0; kt < 2; ++kt) {
    s[kt] = f32x4{0.f, 0.f, 0.f, 0.f};
#pragma unroll
    for (int ks = 0; ks < 2; ++ks) s[kt] = mfma16(f.k[kt][ks], qf[ks], s[kt]);
  }
  if (MODE != 0) {
#pragma unroll
    for (int kt = 0; kt < 2; ++kt)
#pragma unroll
      for (int j = 0; j < 4; ++j) {
        int kpos = kpos0 + 8 * fq + 4 * kt + j;
        if (MODE == 1) {
          int d = qpos - kpos;
          if (d > 128 || d < -128) s[kt][j] = -1e30f;
        } else {
          int cs = min(max(qpos - 8, 0), 48);
          int dc = min(max(kpos - qpos, -15), 15) + 15;
          float b = rpbrow[dc];
          s[kt][j] = (kpos >= cs && kpos < cs + 16) ? s[kt][j] + b : -1e30f;
        }
      }
  }
  float mx = fmaxf(fmaxf(fmaxf(s[0][0], s[0][1]), fmaxf(s[0][2], s[0][3])), fmaxf(fmaxf(s[1][0], s[1][1]), fmaxf(s[1][2], s[1][3])));
  mx = fmaxf(mx, __shfl_xor(mx, 16));
  mx = fmaxf(mx, __shfl_xor(mx, 32));
  float mn = fmaxf(st.m, mx);
  float alpha = __expf(st.m - mn);
  st.m = mn;
  float ps = 0.f;
  float pv[8];
#pragma unroll
  for (int kt = 0; kt < 2; ++kt)
#pragma unroll
    for (int j = 0; j < 4; ++j) { float e = __expf(s[kt][j] - mn); pv[kt * 4 + j] = e; ps += e; }
  st.l = st.l * alpha + ps;
  u32x4 pk;
  pk[0] = pack2(pv[0], pv[1]); pk[1] = pack2(pv[2], pv[3]); pk[2] = pack2(pv[4], pv[5]); pk[3] = pack2(pv[6], pv[7]);
  bf16x8 pf = __builtin_bit_cast(bf16x8, pk);
#pragma unroll
  for (int dt = 0; dt < 4; ++dt) {
    bf16x8 vf = f.v[dt];
#pragma unroll
    for (int j = 0; j < 4; ++j) st.o[dt][j] *= alpha;
    st.o[dt] = mfma16(vf, pf, st.o[dt]);
  }
}

DI void attn_item(const Params& p, char* ws, int lane, int l, int item) {
  const int fr = lane & 15, fq = lane >> 4;
  const int type = item >> 10, r = item & 1023;
  const int h = r & 7, qp = r >> 3;
  AttnSt st[2];
  const u16* Q;
  u16* Y;
  if (type == 0 || type == 2) { Q = (const u16*)(ws + O_QA); Y = (u16*)(ws + O_YABC); }
  else { Q = (const u16*)(ws + O_QC); Y = (u16*)(ws + O_YABC) + 2ull * NT * 512; }
  const int tok0 = (type < 2 ? NCTX : 0) + qp * 32;
  bf16x8 qf[2][2];
  const bool hasSink = (type == 0 || type == 2);
#pragma unroll
  for (int i = 0; i < 2; ++i) {
#pragma unroll
    for (int dt = 0; dt < 4; ++dt) st[i].o[dt] = f32x4{0.f, 0.f, 0.f, 0.f};
#pragma unroll
    for (int ks = 0; ks < 2; ++ks) qf[i][ks] = *(const bf16x8*)(Q + (size_t)(tok0 + i * 16 + fr) * 512 + h * 64 + ks * 32 + fq * 8);
    if (hasSink) { st[i].m = p.in[15][l * 8 + h]; st[i].l = fq == 0 ? 1.f : 0.f; }
    else { st[i].m = -1e30f; st[i].l = 0.f; }
  }
  AttnKVF f;
  if (type == 0) {
    const int qt = qp * 2;
    const int b = qt >> 7, kv = h >> 2;
    const u16* ck = (const u16*)(ws + O_CAK) + ((size_t)(b * 4 + l) * 512) * 128 + kv * 64;
    const u16* cvt = (const u16*)(ws + O_CAVT) + ((size_t)(b * 4 + l) * 128 + kv * 64) * 512;
    for (int p0 = 0; p0 < 512; p0 += 32) {
      attn_kvload(f, ck + (size_t)p0 * 128, 128, cvt + p0, 512, fr, fq);
      attn_core<0>(st[0], qf[0], f, fr, fq, 0, 0, nullptr);
      attn_core<0>(st[1], qf[1], f, fr, fq, 0, 0, nullptr);
    }
    const u16* K = (const u16*)(ws + O_KA) + (size_t)(NCTX + b * 2048) * 128 + kv * 64;
    const u16* VT = (const u16*)(ws + O_VAT) + (size_t)(kv * 64) * NT + NCTX + b * 2048;
    const int ta = (qt & 127) * 16;
    const int kb0 = max(0, ((ta - 128) >> 5) << 5), kb1 = min(2048, ta + 32 + 128);
    for (int k0 = kb0; k0 < kb1; k0 += 32) {
      attn_kvload(f, K + (size_t)k0 * 128, 128, VT + k0, NT, fr, fq);
      attn_core<1>(st[0], qf[0], f, fr, fq, ta + fr, k0, nullptr);
      attn_core<1>(st[1], qf[1], f, fr, fq, ta + 16 + fr, k0, nullptr);
    }
  } else if (type == 1) {
    const int qt = qp * 2;
    const int b = qt >> 7;
    const u16* ck = (const u16*)(ws + O_CCK) + ((size_t)(b * 4 + l) * 512) * 512 + h * 64;
    const u16* cvt = (const u16*)(ws + O_CCVT) + ((size_t)(b * 4 + l) * 512 + h * 64) * 512;
    for (int p0 = 0; p0 < 512; p0 += 32) {
      attn_kvload(f, ck + (size_t)p0 * 512, 512, cvt + p0, 512, fr, fq);
      attn_core<0>(st[0], qf[0], f, fr, fq, 0, 0, nullptr);
      attn_core<0>(st[1], qf[1], f, fr, fq, 0, 0, nullptr);
    }
    const u16* K = (const u16*)(ws + O_KC) + (size_t)(NCTX + b * 2048) * 512 + h * 64;
    const u16* VT = (const u16*)(ws + O_VCT) + (size_t)(h * 64) * NT + NCTX + b * 2048;
    const float* rpb = p.in[29] + (size_t)(l * 8 + h) * 15 * 31;
#pragma unroll
    for (int i = 0; i < 2; ++i) {
      const int t0 = ((qt + i) & 127) * 16;
      const int qrow = t0 >> 6, c0 = t0 & 63;
      const int rs = min(max(qrow - 4, 0), 24);
      const int cstart = min(max(c0 - 8, 0), 32);
      for (int a = 0; a < 8; ++a) {
        int krow = rs + a;
        int k0 = krow * 64 + cstart;
        attn_kvload(f, K + (size_t)k0 * 512, 512, VT + k0, NT, fr, fq);
        attn_core<2>(st[i], qf[i], f, fr, fq, c0 + fr, cstart, rpb + (krow - qrow + 7) * 31);
      }
    }
  } else if (type == 2) {
    const int b = (qp * 2) >> 4, kv = h >> 2;
    const u16* K = (const u16*)(ws + O_KA) + (size_t)(b * 256) * 128 + kv * 64;
    const u16* VT = (const u16*)(ws + O_VAT) + (size_t)(kv * 64) * NT + b * 256;
    for (int k0 = 0; k0 < 256; k0 += 32) {
      attn_kvload(f, K + (size_t)k0 * 128, 128, VT + k0, NT, fr, fq);
      attn_core<0>(st[0], qf[0], f, fr, fq, 0, 0, nullptr);
      attn_core<0>(st[1], qf[1], f, fr, fq, 0, 0, nullptr);
    }
  } else {
    const int b = (qp * 2) >> 4;
    const u16* K = (const u16*)(ws + O_KC) + (size_t)(b * 256) * 512 + h * 64;
    const u16* VT = (const u16*)(ws + O_VCT) + (size_t)(h * 64) * NT + b * 256;
    for (int k0 = 0; k0 < 256; k0 += 32) {
      attn_kvload(f, K + (size_t)k0 * 512, 512, VT + k0, NT, fr, fq);
      attn_core<0>(st[0], qf[0], f, fr, fq, 0, 0, nullptr);
      attn_core<0>(st[1], qf[1], f, fr, fq, 0, 0, nullptr);
    }
  }
#pragma unroll
  for (int i = 0; i < 2; ++i) {
    float lt = st[i].l;
    lt += __shfl_xor(lt, 16);
    lt += __shfl_xor(lt, 32);
    float inv = 1.f / lt;
#pragma unroll
    for (int dt = 0; dt < 4; ++dt) {
      u32x2 o; o[0] = pack2(st[i].o[dt][0] * inv, st[i].o[dt][1] * inv); o[1] = pack2(st[i].o[dt][2] * inv, st[i].o[dt][3] * inv);
      *(u32x2*)(Y + (size_t)(tok0 + i * 16 + fr) * 512 + h * 64 + dt * 16 + fq * 4) = o;
    }
  }
}


__device__ void phase_mix(const Params& p, int l) {
  char* ws = opaque_ptr(p.ws);
  const int tid = opaque_tid();
  const int wid = tid >> 6, lane = tid & 63;
  constexpr int LJPL = 4;
  constexpr int BPS = 64 / (4 * LJPL);
  const int NLB = (int)gridDim.x >= 2 * 32 * BPS ? 32 * BPS : 0;
  if ((int)blockIdx.x < NLB) {
    __builtin_amdgcn_s_setprio(3);
    const int it = blockIdx.x;
    const int sc = it / BPS, hf = it % BPS;
    const int z = sc & 1, h = (sc >> 1) & 7, b = sc >> 4;
    const float* s0 = p.in[6] + ((size_t)((b * 4 + l) * 2 + z) * 8 + h) * 4096;
    scan_latent_block<LJPL>(ws, tid, z, h, NCTX + b * 2048, hf * 4 * LJPL, s0);
  } else {
    __builtin_amdgcn_s_setprio(1);
    if (NLB == 0) {
      for (int it = blockIdx.x * 4 + wid; it < 256; it += gridDim.x * 4) {
        int sc = it >> 3, part = it & 7;
        int z = sc & 1, h = (sc >> 1) & 7, b = sc >> 4;
        const float* s0 = p.in[6] + ((size_t)((b * 4 + l) * 2 + z) * 8 + h) * 4096;
        scan_wave_dma<8, 8>(ws, lane, wid * 12288, z, h, NCTX + b * 2048, 2048, part * 8, s0, nullptr);
      }
    }
    const int nw = (gridDim.x - NLB) * 4;
    for (int it = ((int)blockIdx.x - NLB) * 4 + wid; it < 2048; it += nw) {
      int sc = it >> 3, part = it & 7;
      int z = sc & 1, h = (sc >> 1) & 7, b = sc >> 4;
      float* so = p.out + OUT_ST + ((size_t)((b * 4 + l) * 2 + z) * 8 + h) * 4096;
      scan_wave_dma<8, 8>(ws, lane, wid * 12288, z, h, b * 256, 256, part * 8, nullptr, so);
    }
  }
  __builtin_amdgcn_s_setprio(0);
  int* cnt = (int*)(ws + O_CNT) + l;
  while (true) {
    int it = 0;
    if (lane == 0) it = atomicAdd(cnt, 1);
    it = __builtin_amdgcn_readfirstlane(it);
    if (it >= 4096) break;
    attn_item(p, ws, lane, l, it);
  }
  if (l == 0) {
    int* cnt2 = (int*)(ws + O_CNT) + 8;
    while (true) {
      int it = 0;
      if (lane == 0) it = atomicAdd(cnt2, 1);
      it = __builtin_amdgcn_readfirstlane(it);
      if (it >= 4096) break;
      const int tab = it >> 11, rb = (it & 2047) * 32;
      if (tab == 0) convert_rows_fp8_wave(lane, p.in[34], (unsigned char*)(ws + O_PEU), (float*)(ws + O_SCU), rb, rb + 32);
      else convert_rows_fp8_wave(lane, p.in[35], (unsigned char*)(ws + O_PEV), (float*)(ws + O_SCV), rb, rb + 32);
    }
  }
}

__device__ void phase_rwkv_post(const Params& p, int l) {
  char* ws = opaque_ptr(p.ws);
  const int tid = opaque_tid();
  const int lane = tid & 63;
  const int gw = blockIdx.x * 4 + (tid >> 6), GW = gridDim.x * 4;
  const float* Y0 = (const float*)(ws + O_YS);
  const float* Y1 = Y0 + (size_t)NT * 512;
  const float* KD0 = (const float*)(ws + O_KD);
  const float* KD1 = KD0 + (size_t)NT * 512;
  for (int tok = gw; tok < NT; tok += GW) {
#pragma unroll
    for (int i = 0; i < 2; ++i) {
      int c = (lane + 64 * i) * 4;
      size_t e = (size_t)tok * 512 + c;
      f32x4 a = *(const f32x4*)(Y0 + e), b = *(const f32x4*)(Y1 + e);
      f32x4 y;
      float s = 0.f;
#pragma unroll
      for (int j = 0; j < 4; ++j) { y[j] = a[j] + b[j]; s += y[j]; }
      float mu = row_sum16(s) * (1.f / 64.f);
      float vs = 0.f;
#pragma unroll
      for (int j = 0; j < 4; ++j) { y[j] -= mu; vs += y[j] * y[j]; }
      float var = row_sum16(vs) * (1.f / 64.f);
      float rstd = rsqrtf(var + 64e-5f);
      f32x4 g = *(const f32x4*)(p.in[26] + l * 512 + c), bb = *(const f32x4*)(p.in[27] + l * 512 + c);
      f32x4 r = *(const f32x4*)((const float*)(ws + O_XRKV) + (size_t)tok * 1536 + c);
      f32x4 v = *(const f32x4*)((const float*)(ws + O_XRKV) + (size_t)tok * 1536 + 1024 + c);
      f32x4 k0 = *(const f32x4*)(KD0 + e), k1 = *(const f32x4*)(KD1 + e);
      f32x4 rk = *(const f32x4*)(p.in[25] + l * 512 + c);
      float bs = 0.f;
#pragma unroll
      for (int j = 0; j < 4; ++j) bs += r[j] * (k0[j] + k1[j]) * rk[j];
      bs = row_sum16(bs);
      f32x4 gg = *(const f32x4*)((const float*)(ws + O_GG) + e);
      float o[4];
#pragma unroll
      for (int j = 0; j < 4; ++j) o[j] = (y[j] * rstd * g[j] + bb[j] + bs * v[j]) * gg[j];
      u32x2 ov; ov[0] = pack2(o[0], o[1]); ov[1] = pack2(o[2], o[3]);
      *(u32x2*)((u16*)(ws + O_YABC) + (size_t)NT * 512 + e) = ov;
    }
  }
}

__device__ void phase_branch(const Params& p, int l) {
  char* ws = opaque_ptr(p.ws);
  const int tid = opaque_tid();
  const int wid = tid >> 6, lane = tid & 63, wr = wid >> 1, wc = wid & 1, fr = lane & 15, fq = lane >> 4;
  const u16* G = (const u16*)(ws + O_GATE);
  for (int t = blockIdx.x; t < 64 * 8; t += gridDim.x) {
    const int tm = t & 63, tn = t >> 6;
    const int brow = tm * 128, bcol = tn * 128;
    f32x4 tot[4][4];
    zero_acc(tot);
#pragma unroll 1
    for (int br = 0; br < 3; ++br) {
      f32x4 acc[4][4];
      zero_acc(acc);
      const u16* Wb = (const u16*)(ws + (br == 0 ? O_AOUT : br == 1 ? O_RWOUT : O_NAOUT)) + ((size_t)l * 1024 + bcol) * 512;
      gemm_main(tid, (const u16*)(ws + O_YABC) + (size_t)br * NT * 512 + (size_t)brow * 512, 512, Wb, 512, 512, acc, ((tm >> 3) + (tn & 7)) & 7);
#pragma unroll
      for (int m = 0; m < 4; ++m) {
        const int tok = brow + wr * 64 + m * 16 + fr;
#pragma unroll
        for (int n = 0; n < 4; ++n) {
          const int c = bcol + wc * 64 + n * 16 + fq * 4;
          u32x2 gv = *(const u32x2*)(G + (size_t)tok * 3072 + br * 1024 + c);
          tot[m][n][0] += acc[m][n][0] * __uint_as_float(gv[0] << 16);
          tot[m][n][1] += acc[m][n][1] * __uint_as_float(gv[0] & 0xffff0000u);
          tot[m][n][2] += acc[m][n][2] * __uint_as_float(gv[1] << 16);
          tot[m][n][3] += acc[m][n][3] * __uint_as_float(gv[1] & 0xffff0000u);
        }
      }
    }
#pragma unroll
    for (int m = 0; m < 4; ++m) {
      const int tok = brow + wr * 64 + m * 16 + fr;
#pragma unroll
      for (int n = 0; n < 4; ++n) {
        const int c = bcol + wc * 64 + n * 16 + fq * 4;
        u32x2 o; o[0] = pack2(tot[m][n][0], tot[m][n][1]); o[1] = pack2(tot[m][n][2], tot[m][n][3]);
        *(u32x2*)((u16*)(ws + O_MERG) + (size_t)tok * 1024 + c) = o;
      }
    }
  }
}

__device__ void phase_wo(const Params& p, int l) {
  char* ws = opaque_ptr(p.ws);
  const int tid = opaque_tid();
  const int wid = tid >> 6, lane = tid & 63, wr = wid >> 1, wc = wid & 1, fr = lane & 15, fq = lane >> 4;
  float* X = (float*)(ws + O_X);
  for (int t = blockIdx.x; t < 64 * 8; t += gridDim.x) {
    const int tm = t & 63, tn = t >> 6;
    const int brow = tm * 128, bcol = tn * 128;
    f32x4 acc[4][4];
    zero_acc(acc);
    gemm_main(tid, (const u16*)(ws + O_MERG) + (size_t)brow * 1024, 1024, (const u16*)(ws + O_WO) + ((size_t)l * 1024 + bcol) * 1024, 1024, 1024, acc, (((tm >> 3) + (tn & 7)) * 2) & 15);
#pragma unroll
    for (int m = 0; m < 4; ++m) {
      const int tok = brow + wr * 64 + m * 16 + fr;
      const float* gate = (const float*)(ws + O_MOD) + ((size_t)l * 3 + tok_cond(tok)) * 6144 + 2 * 1024;
#pragma unroll
      for (int n = 0; n < 4; ++n) {
        const int c = bcol + wc * 64 + n * 16 + fq * 4;
        f32x4 x = *(f32x4*)(X + (size_t)tok * 1024 + c);
        f32x4 g = *(const f32x4*)(gate + c);
#pragma unroll
        for (int j = 0; j < 4; ++j) x[j] += g[j] * acc[m][n][j];
        *(f32x4*)(X + (size_t)tok * 1024 + c) = x;
      }
    }
  }
}

__device__ void phase_peq(const Params& p, int l) {
  char* ws = opaque_ptr(p.ws);
  const int tid = opaque_tid();
  const int wid = tid >> 6, lane = tid & 63, wr = wid >> 1, wc = wid & 1, fr = lane & 15, fq = lane >> 4;
  for (int t = blockIdx.x; t < 64 * 16; t += gridDim.x) {
    const int tm = t & 63, tn = t >> 6;
    const int brow = tm * 128, bcol = tn * 128;
    f32x4 acc[4][4];
    zero_acc(acc);
    gemm_main(tid, (const u16*)(ws + O_H) + (size_t)brow * 1024, 1024, (const u16*)(ws + O_PEQ) + ((size_t)l * 2048 + bcol) * 1024, 1024, 1024, acc, (((tm >> 3) + (tn & 7)) * 2) & 15);
#pragma unroll
    for (int m = 0; m < 4; ++m) {
      const int tok = brow + wr * 64 + m * 16 + fr;
#pragma unroll
      for (int n = 0; n < 4; ++n) {
        const int c = bcol + wc * 64 + n * 16 + fq * 4;
        u32x2 o; o[0] = pack2(acc[m][n][0], acc[m][n][1]); o[1] = pack2(acc[m][n][2], acc[m][n][3]);
        *(u32x2*)((u16*)(ws + O_PQ) + (size_t)tok * 2048 + c) = o;
      }
    }
  }
}

__device__ const unsigned char kCand[64] = {
    0x00, 0x01, 0x02, 0x03, 0x04, 0x05, 0x06, 0x07, 0x08, 0x09, 0x0a, 0x0b, 0x0c, 0x0d, 0x0e, 0x0f,
    0x10, 0x11, 0x12, 0x13, 0x14, 0x15, 0x16, 0x17, 0x20, 0x21, 0x22, 0x23, 0x24, 0x30, 0x31, 0x32,
    0x33, 0x40, 0x41, 0x42, 0x50, 0x51, 0x60, 0x61, 0x70, 0x71, 0x80, 0x90, 0xa0, 0xb0, 0xc0, 0xd0,
    0xe0, 0xf0, 0xff, 0xff, 0xff, 0xff, 0xff, 0xff, 0xff, 0xff, 0xff, 0xff, 0xff, 0xff, 0xff, 0xff};

DI unsigned f2key(float f) { unsigned u = __float_as_uint(f); return (u & 0x80000000u) ? ~u : (u | 0x80000000u); }
DI float key2f(unsigned k) { unsigned u = (k & 0x80000000u) ? (k & 0x7fffffffu) : ~k; return __uint_as_float(u); }
template <int CTRL> DI unsigned dppu(unsigned v) { return (unsigned)__builtin_amdgcn_update_dpp(0, (int)v, CTRL, 0xf, 0xf, true); }
DI unsigned row_max16u(unsigned v) { v = max(v, dppu<0xB1>(v)); v = max(v, dppu<0x4E>(v)); v = max(v, dppu<0x141>(v)); v = max(v, dppu<0x140>(v)); return v; }

__device__ void phase_peer_sel(const Params& p, int l) {
  char* ws = opaque_ptr(p.ws);
  const int tid = opaque_tid();
  const int wid = tid >> 6, lane = tid & 63, fr = lane & 15, fq = lane >> 4;
  const int gw = blockIdx.x * 4 + wid, GW = gridDim.x * 4;
  float* lv = (float*)(g_smem + wid * 4096);
  int* li = (int*)(g_smem + wid * 4096 + 2048);
  const u16* PQ = (const u16*)(ws + O_PQ);
  int ca[4], cb[4];
  bool cvld[4];
#pragma unroll
  for (int c = 0; c < 4; ++c) { int code = kCand[c * 16 + fr]; cvld[c] = code != 0xff; ca[c] = (code >> 4) & 15; cb[c] = code & 15; }
  for (int it = gw; it < 512 * 8; it += GW) {
    const int h = it >> 9, tg = it & 511;
    const u16* SK = (const u16*)(ws + O_SUBK) + ((size_t)(l * 8 + h) * 2) * 128 * 128;
    f32x4 sc[2][8];
#pragma unroll
    for (int z = 0; z < 2; ++z) {
      bf16x8 qf[4];
#pragma unroll
      for (int ks = 0; ks < 4; ++ks) qf[ks] = *(const bf16x8*)(PQ + (size_t)(tg * 16 + fr) * 2048 + (h * 2 + z) * 128 + ks * 32 + fq * 8);
#pragma unroll
      for (int nt = 0; nt < 8; ++nt) {
        sc[z][nt] = f32x4{0.f, 0.f, 0.f, 0.f};
#pragma unroll
        for (int ks = 0; ks < 4; ++ks) {
          bf16x8 kf = *(const bf16x8*)(SK + ((size_t)z * 128 + nt * 16 + fr) * 128 + ks * 32 + fq * 8);
          sc[z][nt] = mfma16(qf[ks], kf, sc[z][nt]);
        }
      }
    }
#pragma unroll
    for (int z = 0; z < 2; ++z) {
#pragma unroll
      for (int j = 0; j < 4; ++j) {
        unsigned key[8];
#pragma unroll
        for (int nt = 0; nt < 8; ++nt) key[nt] = (f2key(sc[z][nt][j]) & ~127u) | (unsigned)(127 - (nt * 16 + fr));
        unsigned tk = 0u;
#pragma unroll 1
        for (int k = 0; k < 16; ++k) {
          unsigned m = key[0];
#pragma unroll
          for (int nt = 1; nt < 8; ++nt) m = max(m, key[nt]);
          unsigned M = row_max16u(m);
#pragma unroll
          for (int nt = 0; nt < 8; ++nt) key[nt] = key[nt] == M ? 0u : key[nt];
          if (fr == k) tk = M;
        }
        lv[((fq * 4 + j) * 2 + z) * 16 + fr] = key2f(tk & ~127u);
        li[((fq * 4 + j) * 2 + z) * 16 + fr] = 127 - (int)(tk & 127u);
      }
    }
    __builtin_amdgcn_s_waitcnt(0xc07f);
    __builtin_amdgcn_wave_barrier();
#pragma unroll 1
    for (int j = 0; j < 4; ++j) {
      const int tl = fq * 4 + j;
      float cand[4];
#pragma unroll
      for (int c = 0; c < 4; ++c) cand[c] = cvld[c] ? lv[(tl * 2 + 0) * 16 + ca[c]] + lv[(tl * 2 + 1) * 16 + cb[c]] : -3e38f;
      unsigned ck[4];
#pragma unroll
      for (int c = 0; c < 4; ++c) ck[c] = cvld[c] ? ((f2key(cand[c]) & ~63u) | (unsigned)(63 - (c * 16 + fr))) : 0u;
      unsigned sk = 0u;
#pragma unroll 1
      for (int k = 0; k < 16; ++k) {
        unsigned m = max(max(ck[0], ck[1]), max(ck[2], ck[3]));
        unsigned M = row_max16u(m);
#pragma unroll
        for (int c = 0; c < 4; ++c) ck[c] = ck[c] == M ? 0u : ck[c];
        if (fr == k) sk = M;
      }
      const float sv = key2f(sk & ~63u);
      const int scode = 63 - (int)(sk & 63u);
      int ab = kCand[scode];
      int e = li[(tl * 2 + 0) * 16 + ((ab >> 4) & 15)] * 128 + li[(tl * 2 + 1) * 16 + (ab & 15)];
      float mx = row_max16(sv);
      float ex = __expf(sv - mx);
      float sum = row_sum16(ex);
      int tok = tg * 16 + tl;
      ((int*)(ws + O_EIDX))[(size_t)tok * 128 + h * 16 + fr] = e;
      ((float*)(ws + O_EGATE))[(size_t)tok * 128 + h * 16 + fr] = ex / sum;
    }
    __builtin_amdgcn_s_waitcnt(0xc07f);
    __builtin_amdgcn_wave_barrier();
  }
}

DI void cvt8(const bf16x8& v, float (&f)[8]) {
  u32x4 u = __builtin_bit_cast(u32x4, v);
#pragma unroll
  for (int q = 0; q < 4; ++q) { f[2 * q] = __uint_as_float(u[q] << 16); f[2 * q + 1] = __uint_as_float(u[q] & 0xffff0000u); }
}
DI void cvt16(const u32x4& q, float (&f)[16]) {
#pragma unroll
  for (int i = 0; i < 4; ++i) {
    f32x2 a = __builtin_amdgcn_cvt_pk_f32_fp8((int)q[i], false), b = __builtin_amdgcn_cvt_pk_f32_fp8((int)q[i], true);
    f[4 * i] = a[0]; f[4 * i + 1] = a[1]; f[4 * i + 2] = b[0]; f[4 * i + 3] = b[1];
  }
}

__device__ void phase_peer_gather(const Params& p, int l, bool dry = false) {
  char* ws = opaque_ptr(p.ws);
  const int tid = opaque_tid();
  const int lane = tid & 63;
  const int gw = blockIdx.x * 4 + (tid >> 6), GW = gridDim.x * 4;
  const unsigned char* U = (const unsigned char*)(ws + O_PEU) + (size_t)l * 16384 * 1024;
  const unsigned char* V = (const unsigned char*)(ws + O_PEV) + (size_t)l * 16384 * 1024;
  const float* SU = (const float*)(ws + O_SCU) + l * 16384;
  const float* SV = (const float*)(ws + O_SCV) + l * 16384;
  float* X = (float*)(ws + O_X);
  float* XW = dry ? (float*)(ws + O_YS) : X;
  u16* HW = dry ? (u16*)(ws + O_MERG) : (u16*)(ws + O_H);
  float* OW = dry ? (float*)(ws + O_PB) : p.out + OUT_Y;
  for (int tok = gw; tok < NT; tok += GW) {
    float hf[16];
    {
      const u16* hr = (const u16*)(ws + O_H) + (size_t)tok * 1024 + lane * 16;
      bf16x8 h0 = *(const bf16x8*)(hr), h1 = *(const bf16x8*)(hr + 8);
      float t0[8], t1[8];
      cvt8(h0, t0); cvt8(h1, t1);
#pragma unroll
      for (int i = 0; i < 8; ++i) { hf[i] = t0[i]; hf[8 + i] = t1[i]; }
    }
    float acc[16];
#pragma unroll
    for (int i = 0; i < 16; ++i) acc[i] = 0.f;
    const int id0 = ((const int*)(ws + O_EIDX))[(size_t)tok * 128 + lane], id1 = ((const int*)(ws + O_EIDX))[(size_t)tok * 128 + 64 + lane];
    const float g0 = ((const float*)(ws + O_EGATE))[(size_t)tok * 128 + lane], g1 = ((const float*)(ws + O_EGATE))[(size_t)tok * 128 + 64 + lane];
#define PG_LOAD(G, ids, gts, su, sv, uq, vq)                                                                      \
  do {                                                                                                            \
    _Pragma("unroll") for (int e = 0; e < 4; ++e) {                                                               \
      int k = (G) * 4 + e;                                                                                        \
      int sel = k & 63;                                                                                           \
      int a_ = __builtin_amdgcn_readlane(id0, sel), b_ = __builtin_amdgcn_readlane(id1, sel);                     \
      float ga_ = __builtin_bit_cast(float, __builtin_amdgcn_readlane(__builtin_bit_cast(int, g0), sel));         \
      float gb_ = __builtin_bit_cast(float, __builtin_amdgcn_readlane(__builtin_bit_cast(int, g1), sel));         \
      ids[e] = (G) < 16 ? a_ : b_;                                                                                 \
      gts[e] = (G) < 16 ? ga_ : gb_;                                                                               \
    }                                                                                                             \
    _Pragma("unroll") for (int e = 0; e < 4; ++e) uq[e] = *(const u32x4*)(U + (size_t)ids[e] * 1024 + lane * 16); \
    _Pragma("unroll") for (int e = 0; e < 4; ++e) vq[e] = *(const u32x4*)(V + (size_t)ids[e] * 1024 + lane * 16); \
    _Pragma("unroll") for (int e = 0; e < 4; ++e) { su[e] = SU[ids[e]]; sv[e] = SV[ids[e]]; }                     \
  } while (0)
#define PG_COMP(gts, su, sv, uq, vq)                                                                              \
  do {                                                                                                            \
    float cf[4];                                                                                                  \
    _Pragma("unroll") for (int e = 0; e < 4; ++e) {                                                               \
      float a[16];                                                                                                \
      cvt16(uq[e], a);                                                                                            \
      float d0 = 0.f, d1 = 0.f;                                                                                   \
      _Pragma("unroll") for (int i = 0; i < 16; i += 2) { d0 += a[i] * hf[i]; d1 += a[i + 1] * hf[i + 1]; }       \
      float d = wave_sum(d0 + d1) * su[e];                                                                        \
      float u3 = 0.7978845608028654f * (d + 0.044715f * d * d * d);                                               \
      float th = 1.f - 2.f / (__expf(2.f * u3) + 1.f);                                                            \
      cf[e] = gts[e] * 0.5f * d * (1.f + th) * sv[e];                                                             \
    }                                                                                                             \
    _Pragma("unroll") for (int e = 0; e < 4; ++e) {                                                               \
      float a[16];                                                                                                \
      cvt16(vq[e], a);                                                                                            \
      _Pragma("unroll") for (int i = 0; i < 16; ++i) acc[i] += cf[e] * a[i];                                      \
    }                                                                                                             \
  } while (0)
    {
      int idA[4], idB[4];
      float gtA[4], gtB[4], suA[4], svA[4], suB[4], svB[4];
      u32x4 uqA[4], vqA[4], uqB[4], vqB[4];
      PG_LOAD(0, idA, gtA, suA, svA, uqA, vqA);
#pragma unroll 1
      for (int g = 0; g < 32; g += 2) {
        PG_LOAD(g + 1, idB, gtB, suB, svB, uqB, vqB);
        PG_COMP(gtA, suA, svA, uqA, vqA);
        if (g + 2 < 32) PG_LOAD(g + 2, idA, gtA, suA, svA, uqA, vqA);
        PG_COMP(gtB, suB, svB, uqB, vqB);
      }
    }
#undef PG_LOAD
#undef PG_COMP
    const float* mod = (const float*)(ws + O_MOD) + ((size_t)l * 3 + tok_cond(tok)) * 6144;
    float x[16];
    const int e0 = lane * 16;
#pragma unroll
    for (int q = 0; q < 4; ++q) {
      f32x4 a = *(const f32x4*)(X + (size_t)tok * 1024 + e0 + q * 4);
      f32x4 ga = *(const f32x4*)(mod + 5 * 1024 + e0 + q * 4);
#pragma unroll
      for (int i = 0; i < 4; ++i) { a[i] += ga[i] * acc[q * 4 + i]; x[q * 4 + i] = a[i]; }
      *(f32x4*)(XW + (size_t)tok * 1024 + e0 + q * 4) = a;
    }
    float ss = 0.f;
#pragma unroll
    for (int i = 0; i < 16; ++i) ss += x[i] * x[i];
    ss = wave_sum(ss);
    const float rstd = rsqrtf(ss * (1.f / 1024.f) + 1e-6f);
    if (l < NL - 1) {
      const float* mod2 = (const float*)(ws + O_MOD) + ((size_t)(l + 1) * 3 + tok_cond(tok)) * 6144;
      const float* g = p.in[9] + (l + 1) * 1024;
      float y[16];
#pragma unroll
      for (int q = 0; q < 4; ++q) {
        f32x4 gg = *(const f32x4*)(g + e0 + q * 4), sh = *(const f32x4*)(mod2 + e0 + q * 4), sc = *(const f32x4*)(mod2 + 1024 + e0 + q * 4);
#pragma unroll
        for (int i = 0; i < 4; ++i) y[q * 4 + i] = x[q * 4 + i] * rstd * gg[i] * (1.f + sc[i]) + sh[i];
      }
      u32x4 o0, o1;
      o0[0] = pack2(y[0], y[1]); o0[1] = pack2(y[2], y[3]); o0[2] = pack2(y[4], y[5]); o0[3] = pack2(y[6], y[7]);
      o1[0] = pack2(y[8], y[9]); o1[1] = pack2(y[10], y[11]); o1[2] = pack2(y[12], y[13]); o1[3] = pack2(y[14], y[15]);
      *(u32x4*)(HW + (size_t)tok * 1024 + e0) = o0;
      *(u32x4*)(HW + (size_t)tok * 1024 + e0 + 8) = o1;
    } else {
      const float* g = p.in[11];
#pragma unroll
      for (int q = 0; q < 4; ++q) {
        f32x4 gg = *(const f32x4*)(g + e0 + q * 4), a;
#pragma unroll
        for (int i = 0; i < 4; ++i) a[i] = x[q * 4 + i] * rstd * gg[i];
        *(f32x4*)(OW + (size_t)tok * 1024 + e0 + q * 4) = a;
      }
    }
  }
}

#define XB_TMO 128
#define XB_XCNT(j) (256 + 64 * (j))
#define XB_XSUB(j) (1280 + 64 * (j))
#define XB_XGEN(j) (2304 + 64 * (j))
#define XB_TOP 3328
#define XB_TOPGEN 3392
#define XCD_BAR_WORDS 3456
#define XB_SPIN_CAP (1u << 18)
DI unsigned xb_ld(unsigned* q) { return __hip_atomic_load(q, __ATOMIC_RELAXED, __HIP_MEMORY_SCOPE_AGENT); }
DI unsigned xb_add(unsigned* q, unsigned v) { return __hip_atomic_fetch_add(q, v, __ATOMIC_RELAXED, __HIP_MEMORY_SCOPE_AGENT); }
DI unsigned xb_xcc_id() { return (unsigned)__builtin_amdgcn_s_getreg((3 << 11) | 20) & 0xFu; }
#define XB_SPIN(cond, bar)                                                                   \
  do {                                                                                       \
    unsigned _sp = 0;                                                                        \
    while (cond) {                                                                           \
      __builtin_amdgcn_s_sleep(1);                                                           \
      if ((++_sp & 255u) == 0u) {                                                            \
        if (xb_ld(&(bar)[XB_TMO])) break;                                                    \
        if (_sp > XB_SPIN_CAP) { atomicAdd(&(bar)[XB_TMO], 1u); break; }                     \
      }                                                                                      \
    }                                                                                        \
  } while (0)
struct XB { unsigned* bar; unsigned x, nloc, nx; };
DI void xcd_barrier(const XB& b) {
  asm volatile("s_waitcnt vmcnt(0)" ::: "memory");
  __syncthreads();
  if (threadIdx.x == 0) {
    unsigned* bar = b.bar;
    __builtin_amdgcn_s_waitcnt(0);
    const unsigned nloc = b.nloc, nx = b.nx;
    const unsigned old = xb_add(&bar[XB_XSUB(b.x)], 1u);
    const unsigned gen = old / nloc;
    if (old + 1u == (gen + 1u) * nloc) {
      __builtin_amdgcn_fence(__ATOMIC_RELEASE, "agent");
      asm volatile("s_waitcnt vmcnt(0)" ::: "memory");
      const unsigned og = xb_add(&bar[XB_TOP], 1u);
      const unsigned tg = og / nx;
      if (og + 1u == (tg + 1u) * nx) xb_add(&bar[XB_TOPGEN], 1u);
      else XB_SPIN(xb_ld(&bar[XB_TOPGEN]) == tg, bar);
      __builtin_amdgcn_fence(__ATOMIC_ACQUIRE, "agent");
      xb_add(&bar[XB_XGEN(b.x)], 1u);
      asm volatile("s_waitcnt vmcnt(0)" ::: "memory");
    } else {
      XB_SPIN(xb_ld(&bar[XB_XGEN(b.x)]) == gen, bar);
      __builtin_amdgcn_fence(__ATOMIC_ACQUIRE, "agent");
      asm volatile("s_waitcnt vmcnt(0)" ::: "memory");
    }
  }
  __syncthreads();
}

__global__ void __launch_bounds__(256, 2) fwd_megakernel(Params p) {
  cg::grid_group grid = cg::this_grid();
  XB xb;
  xb.bar = (unsigned*)(p.ws + O_BAR);
  xb.x = xb_xcc_id();
  if (threadIdx.x == 0) (void)xb_add(&xb.bar[XB_XCNT(xb.x)], 1u);
  phase_prep(p);
  if (p.ws == nullptr) grid.sync();
  {
    unsigned mine = 0u, cnt = 0u, sum = 0u, sp = 0u;
    for (;;) {
      sum = 0u; cnt = 0u; mine = 0u;
#pragma unroll
      for (unsigned j = 0; j < 16; ++j) { const unsigned c = xb_ld(&xb.bar[XB_XCNT(j)]); sum += c; cnt += (c > 0u) ? 1u : 0u; mine = (j == xb.x) ? c : mine; }
      if (sum == gridDim.x) break;
      __builtin_amdgcn_s_sleep(1);
      if (++sp > XB_SPIN_CAP) break;
    }
    xb.nloc = __builtin_amdgcn_readfirstlane(mine > 0u ? mine : 1u);
    xb.nx = __builtin_amdgcn_readfirstlane(cnt > 0u ? cnt : 1u);
  }
  xcd_barrier(xb);
  phase_norm(p, 0, 0);
  xcd_barrier(xb);
  for (int l = 0; l < NL; ++l) {
    phase_gemm_in(p, l);
    xcd_barrier(xb);
    phase_rwkv_prep(p, l);
    xcd_barrier(xb);
    phase_rwkv_lora(p, l);
    xcd_barrier(xb);
    phase_mix(p, l);
    xcd_barrier(xb);
    phase_rwkv_post(p, l);
    xcd_barrier(xb);
    phase_branch(p, l);
    xcd_barrier(xb);
    phase_wo(p, l);
    xcd_barrier(xb);
    phase_norm(p, l, 1);
    xcd_barrier(xb);
    phase_peq(p, l);
    xcd_barrier(xb);
    phase_peer_sel(p, l);
    xcd_barrier(xb);
    phase_peer_gather(p, l);
    if (l + 1 < NL) xcd_barrier(xb);
  }
}

extern "C" void kernel_launch(void* const* d_in, const int* in_sizes, int n_in, void* d_out, int out_size, void* d_ws, size_t ws_size,
                              hipStream_t stream) {
  static int grid_blocks = 0;
  if (!grid_blocks) {
    int dev = 0, cus = 0, per_cu = 0;
    hipGetDevice(&dev);
    hipDeviceGetAttribute(&cus, hipDeviceAttributeMultiprocessorCount, dev);
    hipOccupancyMaxActiveBlocksPerMultiprocessor(&per_cu, fwd_megakernel, 256, 0);
    if (per_cu > 2) per_cu = 2;
    if (per_cu < 1) per_cu = 1;
    grid_blocks = cus * per_cu;
  }
  Params p{};
  for (int i = 0; i < 36; ++i) p.in[i] = (const float*)d_in[i];
  p.out = (float*)d_out;
  p.ws = (char*)d_ws;
  (void)hipMemsetAsync((char*)d_ws + O_BAR, 0, 3456 * 4, stream);
  void* args[] = {&p};
  hipError_t e = hipLaunchCooperativeKernel((void*)fwd_megakernel, dim3(grid_blocks), dim3(256), args, 0, stream);
  if (e != hipSuccess) fprintf(stderr, "cooperative launch failed: %s (grid %d)\n", hipGetErrorString(e), grid_blocks);
}
```

```cpp
#include <hip/hip_runtime.h>
#include <hip/hip_cooperative_groups.h>
#include <cstdio>
namespace cg = cooperative_groups;

#define DI __device__ __forceinline__
typedef unsigned short u16;
using bf16x8 = __attribute__((ext_vector_type(8))) short;
using bf16x4 = __attribute__((ext_vector_type(4))) short;
using f32x4 = __attribute__((ext_vector_type(4))) float;
using u32x2 = __attribute__((ext_vector_type(2))) unsigned;
using u32x4 = __attribute__((ext_vector_type(4))) unsigned;

constexpr int NT = 8192, NCTX = 4096, DM = 1024, INC = 7296, NL = 4;

constexpr size_t AL(size_t x) { return (x + 255) / 256 * 256; }
constexpr size_t O_WIN = 0;
constexpr size_t O_AOUT = O_WIN + AL(4ull * 7296 * 1024 * 2);
constexpr size_t O_RWOUT = O_AOUT + AL(4ull * 1024 * 512 * 2);
constexpr size_t O_NAOUT = O_RWOUT + AL(4ull * 1024 * 512 * 2);
constexpr size_t O_WO = O_NAOUT + AL(4ull * 1024 * 512 * 2);
constexpr size_t O_PEQ = O_WO + AL(4ull * 1024 * 1024 * 2);
constexpr size_t O_SUBK = O_PEQ + AL(4ull * 2048 * 1024 * 2);
constexpr size_t O_W2 = O_SUBK + AL(4ull * 8 * 2 * 128 * 128 * 2);
constexpr size_t O_A2 = O_W2 + AL(8ull * 512 * 64 * 2);
constexpr size_t O_G2 = O_A2 + AL(8ull * 512 * 64 * 2);
constexpr size_t O_PEU = O_G2 + AL(4ull * 512 * 128 * 2);
constexpr size_t O_PEV = O_PEU + AL(4ull * 16384 * 1024 * 2);
constexpr size_t O_CAK = O_PEV + AL(4ull * 16384 * 1024 * 2);
constexpr size_t O_CAVT = O_CAK + AL(8ull * 512 * 128 * 2);
constexpr size_t O_CCK = O_CAVT + AL(8ull * 128 * 512 * 2);
constexpr size_t O_CCVT = O_CCK + AL(8ull * 512 * 512 * 2);
constexpr size_t O_MOD = O_CCVT + AL(8ull * 512 * 512 * 2);
constexpr size_t O_ROPE = O_MOD + AL(4ull * 3 * 6144 * 4);
constexpr size_t O_CNT = O_ROPE + AL(64 * 16 * 2 * 4);
constexpr size_t O_X = O_CNT + 256;
constexpr size_t O_H = O_X + AL(8192ull * 1024 * 4);
constexpr size_t O_QA = O_H + AL(8192ull * 1024 * 2);
constexpr size_t O_KA = O_QA + AL(8192ull * 512 * 2);
constexpr size_t O_VAT = O_KA + AL(8192ull * 128 * 2);
constexpr size_t O_QC = O_VAT + AL(8192ull * 128 * 2);
constexpr size_t O_KC = O_QC + AL(8192ull * 512 * 2);
constexpr size_t O_VCT = O_KC + AL(8192ull * 512 * 2);
constexpr size_t O_PB = O_VCT + AL(8192ull * 512 * 2);
constexpr size_t O_GATE = O_PB + AL(8192ull * 1920 * 4);
constexpr size_t O_XRKV = O_GATE + AL(8192ull * 3072 * 2);
constexpr size_t O_KK = O_XRKV + AL(8192ull * 1536 * 4);
constexpr size_t O_TW = O_KK + AL(8192ull * 512 * 4);
constexpr size_t O_AD = O_TW + AL(8192ull * 128 * 2);
constexpr size_t O_SG = O_AD + AL(8192ull * 128 * 2);
constexpr size_t O_DEC = O_SG + AL(8192ull * 128 * 2);
constexpr size_t O_KD = O_DEC + AL(2ull * 8192 * 512 * 4);
constexpr size_t O_KKA = O_KD + AL(2ull * 8192 * 512 * 4);
constexpr size_t O_GG = O_KKA + AL(2ull * 8192 * 512 * 4);
constexpr size_t O_YS = O_GG + AL(8192ull * 512 * 4);
constexpr size_t O_YABC = O_YS + AL(2ull * 8192 * 512 * 4);
constexpr size_t O_MERG = O_YABC + AL(3ull * 8192 * 512 * 2);
constexpr size_t O_PQ = O_MERG + AL(8192ull * 1024 * 2);
constexpr size_t O_EIDX = O_PQ + AL(8192ull * 2048 * 2);
constexpr size_t O_EGATE = O_EIDX + AL(8192ull * 128 * 4);
constexpr size_t O_SCU = O_EGATE + AL(8192ull * 128 * 4);
constexpr size_t O_SCV = O_SCU + AL(4ull * 16384 * 4);
constexpr size_t O_BAR = O_SCV + AL(4ull * 16384 * 4);
constexpr size_t WS_TOTAL = O_BAR + AL(3456 * 4);
static_assert(WS_TOTAL < 1020ull * 1024 * 1024, "workspace too large");

constexpr size_t OUT_Y = 0;
constexpr size_t OUT_AK = 8388608;
constexpr size_t OUT_AV = 10485760;
constexpr size_t OUT_CK = 12582912;
constexpr size_t OUT_CV = 20971520;
constexpr size_t OUT_ST = 29360128;

struct Params {
  const float* in[36];
  float* out;
  char* ws;
};

__shared__ __attribute__((aligned(16))) char g_smem[65536];

DI u16 f2bf(float x) { unsigned u = __float_as_uint(x); u += 0x7fffu + ((u >> 16) & 1u); return (u16)(u >> 16); }
DI float bf2f(u16 h) { return __uint_as_float(((unsigned)h) << 16); }
DI unsigned pack2(float a, float b) { return (unsigned)f2bf(a) | ((unsigned)f2bf(b) << 16); }
DI float sigmoidf_(float x) { return 1.f / (1.f + __expf(-x)); }
template <int CTRL> DI float dppf(float v) {
  return __builtin_bit_cast(float, __builtin_amdgcn_update_dpp(0, __builtin_bit_cast(int, v), CTRL, 0xf, 0xf, true));
}
template <int CTRL> DI int dppi(int v) { return __builtin_amdgcn_update_dpp(0, v, CTRL, 0xf, 0xf, true); }
DI float row_sum16(float v) { v += dppf<0xB1>(v); v += dppf<0x4E>(v); v += dppf<0x141>(v); v += dppf<0x140>(v); return v; }
DI float row_max16(float v) { v = fmaxf(v, dppf<0xB1>(v)); v = fmaxf(v, dppf<0x4E>(v)); v = fmaxf(v, dppf<0x141>(v)); v = fmaxf(v, dppf<0x140>(v)); return v; }
DI int row_max16i(int v) { v = max(v, dppi<0xB1>(v)); v = max(v, dppi<0x4E>(v)); v = max(v, dppi<0x141>(v)); v = max(v, dppi<0x140>(v)); return v; }
DI float wave_sum(float v) { v = row_sum16(v); v += __shfl_xor(v, 16); v += __shfl_xor(v, 32); return v; }

DI int opaque_tid() { int t = threadIdx.x; asm volatile("" : "+v"(t)); return t; }
DI char* opaque_ptr(char* q) { size_t z = 0; asm volatile("" : "+s"(z)); return q + z; }
DI f32x4 mfma16(bf16x8 a, bf16x8 b, f32x4 c) { return __builtin_amdgcn_mfma_f32_16x16x32_bf16(a, b, c, 0, 0, 0); }

DI int lds_byte(int r, int c) {
  int st = (r >> 4) * 2 + (c >> 5), rr = r & 15, cc = c & 31, ob = rr * 64 + cc * 2;
  return st * 1024 + (ob ^ (((ob >> 9) & 1) << 5));
}
DI void stage_rc(int b, int& R, int& C) {
  int st = b >> 10, sb = b & 1023, swz = sb ^ (((sb >> 9) & 1) << 5);
  R = (st >> 1) * 16 + (swz >> 6);
  C = (st & 1) * 32 + ((swz & 63) >> 1);
}
DI void gemm_main(int tid, const u16* __restrict__ g0, int ld0, const u16* __restrict__ g1, int ld1, int K, f32x4 (&acc)[4][4], int koff = 0) {
  const int wid = tid >> 6, lane = tid & 63, wr = wid >> 1, wc = wid & 1, fr = lane & 15, fq = lane >> 4;
  const int nk = K >> 6;
  int R0, C0;
  stage_rc(tid * 16, R0, C0);
  const unsigned v0 = (unsigned)(R0 * ld0 + C0), v1 = (unsigned)(R0 * ld1 + C0);
  const int fa0 = lds_byte(wr * 64 + fr, fq * 8), fa1 = 16384 + lds_byte(wc * 64 + fr, fq * 8);
  const int sb = tid * 16;
#define GSTAGE(kt, buf)                                                                                          \
  do {                                                                                                           \
    _Pragma("unroll") for (int i = 0; i < 4; ++i) {                                                              \
      const u16* u0 = g0 + (size_t)(kt) * 64 + (size_t)i * 32 * ld0;                                             \
      const u16* u1 = g1 + (size_t)(kt) * 64 + (size_t)i * 32 * ld1;                                             \
      __builtin_amdgcn_global_load_lds((const unsigned*)(u0 + v0), (unsigned*)(g_smem + (buf) + i * 4096 + sb), 16, 0, 0);          \
      __builtin_amdgcn_global_load_lds((const unsigned*)(u1 + v1), (unsigned*)(g_smem + (buf) + 16384 + i * 4096 + sb), 16, 0, 0);  \
    }                                                                                                            \
  } while (0)
  int kt = koff;
  GSTAGE(kt, 0);
  for (int t = 0; t < nk; ++t) {
    asm volatile("s_waitcnt vmcnt(0)" ::: "memory");
    __syncthreads();
    const int cur = (t & 1) * 32768;
    kt = kt + 1 == nk ? 0 : kt + 1;
    if (t + 1 < nk) GSTAGE(kt, 32768 - cur);
#pragma unroll
    for (int ks = 0; ks < 2; ++ks) {
      bf16x8 f0[4], f1[4];
#pragma unroll
      for (int m = 0; m < 4; ++m) f0[m] = *(const bf16x8*)(g_smem + cur + fa0 + m * 2048 + ks * 1024);
#pragma unroll
      for (int n = 0; n < 4; ++n) f1[n] = *(const bf16x8*)(g_smem + cur + fa1 + n * 2048 + ks * 1024);
#pragma unroll
      for (int m = 0; m < 4; ++m)
#pragma unroll
        for (int n = 0; n < 4; ++n) acc[m][n] = mfma16(f1[n], f0[m], acc[m][n]);
    }
  }
#undef GSTAGE
  __syncthreads();
}
DI void zero_acc(f32x4 (&acc)[4][4]) {
#pragma unroll
  for (int m = 0; m < 4; ++m)
#pragma unroll
    for (int n = 0; n < 4; ++n) acc[m][n] = f32x4{0.f, 0.f, 0.f, 0.f};
}

struct TJob { const float* src; u16* dst; int K, N, nb; };

DI void transpose_tile(int tid, const float* __restrict__ src, u16* __restrict__ dst, int K, int N, int k0, int n0) {
  float* tile = (float*)g_smem;
  {
    const int tr = tid >> 4, tc = tid & 15;
#pragma unroll
    for (int p = 0; p < 4; ++p) {
      int r = tr + 16 * p;
      f32x4 v = *(const f32x4*)(src + (size_t)(k0 + r) * N + n0 + tc * 4);
      tile[r * 65 + tc * 4 + 0] = v[0]; tile[r * 65 + tc * 4 + 1] = v[1];
      tile[r * 65 + tc * 4 + 2] = v[2]; tile[r * 65 + tc * 4 + 3] = v[3];
    }
  }
  __syncthreads();
  {
    const int tn = tid >> 3, tk = tid & 7;
#pragma unroll
    for (int p = 0; p < 2; ++p) {
      int n = tn + 32 * p;
      u32x4 o;
#pragma unroll
      for (int q = 0; q < 4; ++q) o[q] = pack2(tile[(tk * 8 + 2 * q) * 65 + n], tile[(tk * 8 + 2 * q + 1) * 65 + n]);
      *(u32x4*)(dst + (size_t)(n0 + n) * K + k0 + tk * 8) = o;
    }
  }
  __syncthreads();
}

DI void convert_chunks(int tid, const float* __restrict__ src, u16* __restrict__ dst, size_t n) {
  const size_t nch = n / 8192;
  for (size_t c = blockIdx.x; c < nch; c += gridDim.x) {
    size_t e = c * 8192 + tid * 8;
    f32x4 a[4], b[4];
#pragma unroll
    for (int q = 0; q < 4; ++q) { a[q] = __builtin_nontemporal_load((const f32x4*)(src + e + q * 2048)); b[q] = __builtin_nontemporal_load((const f32x4*)(src + e + q * 2048 + 4)); }
#pragma unroll
    for (int q = 0; q < 4; ++q) {
      u32x4 o;
      o[0] = pack2(a[q][0], a[q][1]); o[1] = pack2(a[q][2], a[q][3]); o[2] = pack2(b[q][0], b[q][1]); o[3] = pack2(b[q][2], b[q][3]);
      *(u32x4*)(dst + e + q * 2048) = o;
    }
  }
}

typedef float f32x2 __attribute__((ext_vector_type(2)));
DI void convert_rows_fp8(int tid, const float* __restrict__ src, unsigned char* __restrict__ dst, float* __restrict__ inv_scale, int nrows) {
  const int lane = tid & 63;
  const int gw = blockIdx.x * 4 + (tid >> 6), GW = gridDim.x * 4;
  for (int r0 = gw; r0 < nrows; r0 += 2 * GW) {
    int rws[2] = {r0, r0 + GW < nrows ? r0 + GW : r0};
    f32x4 v[2][4];
#pragma unroll
    for (int u = 0; u < 2; ++u)
#pragma unroll
      for (int q = 0; q < 4; ++q) v[u][q] = __builtin_nontemporal_load((const f32x4*)(src + (size_t)rws[u] * 1024 + lane * 16 + q * 4));
#pragma unroll
    for (int u = 0; u < 2; ++u) {
      float am = 0.f;
#pragma unroll
      for (int q = 0; q < 4; ++q)
#pragma unroll
        for (int j = 0; j < 4; ++j) am = fmaxf(am, fabsf(v[u][q][j]));
      am = row_max16(am);
      am = fmaxf(am, __shfl_xor(am, 16));
      am = fmaxf(am, __shfl_xor(am, 32));
      int ex = (int)((__float_as_uint(am) >> 23) & 0xff) - 127;
      int k = am > 0.f ? 7 - ex : 0;
      k = min(max(k, -100), 100);
      float sc = __uint_as_float((unsigned)(127 + k) << 23), isc = __uint_as_float((unsigned)(127 - k) << 23);
      u32x4 o;
#pragma unroll
      for (int q = 0; q < 4; ++q) {
        int w = __builtin_amdgcn_cvt_pk_fp8_f32(v[u][q][0] * sc, v[u][q][1] * sc, 0, false);
        w = __builtin_amdgcn_cvt_pk_fp8_f32(v[u][q][2] * sc, v[u][q][3] * sc, w, true);
        o[q] = (unsigned)w;
      }
      *(u32x4*)(dst + (size_t)rws[u] * 1024 + lane * 16) = o;
      if (lane == 0) inv_scale[rws[u]] = isc;
    }
  }
}

DI void convert_rows_fp8_wave(int lane, const float* __restrict__ src, unsigned char* __restrict__ dst, float* __restrict__ inv_scale, int r0, int r1) {
  for (int r = r0; r < r1; r += 2) {
    f32x4 v[2][4];
#pragma unroll
    for (int u = 0; u < 2; ++u)
#pragma unroll
      for (int q = 0; q < 4; ++q) v[u][q] = __builtin_nontemporal_load((const f32x4*)(src + (size_t)(r + u) * 1024 + lane * 16 + q * 4));
#pragma unroll
    for (int u = 0; u < 2; ++u) {
      float am = 0.f;
#pragma unroll
      for (int q = 0; q < 4; ++q)
#pragma unroll
        for (int j = 0; j < 4; ++j) am = fmaxf(am, fabsf(v[u][q][j]));
      am = row_max16(am);
      am = fmaxf(am, __shfl_xor(am, 16));
      am = fmaxf(am, __shfl_xor(am, 32));
      int ex = (int)((__float_as_uint(am) >> 23) & 0xff) - 127;
      int k = am > 0.f ? 7 - ex : 0;
      k = min(max(k, -100), 100);
      float sc = __uint_as_float((unsigned)(127 + k) << 23), isc = __uint_as_float((unsigned)(127 - k) << 23);
      u32x4 o;
#pragma unroll
      for (int q = 0; q < 4; ++q) {
        int w = __builtin_amdgcn_cvt_pk_fp8_f32(v[u][q][0] * sc, v[u][q][1] * sc, 0, false);
        w = __builtin_amdgcn_cvt_pk_fp8_f32(v[u][q][2] * sc, v[u][q][3] * sc, w, true);
        o[q] = (unsigned)w;
      }
      *(u32x4*)(dst + (size_t)(r + u) * 1024 + lane * 16) = o;
      if (lane == 0) inv_scale[r + u] = isc;
    }
  }
}

__device__ void phase_prep(const Params& p) {
  char* ws = opaque_ptr(p.ws);
  const int tid = opaque_tid(), wid = tid >> 6, lane = tid & 63;
  if (blockIdx.x == 0 && tid < 64) ((int*)(ws + O_CNT))[tid] = 0;
  if (blockIdx.x < 4) {
    int e = blockIdx.x * 256 + tid;
    int pos = e >> 4, f = e & 15;
    const float fr4[4] = {1.0f, 0.56234132519f, 0.316227766017f, 0.177827941004f};
    float sc = (f >> 2) == 0 ? 1.0f : (f >> 2) == 1 ? 0.1f : (f >> 2) == 2 ? 0.01f : 0.001f;
    float fsel = (f & 3) == 0 ? fr4[0] : (f & 3) == 1 ? fr4[1] : (f & 3) == 2 ? fr4[2] : fr4[3];
    float freq = fsel * sc;
    float ang = (float)pos * freq;
    double a = (double)ang;
    double k = rint(a * 0.15915494309189535);
    double r = a - k * 6.283185307179586;
    double r2 = r * r, ts = r, tc = 1.0, s = r, c = 1.0;
    for (int i = 1; i <= 14; ++i) {
      tc = -tc * r2 / (double)((2 * i - 1) * (2 * i));
      ts = -ts * r2 / (double)((2 * i) * (2 * i + 1));
      c += tc; s += ts;
    }
    float* rope = (float*)(ws + O_ROPE);
    rope[e * 2] = (float)c; rope[e * 2 + 1] = (float)s;
  }
  {
    float* sil = (float*)g_smem;
    float* part = (float*)(g_smem + 16384);
    const float* cvec = p.in[7];
    const float* cctx = p.in[8];
    bool have_sil = false;
    for (int it = blockIdx.x; it < 4 * 96; it += gridDim.x) {
      if (!have_sil) {
        for (int k = tid; k < 1024; k += 256) {
          float a = cctx[k], b = cvec[k], c2 = cvec[1024 + k];
          sil[k] = a * sigmoidf_(a); sil[1024 + k] = b * sigmoidf_(b); sil[2048 + k] = c2 * sigmoidf_(c2);
        }
        have_sil = true;
        __syncthreads();
      }
      int l = it / 96, n = (it % 96) * 64 + lane;
      const float* W = p.in[12] + (size_t)l * 1024 * 6144 + n;
      float a0 = 0.f, a1 = 0.f, a2 = 0.f;
      int kb = wid * 256;
#pragma unroll 8
      for (int k = 0; k < 256; ++k) {
        float w = W[(size_t)(kb + k) * 6144];
        a0 += w * sil[kb + k]; a1 += w * sil[1024 + kb + k]; a2 += w * sil[2048 + kb + k];
      }
      part[(wid * 3 + 0) * 64 + lane] = a0; part[(wid * 3 + 1) * 64 + lane] = a1; part[(wid * 3 + 2) * 64 + lane] = a2;
      __syncthreads();
      if (tid < 192) {
        int c = tid >> 6, ln = tid & 63;
        float s = part[(0 * 3 + c) * 64 + ln] + part[(1 * 3 + c) * 64 + ln] + part[(2 * 3 + c) * 64 + ln] + part[(3 * 3 + c) * 64 + ln];
        int nn = (it % 96) * 64 + ln;
        ((float*)(ws + O_MOD))[((size_t)l * 3 + c) * 6144 + nn] = s + p.in[13][(size_t)l * 6144 + nn];
      }
      __syncthreads();
    }
    __syncthreads();
  }
  {
    TJob jobs[11] = {
        {p.in[14], (u16*)(ws + O_WIN), 1024, 7296, 4},
        {p.in[16], (u16*)(ws + O_AOUT), 512, 1024, 4},
        {p.in[28], (u16*)(ws + O_RWOUT), 512, 1024, 4},
        {p.in[30], (u16*)(ws + O_NAOUT), 512, 1024, 4},
        {p.in[31], (u16*)(ws + O_WO), 1024, 1024, 4},
        {p.in[32], (u16*)(ws + O_PEQ), 1024, 2048, 4},
        {p.in[19], (u16*)(ws + O_W2), 64, 512, 8},
        {p.in[21], (u16*)(ws + O_A2), 64, 512, 8},
        {p.in[22], (u16*)(ws + O_G2), 128, 512, 4},
        {p.in[3], (u16*)(ws + O_CAVT), 512, 128, 8},
        {p.in[5], (u16*)(ws + O_CCVT), 512, 512, 8},
    };
#pragma unroll
    for (int j = 0; j < 11; ++j) {
      const int tk = jobs[j].K / 64, tn = jobs[j].N / 64, per = tk * tn, tot = per * jobs[j].nb;
      for (int t = blockIdx.x; t < tot; t += gridDim.x) {
        int b = t / per, r = t % per;
        int kt = r / tn, ntile = r % tn;
        size_t off = (size_t)b * jobs[j].K * jobs[j].N;
        transpose_tile(tid, jobs[j].src + off, jobs[j].dst + off, jobs[j].K, jobs[j].N, kt * 64, ntile * 64);
      }
    }
  }
  convert_chunks(tid, p.in[33], (u16*)(ws + O_SUBK), 4ull * 8 * 2 * 128 * 128);
  convert_chunks(tid, p.in[2], (u16*)(ws + O_CAK), 8ull * 512 * 128);
  convert_chunks(tid, p.in[4], (u16*)(ws + O_CCK), 8ull * 512 * 512);
  {
    float* X = (float*)(ws + O_X);
    const size_t nch = (size_t)NT * DM / 1024;
    for (size_t c = blockIdx.x; c < nch; c += gridDim.x) {
      size_t e = c * 1024 + tid * 4;
      const float* src = e < (size_t)NCTX * DM ? p.in[0] + e : p.in[1] + (e - (size_t)NCTX * DM);
      *(f32x4*)(X + e) = *(const f32x4*)src;
    }
  }
}

DI int tok_cond(int tok) { return tok < NCTX ? 0 : 1 + ((tok - NCTX) >> 11); }

DI void norm_row_store(const float (&x)[16], const float* __restrict__ g, const float* __restrict__ shift, const float* __restrict__ scale,
                       u16* __restrict__ hrow, int lane) {
  float ss = 0.f;
#pragma unroll
  for (int i = 0; i < 16; ++i) ss += x[i] * x[i];
  ss = wave_sum(ss);
  float rstd = rsqrtf(ss * (1.f / 1024.f) + 1e-6f);
#pragma unroll
  for (int hh = 0; hh < 2; ++hh) {
    int e0 = hh * 512 + lane * 8;
    float y[8];
#pragma unroll
    for (int i = 0; i < 8; ++i) {
      float v = x[hh * 8 + i] * rstd * g[e0 + i];
      y[i] = v * (1.f + scale[e0 + i]) + shift[e0 + i];
    }
    u32x4 o;
    o[0] = pack2(y[0], y[1]); o[1] = pack2(y[2], y[3]); o[2] = pack2(y[4], y[5]); o[3] = pack2(y[6], y[7]);
    *(u32x4*)(hrow + e0) = o;
  }
}

__device__ void phase_norm(const Params& p, int l, int which) {
  char* ws = opaque_ptr(p.ws);
  const int tid = opaque_tid();
  const int lane = tid & 63;
  const int gw = blockIdx.x * 4 + (tid >> 6), GW = gridDim.x * 4;
  const float* X = (const float*)(ws + O_X);
  const float* g = (which == 0 ? p.in[9] : p.in[10]) + l * 1024;
  for (int tok = gw; tok < NT; tok += GW) {
    const float* mod = (const float*)(ws + O_MOD) + ((size_t)l * 3 + tok_cond(tok)) * 6144 + which * 3 * 1024;
    float x[16];
#pragma unroll
    for (int hh = 0; hh < 2; ++hh) {
      f32x4 a = *(const f32x4*)(X + (size_t)tok * 1024 + hh * 512 + lane * 8);
      f32x4 b = *(const f32x4*)(X + (size_t)tok * 1024 + hh * 512 + lane * 8 + 4);
#pragma unroll
      for (int i = 0; i < 4; ++i) { x[hh * 8 + i] = a[i]; x[hh * 8 + 4 + i] = b[i]; }
    }
    norm_row_store(x, g, mod, mod + 1024, (u16*)(ws + O_H) + (size_t)tok * 1024, lane);
  }
}

__device__ void phase_gemm_in(const Params& p, int l) {
  char* ws = opaque_ptr(p.ws);
  const int tid = opaque_tid();
  const int wid = tid >> 6, lane = tid & 63, wr = wid >> 1, wc = wid & 1, fr = lane & 15, fq = lane >> 4;
  const u16* H = (const u16*)(ws + O_H);
  const u16* W = (const u16*)(ws + O_WIN) + (size_t)l * INC * 1024;
  const float* rope = (const float*)(ws + O_ROPE);
  float* out = p.out;
  for (int t = blockIdx.x; t < 64 * 57; t += gridDim.x) {
    const int tm = t & 63, tn = t >> 6;
    const int brow = tm * 128, bcol = tn * 128;
    const bool swapped = (tn == 5) || (tn >= 29 && tn < 33);
    const bool ctx = brow < NCTX;
    f32x4 acc[4][4];
    zero_acc(acc);
    const int koff = (((tm >> 3) + (tn & 7)) * 2) & 15;
    if (!swapped) gemm_main(tid, H + (size_t)brow * 1024, 1024, W + (size_t)bcol * 1024, 1024, 1024, acc, koff);
    else gemm_main(tid, W + (size_t)bcol * 1024, 1024, H + (size_t)brow * 1024, 1024, 1024, acc, koff);
    if (!swapped) {
#pragma unroll
      for (int m = 0; m < 4; ++m) {
        const int tok = brow + wr * 64 + m * 16 + fr;
        const int cb = bcol + wc * 64 + fq * 4;
        if (tn < 5) {
          if (!ctx) {
            int tt = (tok - NCTX) & 2047;
            int pos0 = tt >> 6, pos1 = tt & 63;
#pragma unroll
            for (int ax = 0; ax < 2; ++ax) {
              int pos = ax == 0 ? pos0 : pos1;
#pragma unroll
              for (int j = 0; j < 4; ++j) {
                float c = rope[(pos * 16 + fq * 4 + j) * 2], s = rope[(pos * 16 + fq * 4 + j) * 2 + 1];
                float x1 = acc[m][2 * ax][j], x2 = acc[m][2 * ax + 1][j];
                acc[m][2 * ax][j] = x1 * c - x2 * s;
                acc[m][2 * ax + 1][j] = x2 * c + x1 * s;
              }
            }
          }
          if (tn < 4) {
#pragma unroll
            for (int n = 0; n < 4; ++n) {
              u32x2 o; o[0] = pack2(acc[m][n][0] * 0.125f, acc[m][n][1] * 0.125f); o[1] = pack2(acc[m][n][2] * 0.125f, acc[m][n][3] * 0.125f);
              *(u32x2*)((u16*)(ws + O_QA) + (size_t)tok * 512 + cb + n * 16) = o;
            }
          } else {
#pragma unroll
            for (int n = 0; n < 4; ++n) {
              int c = cb + n * 16 - 512;
              u32x2 o; o[0] = pack2(acc[m][n][0], acc[m][n][1]); o[1] = pack2(acc[m][n][2], acc[m][n][3]);
              *(u32x2*)((u16*)(ws + O_KA) + (size_t)tok * 128 + c) = o;
              if (ctx) *(f32x4*)(out + OUT_AK + ((size_t)((tok >> 8) * 4 + l) * 256 + (tok & 255)) * 128 + c) = acc[m][n];
            }
          }
        } else if (tn < 21) {
#pragma unroll
          for (int n = 0; n < 4; ++n) *(f32x4*)((float*)(ws + O_PB) + (size_t)tok * 1920 + cb + n * 16 - 768) = acc[m][n];
        } else if (tn < 25) {
#pragma unroll
          for (int n = 0; n < 4; ++n) {
            u32x2 o; o[0] = pack2(acc[m][n][0] * 0.125f, acc[m][n][1] * 0.125f); o[1] = pack2(acc[m][n][2] * 0.125f, acc[m][n][3] * 0.125f);
            *(u32x2*)((u16*)(ws + O_QC) + (size_t)tok * 512 + cb + n * 16 - 2688) = o;
          }
        } else if (tn < 29) {
#pragma unroll
          for (int n = 0; n < 4; ++n) {
            int c = cb + n * 16 - 3200;
            u32x2 o; o[0] = pack2(acc[m][n][0], acc[m][n][1]); o[1] = pack2(acc[m][n][2], acc[m][n][3]);
            *(u32x2*)((u16*)(ws + O_KC) + (size_t)tok * 512 + c) = o;
            if (ctx) *(f32x4*)(out + OUT_CK + ((size_t)((tok >> 8) * 4 + l) * 256 + (tok & 255)) * 512 + c) = acc[m][n];
          }
        } else {
#pragma unroll
          for (int n = 0; n < 4; ++n) {
            u32x2 o; o[0] = pack2(sigmoidf_(acc[m][n][0]), sigmoidf_(acc[m][n][1])); o[1] = pack2(sigmoidf_(acc[m][n][2]), sigmoidf_(acc[m][n][3]));
            *(u32x2*)((u16*)(ws + O_GATE) + (size_t)tok * 3072 + cb + n * 16 - 4224) = o;
          }
        }
      }
    } else {
      const bool isA = (tn == 5);
      u16* VT = isA ? (u16*)(ws + O_VAT) : (u16*)(ws + O_VCT);
      const int ncols = isA ? 128 : 512;
      const size_t obase = isA ? OUT_AV : OUT_CV;
#pragma unroll
      for (int m = 0; m < 4; ++m) {
        const int c = (isA ? 0 : (tn - 29) * 128) + wr * 64 + m * 16 + fr;
#pragma unroll
        for (int n = 0; n < 4; ++n) {
          const int tk = brow + wc * 64 + n * 16 + fq * 4;
          u32x2 o; o[0] = pack2(acc[m][n][0], acc[m][n][1]); o[1] = pack2(acc[m][n][2], acc[m][n][3]);
          *(u32x2*)(VT + (size_t)c * NT + tk) = o;
          if (ctx) {
#pragma unroll
            for (int j = 0; j < 4; ++j) {
              int tok = tk + j;
              out[obase + ((size_t)((tok >> 8) * 4 + l) * 256 + (tok & 255)) * ncols + c] = acc[m][n][j];
            }
          }
        }
      }
    }
  }
}

__device__ void phase_rwkv_prep(const Params& p, int l) {
  char* ws = opaque_ptr(p.ws);
  const int tid = opaque_tid();
  const int lane = tid & 63;
  const int gw = blockIdx.x * 4 + (tid >> 6), GW = gridDim.x * 4;
  const float* PB = (const float*)(ws + O_PB);
  const float* mu = p.in[17] + l * 1920;
  const float* kkw = p.in[23] + l * 512;
  for (int tok = gw; tok < NT; tok += GW) {
    int pos, len;
    if (tok < NCTX) { pos = tok & 255; len = 256; } else { pos = (tok - NCTX) & 2047; len = 2048; }
    const bool hp = pos > 0, hn = pos < len - 1;
    const float* row = PB + (size_t)tok * 1920;
#pragma unroll
    for (int i = 0; i < 8; ++i) {
      int q = lane + 64 * i;
      if (q < 480) {
        int c = q * 4;
        f32x4 cur = *(const f32x4*)(row + c);
        f32x4 pv = hp ? *(const f32x4*)(row - 1920 + c) : f32x4{0.f, 0.f, 0.f, 0.f};
        f32x4 nv = hn ? *(const f32x4*)(row + 1920 + c) : f32x4{0.f, 0.f, 0.f, 0.f};
        f32x4 m4 = *(const f32x4*)(mu + c);
        f32x4 xb;
#pragma unroll
        for (int j = 0; j < 4; ++j) xb[j] = cur[j] + m4[j] * (0.5f * (pv[j] + nv[j]) - cur[j]);
        if (i < 6) {
          *(f32x4*)((float*)(ws + O_XRKV) + (size_t)tok * 1536 + c) = xb;
          if (i == 2 || i == 3) {
            int ck = c - 512;
            f32x4 kw = *(const f32x4*)(kkw + ck);
            f32x4 kv;
            float ss = 0.f;
#pragma unroll
            for (int j = 0; j < 4; ++j) { kv[j] = xb[j] * kw[j]; ss += kv[j] * kv[j]; }
            ss = row_sum16(ss);
            float rn = rsqrtf(ss + 1e-12f);
#pragma unroll
            for (int j = 0; j < 4; ++j) kv[j] *= rn;
            *(f32x4*)((float*)(ws + O_KK) + (size_t)tok * 512 + ck) = kv;
          }
        } else {
          u16* dst;
          int cc;
          float v[4];
          if (c < 1664) { dst = (u16*)(ws + O_TW); cc = c - 1536; for (int j = 0; j < 4; ++j) v[j] = tanhf(xb[j]); }
          else if (c < 1792) { dst = (u16*)(ws + O_AD); cc = c - 1664; for (int j = 0; j < 4; ++j) v[j] = xb[j]; }
          else { dst = (u16*)(ws + O_SG); cc = c - 1792; for (int j = 0; j < 4; ++j) v[j] = sigmoidf_(xb[j]); }
          u32x2 o; o[0] = pack2(v[0], v[1]); o[1] = pack2(v[2], v[3]);
          *(u32x2*)(dst + (size_t)tok * 128 + cc) = o;
        }
      }
    }
  }
}

__device__ void phase_rwkv_lora(const Params& p, int l) {
  char* ws = opaque_ptr(p.ws);
  const int tid = opaque_tid();
  const int wid = tid >> 6, lane = tid & 63, wr = wid >> 1, wc = wid & 1, fr = lane & 15, fq = lane >> 4;
  for (int t = blockIdx.x; t < 5 * 256; t += gridDim.x) {
    const int job = t >> 8, r = t & 255, tm = r & 63, tn = r >> 6;
    const int brow = tm * 128, bcol = tn * 128;
    f32x4 acc[4][4];
    zero_acc(acc);
    const int z = job & 1;
    if (job < 2) gemm_main(tid, (const u16*)(ws + O_TW) + (size_t)brow * 128 + z * 64, 128, (const u16*)(ws + O_W2) + ((size_t)(l * 2 + z) * 512 + bcol) * 64, 64, 64, acc);
    else if (job < 4) gemm_main(tid, (const u16*)(ws + O_AD) + (size_t)brow * 128 + z * 64, 128, (const u16*)(ws + O_A2) + ((size_t)(l * 2 + z) * 512 + bcol) * 64, 64, 64, acc);
    else gemm_main(tid, (const u16*)(ws + O_SG) + (size_t)brow * 128, 128, (const u16*)(ws + O_G2) + ((size_t)l * 512 + bcol) * 128, 128, 128, acc);
#pragma unroll
    for (int m = 0; m < 4; ++m) {
      const int tok = brow + wr * 64 + m * 16 + fr;
#pragma unroll
      for (int n = 0; n < 4; ++n) {
        const int c = bcol + wc * 64 + n * 16 + fq * 4;
        if (job < 2) {
          f32x4 w0 = *(const f32x4*)(p.in[18] + (size_t)(l * 2 + z) * 512 + c);
          f32x4 o;
#pragma unroll
          for (int j = 0; j < 4; ++j) {
            float val = w0[j] + acc[m][n][j];
            float y = -val;
            float sp = fmaxf(y, 0.f) + log1pf(__expf(-fabsf(y)));
            float wlog = -sp - 0.5f;
            o[j] = __expf(-__expf(wlog));
          }
          *(f32x4*)((float*)(ws + O_DEC) + ((size_t)z * NT + tok) * 512 + c) = o;
        } else if (job < 4) {
          f32x4 a0 = *(const f32x4*)(p.in[20] + (size_t)(l * 2 + z) * 512 + c);
          f32x4 ka = *(const f32x4*)(p.in[24] + (size_t)l * 512 + c);
          f32x4 kx = *(const f32x4*)((const float*)(ws + O_XRKV) + (size_t)tok * 1536 + 512 + c);
          f32x4 kk = *(const f32x4*)((const float*)(ws + O_KK) + (size_t)tok * 512 + c);
          f32x4 okd, okka;
#pragma unroll
          for (int j = 0; j < 4; ++j) {
            float a = sigmoidf_(a0[j] + acc[m][n][j]);
            okd[j] = kx[j] * (1.f + (a - 1.f) * ka[j]);
            okka[j] = kk[j] * a;
          }
          *(f32x4*)((float*)(ws + O_KD) + ((size_t)z * NT + tok) * 512 + c) = okd;
          *(f32x4*)((float*)(ws + O_KKA) + ((size_t)z * NT + tok) * 512 + c) = okka;
        } else {
          *(f32x4*)((float*)(ws + O_GG) + (size_t)tok * 512 + c) = acc[m][n];
        }
      }
    }
  }
}

template <int JPL> struct ScanOps { float w[JPL], kd[JPL], kk[JPL], kka[JPL], r[JPL]; float v; };

template <int JPL>
DI void scan_load(ScanOps<JPL>& o, const float* __restrict__ dec, const float* __restrict__ kd, const float* __restrict__ kk,
                  const float* __restrict__ kka, const float* __restrict__ rr, const float* __restrict__ vv, int tok, int cj, int ci) {
  const size_t e = (size_t)tok * 512 + cj;
#pragma unroll
  for (int q = 0; q < JPL / 4; ++q) {
    f32x4 a = *(const f32x4*)(dec + e + q * 4), b = *(const f32x4*)(kd + e + q * 4), c = *(const f32x4*)(kk + e + q * 4),
          d = *(const f32x4*)(kka + e + q * 4), f = *(const f32x4*)(rr + (size_t)tok * 1536 + cj + q * 4);
#pragma unroll
    for (int j = 0; j < 4; ++j) { o.w[q * 4 + j] = a[j]; o.kd[q * 4 + j] = b[j]; o.kk[q * 4 + j] = c[j]; o.kka[q * 4 + j] = d[j]; o.r[q * 4 + j] = f[j]; }
  }
  o.v = vv[(size_t)tok * 1536 + 1024 + ci];
}

template <int JPL> DI float scan_red(float v) {
  v += dppf<0xB1>(v);
  v += dppf<0x4E>(v);
  if (JPL <= 8) v += dppf<0x141>(v);
  if (JPL <= 4) v += dppf<0x140>(v);
  return v;
}

template <int JPL>
DI void scan_step(float (&S)[JPL], const ScanOps<JPL>& o, float* __restrict__ y, int tok, int ci, bool wr) {
  float sa0 = 0.f, sa1 = 0.f;
#pragma unroll
  for (int j = 0; j < JPL; j += 2) { sa0 += S[j] * o.kk[j]; sa1 += S[j + 1] * o.kk[j + 1]; }
  float sa = -scan_red<JPL>(sa0 + sa1);
  float y0 = 0.f, y1 = 0.f;
#pragma unroll
  for (int j = 0; j < JPL; j += 2) {
    S[j] = S[j] * o.w[j] + (sa * o.kka[j] + o.v * o.kd[j]);
    S[j + 1] = S[j + 1] * o.w[j + 1] + (sa * o.kka[j + 1] + o.v * o.kd[j + 1]);
    y0 += S[j] * o.r[j]; y1 += S[j + 1] * o.r[j + 1];
  }
  float yv = scan_red<JPL>(y0 + y1);
  if (wr) y[(size_t)tok * 512 + ci] = yv;
}

template <int JPL, int D>
DI void scan_wave(char* ws, int lane, int z, int h, int tok0, int T, int rowbase, const float* __restrict__ s0, float* __restrict__ sout) {
  constexpr int LPR = 64 / JPL;
  const int rr = lane / LPR, pp = lane % LPR;
  const int i = rowbase + rr, j0 = pp * JPL;
  const int cj = h * 64 + j0, ci = h * 64 + i;
  const float* dec = (const float*)(ws + O_DEC) + (size_t)z * NT * 512;
  const float* kd = (const float*)(ws + O_KD) + (size_t)z * NT * 512;
  const float* kka = (const float*)(ws + O_KKA) + (size_t)z * NT * 512;
  const float* kk = (const float*)(ws + O_KK);
  const float* xr = (const float*)(ws + O_XRKV);
  float* y = (float*)(ws + O_YS) + (size_t)z * NT * 512;
  float S[JPL];
#pragma unroll
  for (int j = 0; j < JPL; ++j) S[j] = s0 ? s0[i * 64 + j0 + j] : 0.f;
  const int dir = z == 0 ? 1 : -1;
  const int first = z == 0 ? tok0 : tok0 + T - 1;
  const bool wr = pp == 0;
  ScanOps<JPL> R[D];
#pragma unroll
  for (int d = 0; d < D; ++d) scan_load<JPL>(R[d], dec, kd, kk, kka, xr, xr, first + dir * d, cj, ci);
  for (int n = 0; n < T; n += D) {
#pragma unroll
    for (int d = 0; d < D; ++d) {
      scan_step<JPL>(S, R[d], y, first + dir * (n + d), ci, wr);
      int nn = n + d + D;
      nn = nn < T ? nn : T - 1;
      scan_load<JPL>(R[d], dec, kd, kk, kka, xr, xr, first + dir * nn, cj, ci);
    }
  }
  if (sout) {
#pragma unroll
    for (int j = 0; j < JPL; ++j) sout[i * 64 + j0 + j] = S[j];
  }
}

DI void dma16(const char* gptr, unsigned ldsaddr) {
  asm volatile("s_mov_b32 m0, %0\n\ts_nop 0\n\tglobal_load_lds_dwordx4 %1, off" ::"s"(ldsaddr), "v"(gptr) : "memory");
}
template <int N> DI void wait_vm() { asm volatile("s_waitcnt vmcnt(%0)" ::"n"(N) : "memory"); }

template <int JPL> struct ScanRegs { float w[JPL], kd[JPL], kk[JPL], kka[JPL], r[JPL]; float v; };
template <int JPL> DI void scan_lds_read(ScanRegs<JPL>& o, const char* slot, int pp, int rr) {
#pragma unroll
  for (int q = 0; q < JPL / 4; ++q) {
    f32x4 a = *(const f32x4*)(slot + 0 + pp * JPL * 4 + q * 16), b = *(const f32x4*)(slot + 256 + pp * JPL * 4 + q * 16),
          c = *(const f32x4*)(slot + 512 + pp * JPL * 4 + q * 16), d = *(const f32x4*)(slot + 768 + pp * JPL * 4 + q * 16),
          f = *(const f32x4*)(slot + 1024 + pp * JPL * 4 + q * 16);
#pragma unroll
    for (int j = 0; j < 4; ++j) { o.w[q * 4 + j] = a[j]; o.kd[q * 4 + j] = b[j]; o.kk[q * 4 + j] = c[j]; o.kka[q * 4 + j] = d[j]; o.r[q * 4 + j] = f[j]; }
  }
  o.v = *(const float*)(slot + 1280 + rr * 4);
}
template <int JPL>
DI void scan_step2(float (&S)[JPL], const ScanRegs<JPL>& o, float* __restrict__ yp, bool wr) {
  float sa0 = 0.f, sa1 = 0.f;
#pragma unroll
  for (int j = 0; j < JPL; j += 2) { sa0 += S[j] * o.kk[j]; sa1 += S[j + 1] * o.kk[j + 1]; }
  float sa = -scan_red<JPL>(sa0 + sa1);
  float y0 = 0.f, y1 = 0.f;
#pragma unroll
  for (int j = 0; j < JPL; j += 2) {
    S[j] = sa * o.kka[j] + (S[j] * o.w[j] + o.v * o.kd[j]);
    S[j + 1] = sa * o.kka[j + 1] + (S[j + 1] * o.w[j + 1] + o.v * o.kd[j + 1]);
    y0 += S[j] * o.r[j]; y1 += S[j + 1] * o.r[j + 1];
  }
  float yv = scan_red<JPL>(y0 + y1);
  if (wr) *yp = yv;
}

template <int JPL, int NS>
DI void scan_wave_dma(char* ws, int lane, int ringoff, int z, int h, int tok0, int T, int rowbase, const float* __restrict__ s0,
                      float* __restrict__ sout) {
  constexpr int LPR = 64 / JPL, PD = NS - 1, WN = 3 * PD - 3;
  static_assert(WN <= 63, "vmcnt range");
  const int rr = lane / LPR, pp = lane % LPR;
  const int i = rowbase + rr, j0 = pp * JPL;
  const int dir = z == 0 ? 1 : -1;
  const int first = z == 0 ? tok0 : tok0 + T - 1;
  const bool wr = pp == 0;
  float S[JPL];
#pragma unroll
  for (int j = 0; j < JPL; ++j) S[j] = s0 ? s0[i * 64 + j0 + j] : 0.f;
  const int a = lane >> 4, c16 = lane & 15;
  const float* arr = a == 0 ? (const float*)(ws + O_DEC) + (size_t)z * NT * 512
                   : a == 1 ? (const float*)(ws + O_KD) + (size_t)z * NT * 512
                   : a == 2 ? (const float*)(ws + O_KK)
                            : (const float*)(ws + O_KKA) + (size_t)z * NT * 512;
  const char* gA = (const char*)(arr + (size_t)first * 512 + h * 64 + c16 * 4);
  const char* gB = (const char*)((const float*)(ws + O_XRKV) + (size_t)first * 1536 + (lane < 16 ? h * 64 + c16 * 4 : 1024 + h * 64 + rowbase + (lane - 16) * 4));
  const long stA = (long)dir * 2048, stB = (long)dir * 6144;
  const bool bact = lane < 16 + JPL / 4;
  ringoff = __builtin_amdgcn_readfirstlane(ringoff);
  const unsigned ring = (unsigned)(size_t)g_smem + (unsigned)ringoff;
  const char* ringp = g_smem + ringoff;
  float* yp = (float*)(ws + O_YS) + (size_t)z * NT * 512 + (size_t)first * 512 + h * 64 + i;
  const long sty = (long)dir * 512;
  float* dummy = (float*)(ws + O_MERG) + lane;
#pragma unroll 1
  for (int s = 0; s < PD; ++s) {
    unsigned slot = ring + (unsigned)(s & (NS - 1)) * 1536u;
    dma16(gA, slot);
    if (bact) dma16(gB, slot + 1024u);
    gA += stA; gB += stB;
    if (wr) dummy[s * 64] = 0.f;
  }
  ScanRegs<JPL> A, B;
  wait_vm<3 * PD - 3>();
  wait_vm<3 * (PD - 1)>();
  scan_lds_read<JPL>(A, ringp, pp, rr);
  for (int n = 0; n < T; n += 2) {
    {
      unsigned sl = (unsigned)((n + PD) & (NS - 1)) * 1536u;
      dma16(gA, ring + sl);
      if (bact) dma16(gB, ring + sl + 1024u);
      gA += stA; gB += stB;
      wait_vm<WN>();
      scan_lds_read<JPL>(B, ringp + ((n + 1) & (NS - 1)) * 1536, pp, rr);
      scan_step2<JPL>(S, A, yp, wr);
      yp += sty;
    }
    {
      unsigned sl = (unsigned)((n + 1 + PD) & (NS - 1)) * 1536u;
      dma16(gA, ring + sl);
      if (bact) dma16(gB, ring + sl + 1024u);
      gA += stA; gB += stB;
      wait_vm<WN>();
      scan_lds_read<JPL>(A, ringp + ((n + 2) & (NS - 1)) * 1536, pp, rr);
      scan_step2<JPL>(S, B, yp, wr);
      yp += sty;
    }
  }
  wait_vm<0>();
  if (sout) {
#pragma unroll
    for (int j = 0; j < JPL; ++j) sout[i * 64 + j0 + j] = S[j];
  }
}

template <int JPL>
DI void scan_dots(const float (&S)[JPL], const ScanRegs<JPL>& cur, const ScanRegs<JPL>& prv, float& d1, float& d2) {
  float a0 = 0.f, a1 = 0.f, b0 = 0.f, b1 = 0.f;
#pragma unroll
  for (int j = 0; j < JPL; j += 2) {
    a0 += S[j] * cur.kk[j]; b0 += S[j] * prv.r[j];
    a1 += S[j + 1] * cur.kk[j + 1]; b1 += S[j + 1] * prv.r[j + 1];
  }
  d1 = a0 + a1; d2 = b0 + b1;
}
template <int JPL> DI void scan_red2(float& a, float& b) {
  a += dppf<0xB1>(a); b += dppf<0xB1>(b);
  a += dppf<0x4E>(a); b += dppf<0x4E>(b);
  if (JPL <= 8) { a += dppf<0x141>(a); b += dppf<0x141>(b); }
  if (JPL <= 4) { a += dppf<0x140>(a); b += dppf<0x140>(b); }
}
template <int JPL> DI void scan_pre(float (&Tm)[JPL], const float (&S)[JPL], const ScanRegs<JPL>& o) {
#pragma unroll
  for (int j = 0; j < JPL; ++j) Tm[j] = S[j] * o.w[j] + o.v * o.kd[j];
}
template <int JPL> DI void scan_update(float (&S)[JPL], const float (&Tm)[JPL], const ScanRegs<JPL>& o, float sa) {
#pragma unroll
  for (int j = 0; j < JPL; ++j) S[j] = sa * o.kka[j] + Tm[j];
}

template <int JPL, int T>
DI void scan_latent_block(char* ws, int tid, int z, int h, int tok0, int rowblock, const float* __restrict__ s0, float* __restrict__ sout) {
  constexpr int LPR = 64 / JPL, G = 7, WNV = 6 * G - 2;
  const int wid = __builtin_amdgcn_readfirstlane(tid >> 6), lane = tid & 63;
  const int rr = lane / LPR, pp = lane % LPR;
  const int rloc = wid * JPL + rr;
  const int i = rowblock + rloc, j0 = pp * JPL;
  const int dir = z == 0 ? 1 : -1;
  const int first = z == 0 ? tok0 : tok0 + T - 1;
  const bool wr = pp == 0;
  float S[JPL];
#pragma unroll
  for (int j = 0; j < JPL; ++j) S[j] = s0 ? s0[i * 64 + j0 + j] : 0.f;
  const int a = lane >> 4, c16 = lane & 15;
  const float* arr = a == 0 ? (const float*)(ws + O_DEC) + (size_t)z * NT * 512
                   : a == 1 ? (const float*)(ws + O_KD) + (size_t)z * NT * 512
                   : a == 2 ? (const float*)(ws + O_KK)
                            : (const float*)(ws + O_KKA) + (size_t)z * NT * 512;
  const int fw = first + dir * wid;
  const char* gA = (const char*)(arr + (size_t)fw * 512 + h * 64 + c16 * 4);
  const char* gB = (const char*)((const float*)(ws + O_XRKV) + (size_t)fw * 1536 + (lane < 16 ? h * 64 + c16 * 4 : 1024 + h * 64 + rowblock + (lane - 16) * 4));
  const long stA = (long)dir * 4 * 2048, stB = (long)dir * 4 * 6144;
  const bool bact = lane < 16 + JPL;
  const unsigned ring = (unsigned)(size_t)g_smem;
  const char* ringp = g_smem;
  float* yp = (float*)(ws + O_YS) + (size_t)z * NT * 512 + (size_t)first * 512 + h * 64 + i;
  const long sty = (long)dir * 512;
  float* dummy = (float*)(ws + O_MERG) + tid;
#pragma unroll 1
  for (int g = 0; g < G; ++g) {
    unsigned slot = ring + (unsigned)((4 * g + wid) & 31) * 1536u;
    dma16(gA, slot);
    if (bact) dma16(gB, slot + 1024u);
    gA += stA; gB += stB;
    if (wr) { dummy[(g * 4 + 0) * 256] = 0.f; }
    if (wr) { dummy[(g * 4 + 1) * 256] = 0.f; }
    if (wr) { dummy[(g * 4 + 2) * 256] = 0.f; }
    if (wr) { dummy[(g * 4 + 3) * 256] = 0.f; }
    asm volatile("" ::: "memory");
  }
  ScanRegs<JPL> A, B;
#pragma unroll
  for (int j = 0; j < JPL; ++j) B.r[j] = 0.f;
  float* ypv = dummy + 28 * 256;
  wait_vm<WNV>();
  asm volatile("" ::: "memory");
  __builtin_amdgcn_s_barrier();
  asm volatile("" ::: "memory");
  scan_lds_read<JPL>(A, ringp, pp, rloc);
#pragma unroll 1
  for (int g = 0; g < T / 4; ++g) {
    wait_vm<WNV - 6>();

    asm volatile("" ::: "memory");
    __builtin_amdgcn_s_barrier();
    asm volatile("" ::: "memory");
    {
      unsigned slot = ring + (unsigned)((4 * (g + G) + wid) & 31) * 1536u;
      dma16(gA, slot);
      if (bact) dma16(gB, slot + 1024u);
      gA += stA; gB += stB;
    }
    const char* gp = ringp + ((4 * g) & 31) * 1536;
    if (JPL >= 8) {
#pragma unroll
      for (int k = 0; k < 4; ++k) {
        scan_lds_read<JPL>(A, gp + k * 1536, pp, rloc);
        scan_step2<JPL>(S, A, yp, wr);
        yp += sty;
        asm volatile("" ::: "memory");
      }
      continue;
    }
    float d1, y0, y1, y2, y3;
    float Tm[JPL];
    scan_dots<JPL>(S, A, B, d1, y0);
    scan_pre<JPL>(Tm, S, A);
    scan_lds_read<JPL>(B, gp + 1536, pp, rloc);
    scan_red2<JPL>(d1, y0);
    scan_update<JPL>(S, Tm, A, -d1);
    scan_dots<JPL>(S, B, A, d1, y1);
    scan_pre<JPL>(Tm, S, B);
    scan_lds_read<JPL>(A, gp + 2 * 1536, pp, rloc);
    scan_red2<JPL>(d1, y1);
    scan_update<JPL>(S, Tm, B, -d1);
    scan_dots<JPL>(S, A, B, d1, y2);
    scan_pre<JPL>(Tm, S, A);
    scan_lds_read<JPL>(B, gp + 3 * 1536, pp, rloc);
    scan_red2<JPL>(d1, y2);
    scan_update<JPL>(S, Tm, A, -d1);
    scan_dots<JPL>(S, B, A, d1, y3);
    scan_pre<JPL>(Tm, S, B);
    scan_lds_read<JPL>(A, ringp + ((4 * g + 4) & 31) * 1536, pp, rloc);
    scan_red2<JPL>(d1, y3);
    scan_update<JPL>(S, Tm, B, -d1);
    if (wr) {
      *ypv = y0;
      yp[0] = y1;
      yp[sty] = y2;
      yp[2 * sty] = y3;
    }
    ypv = yp + 3 * sty;
    yp += 4 * sty;
    asm volatile("" ::: "memory");
  }
  {
    float e0 = 0.f, e1 = 0.f;
#pragma unroll
    for (int j = 0; j < JPL; j += 2) { e0 += S[j] * B.r[j]; e1 += S[j + 1] * B.r[j + 1]; }
    float yv = scan_red<JPL>(e0 + e1);
    if (wr) *ypv = yv;
  }
  wait_vm<0>();
  asm volatile("" ::: "memory");
  __builtin_amdgcn_s_barrier();
  asm volatile("" ::: "memory");
  if (sout) {
#pragma unroll
    for (int j = 0; j < JPL; ++j) sout[i * 64 + j0 + j] = S[j];
  }
}

struct AttnSt { float m, l; f32x4 o[4]; };

struct AttnKVF { bf16x8 k[2][2]; bf16x8 v[4]; };
DI void attn_kvload(AttnKVF& f, const u16* __restrict__ kp, int ldk, const u16* __restrict__ vtp, int ldv, int fr, int fq) {
#pragma unroll
  for (int kt = 0; kt < 2; ++kt)
#pragma unroll
    for (int ks = 0; ks < 2; ++ks) f.k[kt][ks] = *(const bf16x8*)(kp + (size_t)(8 * (fr >> 2) + 4 * kt + (fr & 3)) * ldk + ks * 32 + fq * 8);
#pragma unroll
  for (int dt = 0; dt < 4; ++dt) f.v[dt] = *(const bf16x8*)(vtp + (size_t)(dt * 16 + fr) * ldv + fq * 8);
}
template <int MODE>
DI void attn_core(AttnSt& st, const bf16x8 (&qf)[2], const AttnKVF& f, int fr, int fq, int qpos, int kpos0, const float* __restrict__ rpbrow) {
  f32x4 s[2];
#pragma unroll
  for (int kt = 0; kt < 2; ++kt) {
    s[kt] = f32x4{0.f, 0.f, 0.f, 0.f};
#pragma unroll
    for (int ks = 0; ks < 2; ++ks) s[kt] = mfma16(f.k[kt][ks], qf[ks], s[kt]);
  }
  if (MODE != 0) {
#pragma unroll
    for (int kt = 0; kt < 2; ++kt)
#pragma unroll
      for (int j = 0; j < 4; ++j) {
        int kpos = kpos0 + 8 * fq + 4 * kt + j;
        if (MODE == 1) {
          int d = qpos - kpos;
          if (d > 128 || d < -128) s[kt][j] = -1e30f;
        } else {
          int cs = min(max(qpos - 8, 0), 48);
          int dc = min(max(kpos - qpos, -15), 15) + 15;
          float b = rpbrow[dc];
          s[kt][j] = (kpos >= cs && kpos < cs + 16) ? s[kt][j] + b : -1e30f;
        }
      }
  }
  float mx = fmaxf(fmaxf(fmaxf(s[0][0], s[0][1]), fmaxf(s[0][2], s[0][3])), fmaxf(fmaxf(s[1][0], s[1][1]), fmaxf(s[1][2], s[1][3])));
  mx = fmaxf(mx, __shfl_xor(mx, 16));
  mx = fmaxf(mx, __shfl_xor(mx, 32));
  float mn = fmaxf(st.m, mx);
  float alpha = __expf(st.m - mn);
  st.m = mn;
  float ps = 0.f;
  float pv[8];
#pragma unroll
  for (int kt = 0; kt < 2; ++kt)
#pragma unroll
    for (int j = 0; j < 4; ++j) { float e = __expf(s[kt][j] - mn); pv[kt * 4 + j] = e; ps += e; }
  st.l = st.l * alpha + ps;
  u32x4 pk;
  pk[0] = pack2(pv[0], pv[1]); pk[1] = pack2(pv[2], pv[3]); pk[2] = pack2(pv[4], pv[5]); pk[3] = pack2(pv[6], pv[7]);
  bf16x8 pf = __builtin_bit_cast(bf16x8, pk);
#pragma unroll
  for (int dt = 0; dt < 4; ++dt) {
    bf16x8 vf = f.v[dt];
#pragma unroll
    for (int j = 0; j < 4; ++j) st.o[dt][j] *= alpha;
    st.o[dt] = mfma16(vf, pf, st.o[dt]);
  }
}

DI void attn_item(const Params& p, char* ws, int lane, int l, int item) {
  const int fr = lane & 15, fq = lane >> 4;
  const int type = item >> 10, r = item & 1023;
  const int h = r & 7, qp = r >> 3;
  AttnSt st[2];
  const u16* Q;
  u16* Y;
  if (type == 0 || type == 2) { Q = (const u16*)(ws + O_QA); Y = (u16*)(ws + O_YABC); }
  else { Q = (const u16*)(ws + O_QC); Y = (u16*)(ws + O_YABC) + 2ull * NT * 512; }
  const int tok0 = (type < 2 ? NCTX : 0) + qp * 32;
  bf16x8 qf[2][2];
  const bool hasSink = (type == 0 || type == 2);
#pragma unroll
  for (int i = 0; i < 2; ++i) {
#pragma unroll
    for (int dt = 0; dt < 4; ++dt) st[i].o[dt] = f32x4{0.f, 0.f, 0.f, 0.f};
#pragma unroll
    for (int ks = 0; ks < 2; ++ks) qf[i][ks] = *(const bf16x8*)(Q + (size_t)(tok0 + i * 16 + fr) * 512 + h * 64 + ks * 32 + fq * 8);
    if (hasSink) { st[i].m = p.in[15][l * 8 + h]; st[i].l = fq == 0 ? 1.f : 0.f; }
    else { st[i].m = -1e30f; st[i].l = 0.f; }
  }
  AttnKVF f;
  if (type == 0) {
    const int qt = qp * 2;
    const int b = qt >> 7, kv = h >> 2;
    const u16* ck = (const u16*)(ws + O_CAK) + ((size_t)(b * 4 + l) * 512) * 128 + kv * 64;
    const u16* cvt = (const u16*)(ws + O_CAVT) + ((size_t)(b * 4 + l) * 128 + kv * 64) * 512;
    for (int p0 = 0; p0 < 512; p0 += 32) {
      attn_kvload(f, ck + (size_t)p0 * 128, 128, cvt + p0, 512, fr, fq);
      attn_core<0>(st[0], qf[0], f, fr, fq, 0, 0, nullptr);
      attn_core<0>(st[1], qf[1], f, fr, fq, 0, 0, nullptr);
    }
    const u16* K = (const u16*)(ws + O_KA) + (size_t)(NCTX + b * 2048) * 128 + kv * 64;
    const u16* VT = (const u16*)(ws + O_VAT) + (size_t)(kv * 64) * NT + NCTX + b * 2048;
    const int ta = (qt & 127) * 16;
    const int kb0 = max(0, ((ta - 128) >> 5) << 5), kb1 = min(2048, ta + 32 + 128);
    for (int k0 = kb0; k0 < kb1; k0 += 32) {
      attn_kvload(f, K + (size_t)k0 * 128, 128, VT + k0, NT, fr, fq);
      attn_core<1>(st[0], qf[0], f, fr, fq, ta + fr, k0, nullptr);
      attn_core<1>(st[1], qf[1], f, fr, fq, ta + 16 + fr, k0, nullptr);
    }
  } else if (type == 1) {
    const int qt = qp * 2;
    const int b = qt >> 7;
    const u16* ck = (const u16*)(ws + O_CCK) + ((size_t)(b * 4 + l) * 512) * 512 + h * 64;
    const u16* cvt = (const u16*)(ws + O_CCVT) + ((size_t)(b * 4 + l) * 512 + h * 64) * 512;
    for (int p0 = 0; p0 < 512; p0 += 32) {
      attn_kvload(f, ck + (size_t)p0 * 512, 512, cvt + p0, 512, fr, fq);
      attn_core<0>(st[0], qf[0], f, fr, fq, 0, 0, nullptr);
      attn_core<0>(st[1], qf[1], f, fr, fq, 0, 0, nullptr);
    }
    const u16* K = (const u16*)(ws + O_KC) + (size_t)(NCTX + b * 2048) * 512 + h * 64;
    const u16* VT = (const u16*)(ws + O_VCT) + (size_t)(h * 64) * NT + NCTX + b * 2048;
    const float* rpb = p.in[29] + (size_t)(l * 8 + h) * 15 * 31;
#pragma unroll
    for (int i = 0; i < 2; ++i) {
      const int t0 = ((qt + i) & 127) * 16;
      const int qrow = t0 >> 6, c0 = t0 & 63;
      const int rs = min(max(qrow - 4, 0), 24);
      const int cstart = min(max(c0 - 8, 0), 32);
      for (int a = 0; a < 8; ++a) {
        int krow = rs + a;
        int k0 = krow * 64 + cstart;
        attn_kvload(f, K + (size_t)k0 * 512, 512, VT + k0, NT, fr, fq);
        attn_core<2>(st[i], qf[i], f, fr, fq, c0 + fr, cstart, rpb + (krow - qrow + 7) * 31);
      }
    }
  } else if (type == 2) {
    const int b = (qp * 2) >> 4, kv = h >> 2;
    const u16* K = (const u16*)(ws + O_KA) + (size_t)(b * 256) * 128 + kv * 64;
    const u16* VT = (const u16*)(ws + O_VAT) + (size_t)(kv * 64) * NT + b * 256;
    for (int k0 = 0; k0 < 256; k0 += 32) {
      attn_kvload(f, K + (size_t)k0 * 128, 128, VT + k0, NT, fr, fq);
      attn_core<0>(st[0], qf[0], f, fr, fq, 0, 0, nullptr);
      attn_core<0>(st[1], qf[1], f, fr, fq, 0, 0, nullptr);
    }
  } else {
    const int b = (qp * 2) >> 4;
    const u16* K = (const u16*)(ws + O_KC) + (size_t)(b * 256) * 512 + h * 64;
    const u16* VT = (const u16*)(ws + O_VCT) + (size_t)(h * 64) * NT + b * 256;
    for (int k0 = 0; k0 < 256; k0 += 32) {
      attn_kvload(f, K + (size_t)k0 * 512, 512, VT + k0, NT, fr, fq);
      attn_core<0>(st[0], qf[0], f, fr, fq, 0, 0, nullptr);
      attn_core<0>(st[1], qf[1], f, fr, fq, 0, 0, nullptr);
    }
  }
#pragma unroll
  for (int i = 0; i < 2; ++i) {
    float lt = st[i].l;
    lt += __shfl_xor(lt, 16);
    lt += __shfl_xor(lt, 32);
    float inv = 1.f / lt;
#pragma unroll
    for (int dt = 0; dt < 4; ++dt) {
      u32x2 o; o[0] = pack2(st[i].o[dt][0] * inv, st[i].o[dt][1] * inv); o[1] = pack2(st[i].o[dt][2] * inv, st[i].o[dt][3] * inv);
      *(u32x2*)(Y + (size_t)(tok0 + i * 16 + fr) * 512 + h * 64 + dt * 16 + fq * 4) = o;
    }
  }
}


__device__ void phase_mix(const Params& p, int l) {
  char* ws = opaque_ptr(p.ws);
  const int tid = opaque_tid();
  const int wid = tid >> 6, lane = tid & 63;
  constexpr int LJPL = 4;
  constexpr int BPS = 64 / (4 * LJPL);
  const int NLB = (int)gridDim.x >= 2 * 32 * BPS ? 32 * BPS : 0;
  if ((int)blockIdx.x < NLB) {
    __builtin_amdgcn_s_setprio(3);
    const int it = blockIdx.x;
    const int sc = it / BPS, hf = it % BPS;
    const int z = sc & 1, h = (sc >> 1) & 7, b = sc >> 4;
    const float* s0 = p.in[6] + ((size_t)((b * 4 + l) * 2 + z) * 8 + h) * 4096;
    scan_latent_block<LJPL, 2048>(ws, tid, z, h, NCTX + b * 2048, hf * 4 * LJPL, s0, nullptr);
  } else {
    __builtin_amdgcn_s_setprio(1);
    if (NLB == 0) {
      for (int it = blockIdx.x * 4 + wid; it < 256; it += gridDim.x * 4) {
        int sc = it >> 3, part = it & 7;
        int z = sc & 1, h = (sc >> 1) & 7, b = sc >> 4;
        const float* s0 = p.in[6] + ((size_t)((b * 4 + l) * 2 + z) * 8 + h) * 4096;
        scan_wave_dma<8, 8>(ws, lane, wid * 12288, z, h, NCTX + b * 2048, 2048, part * 8, s0, nullptr);
      }
    }
    if (NLB > 0) {
      const int nab = (int)gridDim.x - NLB;
      for (int it = (int)blockIdx.x - NLB; it < 512; it += nab) {
        int sc = it >> 1, hf = it & 1;
        int z = sc & 1, h = (sc >> 1) & 7, b = sc >> 4;
        float* so = p.out + OUT_ST + ((size_t)((b * 4 + l) * 2 + z) * 8 + h) * 4096;
        scan_latent_block<8, 256>(ws, tid, z, h, b * 256, hf * 32, nullptr, so);
      }
    } else {
      const int nw = gridDim.x * 4;
      for (int it = (int)blockIdx.x * 4 + wid; it < 2048; it += nw) {
        int sc = it >> 3, part = it & 7;
        int z = sc & 1, h = (sc >> 1) & 7, b = sc >> 4;
        float* so = p.out + OUT_ST + ((size_t)((b * 4 + l) * 2 + z) * 8 + h) * 4096;
        scan_wave_dma<8, 8>(ws, lane, wid * 12288, z, h, b * 256, 256, part * 8, nullptr, so);
      }
    }
  }
  __builtin_amdgcn_s_setprio(0);
  int* cnt = (int*)(ws + O_CNT) + l;
  while (true) {
    int it = 0;
    if (lane == 0) it = atomicAdd(cnt, 1);
    it = __builtin_amdgcn_readfirstlane(it);
    if (it >= 4096) break;
    attn_item(p, ws, lane, l, it);
  }
  if (l == 0) {
    int* cnt2 = (int*)(ws + O_CNT) + 8;
    while (true) {
      int it = 0;
      if (lane == 0) it = atomicAdd(cnt2, 1);
      it = __builtin_amdgcn_readfirstlane(it);
      if (it >= 4096) break;
      const int tab = it >> 11, rb = (it & 2047) * 32;
      if (tab == 0) convert_rows_fp8_wave(lane, p.in[34], (unsigned char*)(ws + O_PEU), (float*)(ws + O_SCU), rb, rb + 32);
      else convert_rows_fp8_wave(lane, p.in[35], (unsigned char*)(ws + O_PEV), (float*)(ws + O_SCV), rb, rb + 32);
    }
  }
}

__device__ void phase_rwkv_post(const Params& p, int l) {
  char* ws = opaque_ptr(p.ws);
  const int tid = opaque_tid();
  const int lane = tid & 63;
  const int gw = blockIdx.x * 4 + (tid >> 6), GW = gridDim.x * 4;
  const float* Y0 = (const float*)(ws + O_YS);
  const float* Y1 = Y0 + (size_t)NT * 512;
  const float* KD0 = (const float*)(ws + O_KD);
  const float* KD1 = KD0 + (size_t)NT * 512;
  for (int tok = gw; tok < NT; tok += GW) {
#pragma unroll
    for (int i = 0; i < 2; ++i) {
      int c = (lane + 64 * i) * 4;
      size_t e = (size_t)tok * 512 + c;
      f32x4 a = *(const f32x4*)(Y0 + e), b = *(const f32x4*)(Y1 + e);
      f32x4 y;
      float s = 0.f;
#pragma unroll
      for (int j = 0; j < 4; ++j) { y[j] = a[j] + b[j]; s += y[j]; }
      float mu = row_sum16(s) * (1.f / 64.f);
      float vs = 0.f;
#pragma unroll
      for (int j = 0; j < 4; ++j) { y[j] -= mu; vs += y[j] * y[j]; }
      float var = row_sum16(vs) * (1.f / 64.f);
      float rstd = rsqrtf(var + 64e-5f);
      f32x4 g = *(const f32x4*)(p.in[26] + l * 512 + c), bb = *(const f32x4*)(p.in[27] + l * 512 + c);
      f32x4 r = *(const f32x4*)((const float*)(ws + O_XRKV) + (size_t)tok * 1536 + c);
      f32x4 v = *(const f32x4*)((const float*)(ws + O_XRKV) + (size_t)tok * 1536 + 1024 + c);
      f32x4 k0 = *(const f32x4*)(KD0 + e), k1 = *(const f32x4*)(KD1 + e);
      f32x4 rk = *(const f32x4*)(p.in[25] + l * 512 + c);
      float bs = 0.f;
#pragma unroll
      for (int j = 0; j < 4; ++j) bs += r[j] * (k0[j] + k1[j]) * rk[j];
      bs = row_sum16(bs);
      f32x4 gg = *(const f32x4*)((const float*)(ws + O_GG) + e);
      float o[4];
#pragma unroll
      for (int j = 0; j < 4; ++j) o[j] = (y[j] * rstd * g[j] + bb[j] + bs * v[j]) * gg[j];
      u32x2 ov; ov[0] = pack2(o[0], o[1]); ov[1] = pack2(o[2], o[3]);
      *(u32x2*)((u16*)(ws + O_YABC) + (size_t)NT * 512 + e) = ov;
    }
  }
}

__device__ void phase_branch(const Params& p, int l) {
  char* ws = opaque_ptr(p.ws);
  const int tid = opaque_tid();
  const int wid = tid >> 6, lane = tid & 63, wr = wid >> 1, wc = wid & 1, fr = lane & 15, fq = lane >> 4;
  const u16* G = (const u16*)(ws + O_GATE);
  for (int t = blockIdx.x; t < 64 * 8; t += gridDim.x) {
    const int tm = t & 63, tn = t >> 6;
    const int brow = tm * 128, bcol = tn * 128;
    f32x4 tot[4][4];
    zero_acc(tot);
#pragma unroll 1
    for (int br = 0; br < 3; ++br) {
      f32x4 acc[4][4];
      zero_acc(acc);
      const u16* Wb = (const u16*)(ws + (br == 0 ? O_AOUT : br == 1 ? O_RWOUT : O_NAOUT)) + ((size_t)l * 1024 + bcol) * 512;
      gemm_main(tid, (const u16*)(ws + O_YABC) + (size_t)br * NT * 512 + (size_t)brow * 512, 512, Wb, 512, 512, acc, ((tm >> 3) + (tn & 7)) & 7);
#pragma unroll
      for (int m = 0; m < 4; ++m) {
        const int tok = brow + wr * 64 + m * 16 + fr;
#pragma unroll
        for (int n = 0; n < 4; ++n) {
          const int c = bcol + wc * 64 + n * 16 + fq * 4;
          u32x2 gv = *(const u32x2*)(G + (size_t)tok * 3072 + br * 1024 + c);
          tot[m][n][0] += acc[m][n][0] * __uint_as_float(gv[0] << 16);
          tot[m][n][1] += acc[m][n][1] * __uint_as_float(gv[0] & 0xffff0000u);
          tot[m][n][2] += acc[m][n][2] * __uint_as_float(gv[1] << 16);
          tot[m][n][3] += acc[m][n][3] * __uint_as_float(gv[1] & 0xffff0000u);
        }
      }
    }
#pragma unroll
    for (int m = 0; m < 4; ++m) {
      const int tok = brow + wr * 64 + m * 16 + fr;
#pragma unroll
      for (int n = 0; n < 4; ++n) {
        const int c = bcol + wc * 64 + n * 16 + fq * 4;
        u32x2 o; o[0] = pack2(tot[m][n][0], tot[m][n][1]); o[1] = pack2(tot[m][n][2], tot[m][n][3]);
        *(u32x2*)((u16*)(ws + O_MERG) + (size_t)tok * 1024 + c) = o;
      }
    }
  }
}

__device__ void phase_wo(const Params& p, int l) {
  char* ws = opaque_ptr(p.ws);
  const int tid = opaque_tid();
  const int wid = tid >> 6, lane = tid & 63, wr = wid >> 1, wc = wid & 1, fr = lane & 15, fq = lane >> 4;
  float* X = (float*)(ws + O_X);
  for (int t = blockIdx.x; t < 64 * 8; t += gridDim.x) {
    const int tm = t & 63, tn = t >> 6;
    const int brow = tm * 128, bcol = tn * 128;
    f32x4 acc[4][4];
    zero_acc(acc);
    gemm_main(tid, (const u16*)(ws + O_MERG) + (size_t)brow * 1024, 1024, (const u16*)(ws + O_WO) + ((size_t)l * 1024 + bcol) * 1024, 1024, 1024, acc, (((tm >> 3) + (tn & 7)) * 2) & 15);
#pragma unroll
    for (int m = 0; m < 4; ++m) {
      const int tok = brow + wr * 64 + m * 16 + fr;
      const float* gate = (const float*)(ws + O_MOD) + ((size_t)l * 3 + tok_cond(tok)) * 6144 + 2 * 1024;
#pragma unroll
      for (int n = 0; n < 4; ++n) {
        const int c = bcol + wc * 64 + n * 16 + fq * 4;
        f32x4 x = *(f32x4*)(X + (size_t)tok * 1024 + c);
        f32x4 g = *(const f32x4*)(gate + c);
#pragma unroll
        for (int j = 0; j < 4; ++j) x[j] += g[j] * acc[m][n][j];
        *(f32x4*)(X + (size_t)tok * 1024 + c) = x;
      }
    }
  }
}

__device__ void phase_peq(const Params& p, int l) {
  char* ws = opaque_ptr(p.ws);
  const int tid = opaque_tid();
  const int wid = tid >> 6, lane = tid & 63, wr = wid >> 1, wc = wid & 1, fr = lane & 15, fq = lane >> 4;
  for (int t = blockIdx.x; t < 64 * 16; t += gridDim.x) {
    const int tm = t & 63, tn = t >> 6;
    const int brow = tm * 128, bcol = tn * 128;
    f32x4 acc[4][4];
    zero_acc(acc);
    gemm_main(tid, (const u16*)(ws + O_H) + (size_t)brow * 1024, 1024, (const u16*)(ws + O_PEQ) + ((size_t)l * 2048 + bcol) * 1024, 1024, 1024, acc, (((tm >> 3) + (tn & 7)) * 2) & 15);
#pragma unroll
    for (int m = 0; m < 4; ++m) {
      const int tok = brow + wr * 64 + m * 16 + fr;
#pragma unroll
      for (int n = 0; n < 4; ++n) {
        const int c = bcol + wc * 64 + n * 16 + fq * 4;
        u32x2 o; o[0] = pack2(acc[m][n][0], acc[m][n][1]); o[1] = pack2(acc[m][n][2], acc[m][n][3]);
        *(u32x2*)((u16*)(ws + O_PQ) + (size_t)tok * 2048 + c) = o;
      }
    }
  }
}

__device__ const unsigned char kCand[64] = {
    0x00, 0x01, 0x02, 0x03, 0x04, 0x05, 0x06, 0x07, 0x08, 0x09, 0x0a, 0x0b, 0x0c, 0x0d, 0x0e, 0x0f,
    0x10, 0x11, 0x12, 0x13, 0x14, 0x15, 0x16, 0x17, 0x20, 0x21, 0x22, 0x23, 0x24, 0x30, 0x31, 0x32,
    0x33, 0x40, 0x41, 0x42, 0x50, 0x51, 0x60, 0x61, 0x70, 0x71, 0x80, 0x90, 0xa0, 0xb0, 0xc0, 0xd0,
    0xe0, 0xf0, 0xff, 0xff, 0xff, 0xff, 0xff, 0xff, 0xff, 0xff, 0xff, 0xff, 0xff, 0xff, 0xff, 0xff};

DI unsigned f2key(float f) { unsigned u = __float_as_uint(f); return (u & 0x80000000u) ? ~u : (u | 0x80000000u); }
DI float key2f(unsigned k) { unsigned u = (k & 0x80000000u) ? (k & 0x7fffffffu) : ~k; return __uint_as_float(u); }
template <int CTRL> DI unsigned dppu(unsigned v) { return (unsigned)__builtin_amdgcn_update_dpp(0, (int)v, CTRL, 0xf, 0xf, true); }
DI unsigned row_max16u(unsigned v) { v = max(v, dppu<0xB1>(v)); v = max(v, dppu<0x4E>(v)); v = max(v, dppu<0x141>(v)); v = max(v, dppu<0x140>(v)); return v; }

__device__ void phase_peer_sel(const Params& p, int l) {
  char* ws = opaque_ptr(p.ws);
  const int tid = opaque_tid();
  const int wid = tid >> 6, lane = tid & 63, fr = lane & 15, fq = lane >> 4;
  const int gw = blockIdx.x * 4 + wid, GW = gridDim.x * 4;
  float* lv = (float*)(g_smem + wid * 4096);
  int* li = (int*)(g_smem + wid * 4096 + 2048);
  const u16* PQ = (const u16*)(ws + O_PQ);
  int ca[4], cb[4];
  bool cvld[4];
#pragma unroll
  for (int c = 0; c < 4; ++c) { int code = kCand[c * 16 + fr]; cvld[c] = code != 0xff; ca[c] = (code >> 4) & 15; cb[c] = code & 15; }
  for (int it = gw; it < 512 * 8; it += GW) {
    const int h = it >> 9, tg = it & 511;
    const u16* SK = (const u16*)(ws + O_SUBK) + ((size_t)(l * 8 + h) * 2) * 128 * 128;
    f32x4 sc[2][8];
#pragma unroll
    for (int z = 0; z < 2; ++z) {
      bf16x8 qf[4];
#pragma unroll
      for (int ks = 0; ks < 4; ++ks) qf[ks] = *(const bf16x8*)(PQ + (size_t)(tg * 16 + fr) * 2048 + (h * 2 + z) * 128 + ks * 32 + fq * 8);
#pragma unroll
      for (int nt = 0; nt < 8; ++nt) {
        sc[z][nt] = f32x4{0.f, 0.f, 0.f, 0.f};
#pragma unroll
        for (int ks = 0; ks < 4; ++ks) {
          bf16x8 kf = *(const bf16x8*)(SK + ((size_t)z * 128 + nt * 16 + fr) * 128 + ks * 32 + fq * 8);
          sc[z][nt] = mfma16(qf[ks], kf, sc[z][nt]);
        }
      }
    }
#pragma unroll
    for (int z = 0; z < 2; ++z) {
#pragma unroll
      for (int j = 0; j < 4; ++j) {
        unsigned key[8];
#pragma unroll
        for (int nt = 0; nt < 8; ++nt) key[nt] = (f2key(sc[z][nt][j]) & ~127u) | (unsigned)(127 - (nt * 16 + fr));
        unsigned tk = 0u;
#pragma unroll 1
        for (int k = 0; k < 16; ++k) {
          unsigned m = key[0];
#pragma unroll
          for (int nt = 1; nt < 8; ++nt) m = max(m, key[nt]);
          unsigned M = row_max16u(m);
#pragma unroll
          for (int nt = 0; nt < 8; ++nt) key[nt] = key[nt] == M ? 0u : key[nt];
          if (fr == k) tk = M;
        }
        lv[((fq * 4 + j) * 2 + z) * 16 + fr] = key2f(tk & ~127u);
        li[((fq * 4 + j) * 2 + z) * 16 + fr] = 127 - (int)(tk & 127u);
      }
    }
    __builtin_amdgcn_s_waitcnt(0xc07f);
    __builtin_amdgcn_wave_barrier();
#pragma unroll 1
    for (int j = 0; j < 4; ++j) {
      const int tl = fq * 4 + j;
      float cand[4];
#pragma unroll
      for (int c = 0; c < 4; ++c) cand[c] = cvld[c] ? lv[(tl * 2 + 0) * 16 + ca[c]] + lv[(tl * 2 + 1) * 16 + cb[c]] : -3e38f;
      unsigned ck[4];
#pragma unroll
      for (int c = 0; c < 4; ++c) ck[c] = cvld[c] ? ((f2key(cand[c]) & ~63u) | (unsigned)(63 - (c * 16 + fr))) : 0u;
      unsigned sk = 0u;
#pragma unroll 1
      for (int k = 0; k < 16; ++k) {
        unsigned m = max(max(ck[0], ck[1]), max(ck[2], ck[3]));
        unsigned M = row_max16u(m);
#pragma unroll
        for (int c = 0; c < 4; ++c) ck[c] = ck[c] == M ? 0u : ck[c];
        if (fr == k) sk = M;
      }
      const float sv = key2f(sk & ~63u);
      const int scode = 63 - (int)(sk & 63u);
      int ab = kCand[scode];
      int e = li[(tl * 2 + 0) * 16 + ((ab >> 4) & 15)] * 128 + li[(tl * 2 + 1) * 16 + (ab & 15)];
      float mx = row_max16(sv);
      float ex = __expf(sv - mx);
      float sum = row_sum16(ex);
      int tok = tg * 16 + tl;
      ((int*)(ws + O_EIDX))[(size_t)tok * 128 + h * 16 + fr] = e;
      ((float*)(ws + O_EGATE))[(size_t)tok * 128 + h * 16 + fr] = ex / sum;
    }
    __builtin_amdgcn_s_waitcnt(0xc07f);
    __builtin_amdgcn_wave_barrier();
  }
}

DI void cvt8(const bf16x8& v, float (&f)[8]) {
  u32x4 u = __builtin_bit_cast(u32x4, v);
#pragma unroll
  for (int q = 0; q < 4; ++q) { f[2 * q] = __uint_as_float(u[q] << 16); f[2 * q + 1] = __uint_as_float(u[q] & 0xffff0000u); }
}
DI void cvt16(const u32x4& q, float (&f)[16]) {
#pragma unroll
  for (int i = 0; i < 4; ++i) {
    f32x2 a = __builtin_amdgcn_cvt_pk_f32_fp8((int)q[i], false), b = __builtin_amdgcn_cvt_pk_f32_fp8((int)q[i], true);
    f[4 * i] = a[0]; f[4 * i + 1] = a[1]; f[4 * i + 2] = b[0]; f[4 * i + 3] = b[1];
  }
}

__device__ void phase_peer_gather(const Params& p, int l, bool dry = false) {
  char* ws = opaque_ptr(p.ws);
  const int tid = opaque_tid();
  const int lane = tid & 63;
  const int gw = blockIdx.x * 4 + (tid >> 6), GW = gridDim.x * 4;
  const unsigned char* U = (const unsigned char*)(ws + O_PEU) + (size_t)l * 16384 * 1024;
  const unsigned char* V = (const unsigned char*)(ws + O_PEV) + (size_t)l * 16384 * 1024;
  const float* SU = (const float*)(ws + O_SCU) + l * 16384;
  const float* SV = (const float*)(ws + O_SCV) + l * 16384;
  float* X = (float*)(ws + O_X);
  float* XW = dry ? (float*)(ws + O_YS) : X;
  u16* HW = dry ? (u16*)(ws + O_MERG) : (u16*)(ws + O_H);
  float* OW = dry ? (float*)(ws + O_PB) : p.out + OUT_Y;
  for (int tok = gw; tok < NT; tok += GW) {
    float hf[16];
    {
      const u16* hr = (const u16*)(ws + O_H) + (size_t)tok * 1024 + lane * 16;
      bf16x8 h0 = *(const bf16x8*)(hr), h1 = *(const bf16x8*)(hr + 8);
      float t0[8], t1[8];
      cvt8(h0, t0); cvt8(h1, t1);
#pragma unroll
      for (int i = 0; i < 8; ++i) { hf[i] = t0[i]; hf[8 + i] = t1[i]; }
    }
    float acc[16];
#pragma unroll
    for (int i = 0; i < 16; ++i) acc[i] = 0.f;
    const int id0 = ((const int*)(ws + O_EIDX))[(size_t)tok * 128 + lane], id1 = ((const int*)(ws + O_EIDX))[(size_t)tok * 128 + 64 + lane];
    const float g0 = ((const float*)(ws + O_EGATE))[(size_t)tok * 128 + lane], g1 = ((const float*)(ws + O_EGATE))[(size_t)tok * 128 + 64 + lane];
#define PG_LOAD(G, ids, gts, su, sv, uq, vq)                                                                      \
  do {                                                                                                            \
    _Pragma("unroll") for (int e = 0; e < 4; ++e) {                                                               \
      int k = (G) * 4 + e;                                                                                        \
      int sel = k & 63;                                                                                           \
      int a_ = __builtin_amdgcn_readlane(id0, sel), b_ = __builtin_amdgcn_readlane(id1, sel);                     \
      float ga_ = __builtin_bit_cast(float, __builtin_amdgcn_readlane(__builtin_bit_cast(int, g0), sel));         \
      float gb_ = __builtin_bit_cast(float, __builtin_amdgcn_readlane(__builtin_bit_cast(int, g1), sel));         \
      ids[e] = (G) < 16 ? a_ : b_;                                                                                 \
      gts[e] = (G) < 16 ? ga_ : gb_;                                                                               \
    }                                                                                                             \
    _Pragma("unroll") for (int e = 0; e < 4; ++e) uq[e] = *(const u32x4*)(U + (size_t)ids[e] * 1024 + lane * 16); \
    _Pragma("unroll") for (int e = 0; e < 4; ++e) vq[e] = *(const u32x4*)(V + (size_t)ids[e] * 1024 + lane * 16); \
    _Pragma("unroll") for (int e = 0; e < 4; ++e) { su[e] = SU[ids[e]]; sv[e] = SV[ids[e]]; }                     \
  } while (0)
#define PG_COMP(gts, su, sv, uq, vq)                                                                              \
  do {                                                                                                            \
    float cf[4];                                                                                                  \
    _Pragma("unroll") for (int e = 0; e < 4; ++e) {                                                               \
      float a[16];                                                                                                \
      cvt16(uq[e], a);                                                                                            \
      float d0 = 0.f, d1 = 0.f;                                                                                   \
      _Pragma("unroll") for (int i = 0; i < 16; i += 2) { d0 += a[i] * hf[i]; d1 += a[i + 1] * hf[i + 1]; }       \
      float d = wave_sum(d0 + d1) * su[e];                                                                        \
      float u3 = 0.7978845608028654f * (d + 0.044715f * d * d * d);                                               \
      float th = 1.f - 2.f / (__expf(2.f * u3) + 1.f);                                                            \
      cf[e] = gts[e] * 0.5f * d * (1.f + th) * sv[e];                                                             \
    }                                                                                                             \
    _Pragma("unroll") for (int e = 0; e < 4; ++e) {                                                               \
      float a[16];                                                                                                \
      cvt16(vq[e], a);                                                                                            \
      _Pragma("unroll") for (int i = 0; i < 16; ++i) acc[i] += cf[e] * a[i];                                      \
    }                                                                                                             \
  } while (0)
    {
      int idA[4], idB[4];
      float gtA[4], gtB[4], suA[4], svA[4], suB[4], svB[4];
      u32x4 uqA[4], vqA[4], uqB[4], vqB[4];
      PG_LOAD(0, idA, gtA, suA, svA, uqA, vqA);
#pragma unroll 1
      for (int g = 0; g < 32; g += 2) {
        PG_LOAD(g + 1, idB, gtB, suB, svB, uqB, vqB);
        PG_COMP(gtA, suA, svA, uqA, vqA);
        if (g + 2 < 32) PG_LOAD(g + 2, idA, gtA, suA, svA, uqA, vqA);
        PG_COMP(gtB, suB, svB, uqB, vqB);
      }
    }
#undef PG_LOAD
#undef PG_COMP
    const float* mod = (const float*)(ws + O_MOD) + ((size_t)l * 3 + tok_cond(tok)) * 6144;
    float x[16];
    const int e0 = lane * 16;
#pragma unroll
    for (int q = 0; q < 4; ++q) {
      f32x4 a = *(const f32x4*)(X + (size_t)tok * 1024 + e0 + q * 4);
      f32x4 ga = *(const f32x4*)(mod + 5 * 1024 + e0 + q * 4);
#pragma unroll
      for (int i = 0; i < 4; ++i) { a[i] += ga[i] * acc[q * 4 + i]; x[q * 4 + i] = a[i]; }
      *(f32x4*)(XW + (size_t)tok * 1024 + e0 + q * 4) = a;
    }
    float ss = 0.f;
#pragma unroll
    for (int i = 0; i < 16; ++i) ss += x[i] * x[i];
    ss = wave_sum(ss);
    const float rstd = rsqrtf(ss * (1.f / 1024.f) + 1e-6f);
    if (l < NL - 1) {
      const float* mod2 = (const float*)(ws + O_MOD) + ((size_t)(l + 1) * 3 + tok_cond(tok)) * 6144;
      const float* g = p.in[9] + (l + 1) * 1024;
      float y[16];
#pragma unroll
      for (int q = 0; q < 4; ++q) {
        f32x4 gg = *(const f32x4*)(g + e0 + q * 4), sh = *(const f32x4*)(mod2 + e0 + q * 4), sc = *(const f32x4*)(mod2 + 1024 + e0 + q * 4);
#pragma unroll
        for (int i = 0; i < 4; ++i) y[q * 4 + i] = x[q * 4 + i] * rstd * gg[i] * (1.f + sc[i]) + sh[i];
      }
      u32x4 o0, o1;
      o0[0] = pack2(y[0], y[1]); o0[1] = pack2(y[2], y[3]); o0[2] = pack2(y[4], y[5]); o0[3] = pack2(y[6], y[7]);
      o1[0] = pack2(y[8], y[9]); o1[1] = pack2(y[10], y[11]); o1[2] = pack2(y[12], y[13]); o1[3] = pack2(y[14], y[15]);
      *(u32x4*)(HW + (size_t)tok * 1024 + e0) = o0;
      *(u32x4*)(HW + (size_t)tok * 1024 + e0 + 8) = o1;
    } else {
      const float* g = p.in[11];
#pragma unroll
      for (int q = 0; q < 4; ++q) {
        f32x4 gg = *(const f32x4*)(g + e0 + q * 4), a;
#pragma unroll
        for (int i = 0; i < 4; ++i) a[i] = x[q * 4 + i] * rstd * gg[i];
        *(f32x4*)(OW + (size_t)tok * 1024 + e0 + q * 4) = a;
      }
    }
  }
}

#define XB_TMO 128
#define XB_XCNT(j) (256 + 64 * (j))
#define XB_XSUB(j) (1280 + 64 * (j))
#define XB_XGEN(j) (2304 + 64 * (j))
#define XB_TOP 3328
#define XB_TOPGEN 3392
#define XCD_BAR_WORDS 3456
#define XB_SPIN_CAP (1u << 18)
DI unsigned xb_ld(unsigned* q) { return __hip_atomic_load(q, __ATOMIC_RELAXED, __HIP_MEMORY_SCOPE_AGENT); }
DI unsigned xb_add(unsigned* q, unsigned v) { return __hip_atomic_fetch_add(q, v, __ATOMIC_RELAXED, __HIP_MEMORY_SCOPE_AGENT); }
DI unsigned xb_xcc_id() { return (unsigned)__builtin_amdgcn_s_getreg((3 << 11) | 20) & 0xFu; }
#define XB_SPIN(cond, bar)                                                                   \
  do {                                                                                       \
    unsigned _sp = 0;                                                                        \
    while (cond) {                                                                           \
      __builtin_amdgcn_s_sleep(1);                                                           \
      if ((++_sp & 255u) == 0u) {                                                            \
        if (xb_ld(&(bar)[XB_TMO])) break;                                                    \
        if (_sp > XB_SPIN_CAP) { atomicAdd(&(bar)[XB_TMO], 1u); break; }                     \
      }                                                                                      \
    }                                                                                        \
  } while (0)
struct XB { unsigned* bar; unsigned x, nloc, nx; };
DI void xcd_barrier(const XB& b) {
  asm volatile("s_waitcnt vmcnt(0)" ::: "memory");
  __syncthreads();
  if (threadIdx.x == 0) {
    unsigned* bar = b.bar;
    __builtin_amdgcn_s_waitcnt(0);
    const unsigned nloc = b.nloc, nx = b.nx;
    const unsigned old = xb_add(&bar[XB_XSUB(b.x)], 1u);
    const unsigned gen = old / nloc;
    if (old + 1u == (gen + 1u) * nloc) {
      __builtin_amdgcn_fence(__ATOMIC_RELEASE, "agent");
      asm volatile("s_waitcnt vmcnt(0)" ::: "memory");
      const unsigned og = xb_add(&bar[XB_TOP], 1u);
      const unsigned tg = og / nx;
      if (og + 1u == (tg + 1u) * nx) xb_add(&bar[XB_TOPGEN], 1u);
      else XB_SPIN(xb_ld(&bar[XB_TOPGEN]) == tg, bar);
      __builtin_amdgcn_fence(__ATOMIC_ACQUIRE, "agent");
      xb_add(&bar[XB_XGEN(b.x)], 1u);
      asm volatile("s_waitcnt vmcnt(0)" ::: "memory");
    } else {
      XB_SPIN(xb_ld(&bar[XB_XGEN(b.x)]) == gen, bar);
      __builtin_amdgcn_fence(__ATOMIC_ACQUIRE, "agent");
      asm volatile("s_waitcnt vmcnt(0)" ::: "memory");
    }
  }
  __syncthreads();
}

__global__ void __launch_bounds__(256, 2) fwd_megakernel(Params p) {
  cg::grid_group grid = cg::this_grid();
  XB xb;
  xb.bar = (unsigned*)(p.ws + O_BAR);
  xb.x = xb_xcc_id();
  if (threadIdx.x == 0) (void)xb_add(&xb.bar[XB_XCNT(xb.x)], 1u);
  phase_prep(p);
  if (p.ws == nullptr) grid.sync();
  {
    unsigned mine = 0u, cnt = 0u, sum = 0u, sp = 0u;
    for (;;) {
      sum = 0u; cnt = 0u; mine = 0u;
#pragma unroll
      for (unsigned j = 0; j < 16; ++j) { const unsigned c = xb_ld(&xb.bar[XB_XCNT(j)]); sum += c; cnt += (c > 0u) ? 1u : 0u; mine = (j == xb.x) ? c : mine; }
      if (sum == gridDim.x) break;
      __builtin_amdgcn_s_sleep(1);
      if (++sp > XB_SPIN_CAP) break;
    }
    xb.nloc = __builtin_amdgcn_readfirstlane(mine > 0u ? mine : 1u);
    xb.nx = __builtin_amdgcn_readfirstlane(cnt > 0u ? cnt : 1u);
  }
  xcd_barrier(xb);
  phase_norm(p, 0, 0);
  xcd_barrier(xb);
  for (int l = 0; l < NL; ++l) {
    phase_gemm_in(p, l);
    xcd_barrier(xb);
    phase_rwkv_prep(p, l);
    xcd_barrier(xb);
    phase_rwkv_lora(p, l);
    xcd_barrier(xb);
    phase_mix(p, l);
    xcd_barrier(xb);
    phase_rwkv_post(p, l);
    xcd_barrier(xb);
    phase_branch(p, l);
    xcd_barrier(xb);
    phase_wo(p, l);
    xcd_barrier(xb);
    phase_norm(p, l, 1);
    xcd_barrier(xb);
    phase_peq(p, l);
    xcd_barrier(xb);
    phase_peer_sel(p, l);
    xcd_barrier(xb);
    phase_peer_gather(p, l);
    if (l + 1 < NL) xcd_barrier(xb);
  }
}

extern "C" void kernel_launch(void* const* d_in, const int* in_sizes, int n_in, void* d_out, int out_size, void* d_ws, size_t ws_size,
                              hipStream_t stream) {
  static int grid_blocks = 0;
  if (!grid_blocks) {
    int dev = 0, cus = 0, per_cu = 0;
    hipGetDevice(&dev);
    hipDeviceGetAttribute(&cus, hipDeviceAttributeMultiprocessorCount, dev);
    hipOccupancyMaxActiveBlocksPerMultiprocessor(&per_cu, fwd_megakernel, 256, 0);
    if (per_cu > 2) per_cu = 2;
    if (per_cu < 1) per_cu = 1;
    grid_blocks = cus * per_cu;
  }
  Params p{};
  for (int i = 0; i < 36; ++i) p.in[i] = (const float*)d_in[i];
  p.out = (float*)d_out;
  p.ws = (char*)d_ws;
  (void)hipMemsetAsync((char*)d_ws + O_BAR, 0, 3456 * 4, stream);
  void* args[] = {&p};
  hipError_t e = hipLaunchCooperativeKernel((void*)fwd_megakernel, dim3(grid_blocks), dim3(256), args, 0, stream);
  if (e != hipSuccess) fprintf(stderr, "cooperative launch failed: %s (grid %d)\n", hipGetErrorString(e), grid_blocks);
}
```

```cpp
#include <hip/hip_runtime.h>
#include <hip/hip_cooperative_groups.h>
#include <cstdio>
namespace cg = cooperative_groups;

#define DI __device__ __forceinline__
typedef unsigned short u16;
using bf16x8 = __attribute__((ext_vector_type(8))) short;
using bf16x4 = __attribute__((ext_vector_type(4))) short;
using f32x4 = __attribute__((ext_vector_type(4))) float;
using u32x2 = __attribute__((ext_vector_type(2))) unsigned;
using u32x4 = __attribute__((ext_vector_type(4))) unsigned;

constexpr int NT = 8192, NCTX = 4096, DM = 1024, INC = 7296, NL = 4;

constexpr size_t AL(size_t x) { return (x + 255) / 256 * 256; }
constexpr size_t O_WIN = 0;
constexpr size_t O_AOUT = O_WIN + AL(4ull * 7296 * 1024 * 2);
constexpr size_t O_RWOUT = O_AOUT + AL(4ull * 1024 * 512 * 2);
constexpr size_t O_NAOUT = O_RWOUT + AL(4ull * 1024 * 512 * 2);
constexpr size_t O_WO = O_NAOUT + AL(4ull * 1024 * 512 * 2);
constexpr size_t O_PEQ = O_WO + AL(4ull * 1024 * 1024 * 2);
constexpr size_t O_SUBK = O_PEQ + AL(4ull * 2048 * 1024 * 2);
constexpr size_t O_W2 = O_SUBK + AL(4ull * 8 * 2 * 128 * 128 * 2);
constexpr size_t O_A2 = O_W2 + AL(8ull * 512 * 64 * 2);
constexpr size_t O_G2 = O_A2 + AL(8ull * 512 * 64 * 2);
constexpr size_t O_PEU = O_G2 + AL(4ull * 512 * 128 * 2);
constexpr size_t O_PEV = O_PEU + AL(4ull * 16384 * 1024 * 2);
constexpr size_t O_CAK = O_PEV + AL(4ull * 16384 * 1024 * 2);
constexpr size_t O_CAVT = O_CAK + AL(8ull * 512 * 128 * 2);
constexpr size_t O_CCK = O_CAVT + AL(8ull * 128 * 512 * 2);
constexpr size_t O_CCVT = O_CCK + AL(8ull * 512 * 512 * 2);
constexpr size_t O_MOD = O_CCVT + AL(8ull * 512 * 512 * 2);
constexpr size_t O_ROPE = O_MOD + AL(4ull * 3 * 6144 * 4);
constexpr size_t O_CNT = O_ROPE + AL(64 * 16 * 2 * 4);
constexpr size_t O_X = O_CNT + 256;
constexpr size_t O_H = O_X + AL(8192ull * 1024 * 4);
constexpr size_t O_QA = O_H + AL(8192ull * 1024 * 2);
constexpr size_t O_KA = O_QA + AL(8192ull * 512 * 2);
constexpr size_t O_VAT = O_KA + AL(8192ull * 128 * 2);
constexpr size_t O_QC = O_VAT + AL(8192ull * 128 * 2);
constexpr size_t O_KC = O_QC + AL(8192ull * 512 * 2);
constexpr size_t O_VCT = O_KC + AL(8192ull * 512 * 2);
constexpr size_t O_PB = O_VCT + AL(8192ull * 512 * 2);
constexpr size_t O_GATE = O_PB + AL(8192ull * 1920 * 4);
constexpr size_t O_XRKV = O_GATE + AL(8192ull * 3072 * 2);
constexpr size_t O_KK = O_XRKV + AL(8192ull * 1536 * 4);
constexpr size_t O_TW = O_KK + AL(8192ull * 512 * 4);
constexpr size_t O_AD = O_TW + AL(8192ull * 128 * 2);
constexpr size_t O_SG = O_AD + AL(8192ull * 128 * 2);
constexpr size_t O_DEC = O_SG + AL(8192ull * 128 * 2);
constexpr size_t O_KD = O_DEC + AL(2ull * 8192 * 512 * 4);
constexpr size_t O_KKA = O_KD + AL(2ull * 8192 * 512 * 4);
constexpr size_t O_GG = O_KKA + AL(2ull * 8192 * 512 * 4);
constexpr size_t O_YS = O_GG + AL(8192ull * 512 * 4);
constexpr size_t O_YABC = O_YS + AL(2ull * 8192 * 512 * 4);
constexpr size_t O_MERG = O_YABC + AL(3ull * 8192 * 512 * 2);
constexpr size_t O_PQ = O_MERG + AL(8192ull * 1024 * 2);
constexpr size_t O_EIDX = O_PQ + AL(8192ull * 2048 * 2);
constexpr size_t O_EGATE = O_EIDX + AL(8192ull * 128 * 4);
constexpr size_t O_SCU = O_EGATE + AL(8192ull * 128 * 4);
constexpr size_t O_SCV = O_SCU + AL(4ull * 16384 * 4);
constexpr size_t O_BAR = O_SCV + AL(4ull * 16384 * 4);
constexpr size_t WS_TOTAL = O_BAR + AL(3456 * 4);
static_assert(WS_TOTAL < 1020ull * 1024 * 1024, "workspace too large");

constexpr size_t OUT_Y = 0;
constexpr size_t OUT_AK = 8388608;
constexpr size_t OUT_AV = 10485760;
constexpr size_t OUT_CK = 12582912;
constexpr size_t OUT_CV = 20971520;
constexpr size_t OUT_ST = 29360128;

struct Params {
  const float* in[36];
  float* out;
  char* ws;
};

__shared__ __attribute__((aligned(16))) char g_smem[65536];

DI u16 f2bf(float x) { unsigned u = __float_as_uint(x); u += 0x7fffu + ((u >> 16) & 1u); return (u16)(u >> 16); }
DI float bf2f(u16 h) { return __uint_as_float(((unsigned)h) << 16); }
DI unsigned pack2(float a, float b) { return (unsigned)f2bf(a) | ((unsigned)f2bf(b) << 16); }
DI float sigmoidf_(float x) { return 1.f / (1.f + __expf(-x)); }
template <int CTRL> DI float dppf(float v) {
  return __builtin_bit_cast(float, __builtin_amdgcn_update_dpp(0, __builtin_bit_cast(int, v), CTRL, 0xf, 0xf, true));
}
template <int CTRL> DI int dppi(int v) { return __builtin_amdgcn_update_dpp(0, v, CTRL, 0xf, 0xf, true); }
DI float row_sum16(float v) { v += dppf<0xB1>(v); v += dppf<0x4E>(v); v += dppf<0x141>(v); v += dppf<0x140>(v); return v; }
DI float row_max16(float v) { v = fmaxf(v, dppf<0xB1>(v)); v = fmaxf(v, dppf<0x4E>(v)); v = fmaxf(v, dppf<0x141>(v)); v = fmaxf(v, dppf<0x140>(v)); return v; }
DI int row_max16i(int v) { v = max(v, dppi<0xB1>(v)); v = max(v, dppi<0x4E>(v)); v = max(v, dppi<0x141>(v)); v = max(v, dppi<0x140>(v)); return v; }
DI float wave_sum(float v) { v = row_sum16(v); v += __shfl_xor(v, 16); v += __shfl_xor(v, 32); return v; }

DI int opaque_tid() { int t = threadIdx.x; asm volatile("" : "+v"(t)); return t; }
DI char* opaque_ptr(char* q) { size_t z = 0; asm volatile("" : "+s"(z)); return q + z; }
DI f32x4 mfma16(bf16x8 a, bf16x8 b, f32x4 c) { return __builtin_amdgcn_mfma_f32_16x16x32_bf16(a, b, c, 0, 0, 0); }

DI int lds_byte(int r, int c) {
  int st = (r >> 4) * 2 + (c >> 5), rr = r & 15, cc = c & 31, ob = rr * 64 + cc * 2;
  return st * 1024 + (ob ^ (((ob >> 9) & 1) << 5));
}
DI void stage_rc(int b, int& R, int& C) {
  int st = b >> 10, sb = b & 1023, swz = sb ^ (((sb >> 9) & 1) << 5);
  R = (st >> 1) * 16 + (swz >> 6);
  C = (st & 1) * 32 + ((swz & 63) >> 1);
}
DI void gemm_main(int tid, const u16* __restrict__ g0, int ld0, const u16* __restrict__ g1, int ld1, int K, f32x4 (&acc)[4][4], int koff = 0) {
  const int wid = tid >> 6, lane = tid & 63, wr = wid >> 1, wc = wid & 1, fr = lane & 15, fq = lane >> 4;
  const int nk = K >> 6;
  int R0, C0;
  stage_rc(tid * 16, R0, C0);
  const unsigned v0 = (unsigned)(R0 * ld0 + C0), v1 = (unsigned)(R0 * ld1 + C0);
  const int fa0 = lds_byte(wr * 64 + fr, fq * 8), fa1 = 16384 + lds_byte(wc * 64 + fr, fq * 8);
  const int sb = tid * 16;
#define GSTAGE(kt, buf)                                                                                          \
  do {                                                                                                           \
    _Pragma("unroll") for (int i = 0; i < 4; ++i) {                                                              \
      const u16* u0 = g0 + (size_t)(kt) * 64 + (size_t)i * 32 * ld0;                                             \
      const u16* u1 = g1 + (size_t)(kt) * 64 + (size_t)i * 32 * ld1;                                             \
      __builtin_amdgcn_global_load_lds((const unsigned*)(u0 + v0), (unsigned*)(g_smem + (buf) + i * 4096 + sb), 16, 0, 0);          \
      __builtin_amdgcn_global_load_lds((const unsigned*)(u1 + v1), (unsigned*)(g_smem + (buf) + 16384 + i * 4096 + sb), 16, 0, 0);  \
    }                                                                                                            \
  } while (0)
  int kt = koff;
  GSTAGE(kt, 0);
  for (int t = 0; t < nk; ++t) {
    asm volatile("s_waitcnt vmcnt(0)" ::: "memory");
    __syncthreads();
    const int cur = (t & 1) * 32768;
    kt = kt + 1 == nk ? 0 : kt + 1;
    if (t + 1 < nk) GSTAGE(kt, 32768 - cur);
#pragma unroll
    for (int ks = 0; ks < 2; ++ks) {
      bf16x8 f0[4], f1[4];
#pragma unroll
      for (int m = 0; m < 4; ++m) f0[m] = *(const bf16x8*)(g_smem + cur + fa0 + m * 2048 + ks * 1024);
#pragma unroll
      for (int n = 0; n < 4; ++n) f1[n] = *(const bf16x8*)(g_smem + cur + fa1 + n * 2048 + ks * 1024);
#pragma unroll
      for (int m = 0; m < 4; ++m)
#pragma unroll
        for (int n = 0; n < 4; ++n) acc[m][n] = mfma16(f1[n], f0[m], acc[m][n]);
    }
  }
#undef GSTAGE
  __syncthreads();
}
DI void zero_acc(f32x4 (&acc)[4][4]) {
#pragma unroll
  for (int m = 0; m < 4; ++m)
#pragma unroll
    for (int n = 0; n < 4; ++n) acc[m][n] = f32x4{0.f, 0.f, 0.f, 0.f};
}

struct TJob { const float* src; u16* dst; int K, N, nb; };

DI void transpose_tile(int tid, const float* __restrict__ src, u16* __restrict__ dst, int K, int N, int k0, int n0) {
  float* tile = (float*)g_smem;
  {
    const int tr = tid >> 4, tc = tid & 15;
#pragma unroll
    for (int p = 0; p < 4; ++p) {
      int r = tr + 16 * p;
      f32x4 v = *(const f32x4*)(src + (size_t)(k0 + r) * N + n0 + tc * 4);
      tile[r * 65 + tc * 4 + 0] = v[0]; tile[r * 65 + tc * 4 + 1] = v[1];
      tile[r * 65 + tc * 4 + 2] = v[2]; tile[r * 65 + tc * 4 + 3] = v[3];
    }
  }
  __syncthreads();
  {
    const int tn = tid >> 3, tk = tid & 7;
#pragma unroll
    for (int p = 0; p < 2; ++p) {
      int n = tn + 32 * p;
      u32x4 o;
#pragma unroll
      for (int q = 0; q < 4; ++q) o[q] = pack2(tile[(tk * 8 + 2 * q) * 65 + n], tile[(tk * 8 + 2 * q + 1) * 65 + n]);
      *(u32x4*)(dst + (size_t)(n0 + n) * K + k0 + tk * 8) = o;
    }
  }
  __syncthreads();
}

DI void convert_chunks(int tid, const float* __restrict__ src, u16* __restrict__ dst, size_t n) {
  const size_t nch = n / 8192;
  for (size_t c = blockIdx.x; c < nch; c += gridDim.x) {
    size_t e = c * 8192 + tid * 8;
    f32x4 a[4], b[4];
#pragma unroll
    for (int q = 0; q < 4; ++q) { a[q] = __builtin_nontemporal_load((const f32x4*)(src + e + q * 2048)); b[q] = __builtin_nontemporal_load((const f32x4*)(src + e + q * 2048 + 4)); }
#pragma unroll
    for (int q = 0; q < 4; ++q) {
      u32x4 o;
      o[0] = pack2(a[q][0], a[q][1]); o[1] = pack2(a[q][2], a[q][3]); o[2] = pack2(b[q][0], b[q][1]); o[3] = pack2(b[q][2], b[q][3]);
      *(u32x4*)(dst + e + q * 2048) = o;
    }
  }
}

typedef float f32x2 __attribute__((ext_vector_type(2)));
DI void convert_rows_fp8(int tid, const float* __restrict__ src, unsigned char* __restrict__ dst, float* __restrict__ inv_scale, int nrows) {
  const int lane = tid & 63;
  const int gw = blockIdx.x * 4 + (tid >> 6), GW = gridDim.x * 4;
  for (int r0 = gw; r0 < nrows; r0 += 2 * GW) {
    int rws[2] = {r0, r0 + GW < nrows ? r0 + GW : r0};
    f32x4 v[2][4];
#pragma unroll
    for (int u = 0; u < 2; ++u)
#pragma unroll
      for (int q = 0; q < 4; ++q) v[u][q] = __builtin_nontemporal_load((const f32x4*)(src + (size_t)rws[u] * 1024 + lane * 16 + q * 4));
#pragma unroll
    for (int u = 0; u < 2; ++u) {
      float am = 0.f;
#pragma unroll
      for (int q = 0; q < 4; ++q)
#pragma unroll
        for (int j = 0; j < 4; ++j) am = fmaxf(am, fabsf(v[u][q][j]));
      am = row_max16(am);
      am = fmaxf(am, __shfl_xor(am, 16));
      am = fmaxf(am, __shfl_xor(am, 32));
      int ex = (int)((__float_as_uint(am) >> 23) & 0xff) - 127;
      int k = am > 0.f ? 7 - ex : 0;
      k = min(max(k, -100), 100);
      float sc = __uint_as_float((unsigned)(127 + k) << 23), isc = __uint_as_float((unsigned)(127 - k) << 23);
      u32x4 o;
#pragma unroll
      for (int q = 0; q < 4; ++q) {
        int w = __builtin_amdgcn_cvt_pk_fp8_f32(v[u][q][0] * sc, v[u][q][1] * sc, 0, false);
        w = __builtin_amdgcn_cvt_pk_fp8_f32(v[u][q][2] * sc, v[u][q][3] * sc, w, true);
        o[q] = (unsigned)w;
      }
      *(u32x4*)(dst + (size_t)rws[u] * 1024 + lane * 16) = o;
      if (lane == 0) inv_scale[rws[u]] = isc;
    }
  }
}

DI void convert_rows_fp8_wave(int lane, const float* __restrict__ src, unsigned char* __restrict__ dst, float* __restrict__ inv_scale, int r0, int r1) {
  for (int r = r0; r < r1; r += 2) {
    f32x4 v[2][4];
#pragma unroll
    for (int u = 0; u < 2; ++u)
#pragma unroll
      for (int q = 0; q < 4; ++q) v[u][q] = __builtin_nontemporal_load((const f32x4*)(src + (size_t)(r + u) * 1024 + lane * 16 + q * 4));
#pragma unroll
    for (int u = 0; u < 2; ++u) {
      float am = 0.f;
#pragma unroll
      for (int q = 0; q < 4; ++q)
#pragma unroll
        for (int j = 0; j < 4; ++j) am = fmaxf(am, fabsf(v[u][q][j]));
      am = row_max16(am);
      am = fmaxf(am, __shfl_xor(am, 16));
      am = fmaxf(am, __shfl_xor(am, 32));
      int ex = (int)((__float_as_uint(am) >> 23) & 0xff) - 127;
      int k = am > 0.f ? 7 - ex : 0;
      k = min(max(k, -100), 100);
      float sc = __uint_as_float((unsigned)(127 + k) << 23), isc = __uint_as_float((unsigned)(127 - k) << 23);
      u32x4 o;
#pragma unroll
      for (int q = 0; q < 4; ++q) {
        int w = __builtin_amdgcn_cvt_pk_fp8_f32(v[u][q][0] * sc, v[u][q][1] * sc, 0, false);
        w = __builtin_amdgcn_cvt_pk_fp8_f32(v[u][q][2] * sc, v[u][q][3] * sc, w, true);
        o[q] = (unsigned)w;
      }
      *(u32x4*)(dst + (size_t)(r + u) * 1024 + lane * 16) = o;
      if (lane == 0) inv_scale[r + u] = isc;
    }
  }
}

__device__ void phase_prep(const Params& p) {
  char* ws = opaque_ptr(p.ws);
  const int tid = opaque_tid(), wid = tid >> 6, lane = tid & 63;
  if (blockIdx.x == 0 && tid < 64) ((int*)(ws + O_CNT))[tid] = 0;
  if (blockIdx.x < 4) {
    int e = blockIdx.x * 256 + tid;
    int pos = e >> 4, f = e & 15;
    const float fr4[4] = {1.0f, 0.56234132519f, 0.316227766017f, 0.177827941004f};
    float sc = (f >> 2) == 0 ? 1.0f : (f >> 2) == 1 ? 0.1f : (f >> 2) == 2 ? 0.01f : 0.001f;
    float fsel = (f & 3) == 0 ? fr4[0] : (f & 3) == 1 ? fr4[1] : (f & 3) == 2 ? fr4[2] : fr4[3];
    float freq = fsel * sc;
    float ang = (float)pos * freq;
    double a = (double)ang;
    double k = rint(a * 0.15915494309189535);
    double r = a - k * 6.283185307179586;
    double r2 = r * r, ts = r, tc = 1.0, s = r, c = 1.0;
    for (int i = 1; i <= 14; ++i) {
      tc = -tc * r2 / (double)((2 * i - 1) * (2 * i));
      ts = -ts * r2 / (double)((2 * i) * (2 * i + 1));
      c += tc; s += ts;
    }
    float* rope = (float*)(ws + O_ROPE);
    rope[e * 2] = (float)c; rope[e * 2 + 1] = (float)s;
  }
  {
    float* sil = (float*)g_smem;
    float* part = (float*)(g_smem + 16384);
    const float* cvec = p.in[7];
    const float* cctx = p.in[8];
    bool have_sil = false;
    for (int it = blockIdx.x; it < 4 * 96; it += gridDim.x) {
      if (!have_sil) {
        for (int k = tid; k < 1024; k += 256) {
          float a = cctx[k], b = cvec[k], c2 = cvec[1024 + k];
          sil[k] = a * sigmoidf_(a); sil[1024 + k] = b * sigmoidf_(b); sil[2048 + k] = c2 * sigmoidf_(c2);
        }
        have_sil = true;
        __syncthreads();
      }
      int l = it / 96, n = (it % 96) * 64 + lane;
      const float* W = p.in[12] + (size_t)l * 1024 * 6144 + n;
      float a0 = 0.f, a1 = 0.f, a2 = 0.f;
      int kb = wid * 256;
#pragma unroll 8
      for (int k = 0; k < 256; ++k) {
        float w = W[(size_t)(kb + k) * 6144];
        a0 += w * sil[kb + k]; a1 += w * sil[1024 + kb + k]; a2 += w * sil[2048 + kb + k];
      }
      part[(wid * 3 + 0) * 64 + lane] = a0; part[(wid * 3 + 1) * 64 + lane] = a1; part[(wid * 3 + 2) * 64 + lane] = a2;
      __syncthreads();
      if (tid < 192) {
        int c = tid >> 6, ln = tid & 63;
        float s = part[(0 * 3 + c) * 64 + ln] + part[(1 * 3 + c) * 64 + ln] + part[(2 * 3 + c) * 64 + ln] + part[(3 * 3 + c) * 64 + ln];
        int nn = (it % 96) * 64 + ln;
        ((float*)(ws + O_MOD))[((size_t)l * 3 + c) * 6144 + nn] = s + p.in[13][(size_t)l * 6144 + nn];
      }
      __syncthreads();
    }
    __syncthreads();
  }
  {
    TJob jobs[11] = {
        {p.in[14], (u16*)(ws + O_WIN), 1024, 7296, 4},
        {p.in[16], (u16*)(ws + O_AOUT), 512, 1024, 4},
        {p.in[28], (u16*)(ws + O_RWOUT), 512, 1024, 4},
        {p.in[30], (u16*)(ws + O_NAOUT), 512, 1024, 4},
        {p.in[31], (u16*)(ws + O_WO), 1024, 1024, 4},
        {p.in[32], (u16*)(ws + O_PEQ), 1024, 2048, 4},
        {p.in[19], (u16*)(ws + O_W2), 64, 512, 8},
        {p.in[21], (u16*)(ws + O_A2), 64, 512, 8},
        {p.in[22], (u16*)(ws + O_G2), 128, 512, 4},
        {p.in[3], (u16*)(ws + O_CAVT), 512, 128, 8},
        {p.in[5], (u16*)(ws + O_CCVT), 512, 512, 8},
    };
#pragma unroll
    for (int j = 0; j < 11; ++j) {
      const int tk = jobs[j].K / 64, tn = jobs[j].N / 64, per = tk * tn, tot = per * jobs[j].nb;
      for (int t = blockIdx.x; t < tot; t += gridDim.x) {
        int b = t / per, r = t % per;
        int kt = r / tn, ntile = r % tn;
        size_t off = (size_t)b * jobs[j].K * jobs[j].N;
        transpose_tile(tid, jobs[j].src + off, jobs[j].dst + off, jobs[j].K, jobs[j].N, kt * 64, ntile * 64);
      }
    }
  }
  convert_chunks(tid, p.in[33], (u16*)(ws + O_SUBK), 4ull * 8 * 2 * 128 * 128);
  convert_chunks(tid, p.in[2], (u16*)(ws + O_CAK), 8ull * 512 * 128);
  convert_chunks(tid, p.in[4], (u16*)(ws + O_CCK), 8ull * 512 * 512);
  {
    float* X = (float*)(ws + O_X);
    const size_t nch = (size_t)NT * DM / 1024;
    for (size_t c = blockIdx.x; c < nch; c += gridDim.x) {
      size_t e = c * 1024 + tid * 4;
      const float* src = e < (size_t)NCTX * DM ? p.in[0] + e : p.in[1] + (e - (size_t)NCTX * DM);
      *(f32x4*)(X + e) = *(const f32x4*)src;
    }
  }
}

DI int tok_cond(int tok) { return tok < NCTX ? 0 : 1 + ((tok - NCTX) >> 11); }

DI void norm_row_store(const float (&x)[16], const float* __restrict__ g, const float* __restrict__ shift, const float* __restrict__ scale,
                       u16* __restrict__ hrow, int lane) {
  float ss = 0.f;
#pragma unroll
  for (int i = 0; i < 16; ++i) ss += x[i] * x[i];
  ss = wave_sum(ss);
  float rstd = rsqrtf(ss * (1.f / 1024.f) + 1e-6f);
#pragma unroll
  for (int hh = 0; hh < 2; ++hh) {
    int e0 = hh * 512 + lane * 8;
    float y[8];
#pragma unroll
    for (int i = 0; i < 8; ++i) {
      float v = x[hh * 8 + i] * rstd * g[e0 + i];
      y[i] = v * (1.f + scale[e0 + i]) + shift[e0 + i];
    }
    u32x4 o;
    o[0] = pack2(y[0], y[1]); o[1] = pack2(y[2], y[3]); o[2] = pack2(y[4], y[5]); o[3] = pack2(y[6], y[7]);
    *(u32x4*)(hrow + e0) = o;
  }
}

__device__ void phase_norm(const Params& p, int l, int which) {
  char* ws = opaque_ptr(p.ws);
  const int tid = opaque_tid();
  const int lane = tid & 63;
  const int gw = blockIdx.x * 4 + (tid >> 6), GW = gridDim.x * 4;
  const float* X = (const float*)(ws + O_X);
  const float* g = (which == 0 ? p.in[9] : p.in[10]) + l * 1024;
  for (int tok = gw; tok < NT; tok += GW) {
    const float* mod = (const float*)(ws + O_MOD) + ((size_t)l * 3 + tok_cond(tok)) * 6144 + which * 3 * 1024;
    float x[16];
#pragma unroll
    for (int hh = 0; hh < 2; ++hh) {
      f32x4 a = *(const f32x4*)(X + (size_t)tok * 1024 + hh * 512 + lane * 8);
      f32x4 b = *(const f32x4*)(X + (size_t)tok * 1024 + hh * 512 + lane * 8 + 4);
#pragma unroll
      for (int i = 0; i < 4; ++i) { x[hh * 8 + i] = a[i]; x[hh * 8 + 4 + i] = b[i]; }
    }
    norm_row_store(x, g, mod, mod + 1024, (u16*)(ws + O_H) + (size_t)tok * 1024, lane);
  }
}

__device__ void phase_gemm_in(const Params& p, int l) {
  char* ws = opaque_ptr(p.ws);
  const int tid = opaque_tid();
  const int wid = tid >> 6, lane = tid & 63, wr = wid >> 1, wc = wid & 1, fr = lane & 15, fq = lane >> 4;
  const u16* H = (const u16*)(ws + O_H);
  const u16* W = (const u16*)(ws + O_WIN) + (size_t)l * INC * 1024;
  const float* rope = (const float*)(ws + O_ROPE);
  float* out = p.out;
  for (int t = blockIdx.x; t < 64 * 57; t += gridDim.x) {
    const int tm = t & 63, tn = t >> 6;
    const int brow = tm * 128, bcol = tn * 128;
    const bool swapped = (tn == 5) || (tn >= 29 && tn < 33);
    const bool ctx = brow < NCTX;
    f32x4 acc[4][4];
    zero_acc(acc);
    const int koff = (((tm >> 3) + (tn & 7)) * 2) & 15;
    if (!swapped) gemm_main(tid, H + (size_t)brow * 1024, 1024, W + (size_t)bcol * 1024, 1024, 1024, acc, koff);
    else gemm_main(tid, W + (size_t)bcol * 1024, 1024, H + (size_t)brow * 1024, 1024, 1024, acc, koff);
    if (!swapped) {
#pragma unroll
      for (int m = 0; m < 4; ++m) {
        const int tok = brow + wr * 64 + m * 16 + fr;
        const int cb = bcol + wc * 64 + fq * 4;
        if (tn < 5) {
          if (!ctx) {
            int tt = (tok - NCTX) & 2047;
            int pos0 = tt >> 6, pos1 = tt & 63;
#pragma unroll
            for (int ax = 0; ax < 2; ++ax) {
              int pos = ax == 0 ? pos0 : pos1;
#pragma unroll
              for (int j = 0; j < 4; ++j) {
                float c = rope[(pos * 16 + fq * 4 + j) * 2], s = rope[(pos * 16 + fq * 4 + j) * 2 + 1];
                float x1 = acc[m][2 * ax][j], x2 = acc[m][2 * ax + 1][j];
                acc[m][2 * ax][j] = x1 * c - x2 * s;
                acc[m][2 * ax + 1][j] = x2 * c + x1 * s;
              }
            }
          }
          if (tn < 4) {
#pragma unroll
            for (int n = 0; n < 4; ++n) {
              u32x2 o; o[0] = pack2(acc[m][n][0] * 0.125f, acc[m][n][1] * 0.125f); o[1] = pack2(acc[m][n][2] * 0.125f, acc[m][n][3] * 0.125f);
              *(u32x2*)((u16*)(ws + O_QA) + (size_t)tok * 512 + cb + n * 16) = o;
            }
          } else {
#pragma unroll
            for (int n = 0; n < 4; ++n) {
              int c = cb + n * 16 - 512;
              u32x2 o; o[0] = pack2(acc[m][n][0], acc[m][n][1]); o[1] = pack2(acc[m][n][2], acc[m][n][3]);
              *(u32x2*)((u16*)(ws + O_KA) + (size_t)tok * 128 + c) = o;
              if (ctx) *(f32x4*)(out + OUT_AK + ((size_t)((tok >> 8) * 4 + l) * 256 + (tok & 255)) * 128 + c) = acc[m][n];
            }
          }
        } else if (tn < 21) {
#pragma unroll
          for (int n = 0; n < 4; ++n) *(f32x4*)((float*)(ws + O_PB) + (size_t)tok * 1920 + cb + n * 16 - 768) = acc[m][n];
        } else if (tn < 25) {
#pragma unroll
          for (int n = 0; n < 4; ++n) {
            u32x2 o; o[0] = pack2(acc[m][n][0] * 0.125f, acc[m][n][1] * 0.125f); o[1] = pack2(acc[m][n][2] * 0.125f, acc[m][n][3] * 0.125f);
            *(u32x2*)((u16*)(ws + O_QC) + (size_t)tok * 512 + cb + n * 16 - 2688) = o;
          }
        } else if (tn < 29) {
#pragma unroll
          for (int n = 0; n < 4; ++n) {
            int c = cb + n * 16 - 3200;
            u32x2 o; o[0] = pack2(acc[m][n][0], acc[m][n][1]); o[1] = pack2(acc[m][n][2], acc[m][n][3]);
            *(u32x2*)((u16*)(ws + O_KC) + (size_t)tok * 512 + c) = o;
            if (ctx) *(f32x4*)(out + OUT_CK + ((size_t)((tok >> 8) * 4 + l) * 256 + (tok & 255)) * 512 + c) = acc[m][n];
          }
        } else {
#pragma unroll
          for (int n = 0; n < 4; ++n) {
            u32x2 o; o[0] = pack2(sigmoidf_(acc[m][n][0]), sigmoidf_(acc[m][n][1])); o[1] = pack2(sigmoidf_(acc[m][n][2]), sigmoidf_(acc[m][n][3]));
            *(u32x2*)((u16*)(ws + O_GATE) + (size_t)tok * 3072 + cb + n * 16 - 4224) = o;
          }
        }
      }
    } else {
      const bool isA = (tn == 5);
      u16* VT = isA ? (u16*)(ws + O_VAT) : (u16*)(ws + O_VCT);
      const int ncols = isA ? 128 : 512;
      const size_t obase = isA ? OUT_AV : OUT_CV;
#pragma unroll
      for (int m = 0; m < 4; ++m) {
        const int c = (isA ? 0 : (tn - 29) * 128) + wr * 64 + m * 16 + fr;
#pragma unroll
        for (int n = 0; n < 4; ++n) {
          const int tk = brow + wc * 64 + n * 16 + fq * 4;
          u32x2 o; o[0] = pack2(acc[m][n][0], acc[m][n][1]); o[1] = pack2(acc[m][n][2], acc[m][n][3]);
          *(u32x2*)(VT + (size_t)c * NT + tk) = o;
          if (ctx) {
#pragma unroll
            for (int j = 0; j < 4; ++j) {
              int tok = tk + j;
              out[obase + ((size_t)((tok >> 8) * 4 + l) * 256 + (tok & 255)) * ncols + c] = acc[m][n][j];
            }
          }
        }
      }
    }
  }
}

__device__ void phase_rwkv_prep(const Params& p, int l) {
  char* ws = opaque_ptr(p.ws);
  const int tid = opaque_tid();
  const int lane = tid & 63;
  const int gw = blockIdx.x * 4 + (tid >> 6), GW = gridDim.x * 4;
  const float* PB = (const float*)(ws + O_PB);
  const float* mu = p.in[17] + l * 1920;
  const float* kkw = p.in[23] + l * 512;
  for (int tok = gw; tok < NT; tok += GW) {
    int pos, len;
    if (tok < NCTX) { pos = tok & 255; len = 256; } else { pos = (tok - NCTX) & 2047; len = 2048; }
    const bool hp = pos > 0, hn = pos < len - 1;
    const float* row = PB + (size_t)tok * 1920;
#pragma unroll
    for (int i = 0; i < 8; ++i) {
      int q = lane + 64 * i;
      if (q < 480) {
        int c = q * 4;
        f32x4 cur = *(const f32x4*)(row + c);
        f32x4 pv = hp ? *(const f32x4*)(row - 1920 + c) : f32x4{0.f, 0.f, 0.f, 0.f};
        f32x4 nv = hn ? *(const f32x4*)(row + 1920 + c) : f32x4{0.f, 0.f, 0.f, 0.f};
        f32x4 m4 = *(const f32x4*)(mu + c);
        f32x4 xb;
#pragma unroll
        for (int j = 0; j < 4; ++j) xb[j] = cur[j] + m4[j] * (0.5f * (pv[j] + nv[j]) - cur[j]);
        if (i < 6) {
          *(f32x4*)((float*)(ws + O_XRKV) + (size_t)tok * 1536 + c) = xb;
          if (i == 2 || i == 3) {
            int ck = c - 512;
            f32x4 kw = *(const f32x4*)(kkw + ck);
            f32x4 kv;
            float ss = 0.f;
#pragma unroll
            for (int j = 0; j < 4; ++j) { kv[j] = xb[j] * kw[j]; ss += kv[j] * kv[j]; }
            ss = row_sum16(ss);
            float rn = rsqrtf(ss + 1e-12f);
#pragma unroll
            for (int j = 0; j < 4; ++j) kv[j] *= rn;
            *(f32x4*)((float*)(ws + O_KK) + (size_t)tok * 512 + ck) = kv;
          }
        } else {
          u16* dst;
          int cc;
          float v[4];
          if (c < 1664) { dst = (u16*)(ws + O_TW); cc = c - 1536; for (int j = 0; j < 4; ++j) v[j] = tanhf(xb[j]); }
          else if (c < 1792) { dst = (u16*)(ws + O_AD); cc = c - 1664; for (int j = 0; j < 4; ++j) v[j] = xb[j]; }
          else { dst = (u16*)(ws + O_SG); cc = c - 1792; for (int j = 0; j < 4; ++j) v[j] = sigmoidf_(xb[j]); }
          u32x2 o; o[0] = pack2(v[0], v[1]); o[1] = pack2(v[2], v[3]);
          *(u32x2*)(dst + (size_t)tok * 128 + cc) = o;
        }
      }
    }
  }
}

__device__ void phase_rwkv_lora(const Params& p, int l) {
  char* ws = opaque_ptr(p.ws);
  const int tid = opaque_tid();
  const int wid = tid >> 6, lane = tid & 63, wr = wid >> 1, wc = wid & 1, fr = lane & 15, fq = lane >> 4;
  for (int t = blockIdx.x; t < 5 * 256; t += gridDim.x) {
    const int job = t >> 8, r = t & 255, tm = r & 63, tn = r >> 6;
    const int brow = tm * 128, bcol = tn * 128;
    f32x4 acc[4][4];
    zero_acc(acc);
    const int z = job & 1;
    if (job < 2) gemm_main(tid, (const u16*)(ws + O_TW) + (size_t)brow * 128 + z * 64, 128, (const u16*)(ws + O_W2) + ((size_t)(l * 2 + z) * 512 + bcol) * 64, 64, 64, acc);
    else if (job < 4) gemm_main(tid, (const u16*)(ws + O_AD) + (size_t)brow * 128 + z * 64, 128, (const u16*)(ws + O_A2) + ((size_t)(l * 2 + z) * 512 + bcol) * 64, 64, 64, acc);
    else gemm_main(tid, (const u16*)(ws + O_SG) + (size_t)brow * 128, 128, (const u16*)(ws + O_G2) + ((size_t)l * 512 + bcol) * 128, 128, 128, acc);
#pragma unroll
    for (int m = 0; m < 4; ++m) {
      const int tok = brow + wr * 64 + m * 16 + fr;
#pragma unroll
      for (int n = 0; n < 4; ++n) {
        const int c = bcol + wc * 64 + n * 16 + fq * 4;
        if (job < 2) {
          f32x4 w0 = *(const f32x4*)(p.in[18] + (size_t)(l * 2 + z) * 512 + c);
          f32x4 o;
#pragma unroll
          for (int j = 0; j < 4; ++j) {
            float val = w0[j] + acc[m][n][j];
            float y = -val;
            float sp = fmaxf(y, 0.f) + __logf(1.f + __expf(-fabsf(y)));
            float wlog = -sp - 0.5f;
            o[j] = __expf(-__expf(wlog));
          }
          *(f32x4*)((float*)(ws + O_DEC) + ((size_t)z * NT + tok) * 512 + c) = o;
        } else if (job < 4) {
          f32x4 a0 = *(const f32x4*)(p.in[20] + (size_t)(l * 2 + z) * 512 + c);
          f32x4 ka = *(const f32x4*)(p.in[24] + (size_t)l * 512 + c);
          f32x4 kx = *(const f32x4*)((const float*)(ws + O_XRKV) + (size_t)tok * 1536 + 512 + c);
          f32x4 kk = *(const f32x4*)((const float*)(ws + O_KK) + (size_t)tok * 512 + c);
          f32x4 okd, okka;
#pragma unroll
          for (int j = 0; j < 4; ++j) {
            float a = sigmoidf_(a0[j] + acc[m][n][j]);
            okd[j] = kx[j] * (1.f + (a - 1.f) * ka[j]);
            okka[j] = kk[j] * a;
          }
          *(f32x4*)((float*)(ws + O_KD) + ((size_t)z * NT + tok) * 512 + c) = okd;
          *(f32x4*)((float*)(ws + O_KKA) + ((size_t)z * NT + tok) * 512 + c) = okka;
        } else {
          *(f32x4*)((float*)(ws + O_GG) + (size_t)tok * 512 + c) = acc[m][n];
        }
      }
    }
  }
}

template <int JPL> struct ScanOps { float w[JPL], kd[JPL], kk[JPL], kka[JPL], r[JPL]; float v; };

template <int JPL>
DI void scan_load(ScanOps<JPL>& o, const float* __restrict__ dec, const float* __restrict__ kd, const float* __restrict__ kk,
                  const float* __restrict__ kka, const float* __restrict__ rr, const float* __restrict__ vv, int tok, int cj, int ci) {
  const size_t e = (size_t)tok * 512 + cj;
#pragma unroll
  for (int q = 0; q < JPL / 4; ++q) {
    f32x4 a = *(const f32x4*)(dec + e + q * 4), b = *(const f32x4*)(kd + e + q * 4), c = *(const f32x4*)(kk + e + q * 4),
          d = *(const f32x4*)(kka + e + q * 4), f = *(const f32x4*)(rr + (size_t)tok * 1536 + cj + q * 4);
#pragma unroll
    for (int j = 0; j < 4; ++j) { o.w[q * 4 + j] = a[j]; o.kd[q * 4 + j] = b[j]; o.kk[q * 4 + j] = c[j]; o.kka[q * 4 + j] = d[j]; o.r[q * 4 + j] = f[j]; }
  }
  o.v = vv[(size_t)tok * 1536 + 1024 + ci];
}

template <int JPL> DI float scan_red(float v) {
  v += dppf<0xB1>(v);
  v += dppf<0x4E>(v);
  if (JPL <= 8) v += dppf<0x141>(v);
  if (JPL <= 4) v += dppf<0x140>(v);
  return v;
}

template <int JPL>
DI void scan_step(float (&S)[JPL], const ScanOps<JPL>& o, float* __restrict__ y, int tok, int ci, bool wr) {
  float sa0 = 0.f, sa1 = 0.f;
#pragma unroll
  for (int j = 0; j < JPL; j += 2) { sa0 += S[j] * o.kk[j]; sa1 += S[j + 1] * o.kk[j + 1]; }
  float sa = -scan_red<JPL>(sa0 + sa1);
  float y0 = 0.f, y1 = 0.f;
#pragma unroll
  for (int j = 0; j < JPL; j += 2) {
    S[j] = S[j] * o.w[j] + (sa * o.kka[j] + o.v * o.kd[j]);
    S[j + 1] = S[j + 1] * o.w[j + 1] + (sa * o.kka[j + 1] + o.v * o.kd[j + 1]);
    y0 += S[j] * o.r[j]; y1 += S[j + 1] * o.r[j + 1];
  }
  float yv = scan_red<JPL>(y0 + y1);
  if (wr) y[(size_t)tok * 512 + ci] = yv;
}

template <int JPL, int D>
DI void scan_wave(char* ws, int lane, int z, int h, int tok0, int T, int rowbase, const float* __restrict__ s0, float* __restrict__ sout) {
  constexpr int LPR = 64 / JPL;
  const int rr = lane / LPR, pp = lane % LPR;
  const int i = rowbase + rr, j0 = pp * JPL;
  const int cj = h * 64 + j0, ci = h * 64 + i;
  const float* dec = (const float*)(ws + O_DEC) + (size_t)z * NT * 512;
  const float* kd = (const float*)(ws + O_KD) + (size_t)z * NT * 512;
  const float* kka = (const float*)(ws + O_KKA) + (size_t)z * NT * 512;
  const float* kk = (const float*)(ws + O_KK);
  const float* xr = (const float*)(ws + O_XRKV);
  float* y = (float*)(ws + O_YS) + (size_t)z * NT * 512;
  float S[JPL];
#pragma unroll
  for (int j = 0; j < JPL; ++j) S[j] = s0 ? s0[i * 64 + j0 + j] : 0.f;
  const int dir = z == 0 ? 1 : -1;
  const int first = z == 0 ? tok0 : tok0 + T - 1;
  const bool wr = pp == 0;
  ScanOps<JPL> R[D];
#pragma unroll
  for (int d = 0; d < D; ++d) scan_load<JPL>(R[d], dec, kd, kk, kka, xr, xr, first + dir * d, cj, ci);
  for (int n = 0; n < T; n += D) {
#pragma unroll
    for (int d = 0; d < D; ++d) {
      scan_step<JPL>(S, R[d], y, first + dir * (n + d), ci, wr);
      int nn = n + d + D;
      nn = nn < T ? nn : T - 1;
      scan_load<JPL>(R[d], dec, kd, kk, kka, xr, xr, first + dir * nn, cj, ci);
    }
  }
  if (sout) {
#pragma unroll
    for (int j = 0; j < JPL; ++j) sout[i * 64 + j0 + j] = S[j];
  }
}

DI void dma16(const char* gptr, unsigned ldsaddr) {
  asm volatile("s_mov_b32 m0, %0\n\ts_nop 0\n\tglobal_load_lds_dwordx4 %1, off" ::"s"(ldsaddr), "v"(gptr) : "memory");
}
template <int N> DI void wait_vm() { asm volatile("s_waitcnt vmcnt(%0)" ::"n"(N) : "memory"); }

template <int JPL> struct ScanRegs { float w[JPL], kd[JPL], kk[JPL], kka[JPL], r[JPL]; float v; };
template <int JPL> DI void scan_lds_read(ScanRegs<JPL>& o, const char* slot, int pp, int rr) {
#pragma unroll
  for (int q = 0; q < JPL / 4; ++q) {
    f32x4 a = *(const f32x4*)(slot + 0 + pp * JPL * 4 + q * 16), b = *(const f32x4*)(slot + 256 + pp * JPL * 4 + q * 16),
          c = *(const f32x4*)(slot + 512 + pp * JPL * 4 + q * 16), d = *(const f32x4*)(slot + 768 + pp * JPL * 4 + q * 16),
          f = *(const f32x4*)(slot + 1024 + pp * JPL * 4 + q * 16);
#pragma unroll
    for (int j = 0; j < 4; ++j) { o.w[q * 4 + j] = a[j]; o.kd[q * 4 + j] = b[j]; o.kk[q * 4 + j] = c[j]; o.kka[q * 4 + j] = d[j]; o.r[q * 4 + j] = f[j]; }
  }
  o.v = *(const float*)(slot + 1280 + rr * 4);
}
template <int JPL>
DI void scan_step2(float (&S)[JPL], const ScanRegs<JPL>& o, float* __restrict__ yp, bool wr) {
  float sa0 = 0.f, sa1 = 0.f;
#pragma unroll
  for (int j = 0; j < JPL; j += 2) { sa0 += S[j] * o.kk[j]; sa1 += S[j + 1] * o.kk[j + 1]; }
  float sa = -scan_red<JPL>(sa0 + sa1);
  float y0 = 0.f, y1 = 0.f;
#pragma unroll
  for (int j = 0; j < JPL; j += 2) {
    S[j] = sa * o.kka[j] + (S[j] * o.w[j] + o.v * o.kd[j]);
    S[j + 1] = sa * o.kka[j + 1] + (S[j + 1] * o.w[j + 1] + o.v * o.kd[j + 1]);
    y0 += S[j] * o.r[j]; y1 += S[j + 1] * o.r[j + 1];
  }
  float yv = scan_red<JPL>(y0 + y1);
  if (wr) *yp = yv;
}

template <int JPL, int NS>
DI void scan_wave_dma(char* ws, int lane, int ringoff, int z, int h, int tok0, int T, int rowbase, const float* __restrict__ s0,
                      float* __restrict__ sout) {
  constexpr int LPR = 64 / JPL, PD = NS - 1, WN = 3 * PD - 3;
  static_assert(WN <= 63, "vmcnt range");
  const int rr = lane / LPR, pp = lane % LPR;
  const int i = rowbase + rr, j0 = pp * JPL;
  const int dir = z == 0 ? 1 : -1;
  const int first = z == 0 ? tok0 : tok0 + T - 1;
  const bool wr = pp == 0;
  float S[JPL];
#pragma unroll
  for (int j = 0; j < JPL; ++j) S[j] = s0 ? s0[i * 64 + j0 + j] : 0.f;
  const int a = lane >> 4, c16 = lane & 15;
  const float* arr = a == 0 ? (const float*)(ws + O_DEC) + (size_t)z * NT * 512
                   : a == 1 ? (const float*)(ws + O_KD) + (size_t)z * NT * 512
                   : a == 2 ? (const float*)(ws + O_KK)
                            : (const float*)(ws + O_KKA) + (size_t)z * NT * 512;
  const char* gA = (const char*)(arr + (size_t)first * 512 + h * 64 + c16 * 4);
  const char* gB = (const char*)((const float*)(ws + O_XRKV) + (size_t)first * 1536 + (lane < 16 ? h * 64 + c16 * 4 : 1024 + h * 64 + rowbase + (lane - 16) * 4));
  const long stA = (long)dir * 2048, stB = (long)dir * 6144;
  const bool bact = lane < 16 + JPL / 4;
  ringoff = __builtin_amdgcn_readfirstlane(ringoff);
  const unsigned ring = (unsigned)(size_t)g_smem + (unsigned)ringoff;
  const char* ringp = g_smem + ringoff;
  float* yp = (float*)(ws + O_YS) + (size_t)z * NT * 512 + (size_t)first * 512 + h * 64 + i;
  const long sty = (long)dir * 512;
  float* dummy = (float*)(ws + O_MERG) + lane;
#pragma unroll 1
  for (int s = 0; s < PD; ++s) {
    unsigned slot = ring + (unsigned)(s & (NS - 1)) * 1536u;
    dma16(gA, slot);
    if (bact) dma16(gB, slot + 1024u);
    gA += stA; gB += stB;
    if (wr) dummy[s * 64] = 0.f;
  }
  ScanRegs<JPL> A, B;
  wait_vm<3 * PD - 3>();
  wait_vm<3 * (PD - 1)>();
  scan_lds_read<JPL>(A, ringp, pp, rr);
  for (int n = 0; n < T; n += 2) {
    {
      unsigned sl = (unsigned)((n + PD) & (NS - 1)) * 1536u;
      dma16(gA, ring + sl);
      if (bact) dma16(gB, ring + sl + 1024u);
      gA += stA; gB += stB;
      wait_vm<WN>();
      scan_lds_read<JPL>(B, ringp + ((n + 1) & (NS - 1)) * 1536, pp, rr);
      scan_step2<JPL>(S, A, yp, wr);
      yp += sty;
    }
    {
      unsigned sl = (unsigned)((n + 1 + PD) & (NS - 1)) * 1536u;
      dma16(gA, ring + sl);
      if (bact) dma16(gB, ring + sl + 1024u);
      gA += stA; gB += stB;
      wait_vm<WN>();
      scan_lds_read<JPL>(A, ringp + ((n + 2) & (NS - 1)) * 1536, pp, rr);
      scan_step2<JPL>(S, B, yp, wr);
      yp += sty;
    }
  }
  wait_vm<0>();
  if (sout) {
#pragma unroll
    for (int j = 0; j < JPL; ++j) sout[i * 64 + j0 + j] = S[j];
  }
}

template <int JPL>
DI void scan_dots(const float (&S)[JPL], const ScanRegs<JPL>& cur, const ScanRegs<JPL>& prv, float& d1, float& d2) {
  float a0 = 0.f, a1 = 0.f, b0 = 0.f, b1 = 0.f;
#pragma unroll
  for (int j = 0; j < JPL; j += 2) {
    a0 += S[j] * cur.kk[j]; b0 += S[j] * prv.r[j];
    a1 += S[j + 1] * cur.kk[j + 1]; b1 += S[j + 1] * prv.r[j + 1];
  }
  d1 = a0 + a1; d2 = b0 + b1;
}
template <int JPL> DI void scan_red2(float& a, float& b) {
  a += dppf<0xB1>(a); b += dppf<0xB1>(b);
  a += dppf<0x4E>(a); b += dppf<0x4E>(b);
  if (JPL <= 8) { a += dppf<0x141>(a); b += dppf<0x141>(b); }
  if (JPL <= 4) { a += dppf<0x140>(a); b += dppf<0x140>(b); }
}
template <int JPL> DI void scan_pre(float (&Tm)[JPL], const float (&S)[JPL], const ScanRegs<JPL>& o) {
#pragma unroll
  for (int j = 0; j < JPL; ++j) Tm[j] = S[j] * o.w[j] + o.v * o.kd[j];
}
template <int JPL> DI void scan_update(float (&S)[JPL], const float (&Tm)[JPL], const ScanRegs<JPL>& o, float sa) {
#pragma unroll
  for (int j = 0; j < JPL; ++j) S[j] = sa * o.kka[j] + Tm[j];
}

template <int JPL, int T>
DI void scan_latent_block(char* ws, int tid, int z, int h, int tok0, int rowblock, const float* __restrict__ s0, float* __restrict__ sout) {
  constexpr int LPR = 64 / JPL, G = 7, WNV = 6 * G - 2;
  const int wid = __builtin_amdgcn_readfirstlane(tid >> 6), lane = tid & 63;
  const int rr = lane / LPR, pp = lane % LPR;
  const int rloc = wid * JPL + rr;
  const int i = rowblock + rloc, j0 = pp * JPL;
  const int dir = z == 0 ? 1 : -1;
  const int first = z == 0 ? tok0 : tok0 + T - 1;
  const bool wr = pp == 0;
  float S[JPL];
#pragma unroll
  for (int j = 0; j < JPL; ++j) S[j] = s0 ? s0[i * 64 + j0 + j] : 0.f;
  const int a = lane >> 4, c16 = lane & 15;
  const float* arr = a == 0 ? (const float*)(ws + O_DEC) + (size_t)z * NT * 512
                   : a == 1 ? (const float*)(ws + O_KD) + (size_t)z * NT * 512
                   : a == 2 ? (const float*)(ws + O_KK)
                            : (const float*)(ws + O_KKA) + (size_t)z * NT * 512;
  const int fw = first + dir * wid;
  const char* gA = (const char*)(arr + (size_t)fw * 512 + h * 64 + c16 * 4);
  const char* gB = (const char*)((const float*)(ws + O_XRKV) + (size_t)fw * 1536 + (lane < 16 ? h * 64 + c16 * 4 : 1024 + h * 64 + rowblock + (lane - 16) * 4));
  const long stA = (long)dir * 4 * 2048, stB = (long)dir * 4 * 6144;
  const bool bact = lane < 16 + JPL;
  const unsigned ring = (unsigned)(size_t)g_smem;
  const char* ringp = g_smem;
  float* yp = (float*)(ws + O_YS) + (size_t)z * NT * 512 + (size_t)first * 512 + h * 64 + i;
  const long sty = (long)dir * 512;
  float* dummy = (float*)(ws + O_MERG) + tid;
#pragma unroll 1
  for (int g = 0; g < G; ++g) {
    unsigned slot = ring + (unsigned)((4 * g + wid) & 31) * 1536u;
    dma16(gA, slot);
    if (bact) dma16(gB, slot + 1024u);
    gA += stA; gB += stB;
    if (wr) { dummy[(g * 4 + 0) * 256] = 0.f; }
    if (wr) { dummy[(g * 4 + 1) * 256] = 0.f; }
    if (wr) { dummy[(g * 4 + 2) * 256] = 0.f; }
    if (wr) { dummy[(g * 4 + 3) * 256] = 0.f; }
    asm volatile("" ::: "memory");
  }
  ScanRegs<JPL> A, B;
#pragma unroll
  for (int j = 0; j < JPL; ++j) B.r[j] = 0.f;
  float* ypv = dummy + 28 * 256;
  wait_vm<WNV>();
  asm volatile("" ::: "memory");
  __builtin_amdgcn_s_barrier();
  asm volatile("" ::: "memory");
  scan_lds_read<JPL>(A, ringp, pp, rloc);
#pragma unroll 1
  for (int g = 0; g < T / 4; ++g) {
    wait_vm<WNV - 6>();

    asm volatile("" ::: "memory");
    __builtin_amdgcn_s_barrier();
    asm volatile("" ::: "memory");
    {
      unsigned slot = ring + (unsigned)((4 * (g + G) + wid) & 31) * 1536u;
      dma16(gA, slot);
      if (bact) dma16(gB, slot + 1024u);
      gA += stA; gB += stB;
    }
    const char* gp = ringp + ((4 * g) & 31) * 1536;
    if (JPL >= 8) {
#pragma unroll
      for (int k = 0; k < 4; ++k) {
        scan_lds_read<JPL>(A, gp + k * 1536, pp, rloc);
        scan_step2<JPL>(S, A, yp, wr);
        yp += sty;
        asm volatile("" ::: "memory");
      }
      continue;
    }
    float d1, y0, y1, y2, y3;
    float Tm[JPL];
    scan_dots<JPL>(S, A, B, d1, y0);
    scan_pre<JPL>(Tm, S, A);
    scan_lds_read<JPL>(B, gp + 1536, pp, rloc);
    scan_red2<JPL>(d1, y0);
    scan_update<JPL>(S, Tm, A, -d1);
    scan_dots<JPL>(S, B, A, d1, y1);
    scan_pre<JPL>(Tm, S, B);
    scan_lds_read<JPL>(A, gp + 2 * 1536, pp, rloc);
    scan_red2<JPL>(d1, y1);
    scan_update<JPL>(S, Tm, B, -d1);
    scan_dots<JPL>(S, A, B, d1, y2);
    scan_pre<JPL>(Tm, S, A);
    scan_lds_read<JPL>(B, gp + 3 * 1536, pp, rloc);
    scan_red2<JPL>(d1, y2);
    scan_update<JPL>(S, Tm, A, -d1);
    scan_dots<JPL>(S, B, A, d1, y3);
    scan_pre<JPL>(Tm, S, B);
    scan_lds_read<JPL>(A, ringp + ((4 * g + 4) & 31) * 1536, pp, rloc);
    scan_red2<JPL>(d1, y3);
    scan_update<JPL>(S, Tm, B, -d1);
    if (wr) {
      *ypv = y0;
      yp[0] = y1;
      yp[sty] = y2;
      yp[2 * sty] = y3;
    }
    ypv = yp + 3 * sty;
    yp += 4 * sty;
    asm volatile("" ::: "memory");
  }
  {
    float e0 = 0.f, e1 = 0.f;
#pragma unroll
    for (int j = 0; j < JPL; j += 2) { e0 += S[j] * B.r[j]; e1 += S[j + 1] * B.r[j + 1]; }
    float yv = scan_red<JPL>(e0 + e1);
    if (wr) *ypv = yv;
  }
  wait_vm<0>();
  asm volatile("" ::: "memory");
  __builtin_amdgcn_s_barrier();
  asm volatile("" ::: "memory");
  if (sout) {
#pragma unroll
    for (int j = 0; j < JPL; ++j) sout[i * 64 + j0 + j] = S[j];
  }
}

struct AttnSt { float m, l; f32x4 o[4]; };

struct AttnKVF { bf16x8 k[2][2]; bf16x8 v[4]; };
DI void attn_kvload(AttnKVF& f, const u16* __restrict__ kp, int ldk, const u16* __restrict__ vtp, int ldv, int fr, int fq) {
#pragma unroll
  for (int kt = 0; kt < 2; ++kt)
#pragma unroll
    for (int ks = 0; ks < 2; ++ks) f.k[kt][ks] = *(const bf16x8*)(kp + (size_t)(8 * (fr >> 2) + 4 * kt + (fr & 3)) * ldk + ks * 32 + fq * 8);
#pragma unroll
  for (int dt = 0; dt < 4; ++dt) f.v[dt] = *(const bf16x8*)(vtp + (size_t)(dt * 16 + fr) * ldv + fq * 8);
}
template <int MODE>
DI void attn_core(AttnSt& st, const bf16x8 (&qf)[2], const AttnKVF& f, int fr, int fq, int qpos, int kpos0, const float* __restrict__ rpbrow) {
  f32x4 s[2];
#pragma unroll
  for (int kt = 0; kt < 2; ++kt) {
    s[kt] = f32x4{0.f, 0.f, 0.f, 0.f};
#pragma unroll
    for (int ks = 0; ks < 2; ++ks) s[kt] = mfma16(f.k[kt][ks], qf[ks], s[kt]);
  }
  if (MODE != 0) {
#pragma unroll
    for (int kt = 0; kt < 2; ++kt)
#pragma unroll
      for (int j = 0; j < 4; ++j) {
        int kpos = kpos0 + 8 * fq + 4 * kt + j;
        if (MODE == 1) {
          int d = qpos - kpos;
          if (d > 128 || d < -128) s[kt][j] = -1e30f;
        } else {
          int cs = min(max(qpos - 8, 0), 48);
          int dc = min(max(kpos - qpos, -15), 15) + 15;
          float b = rpbrow[dc];
          s[kt][j] = (kpos >= cs && kpos < cs + 16) ? s[kt][j] + b : -1e30f;
        }
      }
  }
  float mx = fmaxf(fmaxf(fmaxf(s[0][0], s[0][1]), fmaxf(s[0][2], s[0][3])), fmaxf(fmaxf(s[1][0], s[1][1]), fmaxf(s[1][2], s[1][3])));
  mx = fmaxf(mx, __shfl_xor(mx, 16));
  mx = fmaxf(mx, __shfl_xor(mx, 32));
  float mn = fmaxf(st.m, mx);
  float alpha = __expf(st.m - mn);
  st.m = mn;
  float ps = 0.f;
  float pv[8];
#pragma unroll
  for (int kt = 0; kt < 2; ++kt)
#pragma unroll
    for (int j = 0; j < 4; ++j) { float e = __expf(s[kt][j] - mn); pv[kt * 4 + j] = e; ps += e; }
  st.l = st.l * alpha + ps;
  u32x4 pk;
  pk[0] = pack2(pv[0], pv[1]); pk[1] = pack2(pv[2], pv[3]); pk[2] = pack2(pv[4], pv[5]); pk[3] = pack2(pv[6], pv[7]);
  bf16x8 pf = __builtin_bit_cast(bf16x8, pk);
#pragma unroll
  for (int dt = 0; dt < 4; ++dt) {
    bf16x8 vf = f.v[dt];
#pragma unroll
    for (int j = 0; j < 4; ++j) st.o[dt][j] *= alpha;
    st.o[dt] = mfma16(vf, pf, st.o[dt]);
  }
}

DI void attn_item(const Params& p, char* ws, int lane, int l, int item) {
  const int fr = lane & 15, fq = lane >> 4;
  const int type = item >> 10, r = item & 1023;
  const int h = r & 7, qp = r >> 3;
  AttnSt st[2];
  const u16* Q;
  u16* Y;
  if (type == 0 || type == 2) { Q = (const u16*)(ws + O_QA); Y = (u16*)(ws + O_YABC); }
  else { Q = (const u16*)(ws + O_QC); Y = (u16*)(ws + O_YABC) + 2ull * NT * 512; }
  const int tok0 = (type < 2 ? NCTX : 0) + qp * 32;
  bf16x8 qf[2][2];
  const bool hasSink = (type == 0 || type == 2);
#pragma unroll
  for (int i = 0; i < 2; ++i) {
#pragma unroll
    for (int dt = 0; dt < 4; ++dt) st[i].o[dt] = f32x4{0.f, 0.f, 0.f, 0.f};
#pragma unroll
    for (int ks = 0; ks < 2; ++ks) qf[i][ks] = *(const bf16x8*)(Q + (size_t)(tok0 + i * 16 + fr) * 512 + h * 64 + ks * 32 + fq * 8);
    if (hasSink) { st[i].m = p.in[15][l * 8 + h]; st[i].l = fq == 0 ? 1.f : 0.f; }
    else { st[i].m = -1e30f; st[i].l = 0.f; }
  }
  AttnKVF f;
  if (type == 0) {
    const int qt = qp * 2;
    const int b = qt >> 7, kv = h >> 2;
    const u16* ck = (const u16*)(ws + O_CAK) + ((size_t)(b * 4 + l) * 512) * 128 + kv * 64;
    const u16* cvt = (const u16*)(ws + O_CAVT) + ((size_t)(b * 4 + l) * 128 + kv * 64) * 512;
    for (int p0 = 0; p0 < 512; p0 += 32) {
      attn_kvload(f, ck + (size_t)p0 * 128, 128, cvt + p0, 512, fr, fq);
      attn_core<0>(st[0], qf[0], f, fr, fq, 0, 0, nullptr);
      attn_core<0>(st[1], qf[1], f, fr, fq, 0, 0, nullptr);
    }
    const u16* K = (const u16*)(ws + O_KA) + (size_t)(NCTX + b * 2048) * 128 + kv * 64;
    const u16* VT = (const u16*)(ws + O_VAT) + (size_t)(kv * 64) * NT + NCTX + b * 2048;
    const int ta = (qt & 127) * 16;
    const int kb0 = max(0, ((ta - 128) >> 5) << 5), kb1 = min(2048, ta + 32 + 128);
    for (int k0 = kb0; k0 < kb1; k0 += 32) {
      attn_kvload(f, K + (size_t)k0 * 128, 128, VT + k0, NT, fr, fq);
      attn_core<1>(st[0], qf[0], f, fr, fq, ta + fr, k0, nullptr);
      attn_core<1>(st[1], qf[1], f, fr, fq, ta + 16 + fr, k0, nullptr);
    }
  } else if (type == 1) {
    const int qt = qp * 2;
    const int b = qt >> 7;
    const u16* ck = (const u16*)(ws + O_CCK) + ((size_t)(b * 4 + l) * 512) * 512 + h * 64;
    const u16* cvt = (const u16*)(ws + O_CCVT) + ((size_t)(b * 4 + l) * 512 + h * 64) * 512;
    for (int p0 = 0; p0 < 512; p0 += 32) {
      attn_kvload(f, ck + (size_t)p0 * 512, 512, cvt + p0, 512, fr, fq);
      attn_core<0>(st[0], qf[0], f, fr, fq, 0, 0, nullptr);
      attn_core<0>(st[1], qf[1], f, fr, fq, 0, 0, nullptr);
    }
    const u16* K = (const u16*)(ws + O_KC) + (size_t)(NCTX + b * 2048) * 512 + h * 64;
    const u16* VT = (const u16*)(ws + O_VCT) + (size_t)(h * 64) * NT + NCTX + b * 2048;
    const float* rpb = p.in[29] + (size_t)(l * 8 + h) * 15 * 31;
#pragma unroll
    for (int i = 0; i < 2; ++i) {
      const int t0 = ((qt + i) & 127) * 16;
      const int qrow = t0 >> 6, c0 = t0 & 63;
      const int rs = min(max(qrow - 4, 0), 24);
      const int cstart = min(max(c0 - 8, 0), 32);
      for (int a = 0; a < 8; ++a) {
        int krow = rs + a;
        int k0 = krow * 64 + cstart;
        attn_kvload(f, K + (size_t)k0 * 512, 512, VT + k0, NT, fr, fq);
        attn_core<2>(st[i], qf[i], f, fr, fq, c0 + fr, cstart, rpb + (krow - qrow + 7) * 31);
      }
    }
  } else if (type == 2) {
    const int b = (qp * 2) >> 4, kv = h >> 2;
    const u16* K = (const u16*)(ws + O_KA) + (size_t)(b * 256) * 128 + kv * 64;
    const u16* VT = (const u16*)(ws + O_VAT) + (size_t)(kv * 64) * NT + b * 256;
    for (int k0 = 0; k0 < 256; k0 += 32) {
      attn_kvload(f, K + (size_t)k0 * 128, 128, VT + k0, NT, fr, fq);
      attn_core<0>(st[0], qf[0], f, fr, fq, 0, 0, nullptr);
      attn_core<0>(st[1], qf[1], f, fr, fq, 0, 0, nullptr);
    }
  } else {
    const int b = (qp * 2) >> 4;
    const u16* K = (const u16*)(ws + O_KC) + (size_t)(b * 256) * 512 + h * 64;
    const u16* VT = (const u16*)(ws + O_VCT) + (size_t)(h * 64) * NT + b * 256;
    for (int k0 = 0; k0 < 256; k0 += 32) {
      attn_kvload(f, K + (size_t)k0 * 512, 512, VT + k0, NT, fr, fq);
      attn_core<0>(st[0], qf[0], f, fr, fq, 0, 0, nullptr);
      attn_core<0>(st[1], qf[1], f, fr, fq, 0, 0, nullptr);
    }
  }
#pragma unroll
  for (int i = 0; i < 2; ++i) {
    float lt = st[i].l;
    lt += __shfl_xor(lt, 16);
    lt += __shfl_xor(lt, 32);
    float inv = 1.f / lt;
#pragma unroll
    for (int dt = 0; dt < 4; ++dt) {
      u32x2 o; o[0] = pack2(st[i].o[dt][0] * inv, st[i].o[dt][1] * inv); o[1] = pack2(st[i].o[dt][2] * inv, st[i].o[dt][3] * inv);
      *(u32x2*)(Y + (size_t)(tok0 + i * 16 + fr) * 512 + h * 64 + dt * 16 + fq * 4) = o;
    }
  }
}


__device__ void phase_mix(const Params& p, int l) {
  char* ws = opaque_ptr(p.ws);
  const int tid = opaque_tid();
  const int wid = tid >> 6, lane = tid & 63;
  constexpr int LJPL = 4;
  constexpr int BPS = 64 / (4 * LJPL);
  const int NLB = (int)gridDim.x >= 2 * 32 * BPS ? 32 * BPS : 0;
  if ((int)blockIdx.x < NLB) {
    __builtin_amdgcn_s_setprio(3);
    const int it = blockIdx.x;
    const int sc = it / BPS, hf = it % BPS;
    const int z = sc & 1, h = (sc >> 1) & 7, b = sc >> 4;
    const float* s0 = p.in[6] + ((size_t)((b * 4 + l) * 2 + z) * 8 + h) * 4096;
    scan_latent_block<LJPL, 2048>(ws, tid, z, h, NCTX + b * 2048, hf * 4 * LJPL, s0, nullptr);
  } else {
    __builtin_amdgcn_s_setprio(1);
    if (NLB == 0) {
      for (int it = blockIdx.x * 4 + wid; it < 256; it += gridDim.x * 4) {
        int sc = it >> 3, part = it & 7;
        int z = sc & 1, h = (sc >> 1) & 7, b = sc >> 4;
        const float* s0 = p.in[6] + ((size_t)((b * 4 + l) * 2 + z) * 8 + h) * 4096;
        scan_wave_dma<8, 8>(ws, lane, wid * 12288, z, h, NCTX + b * 2048, 2048, part * 8, s0, nullptr);
      }
    }
    if (NLB > 0) {
      const int nab = (int)gridDim.x - NLB;
      for (int it = (int)blockIdx.x - NLB; it < 512; it += nab) {
        int sc = it >> 1, hf = it & 1;
        int z = sc & 1, h = (sc >> 1) & 7, b = sc >> 4;
        float* so = p.out + OUT_ST + ((size_t)((b * 4 + l) * 2 + z) * 8 + h) * 4096;
        scan_latent_block<8, 256>(ws, tid, z, h, b * 256, hf * 32, nullptr, so);
      }
    } else {
      const int nw = gridDim.x * 4;
      for (int it = (int)blockIdx.x * 4 + wid; it < 2048; it += nw) {
        int sc = it >> 3, part = it & 7;
        int z = sc & 1, h = (sc >> 1) & 7, b = sc >> 4;
        float* so = p.out + OUT_ST + ((size_t)((b * 4 + l) * 2 + z) * 8 + h) * 4096;
        scan_wave_dma<8, 8>(ws, lane, wid * 12288, z, h, b * 256, 256, part * 8, nullptr, so);
      }
    }
  }
  __builtin_amdgcn_s_setprio(0);
  int* cnt = (int*)(ws + O_CNT) + l;
  while (true) {
    int it = 0;
    if (lane == 0) it = atomicAdd(cnt, 1);
    it = __builtin_amdgcn_readfirstlane(it);
    if (it >= 4096) break;
    attn_item(p, ws, lane, l, it);
  }
  if (l == 0) {
    int* cnt2 = (int*)(ws + O_CNT) + 8;
    while (true) {
      int it = 0;
      if (lane == 0) it = atomicAdd(cnt2, 1);
      it = __builtin_amdgcn_readfirstlane(it);
      if (it >= 4096) break;
      const int tab = it >> 11, rb = (it & 2047) * 32;
      if (tab == 0) convert_rows_fp8_wave(lane, p.in[34], (unsigned char*)(ws + O_PEU), (float*)(ws + O_SCU), rb, rb + 32);
      else convert_rows_fp8_wave(lane, p.in[35], (unsigned char*)(ws + O_PEV), (float*)(ws + O_SCV), rb, rb + 32);
    }
  }
}

__device__ void phase_rwkv_post(const Params& p, int l) {
  char* ws = opaque_ptr(p.ws);
  const int tid = opaque_tid();
  const int lane = tid & 63;
  const int gw = blockIdx.x * 4 + (tid >> 6), GW = gridDim.x * 4;
  const float* Y0 = (const float*)(ws + O_YS);
  const float* Y1 = Y0 + (size_t)NT * 512;
  const float* KD0 = (const float*)(ws + O_KD);
  const float* KD1 = KD0 + (size_t)NT * 512;
  for (int tok = gw; tok < NT; tok += GW) {
#pragma unroll
    for (int i = 0; i < 2; ++i) {
      int c = (lane + 64 * i) * 4;
      size_t e = (size_t)tok * 512 + c;
      f32x4 a = *(const f32x4*)(Y0 + e), b = *(const f32x4*)(Y1 + e);
      f32x4 y;
      float s = 0.f;
#pragma unroll
      for (int j = 0; j < 4; ++j) { y[j] = a[j] + b[j]; s += y[j]; }
      float mu = row_sum16(s) * (1.f / 64.f);
      float vs = 0.f;
#pragma unroll
      for (int j = 0; j < 4; ++j) { y[j] -= mu; vs += y[j] * y[j]; }
      float var = row_sum16(vs) * (1.f / 64.f);
      float rstd = rsqrtf(var + 64e-5f);
      f32x4 g = *(const f32x4*)(p.in[26] + l * 512 + c), bb = *(const f32x4*)(p.in[27] + l * 512 + c);
      f32x4 r = *(const f32x4*)((const float*)(ws + O_XRKV) + (size_t)tok * 1536 + c);
      f32x4 v = *(const f32x4*)((const float*)(ws + O_XRKV) + (size_t)tok * 1536 + 1024 + c);
      f32x4 k0 = *(const f32x4*)(KD0 + e), k1 = *(const f32x4*)(KD1 + e);
      f32x4 rk = *(const f32x4*)(p.in[25] + l * 512 + c);
      float bs = 0.f;
#pragma unroll
      for (int j = 0; j < 4; ++j) bs += r[j] * (k0[j] + k1[j]) * rk[j];
      bs = row_sum16(bs);
      f32x4 gg = *(const f32x4*)((const float*)(ws + O_GG) + e);
      float o[4];
#pragma unroll
      for (int j = 0; j < 4; ++j) o[j] = (y[j] * rstd * g[j] + bb[j] + bs * v[j]) * gg[j];
      u32x2 ov; ov[0] = pack2(o[0], o[1]); ov[1] = pack2(o[2], o[3]);
      *(u32x2*)((u16*)(ws + O_YABC) + (size_t)NT * 512 + e) = ov;
    }
  }
}

__device__ void phase_branch(const Params& p, int l) {
  char* ws = opaque_ptr(p.ws);
  const int tid = opaque_tid();
  const int wid = tid >> 6, lane = tid & 63, wr = wid >> 1, wc = wid & 1, fr = lane & 15, fq = lane >> 4;
  const u16* G = (const u16*)(ws + O_GATE);
  for (int t = blockIdx.x; t < 64 * 8; t += gridDim.x) {
    const int tm = t & 63, tn = t >> 6;
    const int brow = tm * 128, bcol = tn * 128;
    f32x4 tot[4][4];
    zero_acc(tot);
#pragma unroll 1
    for (int br = 0; br < 3; ++br) {
      f32x4 acc[4][4];
      zero_acc(acc);
      const u16* Wb = (const u16*)(ws + (br == 0 ? O_AOUT : br == 1 ? O_RWOUT : O_NAOUT)) + ((size_t)l * 1024 + bcol) * 512;
      gemm_main(tid, (const u16*)(ws + O_YABC) + (size_t)br * NT * 512 + (size_t)brow * 512, 512, Wb, 512, 512, acc, ((tm >> 3) + (tn & 7)) & 7);
#pragma unroll
      for (int m = 0; m < 4; ++m) {
        const int tok = brow + wr * 64 + m * 16 + fr;
#pragma unroll
        for (int n = 0; n < 4; ++n) {
          const int c = bcol + wc * 64 + n * 16 + fq * 4;
          u32x2 gv = *(const u32x2*)(G + (size_t)tok * 3072 + br * 1024 + c);
          tot[m][n][0] += acc[m][n][0] * __uint_as_float(gv[0] << 16);
          tot[m][n][1] += acc[m][n][1] * __uint_as_float(gv[0] & 0xffff0000u);
          tot[m][n][2] += acc[m][n][2] * __uint_as_float(gv[1] << 16);
          tot[m][n][3] += acc[m][n][3] * __uint_as_float(gv[1] & 0xffff0000u);
        }
      }
    }
#pragma unroll
    for (int m = 0; m < 4; ++m) {
      const int tok = brow + wr * 64 + m * 16 + fr;
#pragma unroll
      for (int n = 0; n < 4; ++n) {
        const int c = bcol + wc * 64 + n * 16 + fq * 4;
        u32x2 o; o[0] = pack2(tot[m][n][0], tot[m][n][1]); o[1] = pack2(tot[m][n][2], tot[m][n][3]);
        *(u32x2*)((u16*)(ws + O_MERG) + (size_t)tok * 1024 + c) = o;
      }
    }
  }
}

__device__ void phase_wo(const Params& p, int l) {
  char* ws = opaque_ptr(p.ws);
  const int tid = opaque_tid();
  const int wid = tid >> 6, lane = tid & 63, wr = wid >> 1, wc = wid & 1, fr = lane & 15, fq = lane >> 4;
  float* X = (float*)(ws + O_X);
  for (int t = blockIdx.x; t < 64 * 8; t += gridDim.x) {
    const int tm = t & 63, tn = t >> 6;
    const int brow = tm * 128, bcol = tn * 128;
    f32x4 acc[4][4];
    zero_acc(acc);
    gemm_main(tid, (const u16*)(ws + O_MERG) + (size_t)brow * 1024, 1024, (const u16*)(ws + O_WO) + ((size_t)l * 1024 + bcol) * 1024, 1024, 1024, acc, (((tm >> 3) + (tn & 7)) * 2) & 15);
#pragma unroll
    for (int m = 0; m < 4; ++m) {
      const int tok = brow + wr * 64 + m * 16 + fr;
      const float* gate = (const float*)(ws + O_MOD) + ((size_t)l * 3 + tok_cond(tok)) * 6144 + 2 * 1024;
#pragma unroll
      for (int n = 0; n < 4; ++n) {
        const int c = bcol + wc * 64 + n * 16 + fq * 4;
        f32x4 x = *(f32x4*)(X + (size_t)tok * 1024 + c);
        f32x4 g = *(const f32x4*)(gate + c);
#pragma unroll
        for (int j = 0; j < 4; ++j) x[j] += g[j] * acc[m][n][j];
        *(f32x4*)(X + (size_t)tok * 1024 + c) = x;
      }
    }
  }
}

__device__ void phase_peq(const Params& p, int l) {
  char* ws = opaque_ptr(p.ws);
  const int tid = opaque_tid();
  const int wid = tid >> 6, lane = tid & 63, wr = wid >> 1, wc = wid & 1, fr = lane & 15, fq = lane >> 4;
  for (int t = blockIdx.x; t < 64 * 16; t += gridDim.x) {
    const int tm = t & 63, tn = t >> 6;
    const int brow = tm * 128, bcol = tn * 128;
    f32x4 acc[4][4];
    zero_acc(acc);
    gemm_main(tid, (const u16*)(ws + O_H) + (size_t)brow * 1024, 1024, (const u16*)(ws + O_PEQ) + ((size_t)l * 2048 + bcol) * 1024, 1024, 1024, acc, (((tm >> 3) + (tn & 7)) * 2) & 15);
#pragma unroll
    for (int m = 0; m < 4; ++m) {
      const int tok = brow + wr * 64 + m * 16 + fr;
#pragma unroll
      for (int n = 0; n < 4; ++n) {
        const int c = bcol + wc * 64 + n * 16 + fq * 4;
        u32x2 o; o[0] = pack2(acc[m][n][0], acc[m][n][1]); o[1] = pack2(acc[m][n][2], acc[m][n][3]);
        *(u32x2*)((u16*)(ws + O_PQ) + (size_t)tok * 2048 + c) = o;
      }
    }
  }
}

__device__ const unsigned char kCand[64] = {
    0x00, 0x01, 0x02, 0x03, 0x04, 0x05, 0x06, 0x07, 0x08, 0x09, 0x0a, 0x0b, 0x0c, 0x0d, 0x0e, 0x0f,
    0x10, 0x11, 0x12, 0x13, 0x14, 0x15, 0x16, 0x17, 0x20, 0x21, 0x22, 0x23, 0x24, 0x30, 0x31, 0x32,
    0x33, 0x40, 0x41, 0x42, 0x50, 0x51, 0x60, 0x61, 0x70, 0x71, 0x80, 0x90, 0xa0, 0xb0, 0xc0, 0xd0,
    0xe0, 0xf0, 0xff, 0xff, 0xff, 0xff, 0xff, 0xff, 0xff, 0xff, 0xff, 0xff, 0xff, 0xff, 0xff, 0xff};

DI unsigned f2key(float f) { unsigned u = __float_as_uint(f); return (u & 0x80000000u) ? ~u : (u | 0x80000000u); }
DI float key2f(unsigned k) { unsigned u = (k & 0x80000000u) ? (k & 0x7fffffffu) : ~k; return __uint_as_float(u); }
template <int CTRL> DI unsigned dppu(unsigned v) { return (unsigned)__builtin_amdgcn_update_dpp(0, (int)v, CTRL, 0xf, 0xf, true); }
DI unsigned row_max16u(unsigned v) { v = max(v, dppu<0xB1>(v)); v = max(v, dppu<0x4E>(v)); v = max(v, dppu<0x141>(v)); v = max(v, dppu<0x140>(v)); return v; }

__device__ void phase_peer_sel(const Params& p, int l) {
  char* ws = opaque_ptr(p.ws);
  const int tid = opaque_tid();
  const int wid = tid >> 6, lane = tid & 63, fr = lane & 15, fq = lane >> 4;
  const int gw = blockIdx.x * 4 + wid, GW = gridDim.x * 4;
  float* lv = (float*)(g_smem + wid * 4096);
  int* li = (int*)(g_smem + wid * 4096 + 2048);
  const u16* PQ = (const u16*)(ws + O_PQ);
  int ca[4], cb[4];
  bool cvld[4];
#pragma unroll
  for (int c = 0; c < 4; ++c) { int code = kCand[c * 16 + fr]; cvld[c] = code != 0xff; ca[c] = (code >> 4) & 15; cb[c] = code & 15; }
  for (int it = gw; it < 512 * 8; it += GW) {
    const int h = it >> 9, tg = it & 511;
    const u16* SK = (const u16*)(ws + O_SUBK) + ((size_t)(l * 8 + h) * 2) * 128 * 128;
    f32x4 sc[2][8];
#pragma unroll
    for (int z = 0; z < 2; ++z) {
      bf16x8 qf[4];
#pragma unroll
      for (int ks = 0; ks < 4; ++ks) qf[ks] = *(const bf16x8*)(PQ + (size_t)(tg * 16 + fr) * 2048 + (h * 2 + z) * 128 + ks * 32 + fq * 8);
#pragma unroll
      for (int nt = 0; nt < 8; ++nt) {
        sc[z][nt] = f32x4{0.f, 0.f, 0.f, 0.f};
#pragma unroll
        for (int ks = 0; ks < 4; ++ks) {
          bf16x8 kf = *(const bf16x8*)(SK + ((size_t)z * 128 + nt * 16 + fr) * 128 + ks * 32 + fq * 8);
          sc[z][nt] = mfma16(qf[ks], kf, sc[z][nt]);
        }
      }
    }
#pragma unroll
    for (int z = 0; z < 2; ++z) {
#pragma unroll
      for (int j = 0; j < 4; ++j) {
        unsigned key[8];
#pragma unroll
        for (int nt = 0; nt < 8; ++nt) key[nt] = (f2key(sc[z][nt][j]) & ~127u) | (unsigned)(127 - (nt * 16 + fr));
        unsigned tk = 0u;
#pragma unroll 1
        for (int k = 0; k < 16; ++k) {
          unsigned m = key[0];
#pragma unroll
          for (int nt = 1; nt < 8; ++nt) m = max(m, key[nt]);
          unsigned M = row_max16u(m);
#pragma unroll
          for (int nt = 0; nt < 8; ++nt) key[nt] = key[nt] == M ? 0u : key[nt];
          if (fr == k) tk = M;
        }
        lv[((fq * 4 + j) * 2 + z) * 16 + fr] = key2f(tk & ~127u);
        li[((fq * 4 + j) * 2 + z) * 16 + fr] = 127 - (int)(tk & 127u);
      }
    }
    __builtin_amdgcn_s_waitcnt(0xc07f);
    __builtin_amdgcn_wave_barrier();
#pragma unroll 1
    for (int j = 0; j < 4; ++j) {
      const int tl = fq * 4 + j;
      float cand[4];
#pragma unroll
      for (int c = 0; c < 4; ++c) cand[c] = cvld[c] ? lv[(tl * 2 + 0) * 16 + ca[c]] + lv[(tl * 2 + 1) * 16 + cb[c]] : -3e38f;
      unsigned ck[4];
#pragma unroll
      for (int c = 0; c < 4; ++c) ck[c] = cvld[c] ? ((f2key(cand[c]) & ~63u) | (unsigned)(63 - (c * 16 + fr))) : 0u;
      unsigned sk = 0u;
#pragma unroll 1
      for (int k = 0; k < 16; ++k) {
        unsigned m = max(max(ck[0], ck[1]), max(ck[2], ck[3]));
        unsigned M = row_max16u(m);
#pragma unroll
        for (int c = 0; c < 4; ++c) ck[c] = ck[c] == M ? 0u : ck[c];
        if (fr == k) sk = M;
      }
      const float sv = key2f(sk & ~63u);
      const int scode = 63 - (int)(sk & 63u);
      int ab = kCand[scode];
      int e = li[(tl * 2 + 0) * 16 + ((ab >> 4) & 15)] * 128 + li[(tl * 2 + 1) * 16 + (ab & 15)];
      float mx = row_max16(sv);
      float ex = __expf(sv - mx);
      float sum = row_sum16(ex);
      int tok = tg * 16 + tl;
      ((int*)(ws + O_EIDX))[(size_t)tok * 128 + h * 16 + fr] = e;
      ((float*)(ws + O_EGATE))[(size_t)tok * 128 + h * 16 + fr] = ex / sum;
    }
    __builtin_amdgcn_s_waitcnt(0xc07f);
    __builtin_amdgcn_wave_barrier();
  }
}

DI void cvt8(const bf16x8& v, float (&f)[8]) {
  u32x4 u = __builtin_bit_cast(u32x4, v);
#pragma unroll
  for (int q = 0; q < 4; ++q) { f[2 * q] = __uint_as_float(u[q] << 16); f[2 * q + 1] = __uint_as_float(u[q] & 0xffff0000u); }
}
DI void cvt16(const u32x4& q, float (&f)[16]) {
#pragma unroll
  for (int i = 0; i < 4; ++i) {
    f32x2 a = __builtin_amdgcn_cvt_pk_f32_fp8((int)q[i], false), b = __builtin_amdgcn_cvt_pk_f32_fp8((int)q[i], true);
    f[4 * i] = a[0]; f[4 * i + 1] = a[1]; f[4 * i + 2] = b[0]; f[4 * i + 3] = b[1];
  }
}

__device__ void phase_peer_gather(const Params& p, int l, bool dry = false) {
  char* ws = opaque_ptr(p.ws);
  const int tid = opaque_tid();
  const int lane = tid & 63;
  const int gw = blockIdx.x * 4 + (tid >> 6), GW = gridDim.x * 4;
  const unsigned char* U = (const unsigned char*)(ws + O_PEU) + (size_t)l * 16384 * 1024;
  const unsigned char* V = (const unsigned char*)(ws + O_PEV) + (size_t)l * 16384 * 1024;
  const float* SU = (const float*)(ws + O_SCU) + l * 16384;
  const float* SV = (const float*)(ws + O_SCV) + l * 16384;
  float* X = (float*)(ws + O_X);
  float* XW = dry ? (float*)(ws + O_YS) : X;
  u16* HW = dry ? (u16*)(ws + O_MERG) : (u16*)(ws + O_H);
  float* OW = dry ? (float*)(ws + O_PB) : p.out + OUT_Y;
  for (int tok = gw; tok < NT; tok += GW) {
    float hf[16];
    {
      const u16* hr = (const u16*)(ws + O_H) + (size_t)tok * 1024 + lane * 16;
      bf16x8 h0 = *(const bf16x8*)(hr), h1 = *(const bf16x8*)(hr + 8);
      float t0[8], t1[8];
      cvt8(h0, t0); cvt8(h1, t1);
#pragma unroll
      for (int i = 0; i < 8; ++i) { hf[i] = t0[i]; hf[8 + i] = t1[i]; }
    }
    float acc[16];
#pragma unroll
    for (int i = 0; i < 16; ++i) acc[i] = 0.f;
    const int id0 = ((const int*)(ws + O_EIDX))[(size_t)tok * 128 + lane], id1 = ((const int*)(ws + O_EIDX))[(size_t)tok * 128 + 64 + lane];
    const float g0 = ((const float*)(ws + O_EGATE))[(size_t)tok * 128 + lane], g1 = ((const float*)(ws + O_EGATE))[(size_t)tok * 128 + 64 + lane];
#define PG_LOAD(G, ids, gts, su, sv, uq, vq)                                                                      \
  do {                                                                                                            \
    _Pragma("unroll") for (int e = 0; e < 4; ++e) {                                                               \
      int k = (G) * 4 + e;                                                                                        \
      int sel = k & 63;                                                                                           \
      int a_ = __builtin_amdgcn_readlane(id0, sel), b_ = __builtin_amdgcn_readlane(id1, sel);                     \
      float ga_ = __builtin_bit_cast(float, __builtin_amdgcn_readlane(__builtin_bit_cast(int, g0), sel));         \
      float gb_ = __builtin_bit_cast(float, __builtin_amdgcn_readlane(__builtin_bit_cast(int, g1), sel));         \
      ids[e] = (G) < 16 ? a_ : b_;                                                                                 \
      gts[e] = (G) < 16 ? ga_ : gb_;                                                                               \
    }                                                                                                             \
    _Pragma("unroll") for (int e = 0; e < 4; ++e) uq[e] = *(const u32x4*)(U + (size_t)ids[e] * 1024 + lane * 16); \
    _Pragma("unroll") for (int e = 0; e < 4; ++e) vq[e] = *(const u32x4*)(V + (size_t)ids[e] * 1024 + lane * 16); \
    _Pragma("unroll") for (int e = 0; e < 4; ++e) { su[e] = SU[ids[e]]; sv[e] = SV[ids[e]]; }                     \
  } while (0)
#define PG_COMP(gts, su, sv, uq, vq)                                                                              \
  do {                                                                                                            \
    float cf[4];                                                                                                  \
    _Pragma("unroll") for (int e = 0; e < 4; ++e) {                                                               \
      float a[16];                                                                                                \
      cvt16(uq[e], a);                                                                                            \
      float d0 = 0.f, d1 = 0.f;                                                                                   \
      _Pragma("unroll") for (int i = 0; i < 16; i += 2) { d0 += a[i] * hf[i]; d1 += a[i + 1] * hf[i + 1]; }       \
      float d = wave_sum(d0 + d1) * su[e];                                                                        \
      float u3 = 0.7978845608028654f * (d + 0.044715f * d * d * d);                                               \
      float th = 1.f - 2.f / (__expf(2.f * u3) + 1.f);                                                            \
      cf[e] = gts[e] * 0.5f * d * (1.f + th) * sv[e];                                                             \
    }                                                                                                             \
    _Pragma("unroll") for (int e = 0; e < 4; ++e) {                                                               \
      float a[16];                                                                                                \
      cvt16(vq[e], a);                                                                                            \
      _Pragma("unroll") for (int i = 0; i < 16; ++i) acc[i] += cf[e] * a[i];                                      \
    }                                                                                                             \
  } while (0)
    {
      int idA[4], idB[4];
      float gtA[4], gtB[4], suA[4], svA[4], suB[4], svB[4];
      u32x4 uqA[4], vqA[4], uqB[4], vqB[4];
      PG_LOAD(0, idA, gtA, suA, svA, uqA, vqA);
#pragma unroll 1
      for (int g = 0; g < 32; g += 2) {
        PG_LOAD(g + 1, idB, gtB, suB, svB, uqB, vqB);
        PG_COMP(gtA, suA, svA, uqA, vqA);
        if (g + 2 < 32) PG_LOAD(g + 2, idA, gtA, suA, svA, uqA, vqA);
        PG_COMP(gtB, suB, svB, uqB, vqB);
      }
    }
#undef PG_LOAD
#undef PG_COMP
    const float* mod = (const float*)(ws + O_MOD) + ((size_t)l * 3 + tok_cond(tok)) * 6144;
    float x[16];
    const int e0 = lane * 16;
#pragma unroll
    for (int q = 0; q < 4; ++q) {
      f32x4 a = *(const f32x4*)(X + (size_t)tok * 1024 + e0 + q * 4);
      f32x4 ga = *(const f32x4*)(mod + 5 * 1024 + e0 + q * 4);
#pragma unroll
      for (int i = 0; i < 4; ++i) { a[i] += ga[i] * acc[q * 4 + i]; x[q * 4 + i] = a[i]; }
      *(f32x4*)(XW + (size_t)tok * 1024 + e0 + q * 4) = a;
    }
    float ss = 0.f;
#pragma unroll
    for (int i = 0; i < 16; ++i) ss += x[i] * x[i];
    ss = wave_sum(ss);
    const float rstd = rsqrtf(ss * (1.f / 1024.f) + 1e-6f);
    if (l < NL - 1) {
      const float* mod2 = (const float*)(ws + O_MOD) + ((size_t)(l + 1) * 3 + tok_cond(tok)) * 6144;
      const float* g = p.in[9] + (l + 1) * 1024;
      float y[16];
#pragma unroll
      for (int q = 0; q < 4; ++q) {
        f32x4 gg = *(const f32x4*)(g + e0 + q * 4), sh = *(const f32x4*)(mod2 + e0 + q * 4), sc = *(const f32x4*)(mod2 + 1024 + e0 + q * 4);
#pragma unroll
        for (int i = 0; i < 4; ++i) y[q * 4 + i] = x[q * 4 + i] * rstd * gg[i] * (1.f + sc[i]) + sh[i];
      }
      u32x4 o0, o1;
      o0[0] = pack2(y[0], y[1]); o0[1] = pack2(y[2], y[3]); o0[2] = pack2(y[4], y[5]); o0[3] = pack2(y[6], y[7]);
      o1[0] = pack2(y[8], y[9]); o1[1] = pack2(y[10], y[11]); o1[2] = pack2(y[12], y[13]); o1[3] = pack2(y[14], y[15]);
      *(u32x4*)(HW + (size_t)tok * 1024 + e0) = o0;
      *(u32x4*)(HW + (size_t)tok * 1024 + e0 + 8) = o1;
    } else {
      const float* g = p.in[11];
#pragma unroll
      for (int q = 0; q < 4; ++q) {
        f32x4 gg = *(const f32x4*)(g + e0 + q * 4), a;
#pragma unroll
        for (int i = 0; i < 4; ++i) a[i] = x[q * 4 + i] * rstd * gg[i];
        *(f32x4*)(OW + (size_t)tok * 1024 + e0 + q * 4) = a;
      }
    }
  }
}

#define XB_TMO 128
#define XB_XCNT(j) (256 + 64 * (j))
#define XB_XSUB(j) (1280 + 64 * (j))
#define XB_XGEN(j) (2304 + 64 * (j))
#define XB_TOP 3328
#define XB_TOPGEN 3392
#define XCD_BAR_WORDS 3456
#define XB_SPIN_CAP (1u << 18)
DI unsigned xb_ld(unsigned* q) { return __hip_atomic_load(q, __ATOMIC_RELAXED, __HIP_MEMORY_SCOPE_AGENT); }
DI unsigned xb_add(unsigned* q, unsigned v) { return __hip_atomic_fetch_add(q, v, __ATOMIC_RELAXED, __HIP_MEMORY_SCOPE_AGENT); }
DI unsigned xb_xcc_id() { return (unsigned)__builtin_amdgcn_s_getreg((3 << 11) | 20) & 0xFu; }
#define XB_SPIN(cond, bar)                                                                   \
  do {                                                                                       \
    unsigned _sp = 0;                                                                        \
    while (cond) {                                                                           \
      __builtin_amdgcn_s_sleep(1);                                                           \
      if ((++_sp & 255u) == 0u) {                                                            \
        if (xb_ld(&(bar)[XB_TMO])) break;                                                    \
        if (_sp > XB_SPIN_CAP) { atomicAdd(&(bar)[XB_TMO], 1u); break; }                     \
      }                                                                                      \
    }                                                                                        \
  } while (0)
struct XB { unsigned* bar; unsigned x, nloc, nx; };
DI void xcd_barrier(const XB& b) {
  asm volatile("s_waitcnt vmcnt(0)" ::: "memory");
  __syncthreads();
  if (threadIdx.x == 0) {
    unsigned* bar = b.bar;
    __builtin_amdgcn_s_waitcnt(0);
    const unsigned nloc = b.nloc, nx = b.nx;
    const unsigned old = xb_add(&bar[XB_XSUB(b.x)], 1u);
    const unsigned gen = old / nloc;
    if (old + 1u == (gen + 1u) * nloc) {
      __builtin_amdgcn_fence(__ATOMIC_RELEASE, "agent");
      asm volatile("s_waitcnt vmcnt(0)" ::: "memory");
      const unsigned og = xb_add(&bar[XB_TOP], 1u);
      const unsigned tg = og / nx;
      if (og + 1u == (tg + 1u) * nx) xb_add(&bar[XB_TOPGEN], 1u);
      else XB_SPIN(xb_ld(&bar[XB_TOPGEN]) == tg, bar);
      __builtin_amdgcn_fence(__ATOMIC_ACQUIRE, "agent");
      xb_add(&bar[XB_XGEN(b.x)], 1u);
      asm volatile("s_waitcnt vmcnt(0)" ::: "memory");
    } else {
      XB_SPIN(xb_ld(&bar[XB_XGEN(b.x)]) == gen, bar);
      __builtin_amdgcn_fence(__ATOMIC_ACQUIRE, "agent");
      asm volatile("s_waitcnt vmcnt(0)" ::: "memory");
    }
  }
  __syncthreads();
}

__global__ void __launch_bounds__(256, 2) fwd_megakernel(Params p) {
  cg::grid_group grid = cg::this_grid();
  XB xb;
  xb.bar = (unsigned*)(p.ws + O_BAR);
  xb.x = xb_xcc_id();
  if (threadIdx.x == 0) (void)xb_add(&xb.bar[XB_XCNT(xb.x)], 1u);
  phase_prep(p);
  if (p.ws == nullptr) grid.sync();
  {
    unsigned mine = 0u, cnt = 0u, sum = 0u, sp = 0u;
    for (;;) {
      sum = 0u; cnt = 0u; mine = 0u;
#pragma unroll
      for (unsigned j = 0; j < 16; ++j) { const unsigned c = xb_ld(&xb.bar[XB_XCNT(j)]); sum += c; cnt += (c > 0u) ? 1u : 0u; mine = (j == xb.x) ? c : mine; }
      if (sum == gridDim.x) break;
      __builtin_amdgcn_s_sleep(1);
      if (++sp > XB_SPIN_CAP) break;
    }
    xb.nloc = __builtin_amdgcn_readfirstlane(mine > 0u ? mine : 1u);
    xb.nx = __builtin_amdgcn_readfirstlane(cnt > 0u ? cnt : 1u);
  }
  xcd_barrier(xb);
  phase_norm(p, 0, 0);
  xcd_barrier(xb);
  for (int l = 0; l < NL; ++l) {
    phase_gemm_in(p, l);
    xcd_barrier(xb);
    phase_rwkv_prep(p, l);
    xcd_barrier(xb);
    phase_rwkv_lora(p, l);
    xcd_barrier(xb);
    phase_mix(p, l);
    xcd_barrier(xb);
    phase_rwkv_post(p, l);
    xcd_barrier(xb);
    phase_branch(p, l);
    xcd_barrier(xb);
    phase_wo(p, l);
    xcd_barrier(xb);
    phase_norm(p, l, 1);
    xcd_barrier(xb);
    phase_peq(p, l);
    xcd_barrier(xb);
    phase_peer_sel(p, l);
    xcd_barrier(xb);
    phase_peer_gather(p, l);
    if (l + 1 < NL) xcd_barrier(xb);
  }
}

extern "C" void kernel_launch(void* const* d_in, const int* in_sizes, int n_in, void* d_out, int out_size, void* d_ws, size_t ws_size,
                              hipStream_t stream) {
  static int grid_blocks = 0;
  if (!grid_blocks) {
    int dev = 0, cus = 0, per_cu = 0;
    hipGetDevice(&dev);
    hipDeviceGetAttribute(&cus, hipDeviceAttributeMultiprocessorCount, dev);
    hipOccupancyMaxActiveBlocksPerMultiprocessor(&per_cu, fwd_megakernel, 256, 0);
    if (per_cu > 2) per_cu = 2;
    if (per_cu < 1) per_cu = 1;
    grid_blocks = cus * per_cu;
  }
  Params p{};
  for (int i = 0; i < 36; ++i) p.in[i] = (const float*)d_in[i];
  p.out = (float*)d_out;
  p.ws = (char*)d_ws;
  (void)hipMemsetAsync((char*)d_ws + O_BAR, 0, 3456 * 4, stream);
  void* args[] = {&p};
  hipError_t e = hipLaunchCooperativeKernel((void*)fwd_megakernel, dim3(grid_blocks), dim3(256), args, 0, stream);
  if (e != hipSuccess) fprintf(stderr, "cooperative launch failed: %s (grid %d)\n", hipGetErrorString(e), grid_blocks);
}
```

```cpp
#include <hip/hip_runtime.h>
#include <hip/hip_cooperative_groups.h>
#include <cstdio>
namespace cg = cooperative_groups;

#define DI __device__ __forceinline__
typedef unsigned short u16;
using bf16x8 = __attribute__((ext_vector_type(8))) short;
using bf16x4 = __attribute__((ext_vector_type(4))) short;
using f32x4 = __attribute__((ext_vector_type(4))) float;
using u32x2 = __attribute__((ext_vector_type(2))) unsigned;
using u32x4 = __attribute__((ext_vector_type(4))) unsigned;

constexpr int NT = 8192, NCTX = 4096, DM = 1024, INC = 7296, NL = 4;

constexpr size_t AL(size_t x) { return (x + 255) / 256 * 256; }
constexpr size_t O_WIN = 0;
constexpr size_t O_AOUT = O_WIN + AL(4ull * 7296 * 1024 * 2);
constexpr size_t O_RWOUT = O_AOUT + AL(4ull * 1024 * 512 * 2);
constexpr size_t O_NAOUT = O_RWOUT + AL(4ull * 1024 * 512 * 2);
constexpr size_t O_WO = O_NAOUT + AL(4ull * 1024 * 512 * 2);
constexpr size_t O_PEQ = O_WO + AL(4ull * 1024 * 1024 * 2);
constexpr size_t O_SUBK = O_PEQ + AL(4ull * 2048 * 1024 * 2);
constexpr size_t O_W2 = O_SUBK + AL(4ull * 8 * 2 * 128 * 128 * 2);
constexpr size_t O_A2 = O_W2 + AL(8ull * 512 * 64 * 2);
constexpr size_t O_G2 = O_A2 + AL(8ull * 512 * 64 * 2);
constexpr size_t O_PEU = O_G2 + AL(4ull * 512 * 128 * 2);
constexpr size_t O_PEV = O_PEU + AL(4ull * 16384 * 1024 * 2);
constexpr size_t O_CAK = O_PEV + AL(4ull * 16384 * 1024 * 2);
constexpr size_t O_CAVT = O_CAK + AL(8ull * 512 * 128 * 2);
constexpr size_t O_CCK = O_CAVT + AL(8ull * 128 * 512 * 2);
constexpr size_t O_CCVT = O_CCK + AL(8ull * 512 * 512 * 2);
constexpr size_t O_MOD = O_CCVT + AL(8ull * 512 * 512 * 2);
constexpr size_t O_ROPE = O_MOD + AL(4ull * 3 * 6144 * 4);
constexpr size_t O_CNT = O_ROPE + AL(64 * 16 * 2 * 4);
constexpr size_t O_X = O_CNT + 256;
constexpr size_t O_H = O_X + AL(8192ull * 1024 * 4);
constexpr size_t O_QA = O_H + AL(8192ull * 1024 * 2);
constexpr size_t O_KA = O_QA + AL(8192ull * 512 * 2);
constexpr size_t O_VAT = O_KA + AL(8192ull * 128 * 2);
constexpr size_t O_QC = O_VAT + AL(8192ull * 128 * 2);
constexpr size_t O_KC = O_QC + AL(8192ull * 512 * 2);
constexpr size_t O_VCT = O_KC + AL(8192ull * 512 * 2);
constexpr size_t O_PB = O_VCT + AL(8192ull * 512 * 2);
constexpr size_t O_GATE = O_PB + AL(8192ull * 1920 * 4);
constexpr size_t O_XRKV = O_GATE + AL(8192ull * 3072 * 2);
constexpr size_t O_KK = O_XRKV + AL(8192ull * 1536 * 4);
constexpr size_t O_TW = O_KK + AL(8192ull * 512 * 4);
constexpr size_t O_AD = O_TW + AL(8192ull * 128 * 2);
constexpr size_t O_SG = O_AD + AL(8192ull * 128 * 2);
constexpr size_t O_DEC = O_SG + AL(8192ull * 128 * 2);
constexpr size_t O_KD = O_DEC + AL(2ull * 8192 * 512 * 4);
constexpr size_t O_KKA = O_KD + AL(2ull * 8192 * 512 * 4);
constexpr size_t O_GG = O_KKA + AL(2ull * 8192 * 512 * 4);
constexpr size_t O_YS = O_GG + AL(8192ull * 512 * 4);
constexpr size_t O_YABC = O_YS + AL(2ull * 8192 * 512 * 4);
constexpr size_t O_MERG = O_YABC + AL(3ull * 8192 * 512 * 2);
constexpr size_t O_PQ = O_MERG + AL(8192ull * 1024 * 2);
constexpr size_t O_EIDX = O_PQ + AL(8192ull * 2048 * 2);
constexpr size_t O_EGATE = O_EIDX + AL(8192ull * 128 * 4);
constexpr size_t O_SCU = O_EGATE + AL(8192ull * 128 * 4);
constexpr size_t O_SCV = O_SCU + AL(4ull * 16384 * 4);
constexpr size_t O_BAR = O_SCV + AL(4ull * 16384 * 4);
constexpr size_t WS_TOTAL = O_BAR + AL(3456 * 4);
static_assert(WS_TOTAL < 1020ull * 1024 * 1024, "workspace too large");

constexpr size_t OUT_Y = 0;
constexpr size_t OUT_AK = 8388608;
constexpr size_t OUT_AV = 10485760;
constexpr size_t OUT_CK = 12582912;
constexpr size_t OUT_CV = 20971520;
constexpr size_t OUT_ST = 29360128;

struct Params {
  const float* in[36];
  float* out;
  char* ws;
};

__shared__ __attribute__((aligned(16))) char g_smem[65536];

DI u16 f2bf(float x) { unsigned u = __float_as_uint(x); u += 0x7fffu + ((u >> 16) & 1u); return (u16)(u >> 16); }
DI float bf2f(u16 h) { return __uint_as_float(((unsigned)h) << 16); }
DI unsigned pack2(float a, float b) { return (unsigned)f2bf(a) | ((unsigned)f2bf(b) << 16); }
DI float sigmoidf_(float x) { return __builtin_amdgcn_rcpf(1.f + __expf(-x)); }
template <int CTRL> DI float dppf(float v) {
  return __builtin_bit_cast(float, __builtin_amdgcn_update_dpp(0, __builtin_bit_cast(int, v), CTRL, 0xf, 0xf, true));
}
template <int CTRL> DI int dppi(int v) { return __builtin_amdgcn_update_dpp(0, v, CTRL, 0xf, 0xf, true); }
DI float row_sum16(float v) { v += dppf<0xB1>(v); v += dppf<0x4E>(v); v += dppf<0x141>(v); v += dppf<0x140>(v); return v; }
DI float row_max16(float v) { v = fmaxf(v, dppf<0xB1>(v)); v = fmaxf(v, dppf<0x4E>(v)); v = fmaxf(v, dppf<0x141>(v)); v = fmaxf(v, dppf<0x140>(v)); return v; }
DI int row_max16i(int v) { v = max(v, dppi<0xB1>(v)); v = max(v, dppi<0x4E>(v)); v = max(v, dppi<0x141>(v)); v = max(v, dppi<0x140>(v)); return v; }
DI float wave_sum(float v) { v = row_sum16(v); v += __shfl_xor(v, 16); v += __shfl_xor(v, 32); return v; }

DI int opaque_tid() { int t = threadIdx.x; asm volatile("" : "+v"(t)); return t; }
DI char* opaque_ptr(char* q) { size_t z = 0; asm volatile("" : "+s"(z)); return q + z; }
DI f32x4 mfma16(bf16x8 a, bf16x8 b, f32x4 c) { return __builtin_amdgcn_mfma_f32_16x16x32_bf16(a, b, c, 0, 0, 0); }

DI int lds_byte(int r, int c) {
  int st = (r >> 4) * 2 + (c >> 5), rr = r & 15, cc = c & 31, ob = rr * 64 + cc * 2;
  return st * 1024 + (ob ^ (((ob >> 9) & 1) << 5));
}
DI void stage_rc(int b, int& R, int& C) {
  int st = b >> 10, sb = b & 1023, swz = sb ^ (((sb >> 9) & 1) << 5);
  R = (st >> 1) * 16 + (swz >> 6);
  C = (st & 1) * 32 + ((swz & 63) >> 1);
}
DI void gemm_main(int tid, const u16* __restrict__ g0, int ld0, const u16* __restrict__ g1, int ld1, int K, f32x4 (&acc)[4][4], int koff = 0) {
  const int wid = tid >> 6, lane = tid & 63, wr = wid >> 1, wc = wid & 1, fr = lane & 15, fq = lane >> 4;
  const int nk = K >> 6;
  int R0, C0;
  stage_rc(tid * 16, R0, C0);
  const unsigned v0 = (unsigned)(R0 * ld0 + C0), v1 = (unsigned)(R0 * ld1 + C0);
  const int fa0 = lds_byte(wr * 64 + fr, fq * 8), fa1 = 16384 + lds_byte(wc * 64 + fr, fq * 8);
  const int sb = tid * 16;
#define GSTAGE(kt, buf)                                                                                          \
  do {                                                                                                           \
    _Pragma("unroll") for (int i = 0; i < 4; ++i) {                                                              \
      const u16* u0 = g0 + (size_t)(kt) * 64 + (size_t)i * 32 * ld0;                                             \
      const u16* u1 = g1 + (size_t)(kt) * 64 + (size_t)i * 32 * ld1;                                             \
      __builtin_amdgcn_global_load_lds((const unsigned*)(u0 + v0), (unsigned*)(g_smem + (buf) + i * 4096 + sb), 16, 0, 0);          \
      __builtin_amdgcn_global_load_lds((const unsigned*)(u1 + v1), (unsigned*)(g_smem + (buf) + 16384 + i * 4096 + sb), 16, 0, 0);  \
    }                                                                                                            \
  } while (0)
  int kt = koff;
  GSTAGE(kt, 0);
  for (int t = 0; t < nk; ++t) {
    asm volatile("s_waitcnt vmcnt(0)" ::: "memory");
    __syncthreads();
    const int cur = (t & 1) * 32768;
    kt = kt + 1 == nk ? 0 : kt + 1;
    if (t + 1 < nk) GSTAGE(kt, 32768 - cur);
#pragma unroll
    for (int ks = 0; ks < 2; ++ks) {
      bf16x8 f0[4], f1[4];
#pragma unroll
      for (int m = 0; m < 4; ++m) f0[m] = *(const bf16x8*)(g_smem + cur + fa0 + m * 2048 + ks * 1024);
#pragma unroll
      for (int n = 0; n < 4; ++n) f1[n] = *(const bf16x8*)(g_smem + cur + fa1 + n * 2048 + ks * 1024);
#pragma unroll
      for (int m = 0; m < 4; ++m)
#pragma unroll
        for (int n = 0; n < 4; ++n) acc[m][n] = mfma16(f1[n], f0[m], acc[m][n]);
    }
  }
#undef GSTAGE
  __syncthreads();
}
DI void zero_acc(f32x4 (&acc)[4][4]) {
#pragma unroll
  for (int m = 0; m < 4; ++m)
#pragma unroll
    for (int n = 0; n < 4; ++n) acc[m][n] = f32x4{0.f, 0.f, 0.f, 0.f};
}

struct TJob { const float* src; u16* dst; int K, N, nb; };

DI void transpose_tile(int tid, const float* __restrict__ src, u16* __restrict__ dst, int K, int N, int k0, int n0) {
  float* tile = (float*)g_smem;
  {
    const int tr = tid >> 4, tc = tid & 15;
#pragma unroll
    for (int p = 0; p < 4; ++p) {
      int r = tr + 16 * p;
      f32x4 v = *(const f32x4*)(src + (size_t)(k0 + r) * N + n0 + tc * 4);
      tile[r * 65 + tc * 4 + 0] = v[0]; tile[r * 65 + tc * 4 + 1] = v[1];
      tile[r * 65 + tc * 4 + 2] = v[2]; tile[r * 65 + tc * 4 + 3] = v[3];
    }
  }
  __syncthreads();
  {
    const int tn = tid >> 3, tk = tid & 7;
#pragma unroll
    for (int p = 0; p < 2; ++p) {
      int n = tn + 32 * p;
      u32x4 o;
#pragma unroll
      for (int q = 0; q < 4; ++q) o[q] = pack2(tile[(tk * 8 + 2 * q) * 65 + n], tile[(tk * 8 + 2 * q + 1) * 65 + n]);
      *(u32x4*)(dst + (size_t)(n0 + n) * K + k0 + tk * 8) = o;
    }
  }
  __syncthreads();
}

DI void convert_chunks(int tid, const float* __restrict__ src, u16* __restrict__ dst, size_t n) {
  const size_t nch = n / 8192;
  for (size_t c = blockIdx.x; c < nch; c += gridDim.x) {
    size_t e = c * 8192 + tid * 8;
    f32x4 a[4], b[4];
#pragma unroll
    for (int q = 0; q < 4; ++q) { a[q] = __builtin_nontemporal_load((const f32x4*)(src + e + q * 2048)); b[q] = __builtin_nontemporal_load((const f32x4*)(src + e + q * 2048 + 4)); }
#pragma unroll
    for (int q = 0; q < 4; ++q) {
      u32x4 o;
      o[0] = pack2(a[q][0], a[q][1]); o[1] = pack2(a[q][2], a[q][3]); o[2] = pack2(b[q][0], b[q][1]); o[3] = pack2(b[q][2], b[q][3]);
      *(u32x4*)(dst + e + q * 2048) = o;
    }
  }
}

typedef float f32x2 __attribute__((ext_vector_type(2)));
DI void convert_rows_fp8(int tid, const float* __restrict__ src, unsigned char* __restrict__ dst, float* __restrict__ inv_scale, int nrows) {
  const int lane = tid & 63;
  const int gw = blockIdx.x * 4 + (tid >> 6), GW = gridDim.x * 4;
  for (int r0 = gw; r0 < nrows; r0 += 2 * GW) {
    int rws[2] = {r0, r0 + GW < nrows ? r0 + GW : r0};
    f32x4 v[2][4];
#pragma unroll
    for (int u = 0; u < 2; ++u)
#pragma unroll
      for (int q = 0; q < 4; ++q) v[u][q] = __builtin_nontemporal_load((const f32x4*)(src + (size_t)rws[u] * 1024 + lane * 16 + q * 4));
#pragma unroll
    for (int u = 0; u < 2; ++u) {
      float am = 0.f;
#pragma unroll
      for (int q = 0; q < 4; ++q)
#pragma unroll
        for (int j = 0; j < 4; ++j) am = fmaxf(am, fabsf(v[u][q][j]));
      am = row_max16(am);
      am = fmaxf(am, __shfl_xor(am, 16));
      am = fmaxf(am, __shfl_xor(am, 32));
      int ex = (int)((__float_as_uint(am) >> 23) & 0xff) - 127;
      int k = am > 0.f ? 7 - ex : 0;
      k = min(max(k, -100), 100);
      float sc = __uint_as_float((unsigned)(127 + k) << 23), isc = __uint_as_float((unsigned)(127 - k) << 23);
      u32x4 o;
#pragma unroll
      for (int q = 0; q < 4; ++q) {
        int w = __builtin_amdgcn_cvt_pk_fp8_f32(v[u][q][0] * sc, v[u][q][1] * sc, 0, false);
        w = __builtin_amdgcn_cvt_pk_fp8_f32(v[u][q][2] * sc, v[u][q][3] * sc, w, true);
        o[q] = (unsigned)w;
      }
      *(u32x4*)(dst + (size_t)rws[u] * 1024 + lane * 16) = o;
      if (lane == 0) inv_scale[rws[u]] = isc;
    }
  }
}

DI void convert_rows_fp8_wave(int lane, const float* __restrict__ src, unsigned char* __restrict__ dst, float* __restrict__ inv_scale, int r0, int r1) {
  for (int r = r0; r < r1; r += 2) {
    f32x4 v[2][4];
#pragma unroll
    for (int u = 0; u < 2; ++u)
#pragma unroll
      for (int q = 0; q < 4; ++q) v[u][q] = __builtin_nontemporal_load((const f32x4*)(src + (size_t)(r + u) * 1024 + lane * 16 + q * 4));
#pragma unroll
    for (int u = 0; u < 2; ++u) {
      float am = 0.f;
#pragma unroll
      for (int q = 0; q < 4; ++q)
#pragma unroll
        for (int j = 0; j < 4; ++j) am = fmaxf(am, fabsf(v[u][q][j]));
      am = row_max16(am);
      am = fmaxf(am, __shfl_xor(am, 16));
      am = fmaxf(am, __shfl_xor(am, 32));
      int ex = (int)((__float_as_uint(am) >> 23) & 0xff) - 127;
      int k = am > 0.f ? 7 - ex : 0;
      k = min(max(k, -100), 100);
      float sc = __uint_as_float((unsigned)(127 + k) << 23), isc = __uint_as_float((unsigned)(127 - k) << 23);
      u32x4 o;
#pragma unroll
      for (int q = 0; q < 4; ++q) {
        int w = __builtin_amdgcn_cvt_pk_fp8_f32(v[u][q][0] * sc, v[u][q][1] * sc, 0, false);
        w = __builtin_amdgcn_cvt_pk_fp8_f32(v[u][q][2] * sc, v[u][q][3] * sc, w, true);
        o[q] = (unsigned)w;
      }
      *(u32x4*)(dst + (size_t)(r + u) * 1024 + lane * 16) = o;
      if (lane == 0) inv_scale[r + u] = isc;
    }
  }
}

__device__ void phase_prep(const Params& p) {
  char* ws = opaque_ptr(p.ws);
  const int tid = opaque_tid(), wid = tid >> 6, lane = tid & 63;
  if (blockIdx.x == 0 && tid < 64) ((int*)(ws + O_CNT))[tid] = 0;
  if (blockIdx.x < 4) {
    int e = blockIdx.x * 256 + tid;
    int pos = e >> 4, f = e & 15;
    const float fr4[4] = {1.0f, 0.56234132519f, 0.316227766017f, 0.177827941004f};
    float sc = (f >> 2) == 0 ? 1.0f : (f >> 2) == 1 ? 0.1f : (f >> 2) == 2 ? 0.01f : 0.001f;
    float fsel = (f & 3) == 0 ? fr4[0] : (f & 3) == 1 ? fr4[1] : (f & 3) == 2 ? fr4[2] : fr4[3];
    float freq = fsel * sc;
    float ang = (float)pos * freq;
    double a = (double)ang;
    double k = rint(a * 0.15915494309189535);
    double r = a - k * 6.283185307179586;
    double r2 = r * r, ts = r, tc = 1.0, s = r, c = 1.0;
    for (int i = 1; i <= 14; ++i) {
      tc = -tc * r2 / (double)((2 * i - 1) * (2 * i));
      ts = -ts * r2 / (double)((2 * i) * (2 * i + 1));
      c += tc; s += ts;
    }
    float* rope = (float*)(ws + O_ROPE);
    rope[e * 2] = (float)c; rope[e * 2 + 1] = (float)s;
  }
  {
    float* sil = (float*)g_smem;
    float* part = (float*)(g_smem + 16384);
    const float* cvec = p.in[7];
    const float* cctx = p.in[8];
    bool have_sil = false;
    for (int it = blockIdx.x; it < 4 * 96; it += gridDim.x) {
      if (!have_sil) {
        for (int k = tid; k < 1024; k += 256) {
          float a = cctx[k], b = cvec[k], c2 = cvec[1024 + k];
          sil[k] = a * sigmoidf_(a); sil[1024 + k] = b * sigmoidf_(b); sil[2048 + k] = c2 * sigmoidf_(c2);
        }
        have_sil = true;
        __syncthreads();
      }
      int l = it / 96, n = (it % 96) * 64 + lane;
      const float* W = p.in[12] + (size_t)l * 1024 * 6144 + n;
      float a0 = 0.f, a1 = 0.f, a2 = 0.f;
      int kb = wid * 256;
#pragma unroll 8
      for (int k = 0; k < 256; ++k) {
        float w = W[(size_t)(kb + k) * 6144];
        a0 += w * sil[kb + k]; a1 += w * sil[1024 + kb + k]; a2 += w * sil[2048 + kb + k];
      }
      part[(wid * 3 + 0) * 64 + lane] = a0; part[(wid * 3 + 1) * 64 + lane] = a1; part[(wid * 3 + 2) * 64 + lane] = a2;
      __syncthreads();
      if (tid < 192) {
        int c = tid >> 6, ln = tid & 63;
        float s = part[(0 * 3 + c) * 64 + ln] + part[(1 * 3 + c) * 64 + ln] + part[(2 * 3 + c) * 64 + ln] + part[(3 * 3 + c) * 64 + ln];
        int nn = (it % 96) * 64 + ln;
        ((float*)(ws + O_MOD))[((size_t)l * 3 + c) * 6144 + nn] = s + p.in[13][(size_t)l * 6144 + nn];
      }
      __syncthreads();
    }
    __syncthreads();
  }
  {
    TJob jobs[11] = {
        {p.in[14], (u16*)(ws + O_WIN), 1024, 7296, 4},
        {p.in[16], (u16*)(ws + O_AOUT), 512, 1024, 4},
        {p.in[28], (u16*)(ws + O_RWOUT), 512, 1024, 4},
        {p.in[30], (u16*)(ws + O_NAOUT), 512, 1024, 4},
        {p.in[31], (u16*)(ws + O_WO), 1024, 1024, 4},
        {p.in[32], (u16*)(ws + O_PEQ), 1024, 2048, 4},
        {p.in[19], (u16*)(ws + O_W2), 64, 512, 8},
        {p.in[21], (u16*)(ws + O_A2), 64, 512, 8},
        {p.in[22], (u16*)(ws + O_G2), 128, 512, 4},
        {p.in[3], (u16*)(ws + O_CAVT), 512, 128, 8},
        {p.in[5], (u16*)(ws + O_CCVT), 512, 512, 8},
    };
#pragma unroll
    for (int j = 0; j < 11; ++j) {
      const int tk = jobs[j].K / 64, tn = jobs[j].N / 64, per = tk * tn, tot = per * jobs[j].nb;
      for (int t = blockIdx.x; t < tot; t += gridDim.x) {
        int b = t / per, r = t % per;
        int kt = r / tn, ntile = r % tn;
        size_t off = (size_t)b * jobs[j].K * jobs[j].N;
        transpose_tile(tid, jobs[j].src + off, jobs[j].dst + off, jobs[j].K, jobs[j].N, kt * 64, ntile * 64);
      }
    }
  }
  convert_chunks(tid, p.in[33], (u16*)(ws + O_SUBK), 4ull * 8 * 2 * 128 * 128);
  convert_chunks(tid, p.in[2], (u16*)(ws + O_CAK), 8ull * 512 * 128);
  convert_chunks(tid, p.in[4], (u16*)(ws + O_CCK), 8ull * 512 * 512);
  {
    float* X = (float*)(ws + O_X);
    const size_t nch = (size_t)NT * DM / 1024;
    for (size_t c = blockIdx.x; c < nch; c += gridDim.x) {
      size_t e = c * 1024 + tid * 4;
      const float* src = e < (size_t)NCTX * DM ? p.in[0] + e : p.in[1] + (e - (size_t)NCTX * DM);
      *(f32x4*)(X + e) = *(const f32x4*)src;
    }
  }
}

DI int tok_cond(int tok) { return tok < NCTX ? 0 : 1 + ((tok - NCTX) >> 11); }

DI void norm_row_store(const float (&x)[16], const float* __restrict__ g, const float* __restrict__ shift, const float* __restrict__ scale,
                       u16* __restrict__ hrow, int lane) {
  float ss = 0.f;
#pragma unroll
  for (int i = 0; i < 16; ++i) ss += x[i] * x[i];
  ss = wave_sum(ss);
  float rstd = rsqrtf(ss * (1.f / 1024.f) + 1e-6f);
#pragma unroll
  for (int hh = 0; hh < 2; ++hh) {
    int e0 = hh * 512 + lane * 8;
    float y[8];
#pragma unroll
    for (int i = 0; i < 8; ++i) {
      float v = x[hh * 8 + i] * rstd * g[e0 + i];
      y[i] = v * (1.f + scale[e0 + i]) + shift[e0 + i];
    }
    u32x4 o;
    o[0] = pack2(y[0], y[1]); o[1] = pack2(y[2], y[3]); o[2] = pack2(y[4], y[5]); o[3] = pack2(y[6], y[7]);
    *(u32x4*)(hrow + e0) = o;
  }
}

__device__ void phase_norm(const Params& p, int l, int which) {
  char* ws = opaque_ptr(p.ws);
  const int tid = opaque_tid();
  const int lane = tid & 63;
  const int gw = blockIdx.x * 4 + (tid >> 6), GW = gridDim.x * 4;
  const float* X = (const float*)(ws + O_X);
  const float* g = (which == 0 ? p.in[9] : p.in[10]) + l * 1024;
  for (int tok = gw; tok < NT; tok += GW) {
    const float* mod = (const float*)(ws + O_MOD) + ((size_t)l * 3 + tok_cond(tok)) * 6144 + which * 3 * 1024;
    float x[16];
#pragma unroll
    for (int hh = 0; hh < 2; ++hh) {
      f32x4 a = *(const f32x4*)(X + (size_t)tok * 1024 + hh * 512 + lane * 8);
      f32x4 b = *(const f32x4*)(X + (size_t)tok * 1024 + hh * 512 + lane * 8 + 4);
#pragma unroll
      for (int i = 0; i < 4; ++i) { x[hh * 8 + i] = a[i]; x[hh * 8 + 4 + i] = b[i]; }
    }
    norm_row_store(x, g, mod, mod + 1024, (u16*)(ws + O_H) + (size_t)tok * 1024, lane);
  }
}

__device__ void phase_gemm_in(const Params& p, int l) {
  char* ws = opaque_ptr(p.ws);
  const int tid = opaque_tid();
  const int wid = tid >> 6, lane = tid & 63, wr = wid >> 1, wc = wid & 1, fr = lane & 15, fq = lane >> 4;
  const u16* H = (const u16*)(ws + O_H);
  const u16* W = (const u16*)(ws + O_WIN) + (size_t)l * INC * 1024;
  const float* rope = (const float*)(ws + O_ROPE);
  float* out = p.out;
  for (int t = blockIdx.x; t < 64 * 57; t += gridDim.x) {
    const int tm = t & 63, tn = t >> 6;
    const int brow = tm * 128, bcol = tn * 128;
    const bool swapped = (tn == 5) || (tn >= 29 && tn < 33);
    const bool ctx = brow < NCTX;
    f32x4 acc[4][4];
    zero_acc(acc);
    const int koff = (((tm >> 3) + (tn & 7)) * 2) & 15;
    if (!swapped) gemm_main(tid, H + (size_t)brow * 1024, 1024, W + (size_t)bcol * 1024, 1024, 1024, acc, koff);
    else gemm_main(tid, W + (size_t)bcol * 1024, 1024, H + (size_t)brow * 1024, 1024, 1024, acc, koff);
    if (!swapped) {
#pragma unroll
      for (int m = 0; m < 4; ++m) {
        const int tok = brow + wr * 64 + m * 16 + fr;
        const int cb = bcol + wc * 64 + fq * 4;
        if (tn < 5) {
          if (!ctx) {
            int tt = (tok - NCTX) & 2047;
            int pos0 = tt >> 6, pos1 = tt & 63;
#pragma unroll
            for (int ax = 0; ax < 2; ++ax) {
              int pos = ax == 0 ? pos0 : pos1;
#pragma unroll
              for (int j = 0; j < 4; ++j) {
                float c = rope[(pos * 16 + fq * 4 + j) * 2], s = rope[(pos * 16 + fq * 4 + j) * 2 + 1];
                float x1 = acc[m][2 * ax][j], x2 = acc[m][2 * ax + 1][j];
                acc[m][2 * ax][j] = x1 * c - x2 * s;
                acc[m][2 * ax + 1][j] = x2 * c + x1 * s;
              }
            }
          }
          if (tn < 4) {
#pragma unroll
            for (int n = 0; n < 4; ++n) {
              u32x2 o; o[0] = pack2(acc[m][n][0] * 0.125f, acc[m][n][1] * 0.125f); o[1] = pack2(acc[m][n][2] * 0.125f, acc[m][n][3] * 0.125f);
              *(u32x2*)((u16*)(ws + O_QA) + (size_t)tok * 512 + cb + n * 16) = o;
            }
          } else {
#pragma unroll
            for (int n = 0; n < 4; ++n) {
              int c = cb + n * 16 - 512;
              u32x2 o; o[0] = pack2(acc[m][n][0], acc[m][n][1]); o[1] = pack2(acc[m][n][2], acc[m][n][3]);
              *(u32x2*)((u16*)(ws + O_KA) + (size_t)tok * 128 + c) = o;
              if (ctx) *(f32x4*)(out + OUT_AK + ((size_t)((tok >> 8) * 4 + l) * 256 + (tok & 255)) * 128 + c) = acc[m][n];
            }
          }
        } else if (tn < 21) {
#pragma unroll
          for (int n = 0; n < 4; ++n) *(f32x4*)((float*)(ws + O_PB) + (size_t)tok * 1920 + cb + n * 16 - 768) = acc[m][n];
        } else if (tn < 25) {
#pragma unroll
          for (int n = 0; n < 4; ++n) {
            u32x2 o; o[0] = pack2(acc[m][n][0] * 0.125f, acc[m][n][1] * 0.125f); o[1] = pack2(acc[m][n][2] * 0.125f, acc[m][n][3] * 0.125f);
            *(u32x2*)((u16*)(ws + O_QC) + (size_t)tok * 512 + cb + n * 16 - 2688) = o;
          }
        } else if (tn < 29) {
#pragma unroll
          for (int n = 0; n < 4; ++n) {
            int c = cb + n * 16 - 3200;
            u32x2 o; o[0] = pack2(acc[m][n][0], acc[m][n][1]); o[1] = pack2(acc[m][n][2], acc[m][n][3]);
            *(u32x2*)((u16*)(ws + O_KC) + (size_t)tok * 512 + c) = o;
            if (ctx) *(f32x4*)(out + OUT_CK + ((size_t)((tok >> 8) * 4 + l) * 256 + (tok & 255)) * 512 + c) = acc[m][n];
          }
        } else {
#pragma unroll
          for (int n = 0; n < 4; ++n) {
            u32x2 o; o[0] = pack2(sigmoidf_(acc[m][n][0]), sigmoidf_(acc[m][n][1])); o[1] = pack2(sigmoidf_(acc[m][n][2]), sigmoidf_(acc[m][n][3]));
            *(u32x2*)((u16*)(ws + O_GATE) + (size_t)tok * 3072 + cb + n * 16 - 4224) = o;
          }
        }
      }
    } else {
      const bool isA = (tn == 5);
      u16* VT = isA ? (u16*)(ws + O_VAT) : (u16*)(ws + O_VCT);
      const int ncols = isA ? 128 : 512;
      const size_t obase = isA ? OUT_AV : OUT_CV;
#pragma unroll
      for (int m = 0; m < 4; ++m) {
        const int c = (isA ? 0 : (tn - 29) * 128) + wr * 64 + m * 16 + fr;
#pragma unroll
        for (int n = 0; n < 4; ++n) {
          const int tk = brow + wc * 64 + n * 16 + fq * 4;
          u32x2 o; o[0] = pack2(acc[m][n][0], acc[m][n][1]); o[1] = pack2(acc[m][n][2], acc[m][n][3]);
          *(u32x2*)(VT + (size_t)c * NT + tk) = o;
          if (ctx) {
#pragma unroll
            for (int j = 0; j < 4; ++j) {
              int tok = tk + j;
              out[obase + ((size_t)((tok >> 8) * 4 + l) * 256 + (tok & 255)) * ncols + c] = acc[m][n][j];
            }
          }
        }
      }
    }
  }
}

__device__ void phase_rwkv_prep(const Params& p, int l) {
  char* ws = opaque_ptr(p.ws);
  const int tid = opaque_tid();
  const int lane = tid & 63;
  const int gw = blockIdx.x * 4 + (tid >> 6), GW = gridDim.x * 4;
  const float* PB = (const float*)(ws + O_PB);
  const float* mu = p.in[17] + l * 1920;
  const float* kkw = p.in[23] + l * 512;
  for (int tok = gw; tok < NT; tok += GW) {
    int pos, len;
    if (tok < NCTX) { pos = tok & 255; len = 256; } else { pos = (tok - NCTX) & 2047; len = 2048; }
    const bool hp = pos > 0, hn = pos < len - 1;
    const float* row = PB + (size_t)tok * 1920;
#pragma unroll
    for (int i = 0; i < 8; ++i) {
      int q = lane + 64 * i;
      if (q < 480) {
        int c = q * 4;
        f32x4 cur = *(const f32x4*)(row + c);
        f32x4 pv = hp ? *(const f32x4*)(row - 1920 + c) : f32x4{0.f, 0.f, 0.f, 0.f};
        f32x4 nv = hn ? *(const f32x4*)(row + 1920 + c) : f32x4{0.f, 0.f, 0.f, 0.f};
        f32x4 m4 = *(const f32x4*)(mu + c);
        f32x4 xb;
#pragma unroll
        for (int j = 0; j < 4; ++j) xb[j] = cur[j] + m4[j] * (0.5f * (pv[j] + nv[j]) - cur[j]);
        if (i < 6) {
          *(f32x4*)((float*)(ws + O_XRKV) + (size_t)tok * 1536 + c) = xb;
          if (i == 2 || i == 3) {
            int ck = c - 512;
            f32x4 kw = *(const f32x4*)(kkw + ck);
            f32x4 kv;
            float ss = 0.f;
#pragma unroll
            for (int j = 0; j < 4; ++j) { kv[j] = xb[j] * kw[j]; ss += kv[j] * kv[j]; }
            ss = row_sum16(ss);
            float rn = rsqrtf(ss + 1e-12f);
#pragma unroll
            for (int j = 0; j < 4; ++j) kv[j] *= rn;
            *(f32x4*)((float*)(ws + O_KK) + (size_t)tok * 512 + ck) = kv;
          }
        } else {
          u16* dst;
          int cc;
          float v[4];
          if (c < 1664) { dst = (u16*)(ws + O_TW); cc = c - 1536; for (int j = 0; j < 4; ++j) v[j] = tanhf(xb[j]); }
          else if (c < 1792) { dst = (u16*)(ws + O_AD); cc = c - 1664; for (int j = 0; j < 4; ++j) v[j] = xb[j]; }
          else { dst = (u16*)(ws + O_SG); cc = c - 1792; for (int j = 0; j < 4; ++j) v[j] = sigmoidf_(xb[j]); }
          u32x2 o; o[0] = pack2(v[0], v[1]); o[1] = pack2(v[2], v[3]);
          *(u32x2*)(dst + (size_t)tok * 128 + cc) = o;
        }
      }
    }
  }
}

__device__ void phase_rwkv_lora(const Params& p, int l) {
  char* ws = opaque_ptr(p.ws);
  const int tid = opaque_tid();
  const int wid = tid >> 6, lane = tid & 63, wr = wid >> 1, wc = wid & 1, fr = lane & 15, fq = lane >> 4;
  for (int t = blockIdx.x; t < 5 * 256; t += gridDim.x) {
    const int job = t >> 8, r = t & 255, tm = r & 63, tn = r >> 6;
    const int brow = tm * 128, bcol = tn * 128;
    f32x4 acc[4][4];
    zero_acc(acc);
    const int z = job & 1;
    if (job < 2) gemm_main(tid, (const u16*)(ws + O_TW) + (size_t)brow * 128 + z * 64, 128, (const u16*)(ws + O_W2) + ((size_t)(l * 2 + z) * 512 + bcol) * 64, 64, 64, acc);
    else if (job < 4) gemm_main(tid, (const u16*)(ws + O_AD) + (size_t)brow * 128 + z * 64, 128, (const u16*)(ws + O_A2) + ((size_t)(l * 2 + z) * 512 + bcol) * 64, 64, 64, acc);
    else gemm_main(tid, (const u16*)(ws + O_SG) + (size_t)brow * 128, 128, (const u16*)(ws + O_G2) + ((size_t)l * 512 + bcol) * 128, 128, 128, acc);
#pragma unroll
    for (int m = 0; m < 4; ++m) {
      const int tok = brow + wr * 64 + m * 16 + fr;
#pragma unroll
      for (int n = 0; n < 4; ++n) {
        const int c = bcol + wc * 64 + n * 16 + fq * 4;
        if (job < 2) {
          f32x4 w0 = *(const f32x4*)(p.in[18] + (size_t)(l * 2 + z) * 512 + c);
          f32x4 o;
#pragma unroll
          for (int j = 0; j < 4; ++j) {
            float val = w0[j] + acc[m][n][j];
            float y = -val;
            float sp = fmaxf(y, 0.f) + __logf(1.f + __expf(-fabsf(y)));
            float wlog = -sp - 0.5f;
            o[j] = __expf(-__expf(wlog));
          }
          *(f32x4*)((float*)(ws + O_DEC) + ((size_t)z * NT + tok) * 512 + c) = o;
        } else if (job < 4) {
          f32x4 a0 = *(const f32x4*)(p.in[20] + (size_t)(l * 2 + z) * 512 + c);
          f32x4 ka = *(const f32x4*)(p.in[24] + (size_t)l * 512 + c);
          f32x4 kx = *(const f32x4*)((const float*)(ws + O_XRKV) + (size_t)tok * 1536 + 512 + c);
          f32x4 kk = *(const f32x4*)((const float*)(ws + O_KK) + (size_t)tok * 512 + c);
          f32x4 okd, okka;
#pragma unroll
          for (int j = 0; j < 4; ++j) {
            float a = sigmoidf_(a0[j] + acc[m][n][j]);
            okd[j] = kx[j] * (1.f + (a - 1.f) * ka[j]);
            okka[j] = kk[j] * a;
          }
          *(f32x4*)((float*)(ws + O_KD) + ((size_t)z * NT + tok) * 512 + c) = okd;
          *(f32x4*)((float*)(ws + O_KKA) + ((size_t)z * NT + tok) * 512 + c) = okka;
        } else {
          *(f32x4*)((float*)(ws + O_GG) + (size_t)tok * 512 + c) = acc[m][n];
        }
      }
    }
  }
}

template <int JPL> struct ScanOps { float w[JPL], kd[JPL], kk[JPL], kka[JPL], r[JPL]; float v; };

template <int JPL>
DI void scan_load(ScanOps<JPL>& o, const float* __restrict__ dec, const float* __restrict__ kd, const float* __restrict__ kk,
                  const float* __restrict__ kka, const float* __restrict__ rr, const float* __restrict__ vv, int tok, int cj, int ci) {
  const size_t e = (size_t)tok * 512 + cj;
#pragma unroll
  for (int q = 0; q < JPL / 4; ++q) {
    f32x4 a = *(const f32x4*)(dec + e + q * 4), b = *(const f32x4*)(kd + e + q * 4), c = *(const f32x4*)(kk + e + q * 4),
          d = *(const f32x4*)(kka + e + q * 4), f = *(const f32x4*)(rr + (size_t)tok * 1536 + cj + q * 4);
#pragma unroll
    for (int j = 0; j < 4; ++j) { o.w[q * 4 + j] = a[j]; o.kd[q * 4 + j] = b[j]; o.kk[q * 4 + j] = c[j]; o.kka[q * 4 + j] = d[j]; o.r[q * 4 + j] = f[j]; }
  }
  o.v = vv[(size_t)tok * 1536 + 1024 + ci];
}

template <int JPL> DI float scan_red(float v) {
  v += dppf<0xB1>(v);
  v += dppf<0x4E>(v);
  if (JPL <= 8) v += dppf<0x141>(v);
  if (JPL <= 4) v += dppf<0x140>(v);
  return v;
}

template <int JPL>
DI void scan_step(float (&S)[JPL], const ScanOps<JPL>& o, float* __restrict__ y, int tok, int ci, bool wr) {
  float sa0 = 0.f, sa1 = 0.f;
#pragma unroll
  for (int j = 0; j < JPL; j += 2) { sa0 += S[j] * o.kk[j]; sa1 += S[j + 1] * o.kk[j + 1]; }
  float sa = -scan_red<JPL>(sa0 + sa1);
  float y0 = 0.f, y1 = 0.f;
#pragma unroll
  for (int j = 0; j < JPL; j += 2) {
    S[j] = S[j] * o.w[j] + (sa * o.kka[j] + o.v * o.kd[j]);
    S[j + 1] = S[j + 1] * o.w[j + 1] + (sa * o.kka[j + 1] + o.v * o.kd[j + 1]);
    y0 += S[j] * o.r[j]; y1 += S[j + 1] * o.r[j + 1];
  }
  float yv = scan_red<JPL>(y0 + y1);
  if (wr) y[(size_t)tok * 512 + ci] = yv;
}

template <int JPL, int D>
DI void scan_wave(char* ws, int lane, int z, int h, int tok0, int T, int rowbase, const float* __restrict__ s0, float* __restrict__ sout) {
  constexpr int LPR = 64 / JPL;
  const int rr = lane / LPR, pp = lane % LPR;
  const int i = rowbase + rr, j0 = pp * JPL;
  const int cj = h * 64 + j0, ci = h * 64 + i;
  const float* dec = (const float*)(ws + O_DEC) + (size_t)z * NT * 512;
  const float* kd = (const float*)(ws + O_KD) + (size_t)z * NT * 512;
  const float* kka = (const float*)(ws + O_KKA) + (size_t)z * NT * 512;
  const float* kk = (const float*)(ws + O_KK);
  const float* xr = (const float*)(ws + O_XRKV);
  float* y = (float*)(ws + O_YS) + (size_t)z * NT * 512;
  float S[JPL];
#pragma unroll
  for (int j = 0; j < JPL; ++j) S[j] = s0 ? s0[i * 64 + j0 + j] : 0.f;
  const int dir = z == 0 ? 1 : -1;
  const int first = z == 0 ? tok0 : tok0 + T - 1;
  const bool wr = pp == 0;
  ScanOps<JPL> R[D];
#pragma unroll
  for (int d = 0; d < D; ++d) scan_load<JPL>(R[d], dec, kd, kk, kka, xr, xr, first + dir * d, cj, ci);
  for (int n = 0; n < T; n += D) {
#pragma unroll
    for (int d = 0; d < D; ++d) {
      scan_step<JPL>(S, R[d], y, first + dir * (n + d), ci, wr);
      int nn = n + d + D;
      nn = nn < T ? nn : T - 1;
      scan_load<JPL>(R[d], dec, kd, kk, kka, xr, xr, first + dir * nn, cj, ci);
    }
  }
  if (sout) {
#pragma unroll
    for (int j = 0; j < JPL; ++j) sout[i * 64 + j0 + j] = S[j];
  }
}

DI void dma16(const char* gptr, unsigned ldsaddr) {
  asm volatile("s_mov_b32 m0, %0\n\ts_nop 0\n\tglobal_load_lds_dwordx4 %1, off" ::"s"(ldsaddr), "v"(gptr) : "memory");
}
template <int N> DI void wait_vm() { asm volatile("s_waitcnt vmcnt(%0)" ::"n"(N) : "memory"); }

template <int JPL> struct ScanRegs { float w[JPL], kd[JPL], kk[JPL], kka[JPL], r[JPL]; float v; };
template <int JPL> DI void scan_lds_read(ScanRegs<JPL>& o, const char* slot, int pp, int rr) {
#pragma unroll
  for (int q = 0; q < JPL / 4; ++q) {
    f32x4 a = *(const f32x4*)(slot + 0 + pp * JPL * 4 + q * 16), b = *(const f32x4*)(slot + 256 + pp * JPL * 4 + q * 16),
          c = *(const f32x4*)(slot + 512 + pp * JPL * 4 + q * 16), d = *(const f32x4*)(slot + 768 + pp * JPL * 4 + q * 16),
          f = *(const f32x4*)(slot + 1024 + pp * JPL * 4 + q * 16);
#pragma unroll
    for (int j = 0; j < 4; ++j) { o.w[q * 4 + j] = a[j]; o.kd[q * 4 + j] = b[j]; o.kk[q * 4 + j] = c[j]; o.kka[q * 4 + j] = d[j]; o.r[q * 4 + j] = f[j]; }
  }
  o.v = *(const float*)(slot + 1280 + rr * 4);
}
template <int JPL>
DI void scan_step2(float (&S)[JPL], const ScanRegs<JPL>& o, float* __restrict__ yp, bool wr) {
  float sa0 = 0.f, sa1 = 0.f;
#pragma unroll
  for (int j = 0; j < JPL; j += 2) { sa0 += S[j] * o.kk[j]; sa1 += S[j + 1] * o.kk[j + 1]; }
  float sa = -scan_red<JPL>(sa0 + sa1);
  float y0 = 0.f, y1 = 0.f;
#pragma unroll
  for (int j = 0; j < JPL; j += 2) {
    S[j] = sa * o.kka[j] + (S[j] * o.w[j] + o.v * o.kd[j]);
    S[j + 1] = sa * o.kka[j + 1] + (S[j + 1] * o.w[j + 1] + o.v * o.kd[j + 1]);
    y0 += S[j] * o.r[j]; y1 += S[j + 1] * o.r[j + 1];
  }
  float yv = scan_red<JPL>(y0 + y1);
  if (wr) *yp = yv;
}

template <int JPL, int NS>
DI void scan_wave_dma(char* ws, int lane, int ringoff, int z, int h, int tok0, int T, int rowbase, const float* __restrict__ s0,
                      float* __restrict__ sout) {
  constexpr int LPR = 64 / JPL, PD = NS - 1, WN = 3 * PD - 3;
  static_assert(WN <= 63, "vmcnt range");
  const int rr = lane / LPR, pp = lane % LPR;
  const int i = rowbase + rr, j0 = pp * JPL;
  const int dir = z == 0 ? 1 : -1;
  const int first = z == 0 ? tok0 : tok0 + T - 1;
  const bool wr = pp == 0;
  float S[JPL];
#pragma unroll
  for (int j = 0; j < JPL; ++j) S[j] = s0 ? s0[i * 64 + j0 + j] : 0.f;
  const int a = lane >> 4, c16 = lane & 15;
  const float* arr = a == 0 ? (const float*)(ws + O_DEC) + (size_t)z * NT * 512
                   : a == 1 ? (const float*)(ws + O_KD) + (size_t)z * NT * 512
                   : a == 2 ? (const float*)(ws + O_KK)
                            : (const float*)(ws + O_KKA) + (size_t)z * NT * 512;
  const char* gA = (const char*)(arr + (size_t)first * 512 + h * 64 + c16 * 4);
  const char* gB = (const char*)((const float*)(ws + O_XRKV) + (size_t)first * 1536 + (lane < 16 ? h * 64 + c16 * 4 : 1024 + h * 64 + rowbase + (lane - 16) * 4));
  const long stA = (long)dir * 2048, stB = (long)dir * 6144;
  const bool bact = lane < 16 + JPL / 4;
  ringoff = __builtin_amdgcn_readfirstlane(ringoff);
  const unsigned ring = (unsigned)(size_t)g_smem + (unsigned)ringoff;
  const char* ringp = g_smem + ringoff;
  float* yp = (float*)(ws + O_YS) + (size_t)z * NT * 512 + (size_t)first * 512 + h * 64 + i;
  const long sty = (long)dir * 512;
  float* dummy = (float*)(ws + O_MERG) + lane;
#pragma unroll 1
  for (int s = 0; s < PD; ++s) {
    unsigned slot = ring + (unsigned)(s & (NS - 1)) * 1536u;
    dma16(gA, slot);
    if (bact) dma16(gB, slot + 1024u);
    gA += stA; gB += stB;
    if (wr) dummy[s * 64] = 0.f;
  }
  ScanRegs<JPL> A, B;
  wait_vm<3 * PD - 3>();
  wait_vm<3 * (PD - 1)>();
  scan_lds_read<JPL>(A, ringp, pp, rr);
  for (int n = 0; n < T; n += 2) {
    {
      unsigned sl = (unsigned)((n + PD) & (NS - 1)) * 1536u;
      dma16(gA, ring + sl);
      if (bact) dma16(gB, ring + sl + 1024u);
      gA += stA; gB += stB;
      wait_vm<WN>();
      scan_lds_read<JPL>(B, ringp + ((n + 1) & (NS - 1)) * 1536, pp, rr);
      scan_step2<JPL>(S, A, yp, wr);
      yp += sty;
    }
    {
      unsigned sl = (unsigned)((n + 1 + PD) & (NS - 1)) * 1536u;
      dma16(gA, ring + sl);
      if (bact) dma16(gB, ring + sl + 1024u);
      gA += stA; gB += stB;
      wait_vm<WN>();
      scan_lds_read<JPL>(A, ringp + ((n + 2) & (NS - 1)) * 1536, pp, rr);
      scan_step2<JPL>(S, B, yp, wr);
      yp += sty;
    }
  }
  wait_vm<0>();
  if (sout) {
#pragma unroll
    for (int j = 0; j < JPL; ++j) sout[i * 64 + j0 + j] = S[j];
  }
}

template <int JPL>
DI void scan_dots(const float (&S)[JPL], const ScanRegs<JPL>& cur, const ScanRegs<JPL>& prv, float& d1, float& d2) {
  float a0 = 0.f, a1 = 0.f, b0 = 0.f, b1 = 0.f;
#pragma unroll
  for (int j = 0; j < JPL; j += 2) {
    a0 += S[j] * cur.kk[j]; b0 += S[j] * prv.r[j];
    a1 += S[j + 1] * cur.kk[j + 1]; b1 += S[j + 1] * prv.r[j + 1];
  }
  d1 = a0 + a1; d2 = b0 + b1;
}
template <int JPL> DI void scan_red2(float& a, float& b) {
  a += dppf<0xB1>(a); b += dppf<0xB1>(b);
  a += dppf<0x4E>(a); b += dppf<0x4E>(b);
  if (JPL <= 8) { a += dppf<0x141>(a); b += dppf<0x141>(b); }
  if (JPL <= 4) { a += dppf<0x140>(a); b += dppf<0x140>(b); }
}
template <int JPL> DI void scan_pre(float (&Tm)[JPL], const float (&S)[JPL], const ScanRegs<JPL>& o) {
#pragma unroll
  for (int j = 0; j < JPL; ++j) Tm[j] = S[j] * o.w[j] + o.v * o.kd[j];
}
template <int JPL> DI void scan_update(float (&S)[JPL], const float (&Tm)[JPL], const ScanRegs<JPL>& o, float sa) {
#pragma unroll
  for (int j = 0; j < JPL; ++j) S[j] = sa * o.kka[j] + Tm[j];
}

template <int JPL, int T>
DI void scan_latent_block(char* ws, int tid, int z, int h, int tok0, int rowblock, const float* __restrict__ s0, float* __restrict__ sout) {
  constexpr int LPR = 64 / JPL, G = 7, WNV = 6 * G - 2;
  const int wid = __builtin_amdgcn_readfirstlane(tid >> 6), lane = tid & 63;
  const int rr = lane / LPR, pp = lane % LPR;
  const int rloc = wid * JPL + rr;
  const int i = rowblock + rloc, j0 = pp * JPL;
  const int dir = z == 0 ? 1 : -1;
  const int first = z == 0 ? tok0 : tok0 + T - 1;
  const bool wr = pp == 0;
  float S[JPL];
#pragma unroll
  for (int j = 0; j < JPL; ++j) S[j] = s0 ? s0[i * 64 + j0 + j] : 0.f;
  const int a = lane >> 4, c16 = lane & 15;
  const float* arr = a == 0 ? (const float*)(ws + O_DEC) + (size_t)z * NT * 512
                   : a == 1 ? (const float*)(ws + O_KD) + (size_t)z * NT * 512
                   : a == 2 ? (const float*)(ws + O_KK)
                            : (const float*)(ws + O_KKA) + (size_t)z * NT * 512;
  const int fw = first + dir * wid;
  const char* gA = (const char*)(arr + (size_t)fw * 512 + h * 64 + c16 * 4);
  const char* gB = (const char*)((const float*)(ws + O_XRKV) + (size_t)fw * 1536 + (lane < 16 ? h * 64 + c16 * 4 : 1024 + h * 64 + rowblock + (lane - 16) * 4));
  const long stA = (long)dir * 4 * 2048, stB = (long)dir * 4 * 6144;
  const bool bact = lane < 16 + JPL;
  const unsigned ring = (unsigned)(size_t)g_smem;
  const char* ringp = g_smem;
  float* yp = (float*)(ws + O_YS) + (size_t)z * NT * 512 + (size_t)first * 512 + h * 64 + i;
  const long sty = (long)dir * 512;
  float* dummy = (float*)(ws + O_MERG) + tid;
#pragma unroll 1
  for (int g = 0; g < G; ++g) {
    unsigned slot = ring + (unsigned)((4 * g + wid) & 31) * 1536u;
    dma16(gA, slot);
    if (bact) dma16(gB, slot + 1024u);
    gA += stA; gB += stB;
    if (wr) { dummy[(g * 4 + 0) * 256] = 0.f; }
    if (wr) { dummy[(g * 4 + 1) * 256] = 0.f; }
    if (wr) { dummy[(g * 4 + 2) * 256] = 0.f; }
    if (wr) { dummy[(g * 4 + 3) * 256] = 0.f; }
    asm volatile("" ::: "memory");
  }
  ScanRegs<JPL> A, B;
#pragma unroll
  for (int j = 0; j < JPL; ++j) B.r[j] = 0.f;
  float* ypv = dummy + 28 * 256;
  wait_vm<WNV>();
  asm volatile("" ::: "memory");
  __builtin_amdgcn_s_barrier();
  asm volatile("" ::: "memory");
  scan_lds_read<JPL>(A, ringp, pp, rloc);
#pragma unroll 1
  for (int g = 0; g < T / 4; ++g) {
    wait_vm<WNV - 6>();

    asm volatile("" ::: "memory");
    __builtin_amdgcn_s_barrier();
    asm volatile("" ::: "memory");
    {
      unsigned slot = ring + (unsigned)((4 * (g + G) + wid) & 31) * 1536u;
      dma16(gA, slot);
      if (bact) dma16(gB, slot + 1024u);
      gA += stA; gB += stB;
    }
    const char* gp = ringp + ((4 * g) & 31) * 1536;
    if (JPL >= 8) {
#pragma unroll
      for (int k = 0; k < 4; ++k) {
        scan_lds_read<JPL>(A, gp + k * 1536, pp, rloc);
        scan_step2<JPL>(S, A, yp, wr);
        yp += sty;
        asm volatile("" ::: "memory");
      }
      continue;
    }
    float d1, y0, y1, y2, y3;
    float Tm[JPL];
    scan_dots<JPL>(S, A, B, d1, y0);
    scan_pre<JPL>(Tm, S, A);
    scan_lds_read<JPL>(B, gp + 1536, pp, rloc);
    scan_red2<JPL>(d1, y0);
    scan_update<JPL>(S, Tm, A, -d1);
    scan_dots<JPL>(S, B, A, d1, y1);
    scan_pre<JPL>(Tm, S, B);
    scan_lds_read<JPL>(A, gp + 2 * 1536, pp, rloc);
    scan_red2<JPL>(d1, y1);
    scan_update<JPL>(S, Tm, B, -d1);
    scan_dots<JPL>(S, A, B, d1, y2);
    scan_pre<JPL>(Tm, S, A);
    scan_lds_read<JPL>(B, gp + 3 * 1536, pp, rloc);
    scan_red2<JPL>(d1, y2);
    scan_update<JPL>(S, Tm, A, -d1);
    scan_dots<JPL>(S, B, A, d1, y3);
    scan_pre<JPL>(Tm, S, B);
    scan_lds_read<JPL>(A, ringp + ((4 * g + 4) & 31) * 1536, pp, rloc);
    scan_red2<JPL>(d1, y3);
    scan_update<JPL>(S, Tm, B, -d1);
    if (wr) {
      *ypv = y0;
      yp[0] = y1;
      yp[sty] = y2;
      yp[2 * sty] = y3;
    }
    ypv = yp + 3 * sty;
    yp += 4 * sty;
    asm volatile("" ::: "memory");
  }
  {
    float e0 = 0.f, e1 = 0.f;
#pragma unroll
    for (int j = 0; j < JPL; j += 2) { e0 += S[j] * B.r[j]; e1 += S[j + 1] * B.r[j + 1]; }
    float yv = scan_red<JPL>(e0 + e1);
    if (wr) *ypv = yv;
  }
  wait_vm<0>();
  asm volatile("" ::: "memory");
  __builtin_amdgcn_s_barrier();
  asm volatile("" ::: "memory");
  if (sout) {
#pragma unroll
    for (int j = 0; j < JPL; ++j) sout[i * 64 + j0 + j] = S[j];
  }
}

struct AttnSt { float m, l; f32x4 o[4]; };

struct AttnKVF { bf16x8 k[2][2]; bf16x8 v[4]; };
DI void attn_kvload(AttnKVF& f, const u16* __restrict__ kp, int ldk, const u16* __restrict__ vtp, int ldv, int fr, int fq) {
#pragma unroll
  for (int kt = 0; kt < 2; ++kt)
#pragma unroll
    for (int ks = 0; ks < 2; ++ks) f.k[kt][ks] = *(const bf16x8*)(kp + (size_t)(8 * (fr >> 2) + 4 * kt + (fr & 3)) * ldk + ks * 32 + fq * 8);
#pragma unroll
  for (int dt = 0; dt < 4; ++dt) f.v[dt] = *(const bf16x8*)(vtp + (size_t)(dt * 16 + fr) * ldv + fq * 8);
}
template <int MODE>
DI void attn_core(AttnSt& st, const bf16x8 (&qf)[2], const AttnKVF& f, int fr, int fq, int qpos, int kpos0, const float* __restrict__ rpbrow) {
  f32x4 s[2];
#pragma unroll
  for (int kt = 0; kt < 2; ++kt) {
    s[kt] = f32x4{0.f, 0.f, 0.f, 0.f};
#pragma unroll
    for (int ks = 0; ks < 2; ++ks) s[kt] = mfma16(f.k[kt][ks], qf[ks], s[kt]);
  }
  if (MODE != 0) {
#pragma unroll
    for (int kt = 0; kt < 2; ++kt)
#pragma unroll
      for (int j = 0; j < 4; ++j) {
        int kpos = kpos0 + 8 * fq + 4 * kt + j;
        if (MODE == 1) {
          int d = qpos - kpos;
          if (d > 128 || d < -128) s[kt][j] = -1e30f;
        } else {
          int cs = min(max(qpos - 8, 0), 48);
          int dc = min(max(kpos - qpos, -15), 15) + 15;
          float b = rpbrow[dc];
          s[kt][j] = (kpos >= cs && kpos < cs + 16) ? s[kt][j] + b : -1e30f;
        }
      }
  }
  float mx = fmaxf(fmaxf(fmaxf(s[0][0], s[0][1]), fmaxf(s[0][2], s[0][3])), fmaxf(fmaxf(s[1][0], s[1][1]), fmaxf(s[1][2], s[1][3])));
  mx = fmaxf(mx, __shfl_xor(mx, 16));
  mx = fmaxf(mx, __shfl_xor(mx, 32));
  float mn = fmaxf(st.m, mx);
  float alpha = __expf(st.m - mn);
  st.m = mn;
  float ps = 0.f;
  float pv[8];
#pragma unroll
  for (int kt = 0; kt < 2; ++kt)
#pragma unroll
    for (int j = 0; j < 4; ++j) { float e = __expf(s[kt][j] - mn); pv[kt * 4 + j] = e; ps += e; }
  st.l = st.l * alpha + ps;
  u32x4 pk;
  pk[0] = pack2(pv[0], pv[1]); pk[1] = pack2(pv[2], pv[3]); pk[2] = pack2(pv[4], pv[5]); pk[3] = pack2(pv[6], pv[7]);
  bf16x8 pf = __builtin_bit_cast(bf16x8, pk);
#pragma unroll
  for (int dt = 0; dt < 4; ++dt) {
    bf16x8 vf = f.v[dt];
#pragma unroll
    for (int j = 0; j < 4; ++j) st.o[dt][j] *= alpha;
    st.o[dt] = mfma16(vf, pf, st.o[dt]);
  }
}

DI void attn_item(const Params& p, char* ws, int lane, int l, int item) {
  const int fr = lane & 15, fq = lane >> 4;
  const int type = item >> 10, r = item & 1023;
  const int h = r & 7, qp = r >> 3;
  AttnSt st[2];
  const u16* Q;
  u16* Y;
  if (type == 0 || type == 2) { Q = (const u16*)(ws + O_QA); Y = (u16*)(ws + O_YABC); }
  else { Q = (const u16*)(ws + O_QC); Y = (u16*)(ws + O_YABC) + 2ull * NT * 512; }
  const int tok0 = (type < 2 ? NCTX : 0) + qp * 32;
  bf16x8 qf[2][2];
  const bool hasSink = (type == 0 || type == 2);
#pragma unroll
  for (int i = 0; i < 2; ++i) {
#pragma unroll
    for (int dt = 0; dt < 4; ++dt) st[i].o[dt] = f32x4{0.f, 0.f, 0.f, 0.f};
#pragma unroll
    for (int ks = 0; ks < 2; ++ks) qf[i][ks] = *(const bf16x8*)(Q + (size_t)(tok0 + i * 16 + fr) * 512 + h * 64 + ks * 32 + fq * 8);
    if (hasSink) { st[i].m = p.in[15][l * 8 + h]; st[i].l = fq == 0 ? 1.f : 0.f; }
    else { st[i].m = -1e30f; st[i].l = 0.f; }
  }
  AttnKVF f;
  if (type == 0) {
    const int qt = qp * 2;
    const int b = qt >> 7, kv = h >> 2;
    const u16* ck = (const u16*)(ws + O_CAK) + ((size_t)(b * 4 + l) * 512) * 128 + kv * 64;
    const u16* cvt = (const u16*)(ws + O_CAVT) + ((size_t)(b * 4 + l) * 128 + kv * 64) * 512;
    for (int p0 = 0; p0 < 512; p0 += 32) {
      attn_kvload(f, ck + (size_t)p0 * 128, 128, cvt + p0, 512, fr, fq);
      attn_core<0>(st[0], qf[0], f, fr, fq, 0, 0, nullptr);
      attn_core<0>(st[1], qf[1], f, fr, fq, 0, 0, nullptr);
    }
    const u16* K = (const u16*)(ws + O_KA) + (size_t)(NCTX + b * 2048) * 128 + kv * 64;
    const u16* VT = (const u16*)(ws + O_VAT) + (size_t)(kv * 64) * NT + NCTX + b * 2048;
    const int ta = (qt & 127) * 16;
    const int kb0 = max(0, ((ta - 128) >> 5) << 5), kb1 = min(2048, ta + 32 + 128);
    for (int k0 = kb0; k0 < kb1; k0 += 32) {
      attn_kvload(f, K + (size_t)k0 * 128, 128, VT + k0, NT, fr, fq);
      attn_core<1>(st[0], qf[0], f, fr, fq, ta + fr, k0, nullptr);
      attn_core<1>(st[1], qf[1], f, fr, fq, ta + 16 + fr, k0, nullptr);
    }
  } else if (type == 1) {
    const int qt = qp * 2;
    const int b = qt >> 7;
    const u16* ck = (const u16*)(ws + O_CCK) + ((size_t)(b * 4 + l) * 512) * 512 + h * 64;
    const u16* cvt = (const u16*)(ws + O_CCVT) + ((size_t)(b * 4 + l) * 512 + h * 64) * 512;
    for (int p0 = 0; p0 < 512; p0 += 32) {
      attn_kvload(f, ck + (size_t)p0 * 512, 512, cvt + p0, 512, fr, fq);
      attn_core<0>(st[0], qf[0], f, fr, fq, 0, 0, nullptr);
      attn_core<0>(st[1], qf[1], f, fr, fq, 0, 0, nullptr);
    }
    const u16* K = (const u16*)(ws + O_KC) + (size_t)(NCTX + b * 2048) * 512 + h * 64;
    const u16* VT = (const u16*)(ws + O_VCT) + (size_t)(h * 64) * NT + NCTX + b * 2048;
    const float* rpb = p.in[29] + (size_t)(l * 8 + h) * 15 * 31;
#pragma unroll
    for (int i = 0; i < 2; ++i) {
      const int t0 = ((qt + i) & 127) * 16;
      const int qrow = t0 >> 6, c0 = t0 & 63;
      const int rs = min(max(qrow - 4, 0), 24);
      const int cstart = min(max(c0 - 8, 0), 32);
      for (int a = 0; a < 8; ++a) {
        int krow = rs + a;
        int k0 = krow * 64 + cstart;
        attn_kvload(f, K + (size_t)k0 * 512, 512, VT + k0, NT, fr, fq);
        attn_core<2>(st[i], qf[i], f, fr, fq, c0 + fr, cstart, rpb + (krow - qrow + 7) * 31);
      }
    }
  } else if (type == 2) {
    const int b = (qp * 2) >> 4, kv = h >> 2;
    const u16* K = (const u16*)(ws + O_KA) + (size_t)(b * 256) * 128 + kv * 64;
    const u16* VT = (const u16*)(ws + O_VAT) + (size_t)(kv * 64) * NT + b * 256;
    for (int k0 = 0; k0 < 256; k0 += 32) {
      attn_kvload(f, K + (size_t)k0 * 128, 128, VT + k0, NT, fr, fq);
      attn_core<0>(st[0], qf[0], f, fr, fq, 0, 0, nullptr);
      attn_core<0>(st[1], qf[1], f, fr, fq, 0, 0, nullptr);
    }
  } else {
    const int b = (qp * 2) >> 4;
    const u16* K = (const u16*)(ws + O_KC) + (size_t)(b * 256) * 512 + h * 64;
    const u16* VT = (const u16*)(ws + O_VCT) + (size_t)(h * 64) * NT + b * 256;
    for (int k0 = 0; k0 < 256; k0 += 32) {
      attn_kvload(f, K + (size_t)k0 * 512, 512, VT + k0, NT, fr, fq);
      attn_core<0>(st[0], qf[0], f, fr, fq, 0, 0, nullptr);
      attn_core<0>(st[1], qf[1], f, fr, fq, 0, 0, nullptr);
    }
  }
#pragma unroll
  for (int i = 0; i < 2; ++i) {
    float lt = st[i].l;
    lt += __shfl_xor(lt, 16);
    lt += __shfl_xor(lt, 32);
    float inv = 1.f / lt;
#pragma unroll
    for (int dt = 0; dt < 4; ++dt) {
      u32x2 o; o[0] = pack2(st[i].o[dt][0] * inv, st[i].o[dt][1] * inv); o[1] = pack2(st[i].o[dt][2] * inv, st[i].o[dt][3] * inv);
      *(u32x2*)(Y + (size_t)(tok0 + i * 16 + fr) * 512 + h * 64 + dt * 16 + fq * 4) = o;
    }
  }
}


__device__ void phase_mix(const Params& p, int l) {
  char* ws = opaque_ptr(p.ws);
  const int tid = opaque_tid();
  const int wid = tid >> 6, lane = tid & 63;
  constexpr int LJPL = 4;
  constexpr int BPS = 64 / (4 * LJPL);
  const int NLB = (int)gridDim.x >= 2 * 32 * BPS ? 32 * BPS : 0;
  if ((int)blockIdx.x < NLB) {
    __builtin_amdgcn_s_setprio(3);
    const int it = blockIdx.x;
    const int sc = it / BPS, hf = it % BPS;
    const int z = sc & 1, h = (sc >> 1) & 7, b = sc >> 4;
    const float* s0 = p.in[6] + ((size_t)((b * 4 + l) * 2 + z) * 8 + h) * 4096;
    scan_latent_block<LJPL, 2048>(ws, tid, z, h, NCTX + b * 2048, hf * 4 * LJPL, s0, nullptr);
  } else {
    __builtin_amdgcn_s_setprio(1);
    if (NLB == 0) {
      for (int it = blockIdx.x * 4 + wid; it < 256; it += gridDim.x * 4) {
        int sc = it >> 3, part = it & 7;
        int z = sc & 1, h = (sc >> 1) & 7, b = sc >> 4;
        const float* s0 = p.in[6] + ((size_t)((b * 4 + l) * 2 + z) * 8 + h) * 4096;
        scan_wave_dma<8, 8>(ws, lane, wid * 12288, z, h, NCTX + b * 2048, 2048, part * 8, s0, nullptr);
      }
    }
    if (NLB > 0) {
      const int nab = (int)gridDim.x - NLB;
      for (int it = (int)blockIdx.x - NLB; it < 512; it += nab) {
        int sc = it >> 1, hf = it & 1;
        int z = sc & 1, h = (sc >> 1) & 7, b = sc >> 4;
        float* so = p.out + OUT_ST + ((size_t)((b * 4 + l) * 2 + z) * 8 + h) * 4096;
        scan_latent_block<8, 256>(ws, tid, z, h, b * 256, hf * 32, nullptr, so);
      }
    } else {
      const int nw = gridDim.x * 4;
      for (int it = (int)blockIdx.x * 4 + wid; it < 2048; it += nw) {
        int sc = it >> 3, part = it & 7;
        int z = sc & 1, h = (sc >> 1) & 7, b = sc >> 4;
        float* so = p.out + OUT_ST + ((size_t)((b * 4 + l) * 2 + z) * 8 + h) * 4096;
        scan_wave_dma<8, 8>(ws, lane, wid * 12288, z, h, b * 256, 256, part * 8, nullptr, so);
      }
    }
  }
  __builtin_amdgcn_s_setprio(0);
  int* cnt = (int*)(ws + O_CNT) + l;
  while (true) {
    int it = 0;
    if (lane == 0) it = atomicAdd(cnt, 1);
    it = __builtin_amdgcn_readfirstlane(it);
    if (it >= 4096) break;
    attn_item(p, ws, lane, l, it);
  }
  if (l == 0) {
    int* cnt2 = (int*)(ws + O_CNT) + 8;
    while (true) {
      int it = 0;
      if (lane == 0) it = atomicAdd(cnt2, 1);
      it = __builtin_amdgcn_readfirstlane(it);
      if (it >= 4096) break;
      const int tab = it >> 11, rb = (it & 2047) * 32;
      if (tab == 0) convert_rows_fp8_wave(lane, p.in[34], (unsigned char*)(ws + O_PEU), (float*)(ws + O_SCU), rb, rb + 32);
      else convert_rows_fp8_wave(lane, p.in[35], (unsigned char*)(ws + O_PEV), (float*)(ws + O_SCV), rb, rb + 32);
    }
  }
}

__device__ void phase_rwkv_post(const Params& p, int l) {
  char* ws = opaque_ptr(p.ws);
  const int tid = opaque_tid();
  const int lane = tid & 63;
  const int gw = blockIdx.x * 4 + (tid >> 6), GW = gridDim.x * 4;
  const float* Y0 = (const float*)(ws + O_YS);
  const float* Y1 = Y0 + (size_t)NT * 512;
  const float* KD0 = (const float*)(ws + O_KD);
  const float* KD1 = KD0 + (size_t)NT * 512;
  for (int tok = gw; tok < NT; tok += GW) {
#pragma unroll
    for (int i = 0; i < 2; ++i) {
      int c = (lane + 64 * i) * 4;
      size_t e = (size_t)tok * 512 + c;
      f32x4 a = *(const f32x4*)(Y0 + e), b = *(const f32x4*)(Y1 + e);
      f32x4 y;
      float s = 0.f;
#pragma unroll
      for (int j = 0; j < 4; ++j) { y[j] = a[j] + b[j]; s += y[j]; }
      float mu = row_sum16(s) * (1.f / 64.f);
      float vs = 0.f;
#pragma unroll
      for (int j = 0; j < 4; ++j) { y[j] -= mu; vs += y[j] * y[j]; }
      float var = row_sum16(vs) * (1.f / 64.f);
      float rstd = rsqrtf(var + 64e-5f);
      f32x4 g = *(const f32x4*)(p.in[26] + l * 512 + c), bb = *(const f32x4*)(p.in[27] + l * 512 + c);
      f32x4 r = *(const f32x4*)((const float*)(ws + O_XRKV) + (size_t)tok * 1536 + c);
      f32x4 v = *(const f32x4*)((const float*)(ws + O_XRKV) + (size_t)tok * 1536 + 1024 + c);
      f32x4 k0 = *(const f32x4*)(KD0 + e), k1 = *(const f32x4*)(KD1 + e);
      f32x4 rk = *(const f32x4*)(p.in[25] + l * 512 + c);
      float bs = 0.f;
#pragma unroll
      for (int j = 0; j < 4; ++j) bs += r[j] * (k0[j] + k1[j]) * rk[j];
      bs = row_sum16(bs);
      f32x4 gg = *(const f32x4*)((const float*)(ws + O_GG) + e);
      float o[4];
#pragma unroll
      for (int j = 0; j < 4; ++j) o[j] = (y[j] * rstd * g[j] + bb[j] + bs * v[j]) * gg[j];
      u32x2 ov; ov[0] = pack2(o[0], o[1]); ov[1] = pack2(o[2], o[3]);
      *(u32x2*)((u16*)(ws + O_YABC) + (size_t)NT * 512 + e) = ov;
    }
  }
}

__device__ void phase_branch(const Params& p, int l) {
  char* ws = opaque_ptr(p.ws);
  const int tid = opaque_tid();
  const int wid = tid >> 6, lane = tid & 63, wr = wid >> 1, wc = wid & 1, fr = lane & 15, fq = lane >> 4;
  const u16* G = (const u16*)(ws + O_GATE);
  for (int t = blockIdx.x; t < 64 * 8; t += gridDim.x) {
    const int tm = t & 63, tn = t >> 6;
    const int brow = tm * 128, bcol = tn * 128;
    f32x4 tot[4][4];
    zero_acc(tot);
#pragma unroll 1
    for (int br = 0; br < 3; ++br) {
      f32x4 acc[4][4];
      zero_acc(acc);
      const u16* Wb = (const u16*)(ws + (br == 0 ? O_AOUT : br == 1 ? O_RWOUT : O_NAOUT)) + ((size_t)l * 1024 + bcol) * 512;
      gemm_main(tid, (const u16*)(ws + O_YABC) + (size_t)br * NT * 512 + (size_t)brow * 512, 512, Wb, 512, 512, acc, ((tm >> 3) + (tn & 7)) & 7);
#pragma unroll
      for (int m = 0; m < 4; ++m) {
        const int tok = brow + wr * 64 + m * 16 + fr;
#pragma unroll
        for (int n = 0; n < 4; ++n) {
          const int c = bcol + wc * 64 + n * 16 + fq * 4;
          u32x2 gv = *(const u32x2*)(G + (size_t)tok * 3072 + br * 1024 + c);
          tot[m][n][0] += acc[m][n][0] * __uint_as_float(gv[0] << 16);
          tot[m][n][1] += acc[m][n][1] * __uint_as_float(gv[0] & 0xffff0000u);
          tot[m][n][2] += acc[m][n][2] * __uint_as_float(gv[1] << 16);
          tot[m][n][3] += acc[m][n][3] * __uint_as_float(gv[1] & 0xffff0000u);
        }
      }
    }
#pragma unroll
    for (int m = 0; m < 4; ++m) {
      const int tok = brow + wr * 64 + m * 16 + fr;
#pragma unroll
      for (int n = 0; n < 4; ++n) {
        const int c = bcol + wc * 64 + n * 16 + fq * 4;
        u32x2 o; o[0] = pack2(tot[m][n][0], tot[m][n][1]); o[1] = pack2(tot[m][n][2], tot[m][n][3]);
        *(u32x2*)((u16*)(ws + O_MERG) + (size_t)tok * 1024 + c) = o;
      }
    }
  }
}

__device__ void phase_wo(const Params& p, int l) {
  char* ws = opaque_ptr(p.ws);
  const int tid = opaque_tid();
  const int wid = tid >> 6, lane = tid & 63, wr = wid >> 1, wc = wid & 1, fr = lane & 15, fq = lane >> 4;
  float* X = (float*)(ws + O_X);
  for (int t = blockIdx.x; t < 64 * 8; t += gridDim.x) {
    const int tm = t & 63, tn = t >> 6;
    const int brow = tm * 128, bcol = tn * 128;
    f32x4 acc[4][4];
    zero_acc(acc);
    gemm_main(tid, (const u16*)(ws + O_MERG) + (size_t)brow * 1024, 1024, (const u16*)(ws + O_WO) + ((size_t)l * 1024 + bcol) * 1024, 1024, 1024, acc, (((tm >> 3) + (tn & 7)) * 2) & 15);
#pragma unroll
    for (int m = 0; m < 4; ++m) {
      const int tok = brow + wr * 64 + m * 16 + fr;
      const float* gate = (const float*)(ws + O_MOD) + ((size_t)l * 3 + tok_cond(tok)) * 6144 + 2 * 1024;
#pragma unroll
      for (int n = 0; n < 4; ++n) {
        const int c = bcol + wc * 64 + n * 16 + fq * 4;
        f32x4 x = *(f32x4*)(X + (size_t)tok * 1024 + c);
        f32x4 g = *(const f32x4*)(gate + c);
#pragma unroll
        for (int j = 0; j < 4; ++j) x[j] += g[j] * acc[m][n][j];
        *(f32x4*)(X + (size_t)tok * 1024 + c) = x;
      }
    }
  }
}

__device__ void phase_peq(const Params& p, int l) {
  char* ws = opaque_ptr(p.ws);
  const int tid = opaque_tid();
  const int wid = tid >> 6, lane = tid & 63, wr = wid >> 1, wc = wid & 1, fr = lane & 15, fq = lane >> 4;
  for (int t = blockIdx.x; t < 64 * 16; t += gridDim.x) {
    const int tm = t & 63, tn = t >> 6;
    const int brow = tm * 128, bcol = tn * 128;
    f32x4 acc[4][4];
    zero_acc(acc);
    gemm_main(tid, (const u16*)(ws + O_H) + (size_t)brow * 1024, 1024, (const u16*)(ws + O_PEQ) + ((size_t)l * 2048 + bcol) * 1024, 1024, 1024, acc, (((tm >> 3) + (tn & 7)) * 2) & 15);
#pragma unroll
    for (int m = 0; m < 4; ++m) {
      const int tok = brow + wr * 64 + m * 16 + fr;
#pragma unroll
      for (int n = 0; n < 4; ++n) {
        const int c = bcol + wc * 64 + n * 16 + fq * 4;
        u32x2 o; o[0] = pack2(acc[m][n][0], acc[m][n][1]); o[1] = pack2(acc[m][n][2], acc[m][n][3]);
        *(u32x2*)((u16*)(ws + O_PQ) + (size_t)tok * 2048 + c) = o;
      }
    }
  }
}

__device__ const unsigned char kCand[64] = {
    0x00, 0x01, 0x02, 0x03, 0x04, 0x05, 0x06, 0x07, 0x08, 0x09, 0x0a, 0x0b, 0x0c, 0x0d, 0x0e, 0x0f,
    0x10, 0x11, 0x12, 0x13, 0x14, 0x15, 0x16, 0x17, 0x20, 0x21, 0x22, 0x23, 0x24, 0x30, 0x31, 0x32,
    0x33, 0x40, 0x41, 0x42, 0x50, 0x51, 0x60, 0x61, 0x70, 0x71, 0x80, 0x90, 0xa0, 0xb0, 0xc0, 0xd0,
    0xe0, 0xf0, 0xff, 0xff, 0xff, 0xff, 0xff, 0xff, 0xff, 0xff, 0xff, 0xff, 0xff, 0xff, 0xff, 0xff};

DI unsigned f2key(float f) { unsigned u = __float_as_uint(f); return (u & 0x80000000u) ? ~u : (u | 0x80000000u); }
DI float key2f(unsigned k) { unsigned u = (k & 0x80000000u) ? (k & 0x7fffffffu) : ~k; return __uint_as_float(u); }
template <int CTRL> DI unsigned dppu(unsigned v) { return (unsigned)__builtin_amdgcn_update_dpp(0, (int)v, CTRL, 0xf, 0xf, true); }
DI unsigned row_max16u(unsigned v) { v = max(v, dppu<0xB1>(v)); v = max(v, dppu<0x4E>(v)); v = max(v, dppu<0x141>(v)); v = max(v, dppu<0x140>(v)); return v; }

__device__ void phase_peer_sel(const Params& p, int l) {
  char* ws = opaque_ptr(p.ws);
  const int tid = opaque_tid();
  const int wid = tid >> 6, lane = tid & 63, fr = lane & 15, fq = lane >> 4;
  const int gw = blockIdx.x * 4 + wid, GW = gridDim.x * 4;
  float* lv = (float*)(g_smem + wid * 4096);
  int* li = (int*)(g_smem + wid * 4096 + 2048);
  const u16* PQ = (const u16*)(ws + O_PQ);
  int ca[4], cb[4];
  bool cvld[4];
#pragma unroll
  for (int c = 0; c < 4; ++c) { int code = kCand[c * 16 + fr]; cvld[c] = code != 0xff; ca[c] = (code >> 4) & 15; cb[c] = code & 15; }
  for (int it = gw; it < 512 * 8; it += GW) {
    const int h = it >> 9, tg = it & 511;
    const u16* SK = (const u16*)(ws + O_SUBK) + ((size_t)(l * 8 + h) * 2) * 128 * 128;
    f32x4 sc[2][8];
#pragma unroll
    for (int z = 0; z < 2; ++z) {
      bf16x8 qf[4];
#pragma unroll
      for (int ks = 0; ks < 4; ++ks) qf[ks] = *(const bf16x8*)(PQ + (size_t)(tg * 16 + fr) * 2048 + (h * 2 + z) * 128 + ks * 32 + fq * 8);
#pragma unroll
      for (int nt = 0; nt < 8; ++nt) {
        sc[z][nt] = f32x4{0.f, 0.f, 0.f, 0.f};
#pragma unroll
        for (int ks = 0; ks < 4; ++ks) {
          bf16x8 kf = *(const bf16x8*)(SK + ((size_t)z * 128 + nt * 16 + fr) * 128 + ks * 32 + fq * 8);
          sc[z][nt] = mfma16(qf[ks], kf, sc[z][nt]);
        }
      }
    }
#pragma unroll
    for (int z = 0; z < 2; ++z) {
#pragma unroll
      for (int j = 0; j < 4; ++j) {
        unsigned key[8];
#pragma unroll
        for (int nt = 0; nt < 8; ++nt) key[nt] = (f2key(sc[z][nt][j]) & ~127u) | (unsigned)(127 - (nt * 16 + fr));
        unsigned tk = 0u;
#pragma unroll 1
        for (int k = 0; k < 16; ++k) {
          unsigned m = key[0];
#pragma unroll
          for (int nt = 1; nt < 8; ++nt) m = max(m, key[nt]);
          unsigned M = row_max16u(m);
#pragma unroll
          for (int nt = 0; nt < 8; ++nt) key[nt] = key[nt] == M ? 0u : key[nt];
          if (fr == k) tk = M;
        }
        lv[((fq * 4 + j) * 2 + z) * 16 + fr] = key2f(tk & ~127u);
        li[((fq * 4 + j) * 2 + z) * 16 + fr] = 127 - (int)(tk & 127u);
      }
    }
    __builtin_amdgcn_s_waitcnt(0xc07f);
    __builtin_amdgcn_wave_barrier();
#pragma unroll 1
    for (int j = 0; j < 4; ++j) {
      const int tl = fq * 4 + j;
      float cand[4];
#pragma unroll
      for (int c = 0; c < 4; ++c) cand[c] = cvld[c] ? lv[(tl * 2 + 0) * 16 + ca[c]] + lv[(tl * 2 + 1) * 16 + cb[c]] : -3e38f;
      unsigned ck[4];
#pragma unroll
      for (int c = 0; c < 4; ++c) ck[c] = cvld[c] ? ((f2key(cand[c]) & ~63u) | (unsigned)(63 - (c * 16 + fr))) : 0u;
      unsigned sk = 0u;
#pragma unroll 1
      for (int k = 0; k < 16; ++k) {
        unsigned m = max(max(ck[0], ck[1]), max(ck[2], ck[3]));
        unsigned M = row_max16u(m);
#pragma unroll
        for (int c = 0; c < 4; ++c) ck[c] = ck[c] == M ? 0u : ck[c];
        if (fr == k) sk = M;
      }
      const float sv = key2f(sk & ~63u);
      const int scode = 63 - (int)(sk & 63u);
      int ab = kCand[scode];
      int e = li[(tl * 2 + 0) * 16 + ((ab >> 4) & 15)] * 128 + li[(tl * 2 + 1) * 16 + (ab & 15)];
      float mx = row_max16(sv);
      float ex = __expf(sv - mx);
      float sum = row_sum16(ex);
      int tok = tg * 16 + tl;
      ((int*)(ws + O_EIDX))[(size_t)tok * 128 + h * 16 + fr] = e;
      ((float*)(ws + O_EGATE))[(size_t)tok * 128 + h * 16 + fr] = ex / sum;
    }
    __builtin_amdgcn_s_waitcnt(0xc07f);
    __builtin_amdgcn_wave_barrier();
  }
}

DI void cvt8(const bf16x8& v, float (&f)[8]) {
  u32x4 u = __builtin_bit_cast(u32x4, v);
#pragma unroll
  for (int q = 0; q < 4; ++q) { f[2 * q] = __uint_as_float(u[q] << 16); f[2 * q + 1] = __uint_as_float(u[q] & 0xffff0000u); }
}
DI void cvt16(const u32x4& q, float (&f)[16]) {
#pragma unroll
  for (int i = 0; i < 4; ++i) {
    f32x2 a = __builtin_amdgcn_cvt_pk_f32_fp8((int)q[i], false), b = __builtin_amdgcn_cvt_pk_f32_fp8((int)q[i], true);
    f[4 * i] = a[0]; f[4 * i + 1] = a[1]; f[4 * i + 2] = b[0]; f[4 * i + 3] = b[1];
  }
}

__device__ void phase_peer_gather(const Params& p, int l, bool dry = false) {
  char* ws = opaque_ptr(p.ws);
  const int tid = opaque_tid();
  const int lane = tid & 63;
  const int gw = blockIdx.x * 4 + (tid >> 6), GW = gridDim.x * 4;
  const unsigned char* U = (const unsigned char*)(ws + O_PEU) + (size_t)l * 16384 * 1024;
  const unsigned char* V = (const unsigned char*)(ws + O_PEV) + (size_t)l * 16384 * 1024;
  const float* SU = (const float*)(ws + O_SCU) + l * 16384;
  const float* SV = (const float*)(ws + O_SCV) + l * 16384;
  float* X = (float*)(ws + O_X);
  float* XW = dry ? (float*)(ws + O_YS) : X;
  u16* HW = dry ? (u16*)(ws + O_MERG) : (u16*)(ws + O_H);
  float* OW = dry ? (float*)(ws + O_PB) : p.out + OUT_Y;
  for (int tok = gw; tok < NT; tok += GW) {
    float hf[16];
    {
      const u16* hr = (const u16*)(ws + O_H) + (size_t)tok * 1024 + lane * 16;
      bf16x8 h0 = *(const bf16x8*)(hr), h1 = *(const bf16x8*)(hr + 8);
      float t0[8], t1[8];
      cvt8(h0, t0); cvt8(h1, t1);
#pragma unroll
      for (int i = 0; i < 8; ++i) { hf[i] = t0[i]; hf[8 + i] = t1[i]; }
    }
    float acc[16];
#pragma unroll
    for (int i = 0; i < 16; ++i) acc[i] = 0.f;
    const int id0 = ((const int*)(ws + O_EIDX))[(size_t)tok * 128 + lane], id1 = ((const int*)(ws + O_EIDX))[(size_t)tok * 128 + 64 + lane];
    const float g0 = ((const float*)(ws + O_EGATE))[(size_t)tok * 128 + lane], g1 = ((const float*)(ws + O_EGATE))[(size_t)tok * 128 + 64 + lane];
#define PG_LOAD(G, ids, gts, su, sv, uq, vq)                                                                      \
  do {                                                                                                            \
    _Pragma("unroll") for (int e = 0; e < 4; ++e) {                                                               \
      int k = (G) * 4 + e;                                                                                        \
      int sel = k & 63;                                                                                           \
      int a_ = __builtin_amdgcn_readlane(id0, sel), b_ = __builtin_amdgcn_readlane(id1, sel);                     \
      float ga_ = __builtin_bit_cast(float, __builtin_amdgcn_readlane(__builtin_bit_cast(int, g0), sel));         \
      float gb_ = __builtin_bit_cast(float, __builtin_amdgcn_readlane(__builtin_bit_cast(int, g1), sel));         \
      ids[e] = (G) < 16 ? a_ : b_;                                                                                 \
      gts[e] = (G) < 16 ? ga_ : gb_;                                                                               \
    }                                                                                                             \
    _Pragma("unroll") for (int e = 0; e < 4; ++e) uq[e] = *(const u32x4*)(U + (size_t)ids[e] * 1024 + lane * 16); \
    _Pragma("unroll") for (int e = 0; e < 4; ++e) vq[e] = *(const u32x4*)(V + (size_t)ids[e] * 1024 + lane * 16); \
    _Pragma("unroll") for (int e = 0; e < 4; ++e) { su[e] = SU[ids[e]]; sv[e] = SV[ids[e]]; }                     \
  } while (0)
#define PG_COMP(gts, su, sv, uq, vq)                                                                              \
  do {                                                                                                            \
    float cf[4];                                                                                                  \
    _Pragma("unroll") for (int e = 0; e < 4; ++e) {                                                               \
      float a[16];                                                                                                \
      cvt16(uq[e], a);                                                                                            \
      float d0 = 0.f, d1 = 0.f;                                                                                   \
      _Pragma("unroll") for (int i = 0; i < 16; i += 2) { d0 += a[i] * hf[i]; d1 += a[i + 1] * hf[i + 1]; }       \
      float d = wave_sum(d0 + d1) * su[e];                                                                        \
      float u3 = 0.7978845608028654f * (d + 0.044715f * d * d * d);                                               \
      float th = 1.f - 2.f * __builtin_amdgcn_rcpf(__expf(2.f * u3) + 1.f);                                                            \
      cf[e] = gts[e] * 0.5f * d * (1.f + th) * sv[e];                                                             \
    }                                                                                                             \
    _Pragma("unroll") for (int e = 0; e < 4; ++e) {                                                               \
      float a[16];                                                                                                \
      cvt16(vq[e], a);                                                                                            \
      _Pragma("unroll") for (int i = 0; i < 16; ++i) acc[i] += cf[e] * a[i];                                      \
    }                                                                                                             \
  } while (0)
    {
      int idA[4], idB[4];
      float gtA[4], gtB[4], suA[4], svA[4], suB[4], svB[4];
      u32x4 uqA[4], vqA[4], uqB[4], vqB[4];
      PG_LOAD(0, idA, gtA, suA, svA, uqA, vqA);
#pragma unroll 1
      for (int g = 0; g < 32; g += 2) {
        PG_LOAD(g + 1, idB, gtB, suB, svB, uqB, vqB);
        PG_COMP(gtA, suA, svA, uqA, vqA);
        if (g + 2 < 32) PG_LOAD(g + 2, idA, gtA, suA, svA, uqA, vqA);
        PG_COMP(gtB, suB, svB, uqB, vqB);
      }
    }
#undef PG_LOAD
#undef PG_COMP
    const float* mod = (const float*)(ws + O_MOD) + ((size_t)l * 3 + tok_cond(tok)) * 6144;
    float x[16];
    const int e0 = lane * 16;
#pragma unroll
    for (int q = 0; q < 4; ++q) {
      f32x4 a = *(const f32x4*)(X + (size_t)tok * 1024 + e0 + q * 4);
      f32x4 ga = *(const f32x4*)(mod + 5 * 1024 + e0 + q * 4);
#pragma unroll
      for (int i = 0; i < 4; ++i) { a[i] += ga[i] * acc[q * 4 + i]; x[q * 4 + i] = a[i]; }
      *(f32x4*)(XW + (size_t)tok * 1024 + e0 + q * 4) = a;
    }
    float ss = 0.f;
#pragma unroll
    for (int i = 0; i < 16; ++i) ss += x[i] * x[i];
    ss = wave_sum(ss);
    const float rstd = rsqrtf(ss * (1.f / 1024.f) + 1e-6f);
    if (l < NL - 1) {
      const float* mod2 = (const float*)(ws + O_MOD) + ((size_t)(l + 1) * 3 + tok_cond(tok)) * 6144;
      const float* g = p.in[9] + (l + 1) * 1024;
      float y[16];
#pragma unroll
      for (int q = 0; q < 4; ++q) {
        f32x4 gg = *(const f32x4*)(g + e0 + q * 4), sh = *(const f32x4*)(mod2 + e0 + q * 4), sc = *(const f32x4*)(mod2 + 1024 + e0 + q * 4);
#pragma unroll
        for (int i = 0; i < 4; ++i) y[q * 4 + i] = x[q * 4 + i] * rstd * gg[i] * (1.f + sc[i]) + sh[i];
      }
      u32x4 o0, o1;
      o0[0] = pack2(y[0], y[1]); o0[1] = pack2(y[2], y[3]); o0[2] = pack2(y[4], y[5]); o0[3] = pack2(y[6], y[7]);
      o1[0] = pack2(y[8], y[9]); o1[1] = pack2(y[10], y[11]); o1[2] = pack2(y[12], y[13]); o1[3] = pack2(y[14], y[15]);
      *(u32x4*)(HW + (size_t)tok * 1024 + e0) = o0;
      *(u32x4*)(HW + (size_t)tok * 1024 + e0 + 8) = o1;
    } else {
      const float* g = p.in[11];
#pragma unroll
      for (int q = 0; q < 4; ++q) {
        f32x4 gg = *(const f32x4*)(g + e0 + q * 4), a;
#pragma unroll
        for (int i = 0; i < 4; ++i) a[i] = x[q * 4 + i] * rstd * gg[i];
        *(f32x4*)(OW + (size_t)tok * 1024 + e0 + q * 4) = a;
      }
    }
  }
}

#define XB_TMO 128
#define XB_XCNT(j) (256 + 64 * (j))
#define XB_XSUB(j) (1280 + 64 * (j))
#define XB_XGEN(j) (2304 + 64 * (j))
#define XB_TOP 3328
#define XB_TOPGEN 3392
#define XCD_BAR_WORDS 3456
#define XB_SPIN_CAP (1u << 18)
DI unsigned xb_ld(unsigned* q) { return __hip_atomic_load(q, __ATOMIC_RELAXED, __HIP_MEMORY_SCOPE_AGENT); }
DI unsigned xb_add(unsigned* q, unsigned v) { return __hip_atomic_fetch_add(q, v, __ATOMIC_RELAXED, __HIP_MEMORY_SCOPE_AGENT); }
DI unsigned xb_xcc_id() { return (unsigned)__builtin_amdgcn_s_getreg((3 << 11) | 20) & 0xFu; }
#define XB_SPIN(cond, bar)                                                                   \
  do {                                                                                       \
    unsigned _sp = 0;                                                                        \
    while (cond) {                                                                           \
      __builtin_amdgcn_s_sleep(1);                                                           \
      if ((++_sp & 255u) == 0u) {                                                            \
        if (xb_ld(&(bar)[XB_TMO])) break;                                                    \
        if (_sp > XB_SPIN_CAP) { atomicAdd(&(bar)[XB_TMO], 1u); break; }                     \
      }                                                                                      \
    }                                                                                        \
  } while (0)
struct XB { unsigned* bar; unsigned x, nloc, nx; };
DI void xcd_barrier(const XB& b) {
  asm volatile("s_waitcnt vmcnt(0)" ::: "memory");
  __syncthreads();
  if (threadIdx.x == 0) {
    unsigned* bar = b.bar;
    __builtin_amdgcn_s_waitcnt(0);
    const unsigned nloc = b.nloc, nx = b.nx;
    const unsigned old = xb_add(&bar[XB_XSUB(b.x)], 1u);
    const unsigned gen = old / nloc;
    if (old + 1u == (gen + 1u) * nloc) {
      __builtin_amdgcn_fence(__ATOMIC_RELEASE, "agent");
      asm volatile("s_waitcnt vmcnt(0)" ::: "memory");
      const unsigned og = xb_add(&bar[XB_TOP], 1u);
      const unsigned tg = og / nx;
      if (og + 1u == (tg + 1u) * nx) xb_add(&bar[XB_TOPGEN], 1u);
      else XB_SPIN(xb_ld(&bar[XB_TOPGEN]) == tg, bar);
      __builtin_amdgcn_fence(__ATOMIC_ACQUIRE, "agent");
      xb_add(&bar[XB_XGEN(b.x)], 1u);
      asm volatile("s_waitcnt vmcnt(0)" ::: "memory");
    } else {
      XB_SPIN(xb_ld(&bar[XB_XGEN(b.x)]) == gen, bar);
      __builtin_amdgcn_fence(__ATOMIC_ACQUIRE, "agent");
      asm volatile("s_waitcnt vmcnt(0)" ::: "memory");
    }
  }
  __syncthreads();
}

__global__ void __launch_bounds__(256, 2) fwd_megakernel(Params p) {
  cg::grid_group grid = cg::this_grid();
  XB xb;
  xb.bar = (unsigned*)(p.ws + O_BAR);
  xb.x = xb_xcc_id();
  if (threadIdx.x == 0) (void)xb_add(&xb.bar[XB_XCNT(xb.x)], 1u);
  phase_prep(p);
  if (p.ws == nullptr) grid.sync();
  {
    unsigned mine = 0u, cnt = 0u, sum = 0u, sp = 0u;
    for (;;) {
      sum = 0u; cnt = 0u; mine = 0u;
#pragma unroll
      for (unsigned j = 0; j < 16; ++j) { const unsigned c = xb_ld(&xb.bar[XB_XCNT(j)]); sum += c; cnt += (c > 0u) ? 1u : 0u; mine = (j == xb.x) ? c : mine; }
      if (sum == gridDim.x) break;
      __builtin_amdgcn_s_sleep(1);
      if (++sp > XB_SPIN_CAP) break;
    }
    xb.nloc = __builtin_amdgcn_readfirstlane(mine > 0u ? mine : 1u);
    xb.nx = __builtin_amdgcn_readfirstlane(cnt > 0u ? cnt : 1u);
  }
  xcd_barrier(xb);
  phase_norm(p, 0, 0);
  xcd_barrier(xb);
  for (int l = 0; l < NL; ++l) {
    phase_gemm_in(p, l);
    xcd_barrier(xb);
    phase_rwkv_prep(p, l);
    xcd_barrier(xb);
    phase_rwkv_lora(p, l);
    xcd_barrier(xb);
    phase_mix(p, l);
    xcd_barrier(xb);
    phase_rwkv_post(p, l);
    xcd_barrier(xb);
    phase_branch(p, l);
    xcd_barrier(xb);
    phase_wo(p, l);
    xcd_barrier(xb);
    phase_norm(p, l, 1);
    xcd_barrier(xb);
    phase_peq(p, l);
    xcd_barrier(xb);
    phase_peer_sel(p, l);
    xcd_barrier(xb);
    phase_peer_gather(p, l);
    if (l + 1 < NL) xcd_barrier(xb);
  }
}

extern "C" void kernel_launch(void* const* d_in, const int* in_sizes, int n_in, void* d_out, int out_size, void* d_ws, size_t ws_size,
                              hipStream_t stream) {
  static int grid_blocks = 0;
  if (!grid_blocks) {
    int dev = 0, cus = 0, per_cu = 0;
    hipGetDevice(&dev);
    hipDeviceGetAttribute(&cus, hipDeviceAttributeMultiprocessorCount, dev);
    hipOccupancyMaxActiveBlocksPerMultiprocessor(&per_cu, fwd_megakernel, 256, 0);
    if (per_cu > 2) per_cu = 2;
    if (per_cu < 1) per_cu = 1;
    grid_blocks = cus * per_cu;
  }
  Params p{};
  for (int i = 0; i < 36; ++i) p.in[i] = (const float*)d_in[i];
  p.out = (float*)d_out;
  p.ws = (char*)d_ws;
  (void)hipMemsetAsync((char*)d_ws + O_BAR, 0, 3456 * 4, stream);
  void* args[] = {&p};
  hipError_t e = hipLaunchCooperativeKernel((void*)fwd_megakernel, dim3(grid_blocks), dim3(256), args, 0, stream);
  if (e != hipSuccess) fprintf(stderr, "cooperative launch failed: %s (grid %d)\n", hipGetErrorString(e), grid_blocks);
}
```

```cpp
#include <hip/hip_runtime.h>
#include <hip/hip_cooperative_groups.h>
#include <cstdio>
namespace cg = cooperative_groups;

#define DI __device__ __forceinline__
typedef unsigned short u16;
using bf16x8 = __attribute__((ext_vector_type(8))) short;
using bf16x4 = __attribute__((ext_vector_type(4))) short;
using f32x4 = __attribute__((ext_vector_type(4))) float;
using u32x2 = __attribute__((ext_vector_type(2))) unsigned;
using u32x4 = __attribute__((ext_vector_type(4))) unsigned;

constexpr int NT = 8192, NCTX = 4096, DM = 1024, INC = 7296, NL = 4;

constexpr size_t AL(size_t x) { return (x + 255) / 256 * 256; }
constexpr size_t O_WIN = 0;
constexpr size_t O_AOUT = O_WIN + AL(4ull * 7296 * 1024 * 2);
constexpr size_t O_RWOUT = O_AOUT + AL(4ull * 1024 * 512 * 2);
constexpr size_t O_NAOUT = O_RWOUT + AL(4ull * 1024 * 512 * 2);
constexpr size_t O_WO = O_NAOUT + AL(4ull * 1024 * 512 * 2);
constexpr size_t O_PEQ = O_WO + AL(4ull * 1024 * 1024 * 2);
constexpr size_t O_SUBK = O_PEQ + AL(4ull * 2048 * 1024 * 2);
constexpr size_t O_W2 = O_SUBK + AL(4ull * 8 * 2 * 128 * 128 * 2);
constexpr size_t O_A2 = O_W2 + AL(8ull * 512 * 64 * 2);
constexpr size_t O_G2 = O_A2 + AL(8ull * 512 * 64 * 2);
constexpr size_t O_PEU = O_G2 + AL(4ull * 512 * 128 * 2);
constexpr size_t O_PEV = O_PEU + AL(4ull * 16384 * 1024 * 2);
constexpr size_t O_CAK = O_PEV + AL(4ull * 16384 * 1024 * 2);
constexpr size_t O_CAVT = O_CAK + AL(8ull * 512 * 128 * 2);
constexpr size_t O_CCK = O_CAVT + AL(8ull * 128 * 512 * 2);
constexpr size_t O_CCVT = O_CCK + AL(8ull * 512 * 512 * 2);
constexpr size_t O_MOD = O_CCVT + AL(8ull * 512 * 512 * 2);
constexpr size_t O_ROPE = O_MOD + AL(4ull * 3 * 6144 * 4);
constexpr size_t O_CNT = O_ROPE + AL(64 * 16 * 2 * 4);
constexpr size_t O_X = O_CNT + 256;
constexpr size_t O_H = O_X + AL(8192ull * 1024 * 4);
constexpr size_t O_QA = O_H + AL(8192ull * 1024 * 2);
constexpr size_t O_KA = O_QA + AL(8192ull * 512 * 2);
constexpr size_t O_VAT = O_KA + AL(8192ull * 128 * 2);
constexpr size_t O_QC = O_VAT + AL(8192ull * 128 * 2);
constexpr size_t O_KC = O_QC + AL(8192ull * 512 * 2);
constexpr size_t O_VCT = O_KC + AL(8192ull * 512 * 2);
constexpr size_t O_PB = O_VCT + AL(8192ull * 512 * 2);
constexpr size_t O_GATE = O_PB + AL(8192ull * 1920 * 4);
constexpr size_t O_XRKV = O_GATE + AL(8192ull * 3072 * 2);
constexpr size_t O_KK = O_XRKV + AL(8192ull * 1536 * 4);
constexpr size_t O_TW = O_KK + AL(8192ull * 512 * 4);
constexpr size_t O_AD = O_TW + AL(8192ull * 128 * 2);
constexpr size_t O_SG = O_AD + AL(8192ull * 128 * 2);
constexpr size_t O_DEC = O_SG + AL(8192ull * 128 * 2);
constexpr size_t O_KD = O_DEC + AL(2ull * 8192 * 512 * 4);
constexpr size_t O_KKA = O_KD + AL(2ull * 8192 * 512 * 4);
constexpr size_t O_GG = O_KKA + AL(2ull * 8192 * 512 * 4);
constexpr size_t O_YS = O_GG + AL(8192ull * 512 * 4);
constexpr size_t O_YABC = O_YS + AL(2ull * 8192 * 512 * 4);
constexpr size_t O_MERG = O_YABC + AL(3ull * 8192 * 512 * 2);
constexpr size_t O_PQ = O_MERG + AL(8192ull * 1024 * 2);
constexpr size_t O_EIDX = O_PQ + AL(8192ull * 2048 * 2);
constexpr size_t O_EGATE = O_EIDX + AL(8192ull * 128 * 4);
constexpr size_t O_SCU = O_EGATE + AL(8192ull * 128 * 4);
constexpr size_t O_SCV = O_SCU + AL(4ull * 16384 * 4);
constexpr size_t O_BAR = O_SCV + AL(4ull * 16384 * 4);
constexpr size_t WS_TOTAL = O_BAR + AL(3456 * 4);
static_assert(WS_TOTAL < 1020ull * 1024 * 1024, "workspace too large");

constexpr size_t OUT_Y = 0;
constexpr size_t OUT_AK = 8388608;
constexpr size_t OUT_AV = 10485760;
constexpr size_t OUT_CK = 12582912;
constexpr size_t OUT_CV = 20971520;
constexpr size_t OUT_ST = 29360128;

struct Params {
  const float* in[36];
  float* out;
  char* ws;
};

__shared__ __attribute__((aligned(16))) char g_smem[65536];

DI u16 f2bf(float x) { unsigned u = __float_as_uint(x); u += 0x7fffu + ((u >> 16) & 1u); return (u16)(u >> 16); }
DI float bf2f(u16 h) { return __uint_as_float(((unsigned)h) << 16); }
typedef __bf16 bf16x2_t __attribute__((ext_vector_type(2)));
DI unsigned pack2(float a, float b) { bf16x2_t v = {(__bf16)a, (__bf16)b}; return __builtin_bit_cast(unsigned, v); }
DI float sigmoidf_(float x) { return __builtin_amdgcn_rcpf(1.f + __expf(-x)); }
template <int CTRL> DI float dppf(float v) {
  return __builtin_bit_cast(float, __builtin_amdgcn_update_dpp(0, __builtin_bit_cast(int, v), CTRL, 0xf, 0xf, true));
}
template <int CTRL> DI int dppi(int v) { return __builtin_amdgcn_update_dpp(0, v, CTRL, 0xf, 0xf, true); }
DI float row_sum16(float v) { v += dppf<0xB1>(v); v += dppf<0x4E>(v); v += dppf<0x141>(v); v += dppf<0x140>(v); return v; }
DI float row_max16(float v) { v = fmaxf(v, dppf<0xB1>(v)); v = fmaxf(v, dppf<0x4E>(v)); v = fmaxf(v, dppf<0x141>(v)); v = fmaxf(v, dppf<0x140>(v)); return v; }
DI int row_max16i(int v) { v = max(v, dppi<0xB1>(v)); v = max(v, dppi<0x4E>(v)); v = max(v, dppi<0x141>(v)); v = max(v, dppi<0x140>(v)); return v; }
DI float wave_sum(float v) { v = row_sum16(v); v += __shfl_xor(v, 16); v += __shfl_xor(v, 32); return v; }

DI int opaque_tid() { int t = threadIdx.x; asm volatile("" : "+v"(t)); return t; }
DI char* opaque_ptr(char* q) { size_t z = 0; asm volatile("" : "+s"(z)); return q + z; }
DI f32x4 mfma16(bf16x8 a, bf16x8 b, f32x4 c) { return __builtin_amdgcn_mfma_f32_16x16x32_bf16(a, b, c, 0, 0, 0); }

DI int lds_byte(int r, int c) {
  int st = (r >> 4) * 2 + (c >> 5), rr = r & 15, cc = c & 31, ob = rr * 64 + cc * 2;
  return st * 1024 + (ob ^ (((ob >> 9) & 1) << 5));
}
DI void stage_rc(int b, int& R, int& C) {
  int st = b >> 10, sb = b & 1023, swz = sb ^ (((sb >> 9) & 1) << 5);
  R = (st >> 1) * 16 + (swz >> 6);
  C = (st & 1) * 32 + ((swz & 63) >> 1);
}
DI void gemm_main(int tid, const u16* __restrict__ g0, int ld0, const u16* __restrict__ g1, int ld1, int K, f32x4 (&acc)[4][4], int koff = 0) {
  const int wid = tid >> 6, lane = tid & 63, wr = wid >> 1, wc = wid & 1, fr = lane & 15, fq = lane >> 4;
  const int nk = K >> 6;
  int R0, C0;
  stage_rc(tid * 16, R0, C0);
  const unsigned v0 = (unsigned)(R0 * ld0 + C0), v1 = (unsigned)(R0 * ld1 + C0);
  const int fa0 = lds_byte(wr * 64 + fr, fq * 8), fa1 = 16384 + lds_byte(wc * 64 + fr, fq * 8);
  const int sb = tid * 16;
#define GSTAGE(kt, buf)                                                                                          \
  do {                                                                                                           \
    _Pragma("unroll") for (int i = 0; i < 4; ++i) {                                                              \
      const u16* u0 = g0 + (size_t)(kt) * 64 + (size_t)i * 32 * ld0;                                             \
      const u16* u1 = g1 + (size_t)(kt) * 64 + (size_t)i * 32 * ld1;                                             \
      __builtin_amdgcn_global_load_lds((const unsigned*)(u0 + v0), (unsigned*)(g_smem + (buf) + i * 4096 + sb), 16, 0, 0);          \
      __builtin_amdgcn_global_load_lds((const unsigned*)(u1 + v1), (unsigned*)(g_smem + (buf) + 16384 + i * 4096 + sb), 16, 0, 0);  \
    }                                                                                                            \
  } while (0)
  int kt = koff;
  GSTAGE(kt, 0);
  for (int t = 0; t < nk; ++t) {
    asm volatile("s_waitcnt vmcnt(0)" ::: "memory");
    __syncthreads();
    const int cur = (t & 1) * 32768;
    kt = kt + 1 == nk ? 0 : kt + 1;
    if (t + 1 < nk) GSTAGE(kt, 32768 - cur);
#pragma unroll
    for (int ks = 0; ks < 2; ++ks) {
      bf16x8 f0[4], f1[4];
#pragma unroll
      for (int m = 0; m < 4; ++m) f0[m] = *(const bf16x8*)(g_smem + cur + fa0 + m * 2048 + ks * 1024);
#pragma unroll
      for (int n = 0; n < 4; ++n) f1[n] = *(const bf16x8*)(g_smem + cur + fa1 + n * 2048 + ks * 1024);
#pragma unroll
      for (int m = 0; m < 4; ++m)
#pragma unroll
        for (int n = 0; n < 4; ++n) acc[m][n] = mfma16(f1[n], f0[m], acc[m][n]);
    }
  }
#undef GSTAGE
  __syncthreads();
}
DI void zero_acc(f32x4 (&acc)[4][4]) {
#pragma unroll
  for (int m = 0; m < 4; ++m)
#pragma unroll
    for (int n = 0; n < 4; ++n) acc[m][n] = f32x4{0.f, 0.f, 0.f, 0.f};
}

struct TJob { const float* src; u16* dst; int K, N, nb; };

DI void transpose_tile(int tid, const float* __restrict__ src, u16* __restrict__ dst, int K, int N, int k0, int n0) {
  float* tile = (float*)g_smem;
  {
    const int tr = tid >> 4, tc = tid & 15;
#pragma unroll
    for (int p = 0; p < 4; ++p) {
      int r = tr + 16 * p;
      f32x4 v = *(const f32x4*)(src + (size_t)(k0 + r) * N + n0 + tc * 4);
      tile[r * 65 + tc * 4 + 0] = v[0]; tile[r * 65 + tc * 4 + 1] = v[1];
      tile[r * 65 + tc * 4 + 2] = v[2]; tile[r * 65 + tc * 4 + 3] = v[3];
    }
  }
  __syncthreads();
  {
    const int tn = tid >> 3, tk = tid & 7;
#pragma unroll
    for (int p = 0; p < 2; ++p) {
      int n = tn + 32 * p;
      u32x4 o;
#pragma unroll
      for (int q = 0; q < 4; ++q) o[q] = pack2(tile[(tk * 8 + 2 * q) * 65 + n], tile[(tk * 8 + 2 * q + 1) * 65 + n]);
      *(u32x4*)(dst + (size_t)(n0 + n) * K + k0 + tk * 8) = o;
    }
  }
  __syncthreads();
}

DI void convert_chunks(int tid, const float* __restrict__ src, u16* __restrict__ dst, size_t n) {
  const size_t nch = n / 8192;
  for (size_t c = blockIdx.x; c < nch; c += gridDim.x) {
    size_t e = c * 8192 + tid * 8;
    f32x4 a[4], b[4];
#pragma unroll
    for (int q = 0; q < 4; ++q) { a[q] = __builtin_nontemporal_load((const f32x4*)(src + e + q * 2048)); b[q] = __builtin_nontemporal_load((const f32x4*)(src + e + q * 2048 + 4)); }
#pragma unroll
    for (int q = 0; q < 4; ++q) {
      u32x4 o;
      o[0] = pack2(a[q][0], a[q][1]); o[1] = pack2(a[q][2], a[q][3]); o[2] = pack2(b[q][0], b[q][1]); o[3] = pack2(b[q][2], b[q][3]);
      *(u32x4*)(dst + e + q * 2048) = o;
    }
  }
}

typedef float f32x2 __attribute__((ext_vector_type(2)));
DI void convert_rows_fp8(int tid, const float* __restrict__ src, unsigned char* __restrict__ dst, float* __restrict__ inv_scale, int nrows) {
  const int lane = tid & 63;
  const int gw = blockIdx.x * 4 + (tid >> 6), GW = gridDim.x * 4;
  for (int r0 = gw; r0 < nrows; r0 += 2 * GW) {
    int rws[2] = {r0, r0 + GW < nrows ? r0 + GW : r0};
    f32x4 v[2][4];
#pragma unroll
    for (int u = 0; u < 2; ++u)
#pragma unroll
      for (int q = 0; q < 4; ++q) v[u][q] = __builtin_nontemporal_load((const f32x4*)(src + (size_t)rws[u] * 1024 + lane * 16 + q * 4));
#pragma unroll
    for (int u = 0; u < 2; ++u) {
      float am = 0.f;
#pragma unroll
      for (int q = 0; q < 4; ++q)
#pragma unroll
        for (int j = 0; j < 4; ++j) am = fmaxf(am, fabsf(v[u][q][j]));
      am = row_max16(am);
      am = fmaxf(am, __shfl_xor(am, 16));
      am = fmaxf(am, __shfl_xor(am, 32));
      int ex = (int)((__float_as_uint(am) >> 23) & 0xff) - 127;
      int k = am > 0.f ? 7 - ex : 0;
      k = min(max(k, -100), 100);
      float sc = __uint_as_float((unsigned)(127 + k) << 23), isc = __uint_as_float((unsigned)(127 - k) << 23);
      u32x4 o;
#pragma unroll
      for (int q = 0; q < 4; ++q) {
        int w = __builtin_amdgcn_cvt_pk_fp8_f32(v[u][q][0] * sc, v[u][q][1] * sc, 0, false);
        w = __builtin_amdgcn_cvt_pk_fp8_f32(v[u][q][2] * sc, v[u][q][3] * sc, w, true);
        o[q] = (unsigned)w;
      }
      *(u32x4*)(dst + (size_t)rws[u] * 1024 + lane * 16) = o;
      if (lane == 0) inv_scale[rws[u]] = isc;
    }
  }
}

DI void convert_rows_fp8_wave(int lane, const float* __restrict__ src, unsigned char* __restrict__ dst, float* __restrict__ inv_scale, int r0, int r1) {
  for (int r = r0; r < r1; r += 2) {
    f32x4 v[2][4];
#pragma unroll
    for (int u = 0; u < 2; ++u)
#pragma unroll
      for (int q = 0; q < 4; ++q) v[u][q] = __builtin_nontemporal_load((const f32x4*)(src + (size_t)(r + u) * 1024 + lane * 16 + q * 4));
#pragma unroll
    for (int u = 0; u < 2; ++u) {
      float am = 0.f;
#pragma unroll
      for (int q = 0; q < 4; ++q)
#pragma unroll
        for (int j = 0; j < 4; ++j) am = fmaxf(am, fabsf(v[u][q][j]));
      am = row_max16(am);
      am = fmaxf(am, __shfl_xor(am, 16));
      am = fmaxf(am, __shfl_xor(am, 32));
      int ex = (int)((__float_as_uint(am) >> 23) & 0xff) - 127;
      int k = am > 0.f ? 7 - ex : 0;
      k = min(max(k, -100), 100);
      float sc = __uint_as_float((unsigned)(127 + k) << 23), isc = __uint_as_float((unsigned)(127 - k) << 23);
      u32x4 o;
#pragma unroll
      for (int q = 0; q < 4; ++q) {
        int w = __builtin_amdgcn_cvt_pk_fp8_f32(v[u][q][0] * sc, v[u][q][1] * sc, 0, false);
        w = __builtin_amdgcn_cvt_pk_fp8_f32(v[u][q][2] * sc, v[u][q][3] * sc, w, true);
        o[q] = (unsigned)w;
      }
      *(u32x4*)(dst + (size_t)(r + u) * 1024 + lane * 16) = o;
      if (lane == 0) inv_scale[r + u] = isc;
    }
  }
}

__device__ void phase_prep(const Params& p) {
  char* ws = opaque_ptr(p.ws);
  const int tid = opaque_tid(), wid = tid >> 6, lane = tid & 63;
  if (blockIdx.x == 0 && tid < 64) ((int*)(ws + O_CNT))[tid] = 0;
  if (blockIdx.x < 4) {
    int e = blockIdx.x * 256 + tid;
    int pos = e >> 4, f = e & 15;
    const float fr4[4] = {1.0f, 0.56234132519f, 0.316227766017f, 0.177827941004f};
    float sc = (f >> 2) == 0 ? 1.0f : (f >> 2) == 1 ? 0.1f : (f >> 2) == 2 ? 0.01f : 0.001f;
    float fsel = (f & 3) == 0 ? fr4[0] : (f & 3) == 1 ? fr4[1] : (f & 3) == 2 ? fr4[2] : fr4[3];
    float freq = fsel * sc;
    float ang = (float)pos * freq;
    double a = (double)ang;
    double k = rint(a * 0.15915494309189535);
    double r = a - k * 6.283185307179586;
    double r2 = r * r, ts = r, tc = 1.0, s = r, c = 1.0;
    for (int i = 1; i <= 14; ++i) {
      tc = -tc * r2 / (double)((2 * i - 1) * (2 * i));
      ts = -ts * r2 / (double)((2 * i) * (2 * i + 1));
      c += tc; s += ts;
    }
    float* rope = (float*)(ws + O_ROPE);
    rope[e * 2] = (float)c; rope[e * 2 + 1] = (float)s;
  }
  {
    float* sil = (float*)g_smem;
    float* part = (float*)(g_smem + 16384);
    const float* cvec = p.in[7];
    const float* cctx = p.in[8];
    bool have_sil = false;
    for (int it = blockIdx.x; it < 4 * 96; it += gridDim.x) {
      if (!have_sil) {
        for (int k = tid; k < 1024; k += 256) {
          float a = cctx[k], b = cvec[k], c2 = cvec[1024 + k];
          sil[k] = a * sigmoidf_(a); sil[1024 + k] = b * sigmoidf_(b); sil[2048 + k] = c2 * sigmoidf_(c2);
        }
        have_sil = true;
        __syncthreads();
      }
      int l = it / 96, n = (it % 96) * 64 + lane;
      const float* W = p.in[12] + (size_t)l * 1024 * 6144 + n;
      float a0 = 0.f, a1 = 0.f, a2 = 0.f;
      int kb = wid * 256;
#pragma unroll 8
      for (int k = 0; k < 256; ++k) {
        float w = W[(size_t)(kb + k) * 6144];
        a0 += w * sil[kb + k]; a1 += w * sil[1024 + kb + k]; a2 += w * sil[2048 + kb + k];
      }
      part[(wid * 3 + 0) * 64 + lane] = a0; part[(wid * 3 + 1) * 64 + lane] = a1; part[(wid * 3 + 2) * 64 + lane] = a2;
      __syncthreads();
      if (tid < 192) {
        int c = tid >> 6, ln = tid & 63;
        float s = part[(0 * 3 + c) * 64 + ln] + part[(1 * 3 + c) * 64 + ln] + part[(2 * 3 + c) * 64 + ln] + part[(3 * 3 + c) * 64 + ln];
        int nn = (it % 96) * 64 + ln;
        ((float*)(ws + O_MOD))[((size_t)l * 3 + c) * 6144 + nn] = s + p.in[13][(size_t)l * 6144 + nn];
      }
      __syncthreads();
    }
    __syncthreads();
  }
  {
    TJob jobs[11] = {
        {p.in[14], (u16*)(ws + O_WIN), 1024, 7296, 4},
        {p.in[16], (u16*)(ws + O_AOUT), 512, 1024, 4},
        {p.in[28], (u16*)(ws + O_RWOUT), 512, 1024, 4},
        {p.in[30], (u16*)(ws + O_NAOUT), 512, 1024, 4},
        {p.in[31], (u16*)(ws + O_WO), 1024, 1024, 4},
        {p.in[32], (u16*)(ws + O_PEQ), 1024, 2048, 4},
        {p.in[19], (u16*)(ws + O_W2), 64, 512, 8},
        {p.in[21], (u16*)(ws + O_A2), 64, 512, 8},
        {p.in[22], (u16*)(ws + O_G2), 128, 512, 4},
        {p.in[3], (u16*)(ws + O_CAVT), 512, 128, 8},
        {p.in[5], (u16*)(ws + O_CCVT), 512, 512, 8},
    };
#pragma unroll
    for (int j = 0; j < 11; ++j) {
      const int tk = jobs[j].K / 64, tn = jobs[j].N / 64, per = tk * tn, tot = per * jobs[j].nb;
      for (int t = blockIdx.x; t < tot; t += gridDim.x) {
        int b = t / per, r = t % per;
        int kt = r / tn, ntile = r % tn;
        size_t off = (size_t)b * jobs[j].K * jobs[j].N;
        transpose_tile(tid, jobs[j].src + off, jobs[j].dst + off, jobs[j].K, jobs[j].N, kt * 64, ntile * 64);
      }
    }
  }
  convert_chunks(tid, p.in[33], (u16*)(ws + O_SUBK), 4ull * 8 * 2 * 128 * 128);
  convert_chunks(tid, p.in[2], (u16*)(ws + O_CAK), 8ull * 512 * 128);
  convert_chunks(tid, p.in[4], (u16*)(ws + O_CCK), 8ull * 512 * 512);
  {
    float* X = (float*)(ws + O_X);
    const size_t nch = (size_t)NT * DM / 1024;
    for (size_t c = blockIdx.x; c < nch; c += gridDim.x) {
      size_t e = c * 1024 + tid * 4;
      const float* src = e < (size_t)NCTX * DM ? p.in[0] + e : p.in[1] + (e - (size_t)NCTX * DM);
      *(f32x4*)(X + e) = *(const f32x4*)src;
    }
  }
}

DI int tok_cond(int tok) { return tok < NCTX ? 0 : 1 + ((tok - NCTX) >> 11); }

DI void norm_row_store(const float (&x)[16], const float* __restrict__ g, const float* __restrict__ shift, const float* __restrict__ scale,
                       u16* __restrict__ hrow, int lane) {
  float ss = 0.f;
#pragma unroll
  for (int i = 0; i < 16; ++i) ss += x[i] * x[i];
  ss = wave_sum(ss);
  float rstd = rsqrtf(ss * (1.f / 1024.f) + 1e-6f);
#pragma unroll
  for (int hh = 0; hh < 2; ++hh) {
    int e0 = hh * 512 + lane * 8;
    float y[8];
#pragma unroll
    for (int i = 0; i < 8; ++i) {
      float v = x[hh * 8 + i] * rstd * g[e0 + i];
      y[i] = v * (1.f + scale[e0 + i]) + shift[e0 + i];
    }
    u32x4 o;
    o[0] = pack2(y[0], y[1]); o[1] = pack2(y[2], y[3]); o[2] = pack2(y[4], y[5]); o[3] = pack2(y[6], y[7]);
    *(u32x4*)(hrow + e0) = o;
  }
}

__device__ void phase_norm(const Params& p, int l, int which) {
  char* ws = opaque_ptr(p.ws);
  const int tid = opaque_tid();
  const int lane = tid & 63;
  const int gw = blockIdx.x * 4 + (tid >> 6), GW = gridDim.x * 4;
  const float* X = (const float*)(ws + O_X);
  const float* g = (which == 0 ? p.in[9] : p.in[10]) + l * 1024;
  for (int tok = gw; tok < NT; tok += GW) {
    const float* mod = (const float*)(ws + O_MOD) + ((size_t)l * 3 + tok_cond(tok)) * 6144 + which * 3 * 1024;
    float x[16];
#pragma unroll
    for (int hh = 0; hh < 2; ++hh) {
      f32x4 a = *(const f32x4*)(X + (size_t)tok * 1024 + hh * 512 + lane * 8);
      f32x4 b = *(const f32x4*)(X + (size_t)tok * 1024 + hh * 512 + lane * 8 + 4);
#pragma unroll
      for (int i = 0; i < 4; ++i) { x[hh * 8 + i] = a[i]; x[hh * 8 + 4 + i] = b[i]; }
    }
    norm_row_store(x, g, mod, mod + 1024, (u16*)(ws + O_H) + (size_t)tok * 1024, lane);
  }
}

__device__ void phase_gemm_in(const Params& p, int l) {
  char* ws = opaque_ptr(p.ws);
  const int tid = opaque_tid();
  const int wid = tid >> 6, lane = tid & 63, wr = wid >> 1, wc = wid & 1, fr = lane & 15, fq = lane >> 4;
  const u16* H = (const u16*)(ws + O_H);
  const u16* W = (const u16*)(ws + O_WIN) + (size_t)l * INC * 1024;
  const float* rope = (const float*)(ws + O_ROPE);
  float* out = p.out;
  for (int t = blockIdx.x; t < 64 * 57; t += gridDim.x) {
    const int tm = t & 63, tn = t >> 6;
    const int brow = tm * 128, bcol = tn * 128;
    const bool swapped = (tn == 5) || (tn >= 29 && tn < 33);
    const bool ctx = brow < NCTX;
    f32x4 acc[4][4];
    zero_acc(acc);
    const int koff = (((tm >> 3) + (tn & 7)) * 2) & 15;
    if (!swapped) gemm_main(tid, H + (size_t)brow * 1024, 1024, W + (size_t)bcol * 1024, 1024, 1024, acc, koff);
    else gemm_main(tid, W + (size_t)bcol * 1024, 1024, H + (size_t)brow * 1024, 1024, 1024, acc, koff);
    if (!swapped) {
#pragma unroll
      for (int m = 0; m < 4; ++m) {
        const int tok = brow + wr * 64 + m * 16 + fr;
        const int cb = bcol + wc * 64 + fq * 4;
        if (tn < 5) {
          if (!ctx) {
            int tt = (tok - NCTX) & 2047;
            int pos0 = tt >> 6, pos1 = tt & 63;
#pragma unroll
            for (int ax = 0; ax < 2; ++ax) {
              int pos = ax == 0 ? pos0 : pos1;
#pragma unroll
              for (int j = 0; j < 4; ++j) {
                float c = rope[(pos * 16 + fq * 4 + j) * 2], s = rope[(pos * 16 + fq * 4 + j) * 2 + 1];
                float x1 = acc[m][2 * ax][j], x2 = acc[m][2 * ax + 1][j];
                acc[m][2 * ax][j] = x1 * c - x2 * s;
                acc[m][2 * ax + 1][j] = x2 * c + x1 * s;
              }
            }
          }
          if (tn < 4) {
#pragma unroll
            for (int n = 0; n < 4; ++n) {
              u32x2 o; o[0] = pack2(acc[m][n][0] * 0.125f, acc[m][n][1] * 0.125f); o[1] = pack2(acc[m][n][2] * 0.125f, acc[m][n][3] * 0.125f);
              *(u32x2*)((u16*)(ws + O_QA) + (size_t)tok * 512 + cb + n * 16) = o;
            }
          } else {
#pragma unroll
            for (int n = 0; n < 4; ++n) {
              int c = cb + n * 16 - 512;
              u32x2 o; o[0] = pack2(acc[m][n][0], acc[m][n][1]); o[1] = pack2(acc[m][n][2], acc[m][n][3]);
              *(u32x2*)((u16*)(ws + O_KA) + (size_t)tok * 128 + c) = o;
              if (ctx) *(f32x4*)(out + OUT_AK + ((size_t)((tok >> 8) * 4 + l) * 256 + (tok & 255)) * 128 + c) = acc[m][n];
            }
          }
        } else if (tn < 21) {
#pragma unroll
          for (int n = 0; n < 4; ++n) *(f32x4*)((float*)(ws + O_PB) + (size_t)tok * 1920 + cb + n * 16 - 768) = acc[m][n];
        } else if (tn < 25) {
#pragma unroll
          for (int n = 0; n < 4; ++n) {
            u32x2 o; o[0] = pack2(acc[m][n][0] * 0.125f, acc[m][n][1] * 0.125f); o[1] = pack2(acc[m][n][2] * 0.125f, acc[m][n][3] * 0.125f);
            *(u32x2*)((u16*)(ws + O_QC) + (size_t)tok * 512 + cb + n * 16 - 2688) = o;
          }
        } else if (tn < 29) {
#pragma unroll
          for (int n = 0; n < 4; ++n) {
            int c = cb + n * 16 - 3200;
            u32x2 o; o[0] = pack2(acc[m][n][0], acc[m][n][1]); o[1] = pack2(acc[m][n][2], acc[m][n][3]);
            *(u32x2*)((u16*)(ws + O_KC) + (size_t)tok * 512 + c) = o;
            if (ctx) *(f32x4*)(out + OUT_CK + ((size_t)((tok >> 8) * 4 + l) * 256 + (tok & 255)) * 512 + c) = acc[m][n];
          }
        } else {
#pragma unroll
          for (int n = 0; n < 4; ++n) {
            u32x2 o; o[0] = pack2(sigmoidf_(acc[m][n][0]), sigmoidf_(acc[m][n][1])); o[1] = pack2(sigmoidf_(acc[m][n][2]), sigmoidf_(acc[m][n][3]));
            *(u32x2*)((u16*)(ws + O_GATE) + (size_t)tok * 3072 + cb + n * 16 - 4224) = o;
          }
        }
      }
    } else {
      const bool isA = (tn == 5);
      u16* VT = isA ? (u16*)(ws + O_VAT) : (u16*)(ws + O_VCT);
      const int ncols = isA ? 128 : 512;
      const size_t obase = isA ? OUT_AV : OUT_CV;
#pragma unroll
      for (int m = 0; m < 4; ++m) {
        const int c = (isA ? 0 : (tn - 29) * 128) + wr * 64 + m * 16 + fr;
#pragma unroll
        for (int n = 0; n < 4; ++n) {
          const int tk = brow + wc * 64 + n * 16 + fq * 4;
          u32x2 o; o[0] = pack2(acc[m][n][0], acc[m][n][1]); o[1] = pack2(acc[m][n][2], acc[m][n][3]);
          *(u32x2*)(VT + (size_t)c * NT + tk) = o;
          if (ctx) {
#pragma unroll
            for (int j = 0; j < 4; ++j) {
              int tok = tk + j;
              out[obase + ((size_t)((tok >> 8) * 4 + l) * 256 + (tok & 255)) * ncols + c] = acc[m][n][j];
            }
          }
        }
      }
    }
  }
}

__device__ void phase_rwkv_prep(const Params& p, int l) {
  char* ws = opaque_ptr(p.ws);
  const int tid = opaque_tid();
  const int lane = tid & 63;
  const int gw = blockIdx.x * 4 + (tid >> 6), GW = gridDim.x * 4;
  const float* PB = (const float*)(ws + O_PB);
  const float* mu = p.in[17] + l * 1920;
  const float* kkw = p.in[23] + l * 512;
  for (int tok = gw; tok < NT; tok += GW) {
    int pos, len;
    if (tok < NCTX) { pos = tok & 255; len = 256; } else { pos = (tok - NCTX) & 2047; len = 2048; }
    const bool hp = pos > 0, hn = pos < len - 1;
    const float* row = PB + (size_t)tok * 1920;
#pragma unroll
    for (int i = 0; i < 8; ++i) {
      int q = lane + 64 * i;
      if (q < 480) {
        int c = q * 4;
        f32x4 cur = *(const f32x4*)(row + c);
        f32x4 pv = hp ? *(const f32x4*)(row - 1920 + c) : f32x4{0.f, 0.f, 0.f, 0.f};
        f32x4 nv = hn ? *(const f32x4*)(row + 1920 + c) : f32x4{0.f, 0.f, 0.f, 0.f};
        f32x4 m4 = *(const f32x4*)(mu + c);
        f32x4 xb;
#pragma unroll
        for (int j = 0; j < 4; ++j) xb[j] = cur[j] + m4[j] * (0.5f * (pv[j] + nv[j]) - cur[j]);
        if (i < 6) {
          *(f32x4*)((float*)(ws + O_XRKV) + (size_t)tok * 1536 + c) = xb;
          if (i == 2 || i == 3) {
            int ck = c - 512;
            f32x4 kw = *(const f32x4*)(kkw + ck);
            f32x4 kv;
            float ss = 0.f;
#pragma unroll
            for (int j = 0; j < 4; ++j) { kv[j] = xb[j] * kw[j]; ss += kv[j] * kv[j]; }
            ss = row_sum16(ss);
            float rn = rsqrtf(ss + 1e-12f);
#pragma unroll
            for (int j = 0; j < 4; ++j) kv[j] *= rn;
            *(f32x4*)((float*)(ws + O_KK) + (size_t)tok * 512 + ck) = kv;
          }
        } else {
          u16* dst;
          int cc;
          float v[4];
          if (c < 1664) { dst = (u16*)(ws + O_TW); cc = c - 1536; for (int j = 0; j < 4; ++j) v[j] = tanhf(xb[j]); }
          else if (c < 1792) { dst = (u16*)(ws + O_AD); cc = c - 1664; for (int j = 0; j < 4; ++j) v[j] = xb[j]; }
          else { dst = (u16*)(ws + O_SG); cc = c - 1792; for (int j = 0; j < 4; ++j) v[j] = sigmoidf_(xb[j]); }
          u32x2 o; o[0] = pack2(v[0], v[1]); o[1] = pack2(v[2], v[3]);
          *(u32x2*)(dst + (size_t)tok * 128 + cc) = o;
        }
      }
    }
  }
}

__device__ void phase_rwkv_lora(const Params& p, int l) {
  char* ws = opaque_ptr(p.ws);
  const int tid = opaque_tid();
  const int wid = tid >> 6, lane = tid & 63, wr = wid >> 1, wc = wid & 1, fr = lane & 15, fq = lane >> 4;
  for (int t = blockIdx.x; t < 5 * 256; t += gridDim.x) {
    const int job = t >> 8, r = t & 255, tm = r & 63, tn = r >> 6;
    const int brow = tm * 128, bcol = tn * 128;
    f32x4 acc[4][4];
    zero_acc(acc);
    const int z = job & 1;
    if (job < 2) gemm_main(tid, (const u16*)(ws + O_TW) + (size_t)brow * 128 + z * 64, 128, (const u16*)(ws + O_W2) + ((size_t)(l * 2 + z) * 512 + bcol) * 64, 64, 64, acc);
    else if (job < 4) gemm_main(tid, (const u16*)(ws + O_AD) + (size_t)brow * 128 + z * 64, 128, (const u16*)(ws + O_A2) + ((size_t)(l * 2 + z) * 512 + bcol) * 64, 64, 64, acc);
    else gemm_main(tid, (const u16*)(ws + O_SG) + (size_t)brow * 128, 128, (const u16*)(ws + O_G2) + ((size_t)l * 512 + bcol) * 128, 128, 128, acc);
#pragma unroll
    for (int m = 0; m < 4; ++m) {
      const int tok = brow + wr * 64 + m * 16 + fr;
#pragma unroll
      for (int n = 0; n < 4; ++n) {
        const int c = bcol + wc * 64 + n * 16 + fq * 4;
        if (job < 2) {
          f32x4 w0 = *(const f32x4*)(p.in[18] + (size_t)(l * 2 + z) * 512 + c);
          f32x4 o;
#pragma unroll
          for (int j = 0; j < 4; ++j) {
            float val = w0[j] + acc[m][n][j];
            float y = -val;
            float sp = fmaxf(y, 0.f) + __logf(1.f + __expf(-fabsf(y)));
            float wlog = -sp - 0.5f;
            o[j] = __expf(-__expf(wlog));
          }
          *(f32x4*)((float*)(ws + O_DEC) + ((size_t)z * NT + tok) * 512 + c) = o;
        } else if (job < 4) {
          f32x4 a0 = *(const f32x4*)(p.in[20] + (size_t)(l * 2 + z) * 512 + c);
          f32x4 ka = *(const f32x4*)(p.in[24] + (size_t)l * 512 + c);
          f32x4 kx = *(const f32x4*)((const float*)(ws + O_XRKV) + (size_t)tok * 1536 + 512 + c);
          f32x4 kk = *(const f32x4*)((const float*)(ws + O_KK) + (size_t)tok * 512 + c);
          f32x4 okd, okka;
#pragma unroll
          for (int j = 0; j < 4; ++j) {
            float a = sigmoidf_(a0[j] + acc[m][n][j]);
            okd[j] = kx[j] * (1.f + (a - 1.f) * ka[j]);
            okka[j] = kk[j] * a;
          }
          *(f32x4*)((float*)(ws + O_KD) + ((size_t)z * NT + tok) * 512 + c) = okd;
          *(f32x4*)((float*)(ws + O_KKA) + ((size_t)z * NT + tok) * 512 + c) = okka;
        } else {
          *(f32x4*)((float*)(ws + O_GG) + (size_t)tok * 512 + c) = acc[m][n];
        }
      }
    }
  }
}

template <int JPL> struct ScanOps { float w[JPL], kd[JPL], kk[JPL], kka[JPL], r[JPL]; float v; };

template <int JPL>
DI void scan_load(ScanOps<JPL>& o, const float* __restrict__ dec, const float* __restrict__ kd, const float* __restrict__ kk,
                  const float* __restrict__ kka, const float* __restrict__ rr, const float* __restrict__ vv, int tok, int cj, int ci) {
  const size_t e = (size_t)tok * 512 + cj;
#pragma unroll
  for (int q = 0; q < JPL / 4; ++q) {
    f32x4 a = *(const f32x4*)(dec + e + q * 4), b = *(const f32x4*)(kd + e + q * 4), c = *(const f32x4*)(kk + e + q * 4),
          d = *(const f32x4*)(kka + e + q * 4), f = *(const f32x4*)(rr + (size_t)tok * 1536 + cj + q * 4);
#pragma unroll
    for (int j = 0; j < 4; ++j) { o.w[q * 4 + j] = a[j]; o.kd[q * 4 + j] = b[j]; o.kk[q * 4 + j] = c[j]; o.kka[q * 4 + j] = d[j]; o.r[q * 4 + j] = f[j]; }
  }
  o.v = vv[(size_t)tok * 1536 + 1024 + ci];
}

template <int JPL> DI float scan_red(float v) {
  v += dppf<0xB1>(v);
  v += dppf<0x4E>(v);
  if (JPL <= 8) v += dppf<0x141>(v);
  if (JPL <= 4) v += dppf<0x140>(v);
  return v;
}

template <int JPL>
DI void scan_step(float (&S)[JPL], const ScanOps<JPL>& o, float* __restrict__ y, int tok, int ci, bool wr) {
  float sa0 = 0.f, sa1 = 0.f;
#pragma unroll
  for (int j = 0; j < JPL; j += 2) { sa0 += S[j] * o.kk[j]; sa1 += S[j + 1] * o.kk[j + 1]; }
  float sa = -scan_red<JPL>(sa0 + sa1);
  float y0 = 0.f, y1 = 0.f;
#pragma unroll
  for (int j = 0; j < JPL; j += 2) {
    S[j] = S[j] * o.w[j] + (sa * o.kka[j] + o.v * o.kd[j]);
    S[j + 1] = S[j + 1] * o.w[j + 1] + (sa * o.kka[j + 1] + o.v * o.kd[j + 1]);
    y0 += S[j] * o.r[j]; y1 += S[j + 1] * o.r[j + 1];
  }
  float yv = scan_red<JPL>(y0 + y1);
  if (wr) y[(size_t)tok * 512 + ci] = yv;
}

template <int JPL, int D>
DI void scan_wave(char* ws, int lane, int z, int h, int tok0, int T, int rowbase, const float* __restrict__ s0, float* __restrict__ sout) {
  constexpr int LPR = 64 / JPL;
  const int rr = lane / LPR, pp = lane % LPR;
  const int i = rowbase + rr, j0 = pp * JPL;
  const int cj = h * 64 + j0, ci = h * 64 + i;
  const float* dec = (const float*)(ws + O_DEC) + (size_t)z * NT * 512;
  const float* kd = (const float*)(ws + O_KD) + (size_t)z * NT * 512;
  const float* kka = (const float*)(ws + O_KKA) + (size_t)z * NT * 512;
  const float* kk = (const float*)(ws + O_KK);
  const float* xr = (const float*)(ws + O_XRKV);
  float* y = (float*)(ws + O_YS) + (size_t)z * NT * 512;
  float S[JPL];
#pragma unroll
  for (int j = 0; j < JPL; ++j) S[j] = s0 ? s0[i * 64 + j0 + j] : 0.f;
  const int dir = z == 0 ? 1 : -1;
  const int first = z == 0 ? tok0 : tok0 + T - 1;
  const bool wr = pp == 0;
  ScanOps<JPL> R[D];
#pragma unroll
  for (int d = 0; d < D; ++d) scan_load<JPL>(R[d], dec, kd, kk, kka, xr, xr, first + dir * d, cj, ci);
  for (int n = 0; n < T; n += D) {
#pragma unroll
    for (int d = 0; d < D; ++d) {
      scan_step<JPL>(S, R[d], y, first + dir * (n + d), ci, wr);
      int nn = n + d + D;
      nn = nn < T ? nn : T - 1;
      scan_load<JPL>(R[d], dec, kd, kk, kka, xr, xr, first + dir * nn, cj, ci);
    }
  }
  if (sout) {
#pragma unroll
    for (int j = 0; j < JPL; ++j) sout[i * 64 + j0 + j] = S[j];
  }
}

DI void dma16(const char* gptr, unsigned ldsaddr) {
  asm volatile("s_mov_b32 m0, %0\n\ts_nop 0\n\tglobal_load_lds_dwordx4 %1, off" ::"s"(ldsaddr), "v"(gptr) : "memory");
}
template <int N> DI void wait_vm() { asm volatile("s_waitcnt vmcnt(%0)" ::"n"(N) : "memory"); }

template <int JPL> struct ScanRegs { float w[JPL], kd[JPL], kk[JPL], kka[JPL], r[JPL]; float v; };
template <int JPL> DI void scan_lds_read(ScanRegs<JPL>& o, const char* slot, int pp, int rr) {
#pragma unroll
  for (int q = 0; q < JPL / 4; ++q) {
    f32x4 a = *(const f32x4*)(slot + 0 + pp * JPL * 4 + q * 16), b = *(const f32x4*)(slot + 256 + pp * JPL * 4 + q * 16),
          c = *(const f32x4*)(slot + 512 + pp * JPL * 4 + q * 16), d = *(const f32x4*)(slot + 768 + pp * JPL * 4 + q * 16),
          f = *(const f32x4*)(slot + 1024 + pp * JPL * 4 + q * 16);
#pragma unroll
    for (int j = 0; j < 4; ++j) { o.w[q * 4 + j] = a[j]; o.kd[q * 4 + j] = b[j]; o.kk[q * 4 + j] = c[j]; o.kka[q * 4 + j] = d[j]; o.r[q * 4 + j] = f[j]; }
  }
  o.v = *(const float*)(slot + 1280 + rr * 4);
}
template <int JPL>
DI void scan_step2(float (&S)[JPL], const ScanRegs<JPL>& o, float* __restrict__ yp, bool wr) {
  float sa0 = 0.f, sa1 = 0.f;
#pragma unroll
  for (int j = 0; j < JPL; j += 2) { sa0 += S[j] * o.kk[j]; sa1 += S[j + 1] * o.kk[j + 1]; }
  float sa = -scan_red<JPL>(sa0 + sa1);
  float y0 = 0.f, y1 = 0.f;
#pragma unroll
  for (int j = 0; j < JPL; j += 2) {
    S[j] = sa * o.kka[j] + (S[j] * o.w[j] + o.v * o.kd[j]);
    S[j + 1] = sa * o.kka[j + 1] + (S[j + 1] * o.w[j + 1] + o.v * o.kd[j + 1]);
    y0 += S[j] * o.r[j]; y1 += S[j + 1] * o.r[j + 1];
  }
  float yv = scan_red<JPL>(y0 + y1);
  if (wr) *yp = yv;
}

template <int JPL, int NS>
DI void scan_wave_dma(char* ws, int lane, int ringoff, int z, int h, int tok0, int T, int rowbase, const float* __restrict__ s0,
                      float* __restrict__ sout) {
  constexpr int LPR = 64 / JPL, PD = NS - 1, WN = 3 * PD - 3;
  static_assert(WN <= 63, "vmcnt range");
  const int rr = lane / LPR, pp = lane % LPR;
  const int i = rowbase + rr, j0 = pp * JPL;
  const int dir = z == 0 ? 1 : -1;
  const int first = z == 0 ? tok0 : tok0 + T - 1;
  const bool wr = pp == 0;
  float S[JPL];
#pragma unroll
  for (int j = 0; j < JPL; ++j) S[j] = s0 ? s0[i * 64 + j0 + j] : 0.f;
  const int a = lane >> 4, c16 = lane & 15;
  const float* arr = a == 0 ? (const float*)(ws + O_DEC) + (size_t)z * NT * 512
                   : a == 1 ? (const float*)(ws + O_KD) + (size_t)z * NT * 512
                   : a == 2 ? (const float*)(ws + O_KK)
                            : (const float*)(ws + O_KKA) + (size_t)z * NT * 512;
  const char* gA = (const char*)(arr + (size_t)first * 512 + h * 64 + c16 * 4);
  const char* gB = (const char*)((const float*)(ws + O_XRKV) + (size_t)first * 1536 + (lane < 16 ? h * 64 + c16 * 4 : 1024 + h * 64 + rowbase + (lane - 16) * 4));
  const long stA = (long)dir * 2048, stB = (long)dir * 6144;
  const bool bact = lane < 16 + JPL / 4;
  ringoff = __builtin_amdgcn_readfirstlane(ringoff);
  const unsigned ring = (unsigned)(size_t)g_smem + (unsigned)ringoff;
  const char* ringp = g_smem + ringoff;
  float* yp = (float*)(ws + O_YS) + (size_t)z * NT * 512 + (size_t)first * 512 + h * 64 + i;
  const long sty = (long)dir * 512;
  float* dummy = (float*)(ws + O_MERG) + lane;
#pragma unroll 1
  for (int s = 0; s < PD; ++s) {
    unsigned slot = ring + (unsigned)(s & (NS - 1)) * 1536u;
    dma16(gA, slot);
    if (bact) dma16(gB, slot + 1024u);
    gA += stA; gB += stB;
    if (wr) dummy[s * 64] = 0.f;
  }
  ScanRegs<JPL> A, B;
  wait_vm<3 * PD - 3>();
  wait_vm<3 * (PD - 1)>();
  scan_lds_read<JPL>(A, ringp, pp, rr);
  for (int n = 0; n < T; n += 2) {
    {
      unsigned sl = (unsigned)((n + PD) & (NS - 1)) * 1536u;
      dma16(gA, ring + sl);
      if (bact) dma16(gB, ring + sl + 1024u);
      gA += stA; gB += stB;
      wait_vm<WN>();
      scan_lds_read<JPL>(B, ringp + ((n + 1) & (NS - 1)) * 1536, pp, rr);
      scan_step2<JPL>(S, A, yp, wr);
      yp += sty;
    }
    {
      unsigned sl = (unsigned)((n + 1 + PD) & (NS - 1)) * 1536u;
      dma16(gA, ring + sl);
      if (bact) dma16(gB, ring + sl + 1024u);
      gA += stA; gB += stB;
      wait_vm<WN>();
      scan_lds_read<JPL>(A, ringp + ((n + 2) & (NS - 1)) * 1536, pp, rr);
      scan_step2<JPL>(S, B, yp, wr);
      yp += sty;
    }
  }
  wait_vm<0>();
  if (sout) {
#pragma unroll
    for (int j = 0; j < JPL; ++j) sout[i * 64 + j0 + j] = S[j];
  }
}

template <int JPL>
DI void scan_dots(const float (&S)[JPL], const ScanRegs<JPL>& cur, const ScanRegs<JPL>& prv, float& d1, float& d2) {
  float a0 = 0.f, a1 = 0.f, b0 = 0.f, b1 = 0.f;
#pragma unroll
  for (int j = 0; j < JPL; j += 2) {
    a0 += S[j] * cur.kk[j]; b0 += S[j] * prv.r[j];
    a1 += S[j + 1] * cur.kk[j + 1]; b1 += S[j + 1] * prv.r[j + 1];
  }
  d1 = a0 + a1; d2 = b0 + b1;
}
template <int JPL> DI void scan_red2(float& a, float& b) {
  a += dppf<0xB1>(a); b += dppf<0xB1>(b);
  a += dppf<0x4E>(a); b += dppf<0x4E>(b);
  if (JPL <= 8) { a += dppf<0x141>(a); b += dppf<0x141>(b); }
  if (JPL <= 4) { a += dppf<0x140>(a); b += dppf<0x140>(b); }
}
template <int JPL> DI void scan_pre(float (&Tm)[JPL], const float (&S)[JPL], const ScanRegs<JPL>& o) {
#pragma unroll
  for (int j = 0; j < JPL; ++j) Tm[j] = S[j] * o.w[j] + o.v * o.kd[j];
}
template <int JPL> DI void scan_update(float (&S)[JPL], const float (&Tm)[JPL], const ScanRegs<JPL>& o, float sa) {
#pragma unroll
  for (int j = 0; j < JPL; ++j) S[j] = sa * o.kka[j] + Tm[j];
}

template <int JPL, int T>
DI void scan_latent_block(char* ws, int tid, int z, int h, int tok0, int rowblock, const float* __restrict__ s0, float* __restrict__ sout) {
  constexpr int LPR = 64 / JPL, G = 7, WNV = 6 * G - 2;
  const int wid = __builtin_amdgcn_readfirstlane(tid >> 6), lane = tid & 63;
  const int rr = lane / LPR, pp = lane % LPR;
  const int rloc = wid * JPL + rr;
  const int i = rowblock + rloc, j0 = pp * JPL;
  const int dir = z == 0 ? 1 : -1;
  const int first = z == 0 ? tok0 : tok0 + T - 1;
  const bool wr = pp == 0;
  float S[JPL];
#pragma unroll
  for (int j = 0; j < JPL; ++j) S[j] = s0 ? s0[i * 64 + j0 + j] : 0.f;
  const int a = lane >> 4, c16 = lane & 15;
  const float* arr = a == 0 ? (const float*)(ws + O_DEC) + (size_t)z * NT * 512
                   : a == 1 ? (const float*)(ws + O_KD) + (size_t)z * NT * 512
                   : a == 2 ? (const float*)(ws + O_KK)
                            : (const float*)(ws + O_KKA) + (size_t)z * NT * 512;
  const int fw = first + dir * wid;
  const char* gA = (const char*)(arr + (size_t)fw * 512 + h * 64 + c16 * 4);
  const char* gB = (const char*)((const float*)(ws + O_XRKV) + (size_t)fw * 1536 + (lane < 16 ? h * 64 + c16 * 4 : 1024 + h * 64 + rowblock + (lane - 16) * 4));
  const long stA = (long)dir * 4 * 2048, stB = (long)dir * 4 * 6144;
  const bool bact = lane < 16 + JPL;
  const unsigned ring = (unsigned)(size_t)g_smem;
  const char* ringp = g_smem;
  float* yp = (float*)(ws + O_YS) + (size_t)z * NT * 512 + (size_t)first * 512 + h * 64 + i;
  const long sty = (long)dir * 512;
  float* dummy = (float*)(ws + O_MERG) + tid;
#pragma unroll 1
  for (int g = 0; g < G; ++g) {
    unsigned slot = ring + (unsigned)((4 * g + wid) & 31) * 1536u;
    dma16(gA, slot);
    if (bact) dma16(gB, slot + 1024u);
    gA += stA; gB += stB;
    if (wr) { dummy[(g * 4 + 0) * 256] = 0.f; }
    if (wr) { dummy[(g * 4 + 1) * 256] = 0.f; }
    if (wr) { dummy[(g * 4 + 2) * 256] = 0.f; }
    if (wr) { dummy[(g * 4 + 3) * 256] = 0.f; }
    asm volatile("" ::: "memory");
  }
  ScanRegs<JPL> A, B;
#pragma unroll
  for (int j = 0; j < JPL; ++j) B.r[j] = 0.f;
  float* ypv = dummy + 28 * 256;
  wait_vm<WNV>();
  asm volatile("" ::: "memory");
  __builtin_amdgcn_s_barrier();
  asm volatile("" ::: "memory");
  scan_lds_read<JPL>(A, ringp, pp, rloc);
#pragma unroll 1
  for (int g = 0; g < T / 4; ++g) {
    wait_vm<WNV - 6>();

    asm volatile("" ::: "memory");
    __builtin_amdgcn_s_barrier();
    asm volatile("" ::: "memory");
    {
      unsigned slot = ring + (unsigned)((4 * (g + G) + wid) & 31) * 1536u;
      dma16(gA, slot);
      if (bact) dma16(gB, slot + 1024u);
      gA += stA; gB += stB;
    }
    const char* gp = ringp + ((4 * g) & 31) * 1536;
    if (JPL >= 8) {
#pragma unroll
      for (int k = 0; k < 4; ++k) {
        scan_lds_read<JPL>(A, gp + k * 1536, pp, rloc);
        scan_step2<JPL>(S, A, yp, wr);
        yp += sty;
        asm volatile("" ::: "memory");
      }
      continue;
    }
    float d1, y0, y1, y2, y3;
    float Tm[JPL];
    scan_dots<JPL>(S, A, B, d1, y0);
    scan_pre<JPL>(Tm, S, A);
    scan_lds_read<JPL>(B, gp + 1536, pp, rloc);
    scan_red2<JPL>(d1, y0);
    scan_update<JPL>(S, Tm, A, -d1);
    scan_dots<JPL>(S, B, A, d1, y1);
    scan_pre<JPL>(Tm, S, B);
    scan_lds_read<JPL>(A, gp + 2 * 1536, pp, rloc);
    scan_red2<JPL>(d1, y1);
    scan_update<JPL>(S, Tm, B, -d1);
    scan_dots<JPL>(S, A, B, d1, y2);
    scan_pre<JPL>(Tm, S, A);
    scan_lds_read<JPL>(B, gp + 3 * 1536, pp, rloc);
    scan_red2<JPL>(d1, y2);
    scan_update<JPL>(S, Tm, A, -d1);
    scan_dots<JPL>(S, B, A, d1, y3);
    scan_pre<JPL>(Tm, S, B);
    scan_lds_read<JPL>(A, ringp + ((4 * g + 4) & 31) * 1536, pp, rloc);
    scan_red2<JPL>(d1, y3);
    scan_update<JPL>(S, Tm, B, -d1);
    if (wr) {
      *ypv = y0;
      yp[0] = y1;
      yp[sty] = y2;
      yp[2 * sty] = y3;
    }
    ypv = yp + 3 * sty;
    yp += 4 * sty;
    asm volatile("" ::: "memory");
  }
  {
    float e0 = 0.f, e1 = 0.f;
#pragma unroll
    for (int j = 0; j < JPL; j += 2) { e0 += S[j] * B.r[j]; e1 += S[j + 1] * B.r[j + 1]; }
    float yv = scan_red<JPL>(e0 + e1);
    if (wr) *ypv = yv;
  }
  wait_vm<0>();
  asm volatile("" ::: "memory");
  __builtin_amdgcn_s_barrier();
  asm volatile("" ::: "memory");
  if (sout) {
#pragma unroll
    for (int j = 0; j < JPL; ++j) sout[i * 64 + j0 + j] = S[j];
  }
}

struct AttnSt { float m, l; f32x4 o[4]; };

struct AttnKVF { bf16x8 k[2][2]; bf16x8 v[4]; };
DI void attn_kvload(AttnKVF& f, const u16* __restrict__ kp, int ldk, const u16* __restrict__ vtp, int ldv, int fr, int fq) {
#pragma unroll
  for (int kt = 0; kt < 2; ++kt)
#pragma unroll
    for (int ks = 0; ks < 2; ++ks) f.k[kt][ks] = *(const bf16x8*)(kp + (size_t)(8 * (fr >> 2) + 4 * kt + (fr & 3)) * ldk + ks * 32 + fq * 8);
#pragma unroll
  for (int dt = 0; dt < 4; ++dt) f.v[dt] = *(const bf16x8*)(vtp + (size_t)(dt * 16 + fr) * ldv + fq * 8);
}
template <int MODE>
DI void attn_core(AttnSt& st, const bf16x8 (&qf)[2], const AttnKVF& f, int fr, int fq, int qpos, int kpos0, const float* __restrict__ rpbrow) {
  f32x4 s[2];
#pragma unroll
  for (int kt = 0; kt < 2; ++kt) {
    s[kt] = f32x4{0.f, 0.f, 0.f, 0.f};
#pragma unroll
    for (int ks = 0; ks < 2; ++ks) s[kt] = mfma16(f.k[kt][ks], qf[ks], s[kt]);
  }
  if (MODE != 0) {
#pragma unroll
    for (int kt = 0; kt < 2; ++kt)
#pragma unroll
      for (int j = 0; j < 4; ++j) {
        int kpos = kpos0 + 8 * fq + 4 * kt + j;
        if (MODE == 1) {
          int d = qpos - kpos;
          if (d > 128 || d < -128) s[kt][j] = -1e30f;
        } else {
          int cs = min(max(qpos - 8, 0), 48);
          int dc = min(max(kpos - qpos, -15), 15) + 15;
          float b = rpbrow[dc];
          s[kt][j] = (kpos >= cs && kpos < cs + 16) ? s[kt][j] + b : -1e30f;
        }
      }
  }
  float mx = fmaxf(fmaxf(fmaxf(s[0][0], s[0][1]), fmaxf(s[0][2], s[0][3])), fmaxf(fmaxf(s[1][0], s[1][1]), fmaxf(s[1][2], s[1][3])));
  mx = fmaxf(mx, __shfl_xor(mx, 16));
  mx = fmaxf(mx, __shfl_xor(mx, 32));
  float mn = fmaxf(st.m, mx);
  float alpha = __expf(st.m - mn);
  st.m = mn;
  float ps = 0.f;
  float pv[8];
#pragma unroll
  for (int kt = 0; kt < 2; ++kt)
#pragma unroll
    for (int j = 0; j < 4; ++j) { float e = __expf(s[kt][j] - mn); pv[kt * 4 + j] = e; ps += e; }
  st.l = st.l * alpha + ps;
  u32x4 pk;
  pk[0] = pack2(pv[0], pv[1]); pk[1] = pack2(pv[2], pv[3]); pk[2] = pack2(pv[4], pv[5]); pk[3] = pack2(pv[6], pv[7]);
  bf16x8 pf = __builtin_bit_cast(bf16x8, pk);
#pragma unroll
  for (int dt = 0; dt < 4; ++dt) {
    bf16x8 vf = f.v[dt];
#pragma unroll
    for (int j = 0; j < 4; ++j) st.o[dt][j] *= alpha;
    st.o[dt] = mfma16(vf, pf, st.o[dt]);
  }
}

DI void attn_item(const Params& p, char* ws, int lane, int l, int item) {
  const int fr = lane & 15, fq = lane >> 4;
  const int type = item >> 10, r = item & 1023;
  const int h = r & 7, qp = r >> 3;
  AttnSt st[2];
  const u16* Q;
  u16* Y;
  if (type == 0 || type == 2) { Q = (const u16*)(ws + O_QA); Y = (u16*)(ws + O_YABC); }
  else { Q = (const u16*)(ws + O_QC); Y = (u16*)(ws + O_YABC) + 2ull * NT * 512; }
  const int tok0 = (type < 2 ? NCTX : 0) + qp * 32;
  bf16x8 qf[2][2];
  const bool hasSink = (type == 0 || type == 2);
#pragma unroll
  for (int i = 0; i < 2; ++i) {
#pragma unroll
    for (int dt = 0; dt < 4; ++dt) st[i].o[dt] = f32x4{0.f, 0.f, 0.f, 0.f};
#pragma unroll
    for (int ks = 0; ks < 2; ++ks) qf[i][ks] = *(const bf16x8*)(Q + (size_t)(tok0 + i * 16 + fr) * 512 + h * 64 + ks * 32 + fq * 8);
    if (hasSink) { st[i].m = p.in[15][l * 8 + h]; st[i].l = fq == 0 ? 1.f : 0.f; }
    else { st[i].m = -1e30f; st[i].l = 0.f; }
  }
  AttnKVF f;
  if (type == 0) {
    const int qt = qp * 2;
    const int b = qt >> 7, kv = h >> 2;
    const u16* ck = (const u16*)(ws + O_CAK) + ((size_t)(b * 4 + l) * 512) * 128 + kv * 64;
    const u16* cvt = (const u16*)(ws + O_CAVT) + ((size_t)(b * 4 + l) * 128 + kv * 64) * 512;
    for (int p0 = 0; p0 < 512; p0 += 32) {
      attn_kvload(f, ck + (size_t)p0 * 128, 128, cvt + p0, 512, fr, fq);
      attn_core<0>(st[0], qf[0], f, fr, fq, 0, 0, nullptr);
      attn_core<0>(st[1], qf[1], f, fr, fq, 0, 0, nullptr);
    }
    const u16* K = (const u16*)(ws + O_KA) + (size_t)(NCTX + b * 2048) * 128 + kv * 64;
    const u16* VT = (const u16*)(ws + O_VAT) + (size_t)(kv * 64) * NT + NCTX + b * 2048;
    const int ta = (qt & 127) * 16;
    const int kb0 = max(0, ((ta - 128) >> 5) << 5), kb1 = min(2048, ta + 32 + 128);
    for (int k0 = kb0; k0 < kb1; k0 += 32) {
      attn_kvload(f, K + (size_t)k0 * 128, 128, VT + k0, NT, fr, fq);
      attn_core<1>(st[0], qf[0], f, fr, fq, ta + fr, k0, nullptr);
      attn_core<1>(st[1], qf[1], f, fr, fq, ta + 16 + fr, k0, nullptr);
    }
  } else if (type == 1) {
    const int qt = qp * 2;
    const int b = qt >> 7;
    const u16* ck = (const u16*)(ws + O_CCK) + ((size_t)(b * 4 + l) * 512) * 512 + h * 64;
    const u16* cvt = (const u16*)(ws + O_CCVT) + ((size_t)(b * 4 + l) * 512 + h * 64) * 512;
    for (int p0 = 0; p0 < 512; p0 += 32) {
      attn_kvload(f, ck + (size_t)p0 * 512, 512, cvt + p0, 512, fr, fq);
      attn_core<0>(st[0], qf[0], f, fr, fq, 0, 0, nullptr);
      attn_core<0>(st[1], qf[1], f, fr, fq, 0, 0, nullptr);
    }
    const u16* K = (const u16*)(ws + O_KC) + (size_t)(NCTX + b * 2048) * 512 + h * 64;
    const u16* VT = (const u16*)(ws + O_VCT) + (size_t)(h * 64) * NT + NCTX + b * 2048;
    const float* rpb = p.in[29] + (size_t)(l * 8 + h) * 15 * 31;
#pragma unroll
    for (int i = 0; i < 2; ++i) {
      const int t0 = ((qt + i) & 127) * 16;
      const int qrow = t0 >> 6, c0 = t0 & 63;
      const int rs = min(max(qrow - 4, 0), 24);
      const int cstart = min(max(c0 - 8, 0), 32);
      for (int a = 0; a < 8; ++a) {
        int krow = rs + a;
        int k0 = krow * 64 + cstart;
        attn_kvload(f, K + (size_t)k0 * 512, 512, VT + k0, NT, fr, fq);
        attn_core<2>(st[i], qf[i], f, fr, fq, c0 + fr, cstart, rpb + (krow - qrow + 7) * 31);
      }
    }
  } else if (type == 2) {
    const int b = (qp * 2) >> 4, kv = h >> 2;
    const u16* K = (const u16*)(ws + O_KA) + (size_t)(b * 256) * 128 + kv * 64;
    const u16* VT = (const u16*)(ws + O_VAT) + (size_t)(kv * 64) * NT + b * 256;
    for (int k0 = 0; k0 < 256; k0 += 32) {
      attn_kvload(f, K + (size_t)k0 * 128, 128, VT + k0, NT, fr, fq);
      attn_core<0>(st[0], qf[0], f, fr, fq, 0, 0, nullptr);
      attn_core<0>(st[1], qf[1], f, fr, fq, 0, 0, nullptr);
    }
  } else {
    const int b = (qp * 2) >> 4;
    const u16* K = (const u16*)(ws + O_KC) + (size_t)(b * 256) * 512 + h * 64;
    const u16* VT = (const u16*)(ws + O_VCT) + (size_t)(h * 64) * NT + b * 256;
    for (int k0 = 0; k0 < 256; k0 += 32) {
      attn_kvload(f, K + (size_t)k0 * 512, 512, VT + k0, NT, fr, fq);
      attn_core<0>(st[0], qf[0], f, fr, fq, 0, 0, nullptr);
      attn_core<0>(st[1], qf[1], f, fr, fq, 0, 0, nullptr);
    }
  }
#pragma unroll
  for (int i = 0; i < 2; ++i) {
    float lt = st[i].l;
    lt += __shfl_xor(lt, 16);
    lt += __shfl_xor(lt, 32);
    float inv = 1.f / lt;
#pragma unroll
    for (int dt = 0; dt < 4; ++dt) {
      u32x2 o; o[0] = pack2(st[i].o[dt][0] * inv, st[i].o[dt][1] * inv); o[1] = pack2(st[i].o[dt][2] * inv, st[i].o[dt][3] * inv);
      *(u32x2*)(Y + (size_t)(tok0 + i * 16 + fr) * 512 + h * 64 + dt * 16 + fq * 4) = o;
    }
  }
}


__device__ void phase_mix(const Params& p, int l) {
  char* ws = opaque_ptr(p.ws);
  const int tid = opaque_tid();
  const int wid = tid >> 6, lane = tid & 63;
  constexpr int LJPL = 4;
  constexpr int BPS = 64 / (4 * LJPL);
  const int NLB = (int)gridDim.x >= 2 * 32 * BPS ? 32 * BPS : 0;
  if ((int)blockIdx.x < NLB) {
    __builtin_amdgcn_s_setprio(3);
    const int it = blockIdx.x;
    const int sc = it / BPS, hf = it % BPS;
    const int z = sc & 1, h = (sc >> 1) & 7, b = sc >> 4;
    const float* s0 = p.in[6] + ((size_t)((b * 4 + l) * 2 + z) * 8 + h) * 4096;
    scan_latent_block<LJPL, 2048>(ws, tid, z, h, NCTX + b * 2048, hf * 4 * LJPL, s0, nullptr);
  } else {
    __builtin_amdgcn_s_setprio(1);
    if (NLB == 0) {
      for (int it = blockIdx.x * 4 + wid; it < 256; it += gridDim.x * 4) {
        int sc = it >> 3, part = it & 7;
        int z = sc & 1, h = (sc >> 1) & 7, b = sc >> 4;
        const float* s0 = p.in[6] + ((size_t)((b * 4 + l) * 2 + z) * 8 + h) * 4096;
        scan_wave_dma<8, 8>(ws, lane, wid * 12288, z, h, NCTX + b * 2048, 2048, part * 8, s0, nullptr);
      }
    }
    if (NLB > 0) {
      const int nab = (int)gridDim.x - NLB;
      for (int it = (int)blockIdx.x - NLB; it < 512; it += nab) {
        int sc = it >> 1, hf = it & 1;
        int z = sc & 1, h = (sc >> 1) & 7, b = sc >> 4;
        float* so = p.out + OUT_ST + ((size_t)((b * 4 + l) * 2 + z) * 8 + h) * 4096;
        scan_latent_block<8, 256>(ws, tid, z, h, b * 256, hf * 32, nullptr, so);
      }
    } else {
      const int nw = gridDim.x * 4;
      for (int it = (int)blockIdx.x * 4 + wid; it < 2048; it += nw) {
        int sc = it >> 3, part = it & 7;
        int z = sc & 1, h = (sc >> 1) & 7, b = sc >> 4;
        float* so = p.out + OUT_ST + ((size_t)((b * 4 + l) * 2 + z) * 8 + h) * 4096;
        scan_wave_dma<8, 8>(ws, lane, wid * 12288, z, h, b * 256, 256, part * 8, nullptr, so);
      }
    }
  }
  __builtin_amdgcn_s_setprio(0);
  int* cnt = (int*)(ws + O_CNT) + l;
  while (true) {
    int it = 0;
    if (lane == 0) it = atomicAdd(cnt, 1);
    it = __builtin_amdgcn_readfirstlane(it);
    if (it >= 4096) break;
    attn_item(p, ws, lane, l, it);
  }
  if (l == 0) {
    int* cnt2 = (int*)(ws + O_CNT) + 8;
    while (true) {
      int it = 0;
      if (lane == 0) it = atomicAdd(cnt2, 1);
      it = __builtin_amdgcn_readfirstlane(it);
      if (it >= 4096) break;
      const int tab = it >> 11, rb = (it & 2047) * 32;
      if (tab == 0) convert_rows_fp8_wave(lane, p.in[34], (unsigned char*)(ws + O_PEU), (float*)(ws + O_SCU), rb, rb + 32);
      else convert_rows_fp8_wave(lane, p.in[35], (unsigned char*)(ws + O_PEV), (float*)(ws + O_SCV), rb, rb + 32);
    }
  }
}

__device__ void phase_rwkv_post(const Params& p, int l) {
  char* ws = opaque_ptr(p.ws);
  const int tid = opaque_tid();
  const int lane = tid & 63;
  const int gw = blockIdx.x * 4 + (tid >> 6), GW = gridDim.x * 4;
  const float* Y0 = (const float*)(ws + O_YS);
  const float* Y1 = Y0 + (size_t)NT * 512;
  const float* KD0 = (const float*)(ws + O_KD);
  const float* KD1 = KD0 + (size_t)NT * 512;
  for (int tok = gw; tok < NT; tok += GW) {
#pragma unroll
    for (int i = 0; i < 2; ++i) {
      int c = (lane + 64 * i) * 4;
      size_t e = (size_t)tok * 512 + c;
      f32x4 a = *(const f32x4*)(Y0 + e), b = *(const f32x4*)(Y1 + e);
      f32x4 y;
      float s = 0.f;
#pragma unroll
      for (int j = 0; j < 4; ++j) { y[j] = a[j] + b[j]; s += y[j]; }
      float mu = row_sum16(s) * (1.f / 64.f);
      float vs = 0.f;
#pragma unroll
      for (int j = 0; j < 4; ++j) { y[j] -= mu; vs += y[j] * y[j]; }
      float var = row_sum16(vs) * (1.f / 64.f);
      float rstd = rsqrtf(var + 64e-5f);
      f32x4 g = *(const f32x4*)(p.in[26] + l * 512 + c), bb = *(const f32x4*)(p.in[27] + l * 512 + c);
      f32x4 r = *(const f32x4*)((const float*)(ws + O_XRKV) + (size_t)tok * 1536 + c);
      f32x4 v = *(const f32x4*)((const float*)(ws + O_XRKV) + (size_t)tok * 1536 + 1024 + c);
      f32x4 k0 = *(const f32x4*)(KD0 + e), k1 = *(const f32x4*)(KD1 + e);
      f32x4 rk = *(const f32x4*)(p.in[25] + l * 512 + c);
      float bs = 0.f;
#pragma unroll
      for (int j = 0; j < 4; ++j) bs += r[j] * (k0[j] + k1[j]) * rk[j];
      bs = row_sum16(bs);
      f32x4 gg = *(const f32x4*)((const float*)(ws + O_GG) + e);
      float o[4];
#pragma unroll
      for (int j = 0; j < 4; ++j) o[j] = (y[j] * rstd * g[j] + bb[j] + bs * v[j]) * gg[j];
      u32x2 ov; ov[0] = pack2(o[0], o[1]); ov[1] = pack2(o[2], o[3]);
      *(u32x2*)((u16*)(ws + O_YABC) + (size_t)NT * 512 + e) = ov;
    }
  }
}

__device__ void phase_branch(const Params& p, int l) {
  char* ws = opaque_ptr(p.ws);
  const int tid = opaque_tid();
  const int wid = tid >> 6, lane = tid & 63, wr = wid >> 1, wc = wid & 1, fr = lane & 15, fq = lane >> 4;
  const u16* G = (const u16*)(ws + O_GATE);
  for (int t = blockIdx.x; t < 64 * 8; t += gridDim.x) {
    const int tm = t & 63, tn = t >> 6;
    const int brow = tm * 128, bcol = tn * 128;
    f32x4 tot[4][4];
    zero_acc(tot);
#pragma unroll 1
    for (int br = 0; br < 3; ++br) {
      f32x4 acc[4][4];
      zero_acc(acc);
      const u16* Wb = (const u16*)(ws + (br == 0 ? O_AOUT : br == 1 ? O_RWOUT : O_NAOUT)) + ((size_t)l * 1024 + bcol) * 512;
      gemm_main(tid, (const u16*)(ws + O_YABC) + (size_t)br * NT * 512 + (size_t)brow * 512, 512, Wb, 512, 512, acc, ((tm >> 3) + (tn & 7)) & 7);
#pragma unroll
      for (int m = 0; m < 4; ++m) {
        const int tok = brow + wr * 64 + m * 16 + fr;
#pragma unroll
        for (int n = 0; n < 4; ++n) {
          const int c = bcol + wc * 64 + n * 16 + fq * 4;
          u32x2 gv = *(const u32x2*)(G + (size_t)tok * 3072 + br * 1024 + c);
          tot[m][n][0] += acc[m][n][0] * __uint_as_float(gv[0] << 16);
          tot[m][n][1] += acc[m][n][1] * __uint_as_float(gv[0] & 0xffff0000u);
          tot[m][n][2] += acc[m][n][2] * __uint_as_float(gv[1] << 16);
          tot[m][n][3] += acc[m][n][3] * __uint_as_float(gv[1] & 0xffff0000u);
        }
      }
    }
#pragma unroll
    for (int m = 0; m < 4; ++m) {
      const int tok = brow + wr * 64 + m * 16 + fr;
#pragma unroll
      for (int n = 0; n < 4; ++n) {
        const int c = bcol + wc * 64 + n * 16 + fq * 4;
        u32x2 o; o[0] = pack2(tot[m][n][0], tot[m][n][1]); o[1] = pack2(tot[m][n][2], tot[m][n][3]);
        *(u32x2*)((u16*)(ws + O_MERG) + (size_t)tok * 1024 + c) = o;
      }
    }
  }
}

__device__ void phase_wo(const Params& p, int l) {
  char* ws = opaque_ptr(p.ws);
  const int tid = opaque_tid();
  const int wid = tid >> 6, lane = tid & 63, wr = wid >> 1, wc = wid & 1, fr = lane & 15, fq = lane >> 4;
  float* X = (float*)(ws + O_X);
  for (int t = blockIdx.x; t < 64 * 8; t += gridDim.x) {
    const int tm = t & 63, tn = t >> 6;
    const int brow = tm * 128, bcol = tn * 128;
    f32x4 acc[4][4];
    zero_acc(acc);
    gemm_main(tid, (const u16*)(ws + O_MERG) + (size_t)brow * 1024, 1024, (const u16*)(ws + O_WO) + ((size_t)l * 1024 + bcol) * 1024, 1024, 1024, acc, (((tm >> 3) + (tn & 7)) * 2) & 15);
#pragma unroll
    for (int m = 0; m < 4; ++m) {
      const int tok = brow + wr * 64 + m * 16 + fr;
      const float* gate = (const float*)(ws + O_MOD) + ((size_t)l * 3 + tok_cond(tok)) * 6144 + 2 * 1024;
#pragma unroll
      for (int n = 0; n < 4; ++n) {
        const int c = bcol + wc * 64 + n * 16 + fq * 4;
        f32x4 x = *(f32x4*)(X + (size_t)tok * 1024 + c);
        f32x4 g = *(const f32x4*)(gate + c);
#pragma unroll
        for (int j = 0; j < 4; ++j) x[j] += g[j] * acc[m][n][j];
        *(f32x4*)(X + (size_t)tok * 1024 + c) = x;
      }
    }
  }
}

__device__ void phase_peq(const Params& p, int l) {
  char* ws = opaque_ptr(p.ws);
  const int tid = opaque_tid();
  const int wid = tid >> 6, lane = tid & 63, wr = wid >> 1, wc = wid & 1, fr = lane & 15, fq = lane >> 4;
  for (int t = blockIdx.x; t < 64 * 16; t += gridDim.x) {
    const int tm = t & 63, tn = t >> 6;
    const int brow = tm * 128, bcol = tn * 128;
    f32x4 acc[4][4];
    zero_acc(acc);
    gemm_main(tid, (const u16*)(ws + O_H) + (size_t)brow * 1024, 1024, (const u16*)(ws + O_PEQ) + ((size_t)l * 2048 + bcol) * 1024, 1024, 1024, acc, (((tm >> 3) + (tn & 7)) * 2) & 15);
#pragma unroll
    for (int m = 0; m < 4; ++m) {
      const int tok = brow + wr * 64 + m * 16 + fr;
#pragma unroll
      for (int n = 0; n < 4; ++n) {
        const int c = bcol + wc * 64 + n * 16 + fq * 4;
        u32x2 o; o[0] = pack2(acc[m][n][0], acc[m][n][1]); o[1] = pack2(acc[m][n][2], acc[m][n][3]);
        *(u32x2*)((u16*)(ws + O_PQ) + (size_t)tok * 2048 + c) = o;
      }
    }
  }
}

__device__ const unsigned char kCand[64] = {
    0x00, 0x01, 0x02, 0x03, 0x04, 0x05, 0x06, 0x07, 0x08, 0x09, 0x0a, 0x0b, 0x0c, 0x0d, 0x0e, 0x0f,
    0x10, 0x11, 0x12, 0x13, 0x14, 0x15, 0x16, 0x17, 0x20, 0x21, 0x22, 0x23, 0x24, 0x30, 0x31, 0x32,
    0x33, 0x40, 0x41, 0x42, 0x50, 0x51, 0x60, 0x61, 0x70, 0x71, 0x80, 0x90, 0xa0, 0xb0, 0xc0, 0xd0,
    0xe0, 0xf0, 0xff, 0xff, 0xff, 0xff, 0xff, 0xff, 0xff, 0xff, 0xff, 0xff, 0xff, 0xff, 0xff, 0xff};

DI unsigned f2key(float f) { unsigned u = __float_as_uint(f); return (u & 0x80000000u) ? ~u : (u | 0x80000000u); }
DI float key2f(unsigned k) { unsigned u = (k & 0x80000000u) ? (k & 0x7fffffffu) : ~k; return __uint_as_float(u); }
template <int CTRL> DI unsigned dppu(unsigned v) { return (unsigned)__builtin_amdgcn_update_dpp(0, (int)v, CTRL, 0xf, 0xf, true); }
DI unsigned row_max16u(unsigned v) { v = max(v, dppu<0xB1>(v)); v = max(v, dppu<0x4E>(v)); v = max(v, dppu<0x141>(v)); v = max(v, dppu<0x140>(v)); return v; }

__device__ void phase_peer_sel(const Params& p, int l) {
  char* ws = opaque_ptr(p.ws);
  const int tid = opaque_tid();
  const int wid = tid >> 6, lane = tid & 63, fr = lane & 15, fq = lane >> 4;
  const int gw = blockIdx.x * 4 + wid, GW = gridDim.x * 4;
  float* lv = (float*)(g_smem + wid * 4096);
  int* li = (int*)(g_smem + wid * 4096 + 2048);
  const u16* PQ = (const u16*)(ws + O_PQ);
  int ca[4], cb[4];
  bool cvld[4];
#pragma unroll
  for (int c = 0; c < 4; ++c) { int code = kCand[c * 16 + fr]; cvld[c] = code != 0xff; ca[c] = (code >> 4) & 15; cb[c] = code & 15; }
  for (int it = gw; it < 512 * 8; it += GW) {
    const int h = it >> 9, tg = it & 511;
    const u16* SK = (const u16*)(ws + O_SUBK) + ((size_t)(l * 8 + h) * 2) * 128 * 128;
    f32x4 sc[2][8];
#pragma unroll
    for (int z = 0; z < 2; ++z) {
      bf16x8 qf[4];
#pragma unroll
      for (int ks = 0; ks < 4; ++ks) qf[ks] = *(const bf16x8*)(PQ + (size_t)(tg * 16 + fr) * 2048 + (h * 2 + z) * 128 + ks * 32 + fq * 8);
#pragma unroll
      for (int nt = 0; nt < 8; ++nt) {
        sc[z][nt] = f32x4{0.f, 0.f, 0.f, 0.f};
#pragma unroll
        for (int ks = 0; ks < 4; ++ks) {
          bf16x8 kf = *(const bf16x8*)(SK + ((size_t)z * 128 + nt * 16 + fr) * 128 + ks * 32 + fq * 8);
          sc[z][nt] = mfma16(qf[ks], kf, sc[z][nt]);
        }
      }
    }
#pragma unroll
    for (int z = 0; z < 2; ++z) {
#pragma unroll
      for (int j = 0; j < 4; ++j) {
        unsigned key[8];
#pragma unroll
        for (int nt = 0; nt < 8; ++nt) key[nt] = (f2key(sc[z][nt][j]) & ~127u) | (unsigned)(127 - (nt * 16 + fr));
        unsigned tk = 0u;
#pragma unroll 1
        for (int k = 0; k < 16; ++k) {
          unsigned m = key[0];
#pragma unroll
          for (int nt = 1; nt < 8; ++nt) m = max(m, key[nt]);
          unsigned M = row_max16u(m);
#pragma unroll
          for (int nt = 0; nt < 8; ++nt) key[nt] = key[nt] == M ? 0u : key[nt];
          if (fr == k) tk = M;
        }
        lv[((fq * 4 + j) * 2 + z) * 16 + fr] = key2f(tk & ~127u);
        li[((fq * 4 + j) * 2 + z) * 16 + fr] = 127 - (int)(tk & 127u);
      }
    }
    __builtin_amdgcn_s_waitcnt(0xc07f);
    __builtin_amdgcn_wave_barrier();
#pragma unroll 1
    for (int j = 0; j < 4; ++j) {
      const int tl = fq * 4 + j;
      float cand[4];
#pragma unroll
      for (int c = 0; c < 4; ++c) cand[c] = cvld[c] ? lv[(tl * 2 + 0) * 16 + ca[c]] + lv[(tl * 2 + 1) * 16 + cb[c]] : -3e38f;
      unsigned ck[4];
#pragma unroll
      for (int c = 0; c < 4; ++c) ck[c] = cvld[c] ? ((f2key(cand[c]) & ~63u) | (unsigned)(63 - (c * 16 + fr))) : 0u;
      unsigned sk = 0u;
#pragma unroll 1
      for (int k = 0; k < 16; ++k) {
        unsigned m = max(max(ck[0], ck[1]), max(ck[2], ck[3]));
        unsigned M = row_max16u(m);
#pragma unroll
        for (int c = 0; c < 4; ++c) ck[c] = ck[c] == M ? 0u : ck[c];
        if (fr == k) sk = M;
      }
      const float sv = key2f(sk & ~63u);
      const int scode = 63 - (int)(sk & 63u);
      int ab = kCand[scode];
      int e = li[(tl * 2 + 0) * 16 + ((ab >> 4) & 15)] * 128 + li[(tl * 2 + 1) * 16 + (ab & 15)];
      float mx = row_max16(sv);
      float ex = __expf(sv - mx);
      float sum = row_sum16(ex);
      int tok = tg * 16 + tl;
      ((int*)(ws + O_EIDX))[(size_t)tok * 128 + h * 16 + fr] = e;
      ((float*)(ws + O_EGATE))[(size_t)tok * 128 + h * 16 + fr] = ex / sum;
    }
    __builtin_amdgcn_s_waitcnt(0xc07f);
    __builtin_amdgcn_wave_barrier();
  }
}

DI void cvt8(const bf16x8& v, float (&f)[8]) {
  u32x4 u = __builtin_bit_cast(u32x4, v);
#pragma unroll
  for (int q = 0; q < 4; ++q) { f[2 * q] = __uint_as_float(u[q] << 16); f[2 * q + 1] = __uint_as_float(u[q] & 0xffff0000u); }
}
DI void cvt16(const u32x4& q, float (&f)[16]) {
#pragma unroll
  for (int i = 0; i < 4; ++i) {
    f32x2 a = __builtin_amdgcn_cvt_pk_f32_fp8((int)q[i], false), b = __builtin_amdgcn_cvt_pk_f32_fp8((int)q[i], true);
    f[4 * i] = a[0]; f[4 * i + 1] = a[1]; f[4 * i + 2] = b[0]; f[4 * i + 3] = b[1];
  }
}

__device__ void phase_peer_gather(const Params& p, int l, bool dry = false) {
  char* ws = opaque_ptr(p.ws);
  const int tid = opaque_tid();
  const int lane = tid & 63;
  const int gw = blockIdx.x * 4 + (tid >> 6), GW = gridDim.x * 4;
  const unsigned char* U = (const unsigned char*)(ws + O_PEU) + (size_t)l * 16384 * 1024;
  const unsigned char* V = (const unsigned char*)(ws + O_PEV) + (size_t)l * 16384 * 1024;
  const float* SU = (const float*)(ws + O_SCU) + l * 16384;
  const float* SV = (const float*)(ws + O_SCV) + l * 16384;
  float* X = (float*)(ws + O_X);
  float* XW = dry ? (float*)(ws + O_YS) : X;
  u16* HW = dry ? (u16*)(ws + O_MERG) : (u16*)(ws + O_H);
  float* OW = dry ? (float*)(ws + O_PB) : p.out + OUT_Y;
  for (int tok = gw; tok < NT; tok += GW) {
    float hf[16];
    {
      const u16* hr = (const u16*)(ws + O_H) + (size_t)tok * 1024 + lane * 16;
      bf16x8 h0 = *(const bf16x8*)(hr), h1 = *(const bf16x8*)(hr + 8);
      float t0[8], t1[8];
      cvt8(h0, t0); cvt8(h1, t1);
#pragma unroll
      for (int i = 0; i < 8; ++i) { hf[i] = t0[i]; hf[8 + i] = t1[i]; }
    }
    float acc[16];
#pragma unroll
    for (int i = 0; i < 16; ++i) acc[i] = 0.f;
    const int id0 = ((const int*)(ws + O_EIDX))[(size_t)tok * 128 + lane], id1 = ((const int*)(ws + O_EIDX))[(size_t)tok * 128 + 64 + lane];
    const float g0 = ((const float*)(ws + O_EGATE))[(size_t)tok * 128 + lane], g1 = ((const float*)(ws + O_EGATE))[(size_t)tok * 128 + 64 + lane];
#define PG_LOAD(G, ids, gts, su, sv, uq, vq)                                                                      \
  do {                                                                                                            \
    _Pragma("unroll") for (int e = 0; e < 4; ++e) {                                                               \
      int k = (G) * 4 + e;                                                                                        \
      int sel = k & 63;                                                                                           \
      int a_ = __builtin_amdgcn_readlane(id0, sel), b_ = __builtin_amdgcn_readlane(id1, sel);                     \
      float ga_ = __builtin_bit_cast(float, __builtin_amdgcn_readlane(__builtin_bit_cast(int, g0), sel));         \
      float gb_ = __builtin_bit_cast(float, __builtin_amdgcn_readlane(__builtin_bit_cast(int, g1), sel));         \
      ids[e] = (G) < 16 ? a_ : b_;                                                                                 \
      gts[e] = (G) < 16 ? ga_ : gb_;                                                                               \
    }                                                                                                             \
    _Pragma("unroll") for (int e = 0; e < 4; ++e) uq[e] = *(const u32x4*)(U + (size_t)ids[e] * 1024 + lane * 16); \
    _Pragma("unroll") for (int e = 0; e < 4; ++e) vq[e] = *(const u32x4*)(V + (size_t)ids[e] * 1024 + lane * 16); \
    _Pragma("unroll") for (int e = 0; e < 4; ++e) { su[e] = SU[ids[e]]; sv[e] = SV[ids[e]]; }                     \
  } while (0)
#define PG_COMP(gts, su, sv, uq, vq)                                                                              \
  do {                                                                                                            \
    float cf[4];                                                                                                  \
    _Pragma("unroll") for (int e = 0; e < 4; ++e) {                                                               \
      float a[16];                                                                                                \
      cvt16(uq[e], a);                                                                                            \
      float d0 = 0.f, d1 = 0.f;                                                                                   \
      _Pragma("unroll") for (int i = 0; i < 16; i += 2) { d0 += a[i] * hf[i]; d1 += a[i + 1] * hf[i + 1]; }       \
      float d = wave_sum(d0 + d1) * su[e];                                                                        \
      float u3 = 0.7978845608028654f * (d + 0.044715f * d * d * d);                                               \
      float th = 1.f - 2.f * __builtin_amdgcn_rcpf(__expf(2.f * u3) + 1.f);                                                            \
      cf[e] = gts[e] * 0.5f * d * (1.f + th) * sv[e];                                                             \
    }                                                                                                             \
    _Pragma("unroll") for (int e = 0; e < 4; ++e) {                                                               \
      float a[16];                                                                                                \
      cvt16(vq[e], a);                                                                                            \
      _Pragma("unroll") for (int i = 0; i < 16; ++i) acc[i] += cf[e] * a[i];                                      \
    }                                                                                                             \
  } while (0)
    {
      int idA[4], idB[4];
      float gtA[4], gtB[4], suA[4], svA[4], suB[4], svB[4];
      u32x4 uqA[4], vqA[4], uqB[4], vqB[4];
      PG_LOAD(0, idA, gtA, suA, svA, uqA, vqA);
#pragma unroll 1
      for (int g = 0; g < 32; g += 2) {
        PG_LOAD(g + 1, idB, gtB, suB, svB, uqB, vqB);
        PG_COMP(gtA, suA, svA, uqA, vqA);
        if (g + 2 < 32) PG_LOAD(g + 2, idA, gtA, suA, svA, uqA, vqA);
        PG_COMP(gtB, suB, svB, uqB, vqB);
      }
    }
#undef PG_LOAD
#undef PG_COMP
    const float* mod = (const float*)(ws + O_MOD) + ((size_t)l * 3 + tok_cond(tok)) * 6144;
    float x[16];
    const int e0 = lane * 16;
#pragma unroll
    for (int q = 0; q < 4; ++q) {
      f32x4 a = *(const f32x4*)(X + (size_t)tok * 1024 + e0 + q * 4);
      f32x4 ga = *(const f32x4*)(mod + 5 * 1024 + e0 + q * 4);
#pragma unroll
      for (int i = 0; i < 4; ++i) { a[i] += ga[i] * acc[q * 4 + i]; x[q * 4 + i] = a[i]; }
      *(f32x4*)(XW + (size_t)tok * 1024 + e0 + q * 4) = a;
    }
    float ss = 0.f;
#pragma unroll
    for (int i = 0; i < 16; ++i) ss += x[i] * x[i];
    ss = wave_sum(ss);
    const float rstd = rsqrtf(ss * (1.f / 1024.f) + 1e-6f);
    if (l < NL - 1) {
      const float* mod2 = (const float*)(ws + O_MOD) + ((size_t)(l + 1) * 3 + tok_cond(tok)) * 6144;
      const float* g = p.in[9] + (l + 1) * 1024;
      float y[16];
#pragma unroll
      for (int q = 0; q < 4; ++q) {
        f32x4 gg = *(const f32x4*)(g + e0 + q * 4), sh = *(const f32x4*)(mod2 + e0 + q * 4), sc = *(const f32x4*)(mod2 + 1024 + e0 + q * 4);
#pragma unroll
        for (int i = 0; i < 4; ++i) y[q * 4 + i] = x[q * 4 + i] * rstd * gg[i] * (1.f + sc[i]) + sh[i];
      }
      u32x4 o0, o1;
      o0[0] = pack2(y[0], y[1]); o0[1] = pack2(y[2], y[3]); o0[2] = pack2(y[4], y[5]); o0[3] = pack2(y[6], y[7]);
      o1[0] = pack2(y[8], y[9]); o1[1] = pack2(y[10], y[11]); o1[2] = pack2(y[12], y[13]); o1[3] = pack2(y[14], y[15]);
      *(u32x4*)(HW + (size_t)tok * 1024 + e0) = o0;
      *(u32x4*)(HW + (size_t)tok * 1024 + e0 + 8) = o1;
    } else {
      const float* g = p.in[11];
#pragma unroll
      for (int q = 0; q < 4; ++q) {
        f32x4 gg = *(const f32x4*)(g + e0 + q * 4), a;
#pragma unroll
        for (int i = 0; i < 4; ++i) a[i] = x[q * 4 + i] * rstd * gg[i];
        *(f32x4*)(OW + (size_t)tok * 1024 + e0 + q * 4) = a;
      }
    }
  }
}

#define XB_TMO 128
#define XB_XCNT(j) (256 + 64 * (j))
#define XB_XSUB(j) (1280 + 64 * (j))
#define XB_XGEN(j) (2304 + 64 * (j))
#define XB_TOP 3328
#define XB_TOPGEN 3392
#define XCD_BAR_WORDS 3456
#define XB_SPIN_CAP (1u << 18)
DI unsigned xb_ld(unsigned* q) { return __hip_atomic_load(q, __ATOMIC_RELAXED, __HIP_MEMORY_SCOPE_AGENT); }
DI unsigned xb_add(unsigned* q, unsigned v) { return __hip_atomic_fetch_add(q, v, __ATOMIC_RELAXED, __HIP_MEMORY_SCOPE_AGENT); }
DI unsigned xb_xcc_id() { return (unsigned)__builtin_amdgcn_s_getreg((3 << 11) | 20) & 0xFu; }
#define XB_SPIN(cond, bar)                                                                   \
  do {                                                                                       \
    unsigned _sp = 0;                                                                        \
    while (cond) {                                                                           \
      __builtin_amdgcn_s_sleep(1);                                                           \
      if ((++_sp & 255u) == 0u) {                                                            \
        if (xb_ld(&(bar)[XB_TMO])) break;                                                    \
        if (_sp > XB_SPIN_CAP) { atomicAdd(&(bar)[XB_TMO], 1u); break; }                     \
      }                                                                                      \
    }                                                                                        \
  } while (0)
struct XB { unsigned* bar; unsigned x, nloc, nx; };
DI void xcd_barrier(const XB& b) {
  asm volatile("s_waitcnt vmcnt(0)" ::: "memory");
  __syncthreads();
  if (threadIdx.x == 0) {
    unsigned* bar = b.bar;
    __builtin_amdgcn_s_waitcnt(0);
    const unsigned nloc = b.nloc, nx = b.nx;
    const unsigned old = xb_add(&bar[XB_XSUB(b.x)], 1u);
    const unsigned gen = old / nloc;
    if (old + 1u == (gen + 1u) * nloc) {
      __builtin_amdgcn_fence(__ATOMIC_RELEASE, "agent");
      asm volatile("s_waitcnt vmcnt(0)" ::: "memory");
      const unsigned og = xb_add(&bar[XB_TOP], 1u);
      const unsigned tg = og / nx;
      if (og + 1u == (tg + 1u) * nx) xb_add(&bar[XB_TOPGEN], 1u);
      else XB_SPIN(xb_ld(&bar[XB_TOPGEN]) == tg, bar);
      __builtin_amdgcn_fence(__ATOMIC_ACQUIRE, "agent");
      xb_add(&bar[XB_XGEN(b.x)], 1u);
      asm volatile("s_waitcnt vmcnt(0)" ::: "memory");
    } else {
      XB_SPIN(xb_ld(&bar[XB_XGEN(b.x)]) == gen, bar);
      __builtin_amdgcn_fence(__ATOMIC_ACQUIRE, "agent");
      asm volatile("s_waitcnt vmcnt(0)" ::: "memory");
    }
  }
  __syncthreads();
}

__global__ void __launch_bounds__(256, 2) fwd_megakernel(Params p) {
  cg::grid_group grid = cg::this_grid();
  XB xb;
  xb.bar = (unsigned*)(p.ws + O_BAR);
  xb.x = xb_xcc_id();
  if (threadIdx.x == 0) (void)xb_add(&xb.bar[XB_XCNT(xb.x)], 1u);
  phase_prep(p);
  if (p.ws == nullptr) grid.sync();
  {
    unsigned mine = 0u, cnt = 0u, sum = 0u, sp = 0u;
    for (;;) {
      sum = 0u; cnt = 0u; mine = 0u;
#pragma unroll
      for (unsigned j = 0; j < 16; ++j) { const unsigned c = xb_ld(&xb.bar[XB_XCNT(j)]); sum += c; cnt += (c > 0u) ? 1u : 0u; mine = (j == xb.x) ? c : mine; }
      if (sum == gridDim.x) break;
      __builtin_amdgcn_s_sleep(1);
      if (++sp > XB_SPIN_CAP) break;
    }
    xb.nloc = __builtin_amdgcn_readfirstlane(mine > 0u ? mine : 1u);
    xb.nx = __builtin_amdgcn_readfirstlane(cnt > 0u ? cnt : 1u);
  }
  xcd_barrier(xb);
  phase_norm(p, 0, 0);
  xcd_barrier(xb);
  for (int l = 0; l < NL; ++l) {
    phase_gemm_in(p, l);
    xcd_barrier(xb);
    phase_rwkv_prep(p, l);
    xcd_barrier(xb);
    phase_rwkv_lora(p, l);
    xcd_barrier(xb);
    phase_mix(p, l);
    xcd_barrier(xb);
    phase_rwkv_post(p, l);
    xcd_barrier(xb);
    phase_branch(p, l);
    xcd_barrier(xb);
    phase_wo(p, l);
    xcd_barrier(xb);
    phase_norm(p, l, 1);
    xcd_barrier(xb);
    phase_peq(p, l);
    xcd_barrier(xb);
    phase_peer_sel(p, l);
    xcd_barrier(xb);
    phase_peer_gather(p, l);
    if (l + 1 < NL) xcd_barrier(xb);
  }
}

extern "C" void kernel_launch(void* const* d_in, const int* in_sizes, int n_in, void* d_out, int out_size, void* d_ws, size_t ws_size,
                              hipStream_t stream) {
  static int grid_blocks = 0;
  if (!grid_blocks) {
    int dev = 0, cus = 0, per_cu = 0;
    hipGetDevice(&dev);
    hipDeviceGetAttribute(&cus, hipDeviceAttributeMultiprocessorCount, dev);
    hipOccupancyMaxActiveBlocksPerMultiprocessor(&per_cu, fwd_megakernel, 256, 0);
    if (per_cu > 2) per_cu = 2;
    if (per_cu < 1) per_cu = 1;
    grid_blocks = cus * per_cu;
  }
  Params p{};
  for (int i = 0; i < 36; ++i) p.in[i] = (const float*)d_in[i];
  p.out = (float*)d_out;
  p.ws = (char*)d_ws;
  (void)hipMemsetAsync((char*)d_ws + O_BAR, 0, 3456 * 4, stream);
  void* args[] = {&p};
  hipError_t e = hipLaunchCooperativeKernel((void*)fwd_megakernel, dim3(grid_blocks), dim3(256), args, 0, stream);
  if (e != hipSuccess) fprintf(stderr, "cooperative launch failed: %s (grid %d)\n", hipGetErrorString(e), grid_blocks);
}
```

```cpp
#include <hip/hip_runtime.h>
#include <hip/hip_cooperative_groups.h>
#include <cstdio>
namespace cg = cooperative_groups;

#define DI __device__ __forceinline__
typedef unsigned short u16;
using bf16x8 = __attribute__((ext_vector_type(8))) short;
using bf16x4 = __attribute__((ext_vector_type(4))) short;
using f32x4 = __attribute__((ext_vector_type(4))) float;
using u32x2 = __attribute__((ext_vector_type(2))) unsigned;
using u32x4 = __attribute__((ext_vector_type(4))) unsigned;

constexpr int NT = 8192, NCTX = 4096, DM = 1024, INC = 7296, NL = 4;

constexpr size_t AL(size_t x) { return (x + 255) / 256 * 256; }
constexpr size_t O_WIN = 0;
constexpr size_t O_AOUT = O_WIN + AL(4ull * 7296 * 1024 * 2);
constexpr size_t O_RWOUT = O_AOUT + AL(4ull * 1024 * 512 * 2);
constexpr size_t O_NAOUT = O_RWOUT + AL(4ull * 1024 * 512 * 2);
constexpr size_t O_WO = O_NAOUT + AL(4ull * 1024 * 512 * 2);
constexpr size_t O_PEQ = O_WO + AL(4ull * 1024 * 1024 * 2);
constexpr size_t O_SUBK = O_PEQ + AL(4ull * 2048 * 1024 * 2);
constexpr size_t O_W2 = O_SUBK + AL(4ull * 8 * 2 * 128 * 128 * 2);
constexpr size_t O_A2 = O_W2 + AL(8ull * 512 * 64 * 2);
constexpr size_t O_G2 = O_A2 + AL(8ull * 512 * 64 * 2);
constexpr size_t O_PEU = O_G2 + AL(4ull * 512 * 128 * 2);
constexpr size_t O_PEV = O_PEU + AL(4ull * 16384 * 1024 * 2);
constexpr size_t O_CAK = O_PEV + AL(4ull * 16384 * 1024 * 2);
constexpr size_t O_CAVT = O_CAK + AL(8ull * 512 * 128 * 2);
constexpr size_t O_CCK = O_CAVT + AL(8ull * 128 * 512 * 2);
constexpr size_t O_CCVT = O_CCK + AL(8ull * 512 * 512 * 2);
constexpr size_t O_MOD = O_CCVT + AL(8ull * 512 * 512 * 2);
constexpr size_t O_ROPE = O_MOD + AL(4ull * 3 * 6144 * 4);
constexpr size_t O_CNT = O_ROPE + AL(64 * 16 * 2 * 4);
constexpr size_t O_X = O_CNT + 256;
constexpr size_t O_H = O_X + AL(8192ull * 1024 * 4);
constexpr size_t O_QA = O_H + AL(8192ull * 1024 * 2);
constexpr size_t O_KA = O_QA + AL(8192ull * 512 * 2);
constexpr size_t O_VAT = O_KA + AL(8192ull * 128 * 2);
constexpr size_t O_QC = O_VAT + AL(8192ull * 128 * 2);
constexpr size_t O_KC = O_QC + AL(8192ull * 512 * 2);
constexpr size_t O_VCT = O_KC + AL(8192ull * 512 * 2);
constexpr size_t O_PB = O_VCT + AL(8192ull * 512 * 2);
constexpr size_t O_GATE = O_PB + AL(8192ull * 1920 * 4);
constexpr size_t O_XRKV = O_GATE + AL(8192ull * 3072 * 2);
constexpr size_t O_KK = O_XRKV + AL(8192ull * 1536 * 4);
constexpr size_t O_TW = O_KK + AL(8192ull * 512 * 4);
constexpr size_t O_AD = O_TW + AL(8192ull * 128 * 2);
constexpr size_t O_SG = O_AD + AL(8192ull * 128 * 2);
constexpr size_t O_DEC = O_SG + AL(8192ull * 128 * 2);
constexpr size_t O_KD = O_DEC + AL(2ull * 8192 * 512 * 4);
constexpr size_t O_KKA = O_KD + AL(2ull * 8192 * 512 * 4);
constexpr size_t O_GG = O_KKA + AL(2ull * 8192 * 512 * 4);
constexpr size_t O_YS = O_GG + AL(8192ull * 512 * 4);
constexpr size_t O_YABC = O_YS + AL(2ull * 8192 * 512 * 4);
constexpr size_t O_MERG = O_YABC + AL(3ull * 8192 * 512 * 2);
constexpr size_t O_PQ = O_MERG + AL(8192ull * 1024 * 2);
constexpr size_t O_EIDX = O_PQ + AL(8192ull * 2048 * 2);
constexpr size_t O_EGATE = O_EIDX + AL(8192ull * 128 * 4);
constexpr size_t O_SCU = O_EGATE + AL(8192ull * 128 * 4);
constexpr size_t O_SCV = O_SCU + AL(4ull * 16384 * 4);
constexpr size_t O_BAR = O_SCV + AL(4ull * 16384 * 4);
constexpr size_t WS_TOTAL = O_BAR + AL(3456 * 4);
static_assert(WS_TOTAL < 1020ull * 1024 * 1024, "workspace too large");

constexpr size_t OUT_Y = 0;
constexpr size_t OUT_AK = 8388608;
constexpr size_t OUT_AV = 10485760;
constexpr size_t OUT_CK = 12582912;
constexpr size_t OUT_CV = 20971520;
constexpr size_t OUT_ST = 29360128;

struct Params {
  const float* in[36];
  float* out;
  char* ws;
};

__shared__ __attribute__((aligned(16))) char g_smem[65536];

DI u16 f2bf(float x) { unsigned u = __float_as_uint(x); u += 0x7fffu + ((u >> 16) & 1u); return (u16)(u >> 16); }
DI float bf2f(u16 h) { return __uint_as_float(((unsigned)h) << 16); }
typedef __bf16 bf16x2_t __attribute__((ext_vector_type(2)));
DI unsigned pack2(float a, float b) { bf16x2_t v = {(__bf16)a, (__bf16)b}; return __builtin_bit_cast(unsigned, v); }
DI float sigmoidf_(float x) { return __builtin_amdgcn_rcpf(1.f + __expf(-x)); }
template <int CTRL> DI float dppf(float v) {
  return __builtin_bit_cast(float, __builtin_amdgcn_update_dpp(0, __builtin_bit_cast(int, v), CTRL, 0xf, 0xf, true));
}
template <int CTRL> DI int dppi(int v) { return __builtin_amdgcn_update_dpp(0, v, CTRL, 0xf, 0xf, true); }
DI float row_sum16(float v) { v += dppf<0xB1>(v); v += dppf<0x4E>(v); v += dppf<0x141>(v); v += dppf<0x140>(v); return v; }
DI float row_max16(float v) { v = fmaxf(v, dppf<0xB1>(v)); v = fmaxf(v, dppf<0x4E>(v)); v = fmaxf(v, dppf<0x141>(v)); v = fmaxf(v, dppf<0x140>(v)); return v; }
DI int row_max16i(int v) { v = max(v, dppi<0xB1>(v)); v = max(v, dppi<0x4E>(v)); v = max(v, dppi<0x141>(v)); v = max(v, dppi<0x140>(v)); return v; }
DI float wave_sum(float v) { v = row_sum16(v); v += __shfl_xor(v, 16); v += __shfl_xor(v, 32); return v; }

DI int opaque_tid() { int t = threadIdx.x; asm volatile("" : "+v"(t)); return t; }
DI char* opaque_ptr(char* q) { size_t z = 0; asm volatile("" : "+s"(z)); return q + z; }
DI f32x4 mfma16(bf16x8 a, bf16x8 b, f32x4 c) { return __builtin_amdgcn_mfma_f32_16x16x32_bf16(a, b, c, 0, 0, 0); }

DI int lds_byte(int r, int c) {
  int st = (r >> 4) * 2 + (c >> 5), rr = r & 15, cc = c & 31, ob = rr * 64 + cc * 2;
  return st * 1024 + (ob ^ (((ob >> 9) & 1) << 5));
}
DI void stage_rc(int b, int& R, int& C) {
  int st = b >> 10, sb = b & 1023, swz = sb ^ (((sb >> 9) & 1) << 5);
  R = (st >> 1) * 16 + (swz >> 6);
  C = (st & 1) * 32 + ((swz & 63) >> 1);
}
DI void gemm_main(int tid, const u16* __restrict__ g0, int ld0, const u16* __restrict__ g1, int ld1, int K, f32x4 (&acc)[4][4], int koff = 0) {
  const int wid = tid >> 6, lane = tid & 63, wr = wid >> 1, wc = wid & 1, fr = lane & 15, fq = lane >> 4;
  const int nk = K >> 6;
  int R0, C0;
  stage_rc(tid * 16, R0, C0);
  const unsigned v0 = (unsigned)(R0 * ld0 + C0), v1 = (unsigned)(R0 * ld1 + C0);
  const int fa0 = lds_byte(wr * 64 + fr, fq * 8), fa1 = 16384 + lds_byte(wc * 64 + fr, fq * 8);
  const int sb = tid * 16;
#define GSTAGE(kt, buf)                                                                                          \
  do {                                                                                                           \
    _Pragma("unroll") for (int i = 0; i < 4; ++i) {                                                              \
      const u16* u0 = g0 + (size_t)(kt) * 64 + (size_t)i * 32 * ld0;                                             \
      const u16* u1 = g1 + (size_t)(kt) * 64 + (size_t)i * 32 * ld1;                                             \
      __builtin_amdgcn_global_load_lds((const unsigned*)(u0 + v0), (unsigned*)(g_smem + (buf) + i * 4096 + sb), 16, 0, 0);          \
      __builtin_amdgcn_global_load_lds((const unsigned*)(u1 + v1), (unsigned*)(g_smem + (buf) + 16384 + i * 4096 + sb), 16, 0, 0);  \
    }                                                                                                            \
  } while (0)
  int kt = koff;
  GSTAGE(kt, 0);
  for (int t = 0; t < nk; ++t) {
    asm volatile("s_waitcnt vmcnt(0)" ::: "memory");
    __syncthreads();
    const int cur = (t & 1) * 32768;
    kt = kt + 1 == nk ? 0 : kt + 1;
    if (t + 1 < nk) GSTAGE(kt, 32768 - cur);
#pragma unroll
    for (int ks = 0; ks < 2; ++ks) {
      bf16x8 f0[4], f1[4];
#pragma unroll
      for (int m = 0; m < 4; ++m) f0[m] = *(const bf16x8*)(g_smem + cur + fa0 + m * 2048 + ks * 1024);
#pragma unroll
      for (int n = 0; n < 4; ++n) f1[n] = *(const bf16x8*)(g_smem + cur + fa1 + n * 2048 + ks * 1024);
#pragma unroll
      for (int m = 0; m < 4; ++m)
#pragma unroll
        for (int n = 0; n < 4; ++n) acc[m][n] = mfma16(f1[n], f0[m], acc[m][n]);
    }
  }
#undef GSTAGE
  __syncthreads();
}
DI void zero_acc(f32x4 (&acc)[4][4]) {
#pragma unroll
  for (int m = 0; m < 4; ++m)
#pragma unroll
    for (int n = 0; n < 4; ++n) acc[m][n] = f32x4{0.f, 0.f, 0.f, 0.f};
}

struct TJob { const float* src; u16* dst; int K, N, nb; };

DI void transpose_tile(int tid, const float* __restrict__ src, u16* __restrict__ dst, int K, int N, int k0, int n0) {
  float* tile = (float*)g_smem;
  {
    const int tr = tid >> 4, tc = tid & 15;
#pragma unroll
    for (int p = 0; p < 4; ++p) {
      int r = tr + 16 * p;
      f32x4 v = *(const f32x4*)(src + (size_t)(k0 + r) * N + n0 + tc * 4);
      tile[r * 65 + tc * 4 + 0] = v[0]; tile[r * 65 + tc * 4 + 1] = v[1];
      tile[r * 65 + tc * 4 + 2] = v[2]; tile[r * 65 + tc * 4 + 3] = v[3];
    }
  }
  __syncthreads();
  {
    const int tn = tid >> 3, tk = tid & 7;
#pragma unroll
    for (int p = 0; p < 2; ++p) {
      int n = tn + 32 * p;
      u32x4 o;
#pragma unroll
      for (int q = 0; q < 4; ++q) o[q] = pack2(tile[(tk * 8 + 2 * q) * 65 + n], tile[(tk * 8 + 2 * q + 1) * 65 + n]);
      *(u32x4*)(dst + (size_t)(n0 + n) * K + k0 + tk * 8) = o;
    }
  }
  __syncthreads();
}

DI void convert_chunks(int tid, const float* __restrict__ src, u16* __restrict__ dst, size_t n) {
  const size_t nch = n / 8192;
  for (size_t c = blockIdx.x; c < nch; c += gridDim.x) {
    size_t e = c * 8192 + tid * 8;
    f32x4 a[4], b[4];
#pragma unroll
    for (int q = 0; q < 4; ++q) { a[q] = __builtin_nontemporal_load((const f32x4*)(src + e + q * 2048)); b[q] = __builtin_nontemporal_load((const f32x4*)(src + e + q * 2048 + 4)); }
#pragma unroll
    for (int q = 0; q < 4; ++q) {
      u32x4 o;
      o[0] = pack2(a[q][0], a[q][1]); o[1] = pack2(a[q][2], a[q][3]); o[2] = pack2(b[q][0], b[q][1]); o[3] = pack2(b[q][2], b[q][3]);
      *(u32x4*)(dst + e + q * 2048) = o;
    }
  }
}

typedef float f32x2 __attribute__((ext_vector_type(2)));
DI void convert_rows_fp8(int tid, const float* __restrict__ src, unsigned char* __restrict__ dst, float* __restrict__ inv_scale, int nrows) {
  const int lane = tid & 63;
  const int gw = blockIdx.x * 4 + (tid >> 6), GW = gridDim.x * 4;
  for (int r0 = gw; r0 < nrows; r0 += 2 * GW) {
    int rws[2] = {r0, r0 + GW < nrows ? r0 + GW : r0};
    f32x4 v[2][4];
#pragma unroll
    for (int u = 0; u < 2; ++u)
#pragma unroll
      for (int q = 0; q < 4; ++q) v[u][q] = __builtin_nontemporal_load((const f32x4*)(src + (size_t)rws[u] * 1024 + lane * 16 + q * 4));
#pragma unroll
    for (int u = 0; u < 2; ++u) {
      float am = 0.f;
#pragma unroll
      for (int q = 0; q < 4; ++q)
#pragma unroll
        for (int j = 0; j < 4; ++j) am = fmaxf(am, fabsf(v[u][q][j]));
      am = row_max16(am);
      am = fmaxf(am, __shfl_xor(am, 16));
      am = fmaxf(am, __shfl_xor(am, 32));
      int ex = (int)((__float_as_uint(am) >> 23) & 0xff) - 127;
      int k = am > 0.f ? 7 - ex : 0;
      k = min(max(k, -100), 100);
      float sc = __uint_as_float((unsigned)(127 + k) << 23), isc = __uint_as_float((unsigned)(127 - k) << 23);
      u32x4 o;
#pragma unroll
      for (int q = 0; q < 4; ++q) {
        int w = __builtin_amdgcn_cvt_pk_fp8_f32(v[u][q][0] * sc, v[u][q][1] * sc, 0, false);
        w = __builtin_amdgcn_cvt_pk_fp8_f32(v[u][q][2] * sc, v[u][q][3] * sc, w, true);
        o[q] = (unsigned)w;
      }
      *(u32x4*)(dst + (size_t)rws[u] * 1024 + lane * 16) = o;
      if (lane == 0) inv_scale[rws[u]] = isc;
    }
  }
}

DI void convert_rows_fp8_wave(int lane, const float* __restrict__ src, unsigned char* __restrict__ dst, float* __restrict__ inv_scale, int r0, int r1) {
  for (int r = r0; r < r1; r += 2) {
    f32x4 v[2][4];
#pragma unroll
    for (int u = 0; u < 2; ++u)
#pragma unroll
      for (int q = 0; q < 4; ++q) v[u][q] = __builtin_nontemporal_load((const f32x4*)(src + (size_t)(r + u) * 1024 + lane * 16 + q * 4));
#pragma unroll
    for (int u = 0; u < 2; ++u) {
      float am = 0.f;
#pragma unroll
      for (int q = 0; q < 4; ++q)
#pragma unroll
        for (int j = 0; j < 4; ++j) am = fmaxf(am, fabsf(v[u][q][j]));
      am = row_max16(am);
      am = fmaxf(am, __shfl_xor(am, 16));
      am = fmaxf(am, __shfl_xor(am, 32));
      int ex = (int)((__float_as_uint(am) >> 23) & 0xff) - 127;
      int k = am > 0.f ? 7 - ex : 0;
      k = min(max(k, -100), 100);
      float sc = __uint_as_float((unsigned)(127 + k) << 23), isc = __uint_as_float((unsigned)(127 - k) << 23);
      u32x4 o;
#pragma unroll
      for (int q = 0; q < 4; ++q) {
        int w = __builtin_amdgcn_cvt_pk_fp8_f32(v[u][q][0] * sc, v[u][q][1] * sc, 0, false);
        w = __builtin_amdgcn_cvt_pk_fp8_f32(v[u][q][2] * sc, v[u][q][3] * sc, w, true);
        o[q] = (unsigned)w;
      }
      *(u32x4*)(dst + (size_t)(r + u) * 1024 + lane * 16) = o;
      if (lane == 0) inv_scale[r + u] = isc;
    }
  }
}

__device__ void phase_prep(const Params& p) {
  char* ws = opaque_ptr(p.ws);
  const int tid = opaque_tid(), wid = tid >> 6, lane = tid & 63;
  if (blockIdx.x == 0 && tid < 64) ((int*)(ws + O_CNT))[tid] = 0;
  if (blockIdx.x < 4) {
    int e = blockIdx.x * 256 + tid;
    int pos = e >> 4, f = e & 15;
    const float fr4[4] = {1.0f, 0.56234132519f, 0.316227766017f, 0.177827941004f};
    float sc = (f >> 2) == 0 ? 1.0f : (f >> 2) == 1 ? 0.1f : (f >> 2) == 2 ? 0.01f : 0.001f;
    float fsel = (f & 3) == 0 ? fr4[0] : (f & 3) == 1 ? fr4[1] : (f & 3) == 2 ? fr4[2] : fr4[3];
    float freq = fsel * sc;
    float ang = (float)pos * freq;
    double a = (double)ang;
    double k = rint(a * 0.15915494309189535);
    double r = a - k * 6.283185307179586;
    double r2 = r * r, ts = r, tc = 1.0, s = r, c = 1.0;
    for (int i = 1; i <= 14; ++i) {
      tc = -tc * r2 / (double)((2 * i - 1) * (2 * i));
      ts = -ts * r2 / (double)((2 * i) * (2 * i + 1));
      c += tc; s += ts;
    }
    float* rope = (float*)(ws + O_ROPE);
    rope[e * 2] = (float)c; rope[e * 2 + 1] = (float)s;
  }
  {
    float* sil = (float*)g_smem;
    float* part = (float*)(g_smem + 16384);
    const float* cvec = p.in[7];
    const float* cctx = p.in[8];
    bool have_sil = false;
    for (int it = blockIdx.x; it < 4 * 96; it += gridDim.x) {
      if (!have_sil) {
        for (int k = tid; k < 1024; k += 256) {
          float a = cctx[k], b = cvec[k], c2 = cvec[1024 + k];
          sil[k] = a * sigmoidf_(a); sil[1024 + k] = b * sigmoidf_(b); sil[2048 + k] = c2 * sigmoidf_(c2);
        }
        have_sil = true;
        __syncthreads();
      }
      int l = it / 96, n = (it % 96) * 64 + lane;
      const float* W = p.in[12] + (size_t)l * 1024 * 6144 + n;
      float a0 = 0.f, a1 = 0.f, a2 = 0.f;
      int kb = wid * 256;
#pragma unroll 8
      for (int k = 0; k < 256; ++k) {
        float w = W[(size_t)(kb + k) * 6144];
        a0 += w * sil[kb + k]; a1 += w * sil[1024 + kb + k]; a2 += w * sil[2048 + kb + k];
      }
      part[(wid * 3 + 0) * 64 + lane] = a0; part[(wid * 3 + 1) * 64 + lane] = a1; part[(wid * 3 + 2) * 64 + lane] = a2;
      __syncthreads();
      if (tid < 192) {
        int c = tid >> 6, ln = tid & 63;
        float s = part[(0 * 3 + c) * 64 + ln] + part[(1 * 3 + c) * 64 + ln] + part[(2 * 3 + c) * 64 + ln] + part[(3 * 3 + c) * 64 + ln];
        int nn = (it % 96) * 64 + ln;
        ((float*)(ws + O_MOD))[((size_t)l * 3 + c) * 6144 + nn] = s + p.in[13][(size_t)l * 6144 + nn];
      }
      __syncthreads();
    }
    __syncthreads();
  }
  {
    TJob jobs[11] = {
        {p.in[14], (u16*)(ws + O_WIN), 1024, 7296, 4},
        {p.in[16], (u16*)(ws + O_AOUT), 512, 1024, 4},
        {p.in[28], (u16*)(ws + O_RWOUT), 512, 1024, 4},
        {p.in[30], (u16*)(ws + O_NAOUT), 512, 1024, 4},
        {p.in[31], (u16*)(ws + O_WO), 1024, 1024, 4},
        {p.in[32], (u16*)(ws + O_PEQ), 1024, 2048, 4},
        {p.in[19], (u16*)(ws + O_W2), 64, 512, 8},
        {p.in[21], (u16*)(ws + O_A2), 64, 512, 8},
        {p.in[22], (u16*)(ws + O_G2), 128, 512, 4},
        {p.in[3], (u16*)(ws + O_CAVT), 512, 128, 8},
        {p.in[5], (u16*)(ws + O_CCVT), 512, 512, 8},
    };
#pragma unroll
    for (int j = 0; j < 11; ++j) {
      const int tk = jobs[j].K / 64, tn = jobs[j].N / 64, per = tk * tn, tot = per * jobs[j].nb;
      for (int t = blockIdx.x; t < tot; t += gridDim.x) {
        int b = t / per, r = t % per;
        int kt = r / tn, ntile = r % tn;
        size_t off = (size_t)b * jobs[j].K * jobs[j].N;
        transpose_tile(tid, jobs[j].src + off, jobs[j].dst + off, jobs[j].K, jobs[j].N, kt * 64, ntile * 64);
      }
    }
  }
  convert_chunks(tid, p.in[33], (u16*)(ws + O_SUBK), 4ull * 8 * 2 * 128 * 128);
  convert_chunks(tid, p.in[2], (u16*)(ws + O_CAK), 8ull * 512 * 128);
  convert_chunks(tid, p.in[4], (u16*)(ws + O_CCK), 8ull * 512 * 512);
  {
    float* X = (float*)(ws + O_X);
    const size_t nch = (size_t)NT * DM / 1024;
    for (size_t c = blockIdx.x; c < nch; c += gridDim.x) {
      size_t e = c * 1024 + tid * 4;
      const float* src = e < (size_t)NCTX * DM ? p.in[0] + e : p.in[1] + (e - (size_t)NCTX * DM);
      *(f32x4*)(X + e) = *(const f32x4*)src;
    }
  }
}

DI int tok_cond(int tok) { return tok < NCTX ? 0 : 1 + ((tok - NCTX) >> 11); }

DI void norm_row_store(const float (&x)[16], const float* __restrict__ g, const float* __restrict__ shift, const float* __restrict__ scale,
                       u16* __restrict__ hrow, int lane) {
  float ss = 0.f;
#pragma unroll
  for (int i = 0; i < 16; ++i) ss += x[i] * x[i];
  ss = wave_sum(ss);
  float rstd = rsqrtf(ss * (1.f / 1024.f) + 1e-6f);
#pragma unroll
  for (int hh = 0; hh < 2; ++hh) {
    int e0 = hh * 512 + lane * 8;
    float y[8];
#pragma unroll
    for (int i = 0; i < 8; ++i) {
      float v = x[hh * 8 + i] * rstd * g[e0 + i];
      y[i] = v * (1.f + scale[e0 + i]) + shift[e0 + i];
    }
    u32x4 o;
    o[0] = pack2(y[0], y[1]); o[1] = pack2(y[2], y[3]); o[2] = pack2(y[4], y[5]); o[3] = pack2(y[6], y[7]);
    *(u32x4*)(hrow + e0) = o;
  }
}

__device__ void phase_norm(const Params& p, int l, int which) {
  char* ws = opaque_ptr(p.ws);
  const int tid = opaque_tid();
  const int lane = tid & 63;
  const int gw = blockIdx.x * 4 + (tid >> 6), GW = gridDim.x * 4;
  const float* X = (const float*)(ws + O_X);
  const float* g = (which == 0 ? p.in[9] : p.in[10]) + l * 1024;
  for (int tok = gw; tok < NT; tok += GW) {
    const float* mod = (const float*)(ws + O_MOD) + ((size_t)l * 3 + tok_cond(tok)) * 6144 + which * 3 * 1024;
    float x[16];
#pragma unroll
    for (int hh = 0; hh < 2; ++hh) {
      f32x4 a = *(const f32x4*)(X + (size_t)tok * 1024 + hh * 512 + lane * 8);
      f32x4 b = *(const f32x4*)(X + (size_t)tok * 1024 + hh * 512 + lane * 8 + 4);
#pragma unroll
      for (int i = 0; i < 4; ++i) { x[hh * 8 + i] = a[i]; x[hh * 8 + 4 + i] = b[i]; }
    }
    norm_row_store(x, g, mod, mod + 1024, (u16*)(ws + O_H) + (size_t)tok * 1024, lane);
  }
}

__device__ void phase_gemm_in(const Params& p, int l) {
  char* ws = opaque_ptr(p.ws);
  const int tid = opaque_tid();
  const int wid = tid >> 6, lane = tid & 63, wr = wid >> 1, wc = wid & 1, fr = lane & 15, fq = lane >> 4;
  const u16* H = (const u16*)(ws + O_H);
  const u16* W = (const u16*)(ws + O_WIN) + (size_t)l * INC * 1024;
  const float* rope = (const float*)(ws + O_ROPE);
  float* out = p.out;
  const int ntiles = gridDim.x == 512 ? 64 * 56 : 64 * 57;
  for (int t = blockIdx.x; t < ntiles; t += gridDim.x) {
    const int tm = t & 63, tn = t >> 6;
    const int brow = tm * 128, bcol = tn * 128;
    const bool swapped = (tn == 5) || (tn >= 29 && tn < 33);
    const bool ctx = brow < NCTX;
    f32x4 acc[4][4];
    zero_acc(acc);
    const int koff = (((tm >> 3) + (tn & 7)) * 2) & 15;
    if (!swapped) gemm_main(tid, H + (size_t)brow * 1024, 1024, W + (size_t)bcol * 1024, 1024, 1024, acc, koff);
    else gemm_main(tid, W + (size_t)bcol * 1024, 1024, H + (size_t)brow * 1024, 1024, 1024, acc, koff);
    if (!swapped) {
#pragma unroll
      for (int m = 0; m < 4; ++m) {
        const int tok = brow + wr * 64 + m * 16 + fr;
        const int cb = bcol + wc * 64 + fq * 4;
        if (tn < 5) {
          if (!ctx) {
            int tt = (tok - NCTX) & 2047;
            int pos0 = tt >> 6, pos1 = tt & 63;
#pragma unroll
            for (int ax = 0; ax < 2; ++ax) {
              int pos = ax == 0 ? pos0 : pos1;
#pragma unroll
              for (int j = 0; j < 4; ++j) {
                float c = rope[(pos * 16 + fq * 4 + j) * 2], s = rope[(pos * 16 + fq * 4 + j) * 2 + 1];
                float x1 = acc[m][2 * ax][j], x2 = acc[m][2 * ax + 1][j];
                acc[m][2 * ax][j] = x1 * c - x2 * s;
                acc[m][2 * ax + 1][j] = x2 * c + x1 * s;
              }
            }
          }
          if (tn < 4) {
#pragma unroll
            for (int n = 0; n < 4; ++n) {
              u32x2 o; o[0] = pack2(acc[m][n][0] * 0.125f, acc[m][n][1] * 0.125f); o[1] = pack2(acc[m][n][2] * 0.125f, acc[m][n][3] * 0.125f);
              *(u32x2*)((u16*)(ws + O_QA) + (size_t)tok * 512 + cb + n * 16) = o;
            }
          } else {
#pragma unroll
            for (int n = 0; n < 4; ++n) {
              int c = cb + n * 16 - 512;
              u32x2 o; o[0] = pack2(acc[m][n][0], acc[m][n][1]); o[1] = pack2(acc[m][n][2], acc[m][n][3]);
              *(u32x2*)((u16*)(ws + O_KA) + (size_t)tok * 128 + c) = o;
              if (ctx) *(f32x4*)(out + OUT_AK + ((size_t)((tok >> 8) * 4 + l) * 256 + (tok & 255)) * 128 + c) = acc[m][n];
            }
          }
        } else if (tn < 21) {
#pragma unroll
          for (int n = 0; n < 4; ++n) *(f32x4*)((float*)(ws + O_PB) + (size_t)tok * 1920 + cb + n * 16 - 768) = acc[m][n];
        } else if (tn < 25) {
#pragma unroll
          for (int n = 0; n < 4; ++n) {
            u32x2 o; o[0] = pack2(acc[m][n][0] * 0.125f, acc[m][n][1] * 0.125f); o[1] = pack2(acc[m][n][2] * 0.125f, acc[m][n][3] * 0.125f);
            *(u32x2*)((u16*)(ws + O_QC) + (size_t)tok * 512 + cb + n * 16 - 2688) = o;
          }
        } else if (tn < 29) {
#pragma unroll
          for (int n = 0; n < 4; ++n) {
            int c = cb + n * 16 - 3200;
            u32x2 o; o[0] = pack2(acc[m][n][0], acc[m][n][1]); o[1] = pack2(acc[m][n][2], acc[m][n][3]);
            *(u32x2*)((u16*)(ws + O_KC) + (size_t)tok * 512 + c) = o;
            if (ctx) *(f32x4*)(out + OUT_CK + ((size_t)((tok >> 8) * 4 + l) * 256 + (tok & 255)) * 512 + c) = acc[m][n];
          }
        } else {
#pragma unroll
          for (int n = 0; n < 4; ++n) {
            u32x2 o; o[0] = pack2(sigmoidf_(acc[m][n][0]), sigmoidf_(acc[m][n][1])); o[1] = pack2(sigmoidf_(acc[m][n][2]), sigmoidf_(acc[m][n][3]));
            *(u32x2*)((u16*)(ws + O_GATE) + (size_t)tok * 3072 + cb + n * 16 - 4224) = o;
          }
        }
      }
    } else {
      const bool isA = (tn == 5);
      u16* VT = isA ? (u16*)(ws + O_VAT) : (u16*)(ws + O_VCT);
      const int ncols = isA ? 128 : 512;
      const size_t obase = isA ? OUT_AV : OUT_CV;
#pragma unroll
      for (int m = 0; m < 4; ++m) {
        const int c = (isA ? 0 : (tn - 29) * 128) + wr * 64 + m * 16 + fr;
#pragma unroll
        for (int n = 0; n < 4; ++n) {
          const int tk = brow + wc * 64 + n * 16 + fq * 4;
          u32x2 o; o[0] = pack2(acc[m][n][0], acc[m][n][1]); o[1] = pack2(acc[m][n][2], acc[m][n][3]);
          *(u32x2*)(VT + (size_t)c * NT + tk) = o;
          if (ctx) {
#pragma unroll
            for (int j = 0; j < 4; ++j) {
              int tok = tk + j;
              out[obase + ((size_t)((tok >> 8) * 4 + l) * 256 + (tok & 255)) * ncols + c] = acc[m][n][j];
            }
          }
        }
      }
    }
  }
}

__device__ void phase_rwkv_prep(const Params& p, int l) {
  char* ws = opaque_ptr(p.ws);
  const int tid = opaque_tid();
  const int lane = tid & 63;
  const bool split = gridDim.x == 512;
  if (split && blockIdx.x < 64) {
    const int wid = tid >> 6, wr = wid >> 1, wc = wid & 1, fr = lane & 15, fq = lane >> 4;
    const int brow = blockIdx.x * 128, bcol = 56 * 128;
    f32x4 acc[4][4];
    zero_acc(acc);
    gemm_main(tid, (const u16*)(ws + O_H) + (size_t)brow * 1024, 1024, (const u16*)(ws + O_WIN) + ((size_t)l * INC + bcol) * 1024, 1024, 1024, acc);
#pragma unroll
    for (int m = 0; m < 4; ++m) {
      const int tok = brow + wr * 64 + m * 16 + fr;
      const int cb = bcol + wc * 64 + fq * 4;
#pragma unroll
      for (int n = 0; n < 4; ++n) {
        u32x2 o; o[0] = pack2(sigmoidf_(acc[m][n][0]), sigmoidf_(acc[m][n][1])); o[1] = pack2(sigmoidf_(acc[m][n][2]), sigmoidf_(acc[m][n][3]));
        *(u32x2*)((u16*)(ws + O_GATE) + (size_t)tok * 3072 + cb + n * 16 - 4224) = o;
      }
    }
    return;
  }
  const int gw = split ? ((int)blockIdx.x - 64) * 4 + (tid >> 6) : (int)blockIdx.x * 4 + (tid >> 6);
  const int GW = split ? 448 * 4 : (int)gridDim.x * 4;
  const float* PB = (const float*)(ws + O_PB);
  const float* mu = p.in[17] + l * 1920;
  const float* kkw = p.in[23] + l * 512;
  for (int tok = gw; tok < NT; tok += GW) {
    int pos, len;
    if (tok < NCTX) { pos = tok & 255; len = 256; } else { pos = (tok - NCTX) & 2047; len = 2048; }
    const bool hp = pos > 0, hn = pos < len - 1;
    const float* row = PB + (size_t)tok * 1920;
#pragma unroll
    for (int i = 0; i < 8; ++i) {
      int q = lane + 64 * i;
      if (q < 480) {
        int c = q * 4;
        f32x4 cur = *(const f32x4*)(row + c);
        f32x4 pv = hp ? *(const f32x4*)(row - 1920 + c) : f32x4{0.f, 0.f, 0.f, 0.f};
        f32x4 nv = hn ? *(const f32x4*)(row + 1920 + c) : f32x4{0.f, 0.f, 0.f, 0.f};
        f32x4 m4 = *(const f32x4*)(mu + c);
        f32x4 xb;
#pragma unroll
        for (int j = 0; j < 4; ++j) xb[j] = cur[j] + m4[j] * (0.5f * (pv[j] + nv[j]) - cur[j]);
        if (i < 6) {
          *(f32x4*)((float*)(ws + O_XRKV) + (size_t)tok * 1536 + c) = xb;
          if (i == 2 || i == 3) {
            int ck = c - 512;
            f32x4 kw = *(const f32x4*)(kkw + ck);
            f32x4 kv;
            float ss = 0.f;
#pragma unroll
            for (int j = 0; j < 4; ++j) { kv[j] = xb[j] * kw[j]; ss += kv[j] * kv[j]; }
            ss = row_sum16(ss);
            float rn = rsqrtf(ss + 1e-12f);
#pragma unroll
            for (int j = 0; j < 4; ++j) kv[j] *= rn;
            *(f32x4*)((float*)(ws + O_KK) + (size_t)tok * 512 + ck) = kv;
          }
        } else {
          u16* dst;
          int cc;
          float v[4];
          if (c < 1664) { dst = (u16*)(ws + O_TW); cc = c - 1536; for (int j = 0; j < 4; ++j) v[j] = tanhf(xb[j]); }
          else if (c < 1792) { dst = (u16*)(ws + O_AD); cc = c - 1664; for (int j = 0; j < 4; ++j) v[j] = xb[j]; }
          else { dst = (u16*)(ws + O_SG); cc = c - 1792; for (int j = 0; j < 4; ++j) v[j] = sigmoidf_(xb[j]); }
          u32x2 o; o[0] = pack2(v[0], v[1]); o[1] = pack2(v[2], v[3]);
          *(u32x2*)(dst + (size_t)tok * 128 + cc) = o;
        }
      }
    }
  }
}

__device__ void phase_rwkv_lora(const Params& p, int l) {
  char* ws = opaque_ptr(p.ws);
  const int tid = opaque_tid();
  const int wid = tid >> 6, lane = tid & 63, wr = wid >> 1, wc = wid & 1, fr = lane & 15, fq = lane >> 4;
  for (int t = blockIdx.x; t < 5 * 256; t += gridDim.x) {
    const int job = t >> 8, r = t & 255, tm = r & 63, tn = r >> 6;
    const int brow = tm * 128, bcol = tn * 128;
    f32x4 acc[4][4];
    zero_acc(acc);
    const int z = job & 1;
    if (job < 2) gemm_main(tid, (const u16*)(ws + O_TW) + (size_t)brow * 128 + z * 64, 128, (const u16*)(ws + O_W2) + ((size_t)(l * 2 + z) * 512 + bcol) * 64, 64, 64, acc);
    else if (job < 4) gemm_main(tid, (const u16*)(ws + O_AD) + (size_t)brow * 128 + z * 64, 128, (const u16*)(ws + O_A2) + ((size_t)(l * 2 + z) * 512 + bcol) * 64, 64, 64, acc);
    else gemm_main(tid, (const u16*)(ws + O_SG) + (size_t)brow * 128, 128, (const u16*)(ws + O_G2) + ((size_t)l * 512 + bcol) * 128, 128, 128, acc);
#pragma unroll
    for (int m = 0; m < 4; ++m) {
      const int tok = brow + wr * 64 + m * 16 + fr;
#pragma unroll
      for (int n = 0; n < 4; ++n) {
        const int c = bcol + wc * 64 + n * 16 + fq * 4;
        if (job < 2) {
          f32x4 w0 = *(const f32x4*)(p.in[18] + (size_t)(l * 2 + z) * 512 + c);
          f32x4 o;
#pragma unroll
          for (int j = 0; j < 4; ++j) {
            float val = w0[j] + acc[m][n][j];
            float y = -val;
            float sp = fmaxf(y, 0.f) + __logf(1.f + __expf(-fabsf(y)));
            float wlog = -sp - 0.5f;
            o[j] = __expf(-__expf(wlog));
          }
          *(f32x4*)((float*)(ws + O_DEC) + ((size_t)z * NT + tok) * 512 + c) = o;
        } else if (job < 4) {
          f32x4 a0 = *(const f32x4*)(p.in[20] + (size_t)(l * 2 + z) * 512 + c);
          f32x4 ka = *(const f32x4*)(p.in[24] + (size_t)l * 512 + c);
          f32x4 kx = *(const f32x4*)((const float*)(ws + O_XRKV) + (size_t)tok * 1536 + 512 + c);
          f32x4 kk = *(const f32x4*)((const float*)(ws + O_KK) + (size_t)tok * 512 + c);
          f32x4 okd, okka;
#pragma unroll
          for (int j = 0; j < 4; ++j) {
            float a = sigmoidf_(a0[j] + acc[m][n][j]);
            okd[j] = kx[j] * (1.f + (a - 1.f) * ka[j]);
            okka[j] = kk[j] * a;
          }
          *(f32x4*)((float*)(ws + O_KD) + ((size_t)z * NT + tok) * 512 + c) = okd;
          *(f32x4*)((float*)(ws + O_KKA) + ((size_t)z * NT + tok) * 512 + c) = okka;
        } else {
          *(f32x4*)((float*)(ws + O_GG) + (size_t)tok * 512 + c) = acc[m][n];
        }
      }
    }
  }
}

template <int JPL> struct ScanOps { float w[JPL], kd[JPL], kk[JPL], kka[JPL], r[JPL]; float v; };

template <int JPL>
DI void scan_load(ScanOps<JPL>& o, const float* __restrict__ dec, const float* __restrict__ kd, const float* __restrict__ kk,
                  const float* __restrict__ kka, const float* __restrict__ rr, const float* __restrict__ vv, int tok, int cj, int ci) {
  const size_t e = (size_t)tok * 512 + cj;
#pragma unroll
  for (int q = 0; q < JPL / 4; ++q) {
    f32x4 a = *(const f32x4*)(dec + e + q * 4), b = *(const f32x4*)(kd + e + q * 4), c = *(const f32x4*)(kk + e + q * 4),
          d = *(const f32x4*)(kka + e + q * 4), f = *(const f32x4*)(rr + (size_t)tok * 1536 + cj + q * 4);
#pragma unroll
    for (int j = 0; j < 4; ++j) { o.w[q * 4 + j] = a[j]; o.kd[q * 4 + j] = b[j]; o.kk[q * 4 + j] = c[j]; o.kka[q * 4 + j] = d[j]; o.r[q * 4 + j] = f[j]; }
  }
  o.v = vv[(size_t)tok * 1536 + 1024 + ci];
}

template <int JPL> DI float scan_red(float v) {
  v += dppf<0xB1>(v);
  v += dppf<0x4E>(v);
  if (JPL <= 8) v += dppf<0x141>(v);
  if (JPL <= 4) v += dppf<0x140>(v);
  return v;
}

template <int JPL>
DI void scan_step(float (&S)[JPL], const ScanOps<JPL>& o, float* __restrict__ y, int tok, int ci, bool wr) {
  float sa0 = 0.f, sa1 = 0.f;
#pragma unroll
  for (int j = 0; j < JPL; j += 2) { sa0 += S[j] * o.kk[j]; sa1 += S[j + 1] * o.kk[j + 1]; }
  float sa = -scan_red<JPL>(sa0 + sa1);
  float y0 = 0.f, y1 = 0.f;
#pragma unroll
  for (int j = 0; j < JPL; j += 2) {
    S[j] = S[j] * o.w[j] + (sa * o.kka[j] + o.v * o.kd[j]);
    S[j + 1] = S[j + 1] * o.w[j + 1] + (sa * o.kka[j + 1] + o.v * o.kd[j + 1]);
    y0 += S[j] * o.r[j]; y1 += S[j + 1] * o.r[j + 1];
  }
  float yv = scan_red<JPL>(y0 + y1);
  if (wr) y[(size_t)tok * 512 + ci] = yv;
}

template <int JPL, int D>
DI void scan_wave(char* ws, int lane, int z, int h, int tok0, int T, int rowbase, const float* __restrict__ s0, float* __restrict__ sout) {
  constexpr int LPR = 64 / JPL;
  const int rr = lane / LPR, pp = lane % LPR;
  const int i = rowbase + rr, j0 = pp * JPL;
  const int cj = h * 64 + j0, ci = h * 64 + i;
  const float* dec = (const float*)(ws + O_DEC) + (size_t)z * NT * 512;
  const float* kd = (const float*)(ws + O_KD) + (size_t)z * NT * 512;
  const float* kka = (const float*)(ws + O_KKA) + (size_t)z * NT * 512;
  const float* kk = (const float*)(ws + O_KK);
  const float* xr = (const float*)(ws + O_XRKV);
  float* y = (float*)(ws + O_YS) + (size_t)z * NT * 512;
  float S[JPL];
#pragma unroll
  for (int j = 0; j < JPL; ++j) S[j] = s0 ? s0[i * 64 + j0 + j] : 0.f;
  const int dir = z == 0 ? 1 : -1;
  const int first = z == 0 ? tok0 : tok0 + T - 1;
  const bool wr = pp == 0;
  ScanOps<JPL> R[D];
#pragma unroll
  for (int d = 0; d < D; ++d) scan_load<JPL>(R[d], dec, kd, kk, kka, xr, xr, first + dir * d, cj, ci);
  for (int n = 0; n < T; n += D) {
#pragma unroll
    for (int d = 0; d < D; ++d) {
      scan_step<JPL>(S, R[d], y, first + dir * (n + d), ci, wr);
      int nn = n + d + D;
      nn = nn < T ? nn : T - 1;
      scan_load<JPL>(R[d], dec, kd, kk, kka, xr, xr, first + dir * nn, cj, ci);
    }
  }
  if (sout) {
#pragma unroll
    for (int j = 0; j < JPL; ++j) sout[i * 64 + j0 + j] = S[j];
  }
}

DI void dma16(const char* gptr, unsigned ldsaddr) {
  asm volatile("s_mov_b32 m0, %0\n\ts_nop 0\n\tglobal_load_lds_dwordx4 %1, off" ::"s"(ldsaddr), "v"(gptr) : "memory");
}
template <int N> DI void wait_vm() { asm volatile("s_waitcnt vmcnt(%0)" ::"n"(N) : "memory"); }

template <int JPL> struct ScanRegs { float w[JPL], kd[JPL], kk[JPL], kka[JPL], r[JPL]; float v; };
template <int JPL> DI void scan_lds_read(ScanRegs<JPL>& o, const char* slot, int pp, int rr) {
#pragma unroll
  for (int q = 0; q < JPL / 4; ++q) {
    f32x4 a = *(const f32x4*)(slot + 0 + pp * JPL * 4 + q * 16), b = *(const f32x4*)(slot + 256 + pp * JPL * 4 + q * 16),
          c = *(const f32x4*)(slot + 512 + pp * JPL * 4 + q * 16), d = *(const f32x4*)(slot + 768 + pp * JPL * 4 + q * 16),
          f = *(const f32x4*)(slot + 1024 + pp * JPL * 4 + q * 16);
#pragma unroll
    for (int j = 0; j < 4; ++j) { o.w[q * 4 + j] = a[j]; o.kd[q * 4 + j] = b[j]; o.kk[q * 4 + j] = c[j]; o.kka[q * 4 + j] = d[j]; o.r[q * 4 + j] = f[j]; }
  }
  o.v = *(const float*)(slot + 1280 + rr * 4);
}
template <int JPL>
DI void scan_step2(float (&S)[JPL], const ScanRegs<JPL>& o, float* __restrict__ yp, bool wr) {
  float sa0 = 0.f, sa1 = 0.f;
#pragma unroll
  for (int j = 0; j < JPL; j += 2) { sa0 += S[j] * o.kk[j]; sa1 += S[j + 1] * o.kk[j + 1]; }
  float sa = -scan_red<JPL>(sa0 + sa1);
  float y0 = 0.f, y1 = 0.f;
#pragma unroll
  for (int j = 0; j < JPL; j += 2) {
    S[j] = sa * o.kka[j] + (S[j] * o.w[j] + o.v * o.kd[j]);
    S[j + 1] = sa * o.kka[j + 1] + (S[j + 1] * o.w[j + 1] + o.v * o.kd[j + 1]);
    y0 += S[j] * o.r[j]; y1 += S[j + 1] * o.r[j + 1];
  }
  float yv = scan_red<JPL>(y0 + y1);
  if (wr) *yp = yv;
}

template <int JPL, int NS>
DI void scan_wave_dma(char* ws, int lane, int ringoff, int z, int h, int tok0, int T, int rowbase, const float* __restrict__ s0,
                      float* __restrict__ sout) {
  constexpr int LPR = 64 / JPL, PD = NS - 1, WN = 3 * PD - 3;
  static_assert(WN <= 63, "vmcnt range");
  const int rr = lane / LPR, pp = lane % LPR;
  const int i = rowbase + rr, j0 = pp * JPL;
  const int dir = z == 0 ? 1 : -1;
  const int first = z == 0 ? tok0 : tok0 + T - 1;
  const bool wr = pp == 0;
  float S[JPL];
#pragma unroll
  for (int j = 0; j < JPL; ++j) S[j] = s0 ? s0[i * 64 + j0 + j] : 0.f;
  const int a = lane >> 4, c16 = lane & 15;
  const float* arr = a == 0 ? (const float*)(ws + O_DEC) + (size_t)z * NT * 512
                   : a == 1 ? (const float*)(ws + O_KD) + (size_t)z * NT * 512
                   : a == 2 ? (const float*)(ws + O_KK)
                            : (const float*)(ws + O_KKA) + (size_t)z * NT * 512;
  const char* gA = (const char*)(arr + (size_t)first * 512 + h * 64 + c16 * 4);
  const char* gB = (const char*)((const float*)(ws + O_XRKV) + (size_t)first * 1536 + (lane < 16 ? h * 64 + c16 * 4 : 1024 + h * 64 + rowbase + (lane - 16) * 4));
  const long stA = (long)dir * 2048, stB = (long)dir * 6144;
  const bool bact = lane < 16 + JPL / 4;
  ringoff = __builtin_amdgcn_readfirstlane(ringoff);
  const unsigned ring = (unsigned)(size_t)g_smem + (unsigned)ringoff;
  const char* ringp = g_smem + ringoff;
  float* yp = (float*)(ws + O_YS) + (size_t)z * NT * 512 + (size_t)first * 512 + h * 64 + i;
  const long sty = (long)dir * 512;
  float* dummy = (float*)(ws + O_MERG) + lane;
#pragma unroll 1
  for (int s = 0; s < PD; ++s) {
    unsigned slot = ring + (unsigned)(s & (NS - 1)) * 1536u;
    dma16(gA, slot);
    if (bact) dma16(gB, slot + 1024u);
    gA += stA; gB += stB;
    if (wr) dummy[s * 64] = 0.f;
  }
  ScanRegs<JPL> A, B;
  wait_vm<3 * PD - 3>();
  wait_vm<3 * (PD - 1)>();
  scan_lds_read<JPL>(A, ringp, pp, rr);
  for (int n = 0; n < T; n += 2) {
    {
      unsigned sl = (unsigned)((n + PD) & (NS - 1)) * 1536u;
      dma16(gA, ring + sl);
      if (bact) dma16(gB, ring + sl + 1024u);
      gA += stA; gB += stB;
      wait_vm<WN>();
      scan_lds_read<JPL>(B, ringp + ((n + 1) & (NS - 1)) * 1536, pp, rr);
      scan_step2<JPL>(S, A, yp, wr);
      yp += sty;
    }
    {
      unsigned sl = (unsigned)((n + 1 + PD) & (NS - 1)) * 1536u;
      dma16(gA, ring + sl);
      if (bact) dma16(gB, ring + sl + 1024u);
      gA += stA; gB += stB;
      wait_vm<WN>();
      scan_lds_read<JPL>(A, ringp + ((n + 2) & (NS - 1)) * 1536, pp, rr);
      scan_step2<JPL>(S, B, yp, wr);
      yp += sty;
    }
  }
  wait_vm<0>();
  if (sout) {
#pragma unroll
    for (int j = 0; j < JPL; ++j) sout[i * 64 + j0 + j] = S[j];
  }
}

template <int JPL>
DI void scan_dots(const float (&S)[JPL], const ScanRegs<JPL>& cur, const ScanRegs<JPL>& prv, float& d1, float& d2) {
  float a0 = 0.f, a1 = 0.f, b0 = 0.f, b1 = 0.f;
#pragma unroll
  for (int j = 0; j < JPL; j += 2) {
    a0 += S[j] * cur.kk[j]; b0 += S[j] * prv.r[j];
    a1 += S[j + 1] * cur.kk[j + 1]; b1 += S[j + 1] * prv.r[j + 1];
  }
  d1 = a0 + a1; d2 = b0 + b1;
}
template <int JPL> DI void scan_red2(float& a, float& b) {
  a += dppf<0xB1>(a); b += dppf<0xB1>(b);
  a += dppf<0x4E>(a); b += dppf<0x4E>(b);
  if (JPL <= 8) { a += dppf<0x141>(a); b += dppf<0x141>(b); }
  if (JPL <= 4) { a += dppf<0x140>(a); b += dppf<0x140>(b); }
}
template <int JPL> DI void scan_pre(float (&Tm)[JPL], const float (&S)[JPL], const ScanRegs<JPL>& o) {
#pragma unroll
  for (int j = 0; j < JPL; ++j) Tm[j] = S[j] * o.w[j] + o.v * o.kd[j];
}
template <int JPL> DI void scan_update(float (&S)[JPL], const float (&Tm)[JPL], const ScanRegs<JPL>& o, float sa) {
#pragma unroll
  for (int j = 0; j < JPL; ++j) S[j] = sa * o.kka[j] + Tm[j];
}

template <int JPL, int T>
DI void scan_latent_block(char* ws, int tid, int z, int h, int tok0, int rowblock, const float* __restrict__ s0, float* __restrict__ sout) {
  constexpr int LPR = 64 / JPL, G = 7, WNV = 6 * G - 2;
  const int wid = __builtin_amdgcn_readfirstlane(tid >> 6), lane = tid & 63;
  const int rr = lane / LPR, pp = lane % LPR;
  const int rloc = wid * JPL + rr;
  const int i = rowblock + rloc, j0 = pp * JPL;
  const int dir = z == 0 ? 1 : -1;
  const int first = z == 0 ? tok0 : tok0 + T - 1;
  const bool wr = pp == 0;
  float S[JPL];
#pragma unroll
  for (int j = 0; j < JPL; ++j) S[j] = s0 ? s0[i * 64 + j0 + j] : 0.f;
  const int a = lane >> 4, c16 = lane & 15;
  const float* arr = a == 0 ? (const float*)(ws + O_DEC) + (size_t)z * NT * 512
                   : a == 1 ? (const float*)(ws + O_KD) + (size_t)z * NT * 512
                   : a == 2 ? (const float*)(ws + O_KK)
                            : (const float*)(ws + O_KKA) + (size_t)z * NT * 512;
  const int fw = first + dir * wid;
  const char* gA = (const char*)(arr + (size_t)fw * 512 + h * 64 + c16 * 4);
  const char* gB = (const char*)((const float*)(ws + O_XRKV) + (size_t)fw * 1536 + (lane < 16 ? h * 64 + c16 * 4 : 1024 + h * 64 + rowblock + (lane - 16) * 4));
  const long stA = (long)dir * 4 * 2048, stB = (long)dir * 4 * 6144;
  const bool bact = lane < 16 + JPL;
  const unsigned ring = (unsigned)(size_t)g_smem;
  const char* ringp = g_smem;
  float* yp = (float*)(ws + O_YS) + (size_t)z * NT * 512 + (size_t)first * 512 + h * 64 + i;
  const long sty = (long)dir * 512;
  float* dummy = (float*)(ws + O_MERG) + tid;
#pragma unroll 1
  for (int g = 0; g < G; ++g) {
    unsigned slot = ring + (unsigned)((4 * g + wid) & 31) * 1536u;
    dma16(gA, slot);
    if (bact) dma16(gB, slot + 1024u);
    gA += stA; gB += stB;
    if (wr) { dummy[(g * 4 + 0) * 256] = 0.f; }
    if (wr) { dummy[(g * 4 + 1) * 256] = 0.f; }
    if (wr) { dummy[(g * 4 + 2) * 256] = 0.f; }
    if (wr) { dummy[(g * 4 + 3) * 256] = 0.f; }
    asm volatile("" ::: "memory");
  }
  ScanRegs<JPL> A, B;
#pragma unroll
  for (int j = 0; j < JPL; ++j) B.r[j] = 0.f;
  float* ypv = dummy + 28 * 256;
  wait_vm<WNV>();
  asm volatile("" ::: "memory");
  __builtin_amdgcn_s_barrier();
  asm volatile("" ::: "memory");
  scan_lds_read<JPL>(A, ringp, pp, rloc);
#pragma unroll 1
  for (int g = 0; g < T / 4; ++g) {
    wait_vm<WNV - 6>();

    asm volatile("" ::: "memory");
    __builtin_amdgcn_s_barrier();
    asm volatile("" ::: "memory");
    {
      unsigned slot = ring + (unsigned)((4 * (g + G) + wid) & 31) * 1536u;
      dma16(gA, slot);
      if (bact) dma16(gB, slot + 1024u);
      gA += stA; gB += stB;
    }
    const char* gp = ringp + ((4 * g) & 31) * 1536;
    if (JPL >= 8) {
#pragma unroll
      for (int k = 0; k < 4; ++k) {
        scan_lds_read<JPL>(A, gp + k * 1536, pp, rloc);
        scan_step2<JPL>(S, A, yp, wr);
        yp += sty;
        asm volatile("" ::: "memory");
      }
      continue;
    }
    float d1, y0, y1, y2, y3;
    float Tm[JPL];
    scan_dots<JPL>(S, A, B, d1, y0);
    scan_pre<JPL>(Tm, S, A);
    scan_lds_read<JPL>(B, gp + 1536, pp, rloc);
    scan_red2<JPL>(d1, y0);
    scan_update<JPL>(S, Tm, A, -d1);
    scan_dots<JPL>(S, B, A, d1, y1);
    scan_pre<JPL>(Tm, S, B);
    scan_lds_read<JPL>(A, gp + 2 * 1536, pp, rloc);
    scan_red2<JPL>(d1, y1);
    scan_update<JPL>(S, Tm, B, -d1);
    scan_dots<JPL>(S, A, B, d1, y2);
    scan_pre<JPL>(Tm, S, A);
    scan_lds_read<JPL>(B, gp + 3 * 1536, pp, rloc);
    scan_red2<JPL>(d1, y2);
    scan_update<JPL>(S, Tm, A, -d1);
    scan_dots<JPL>(S, B, A, d1, y3);
    scan_pre<JPL>(Tm, S, B);
    scan_lds_read<JPL>(A, ringp + ((4 * g + 4) & 31) * 1536, pp, rloc);
    scan_red2<JPL>(d1, y3);
    scan_update<JPL>(S, Tm, B, -d1);
    if (wr) {
      *ypv = y0;
      yp[0] = y1;
      yp[sty] = y2;
      yp[2 * sty] = y3;
    }
    ypv = yp + 3 * sty;
    yp += 4 * sty;
    asm volatile("" ::: "memory");
  }
  {
    float e0 = 0.f, e1 = 0.f;
#pragma unroll
    for (int j = 0; j < JPL; j += 2) { e0 += S[j] * B.r[j]; e1 += S[j + 1] * B.r[j + 1]; }
    float yv = scan_red<JPL>(e0 + e1);
    if (wr) *ypv = yv;
  }
  wait_vm<0>();
  asm volatile("" ::: "memory");
  __builtin_amdgcn_s_barrier();
  asm volatile("" ::: "memory");
  if (sout) {
#pragma unroll
    for (int j = 0; j < JPL; ++j) sout[i * 64 + j0 + j] = S[j];
  }
}

struct AttnSt { float m, l; f32x4 o[4]; };

struct AttnKVF { bf16x8 k[2][2]; bf16x8 v[4]; };
DI void attn_kvload(AttnKVF& f, const u16* __restrict__ kp, int ldk, const u16* __restrict__ vtp, int ldv, int fr, int fq) {
#pragma unroll
  for (int kt = 0; kt < 2; ++kt)
#pragma unroll
    for (int ks = 0; ks < 2; ++ks) f.k[kt][ks] = *(const bf16x8*)(kp + (size_t)(8 * (fr >> 2) + 4 * kt + (fr & 3)) * ldk + ks * 32 + fq * 8);
#pragma unroll
  for (int dt = 0; dt < 4; ++dt) f.v[dt] = *(const bf16x8*)(vtp + (size_t)(dt * 16 + fr) * ldv + fq * 8);
}
template <int MODE>
DI void attn_core(AttnSt& st, const bf16x8 (&qf)[2], const AttnKVF& f, int fr, int fq, int qpos, int kpos0, const float* __restrict__ rpbrow) {
  f32x4 s[2];
#pragma unroll
  for (int kt = 0; kt < 2; ++kt) {
    s[kt] = f32x4{0.f, 0.f, 0.f, 0.f};
#pragma unroll
    for (int ks = 0; ks < 2; ++ks) s[kt] = mfma16(f.k[kt][ks], qf[ks], s[kt]);
  }
  if (MODE != 0) {
#pragma unroll
    for (int kt = 0; kt < 2; ++kt)
#pragma unroll
      for (int j = 0; j < 4; ++j) {
        int kpos = kpos0 + 8 * fq + 4 * kt + j;
        if (MODE == 1) {
          int d = qpos - kpos;
          if (d > 128 || d < -128) s[kt][j] = -1e30f;
        } else {
          int cs = min(max(qpos - 8, 0), 48);
          int dc = min(max(kpos - qpos, -15), 15) + 15;
          float b = rpbrow[dc];
          s[kt][j] = (kpos >= cs && kpos < cs + 16) ? s[kt][j] + b : -1e30f;
        }
      }
  }
  float mx = fmaxf(fmaxf(fmaxf(s[0][0], s[0][1]), fmaxf(s[0][2], s[0][3])), fmaxf(fmaxf(s[1][0], s[1][1]), fmaxf(s[1][2], s[1][3])));
  mx = fmaxf(mx, __shfl_xor(mx, 16));
  mx = fmaxf(mx, __shfl_xor(mx, 32));
  float mn = fmaxf(st.m, mx);
  float alpha = __expf(st.m - mn);
  st.m = mn;
  float ps = 0.f;
  float pv[8];
#pragma unroll
  for (int kt = 0; kt < 2; ++kt)
#pragma unroll
    for (int j = 0; j < 4; ++j) { float e = __expf(s[kt][j] - mn); pv[kt * 4 + j] = e; ps += e; }
  st.l = st.l * alpha + ps;
  u32x4 pk;
  pk[0] = pack2(pv[0], pv[1]); pk[1] = pack2(pv[2], pv[3]); pk[2] = pack2(pv[4], pv[5]); pk[3] = pack2(pv[6], pv[7]);
  bf16x8 pf = __builtin_bit_cast(bf16x8, pk);
#pragma unroll
  for (int dt = 0; dt < 4; ++dt) {
    bf16x8 vf = f.v[dt];
#pragma unroll
    for (int j = 0; j < 4; ++j) st.o[dt][j] *= alpha;
    st.o[dt] = mfma16(vf, pf, st.o[dt]);
  }
}

DI void attn_item(const Params& p, char* ws, int lane, int l, int item) {
  const int fr = lane & 15, fq = lane >> 4;
  const int type = item >> 10, r = item & 1023;
  const int h = r & 7, qp = r >> 3;
  AttnSt st[2];
  const u16* Q;
  u16* Y;
  if (type == 0 || type == 2) { Q = (const u16*)(ws + O_QA); Y = (u16*)(ws + O_YABC); }
  else { Q = (const u16*)(ws + O_QC); Y = (u16*)(ws + O_YABC) + 2ull * NT * 512; }
  const int tok0 = (type < 2 ? NCTX : 0) + qp * 32;
  bf16x8 qf[2][2];
  const bool hasSink = (type == 0 || type == 2);
#pragma unroll
  for (int i = 0; i < 2; ++i) {
#pragma unroll
    for (int dt = 0; dt < 4; ++dt) st[i].o[dt] = f32x4{0.f, 0.f, 0.f, 0.f};
#pragma unroll
    for (int ks = 0; ks < 2; ++ks) qf[i][ks] = *(const bf16x8*)(Q + (size_t)(tok0 + i * 16 + fr) * 512 + h * 64 + ks * 32 + fq * 8);
    if (hasSink) { st[i].m = p.in[15][l * 8 + h]; st[i].l = fq == 0 ? 1.f : 0.f; }
    else { st[i].m = -1e30f; st[i].l = 0.f; }
  }
  AttnKVF f;
  if (type == 0) {
    const int qt = qp * 2;
    const int b = qt >> 7, kv = h >> 2;
    const u16* ck = (const u16*)(ws + O_CAK) + ((size_t)(b * 4 + l) * 512) * 128 + kv * 64;
    const u16* cvt = (const u16*)(ws + O_CAVT) + ((size_t)(b * 4 + l) * 128 + kv * 64) * 512;
    for (int p0 = 0; p0 < 512; p0 += 32) {
      attn_kvload(f, ck + (size_t)p0 * 128, 128, cvt + p0, 512, fr, fq);
      attn_core<0>(st[0], qf[0], f, fr, fq, 0, 0, nullptr);
      attn_core<0>(st[1], qf[1], f, fr, fq, 0, 0, nullptr);
    }
    const u16* K = (const u16*)(ws + O_KA) + (size_t)(NCTX + b * 2048) * 128 + kv * 64;
    const u16* VT = (const u16*)(ws + O_VAT) + (size_t)(kv * 64) * NT + NCTX + b * 2048;
    const int ta = (qt & 127) * 16;
    const int kb0 = max(0, ((ta - 128) >> 5) << 5), kb1 = min(2048, ta + 32 + 128);
    for (int k0 = kb0; k0 < kb1; k0 += 32) {
      attn_kvload(f, K + (size_t)k0 * 128, 128, VT + k0, NT, fr, fq);
      attn_core<1>(st[0], qf[0], f, fr, fq, ta + fr, k0, nullptr);
      attn_core<1>(st[1], qf[1], f, fr, fq, ta + 16 + fr, k0, nullptr);
    }
  } else if (type == 1) {
    const int qt = qp * 2;
    const int b = qt >> 7;
    const u16* ck = (const u16*)(ws + O_CCK) + ((size_t)(b * 4 + l) * 512) * 512 + h * 64;
    const u16* cvt = (const u16*)(ws + O_CCVT) + ((size_t)(b * 4 + l) * 512 + h * 64) * 512;
    for (int p0 = 0; p0 < 512; p0 += 32) {
      attn_kvload(f, ck + (size_t)p0 * 512, 512, cvt + p0, 512, fr, fq);
      attn_core<0>(st[0], qf[0], f, fr, fq, 0, 0, nullptr);
      attn_core<0>(st[1], qf[1], f, fr, fq, 0, 0, nullptr);
    }
    const u16* K = (const u16*)(ws + O_KC) + (size_t)(NCTX + b * 2048) * 512 + h * 64;
    const u16* VT = (const u16*)(ws + O_VCT) + (size_t)(h * 64) * NT + NCTX + b * 2048;
    const float* rpb = p.in[29] + (size_t)(l * 8 + h) * 15 * 31;
#pragma unroll
    for (int i = 0; i < 2; ++i) {
      const int t0 = ((qt + i) & 127) * 16;
      const int qrow = t0 >> 6, c0 = t0 & 63;
      const int rs = min(max(qrow - 4, 0), 24);
      const int cstart = min(max(c0 - 8, 0), 32);
      for (int a = 0; a < 8; ++a) {
        int krow = rs + a;
        int k0 = krow * 64 + cstart;
        attn_kvload(f, K + (size_t)k0 * 512, 512, VT + k0, NT, fr, fq);
        attn_core<2>(st[i], qf[i], f, fr, fq, c0 + fr, cstart, rpb + (krow - qrow + 7) * 31);
      }
    }
  } else if (type == 2) {
    const int b = (qp * 2) >> 4, kv = h >> 2;
    const u16* K = (const u16*)(ws + O_KA) + (size_t)(b * 256) * 128 + kv * 64;
    const u16* VT = (const u16*)(ws + O_VAT) + (size_t)(kv * 64) * NT + b * 256;
    for (int k0 = 0; k0 < 256; k0 += 32) {
      attn_kvload(f, K + (size_t)k0 * 128, 128, VT + k0, NT, fr, fq);
      attn_core<0>(st[0], qf[0], f, fr, fq, 0, 0, nullptr);
      attn_core<0>(st[1], qf[1], f, fr, fq, 0, 0, nullptr);
    }
  } else {
    const int b = (qp * 2) >> 4;
    const u16* K = (const u16*)(ws + O_KC) + (size_t)(b * 256) * 512 + h * 64;
    const u16* VT = (const u16*)(ws + O_VCT) + (size_t)(h * 64) * NT + b * 256;
    for (int k0 = 0; k0 < 256; k0 += 32) {
      attn_kvload(f, K + (size_t)k0 * 512, 512, VT + k0, NT, fr, fq);
      attn_core<0>(st[0], qf[0], f, fr, fq, 0, 0, nullptr);
      attn_core<0>(st[1], qf[1], f, fr, fq, 0, 0, nullptr);
    }
  }
#pragma unroll
  for (int i = 0; i < 2; ++i) {
    float lt = st[i].l;
    lt += __shfl_xor(lt, 16);
    lt += __shfl_xor(lt, 32);
    float inv = 1.f / lt;
#pragma unroll
    for (int dt = 0; dt < 4; ++dt) {
      u32x2 o; o[0] = pack2(st[i].o[dt][0] * inv, st[i].o[dt][1] * inv); o[1] = pack2(st[i].o[dt][2] * inv, st[i].o[dt][3] * inv);
      *(u32x2*)(Y + (size_t)(tok0 + i * 16 + fr) * 512 + h * 64 + dt * 16 + fq * 4) = o;
    }
  }
}


__device__ void phase_mix(const Params& p, int l) {
  char* ws = opaque_ptr(p.ws);
  const int tid = opaque_tid();
  const int wid = tid >> 6, lane = tid & 63;
  constexpr int LJPL = 4;
  constexpr int BPS = 64 / (4 * LJPL);
  const int NLB = (int)gridDim.x >= 2 * 32 * BPS ? 32 * BPS : 0;
  if ((int)blockIdx.x < NLB) {
    __builtin_amdgcn_s_setprio(3);
    const int it = blockIdx.x;
    const int sc = it / BPS, hf = it % BPS;
    const int z = sc & 1, h = (sc >> 1) & 7, b = sc >> 4;
    const float* s0 = p.in[6] + ((size_t)((b * 4 + l) * 2 + z) * 8 + h) * 4096;
    scan_latent_block<LJPL, 2048>(ws, tid, z, h, NCTX + b * 2048, hf * 4 * LJPL, s0, nullptr);
  } else {
    __builtin_amdgcn_s_setprio(1);
    if (NLB == 0) {
      for (int it = blockIdx.x * 4 + wid; it < 256; it += gridDim.x * 4) {
        int sc = it >> 3, part = it & 7;
        int z = sc & 1, h = (sc >> 1) & 7, b = sc >> 4;
        const float* s0 = p.in[6] + ((size_t)((b * 4 + l) * 2 + z) * 8 + h) * 4096;
        scan_wave_dma<8, 8>(ws, lane, wid * 12288, z, h, NCTX + b * 2048, 2048, part * 8, s0, nullptr);
      }
    }
    if (NLB > 0) {
      const int nab = (int)gridDim.x - NLB;
      for (int it = (int)blockIdx.x - NLB; it < 512; it += nab) {
        int sc = it >> 1, hf = it & 1;
        int z = sc & 1, h = (sc >> 1) & 7, b = sc >> 4;
        float* so = p.out + OUT_ST + ((size_t)((b * 4 + l) * 2 + z) * 8 + h) * 4096;
        scan_latent_block<8, 256>(ws, tid, z, h, b * 256, hf * 32, nullptr, so);
      }
    } else {
      const int nw = gridDim.x * 4;
      for (int it = (int)blockIdx.x * 4 + wid; it < 2048; it += nw) {
        int sc = it >> 3, part = it & 7;
        int z = sc & 1, h = (sc >> 1) & 7, b = sc >> 4;
        float* so = p.out + OUT_ST + ((size_t)((b * 4 + l) * 2 + z) * 8 + h) * 4096;
        scan_wave_dma<8, 8>(ws, lane, wid * 12288, z, h, b * 256, 256, part * 8, nullptr, so);
      }
    }
  }
  __builtin_amdgcn_s_setprio(0);
  int* cnt = (int*)(ws + O_CNT) + l;
  while (true) {
    int it = 0;
    if (lane == 0) it = atomicAdd(cnt, 1);
    it = __builtin_amdgcn_readfirstlane(it);
    if (it >= 4096) break;
    attn_item(p, ws, lane, l, it);
  }
  if (l == 0) {
    int* cnt2 = (int*)(ws + O_CNT) + 8;
    while (true) {
      int it = 0;
      if (lane == 0) it = atomicAdd(cnt2, 1);
      it = __builtin_amdgcn_readfirstlane(it);
      if (it >= 4096) break;
      const int tab = it >> 11, rb = (it & 2047) * 32;
      if (tab == 0) convert_rows_fp8_wave(lane, p.in[34], (unsigned char*)(ws + O_PEU), (float*)(ws + O_SCU), rb, rb + 32);
      else convert_rows_fp8_wave(lane, p.in[35], (unsigned char*)(ws + O_PEV), (float*)(ws + O_SCV), rb, rb + 32);
    }
  }
}

__device__ void phase_rwkv_post(const Params& p, int l) {
  char* ws = opaque_ptr(p.ws);
  const int tid = opaque_tid();
  const int lane = tid & 63;
  const int gw = blockIdx.x * 4 + (tid >> 6), GW = gridDim.x * 4;
  const float* Y0 = (const float*)(ws + O_YS);
  const float* Y1 = Y0 + (size_t)NT * 512;
  const float* KD0 = (const float*)(ws + O_KD);
  const float* KD1 = KD0 + (size_t)NT * 512;
  for (int tok = gw; tok < NT; tok += GW) {
#pragma unroll
    for (int i = 0; i < 2; ++i) {
      int c = (lane + 64 * i) * 4;
      size_t e = (size_t)tok * 512 + c;
      f32x4 a = *(const f32x4*)(Y0 + e), b = *(const f32x4*)(Y1 + e);
      f32x4 y;
      float s = 0.f;
#pragma unroll
      for (int j = 0; j < 4; ++j) { y[j] = a[j] + b[j]; s += y[j]; }
      float mu = row_sum16(s) * (1.f / 64.f);
      float vs = 0.f;
#pragma unroll
      for (int j = 0; j < 4; ++j) { y[j] -= mu; vs += y[j] * y[j]; }
      float var = row_sum16(vs) * (1.f / 64.f);
      float rstd = rsqrtf(var + 64e-5f);
      f32x4 g = *(const f32x4*)(p.in[26] + l * 512 + c), bb = *(const f32x4*)(p.in[27] + l * 512 + c);
      f32x4 r = *(const f32x4*)((const float*)(ws + O_XRKV) + (size_t)tok * 1536 + c);
      f32x4 v = *(const f32x4*)((const float*)(ws + O_XRKV) + (size_t)tok * 1536 + 1024 + c);
      f32x4 k0 = *(const f32x4*)(KD0 + e), k1 = *(const f32x4*)(KD1 + e);
      f32x4 rk = *(const f32x4*)(p.in[25] + l * 512 + c);
      float bs = 0.f;
#pragma unroll
      for (int j = 0; j < 4; ++j) bs += r[j] * (k0[j] + k1[j]) * rk[j];
      bs = row_sum16(bs);
      f32x4 gg = *(const f32x4*)((const float*)(ws + O_GG) + e);
      float o[4];
#pragma unroll
      for (int j = 0; j < 4; ++j) o[j] = (y[j] * rstd * g[j] + bb[j] + bs * v[j]) * gg[j];
      u32x2 ov; ov[0] = pack2(o[0], o[1]); ov[1] = pack2(o[2], o[3]);
      *(u32x2*)((u16*)(ws + O_YABC) + (size_t)NT * 512 + e) = ov;
    }
  }
}

__device__ void phase_branch(const Params& p, int l) {
  char* ws = opaque_ptr(p.ws);
  const int tid = opaque_tid();
  const int wid = tid >> 6, lane = tid & 63, wr = wid >> 1, wc = wid & 1, fr = lane & 15, fq = lane >> 4;
  const u16* G = (const u16*)(ws + O_GATE);
  for (int t = blockIdx.x; t < 64 * 8; t += gridDim.x) {
    const int tm = t & 63, tn = t >> 6;
    const int brow = tm * 128, bcol = tn * 128;
    f32x4 tot[4][4];
    zero_acc(tot);
#pragma unroll 1
    for (int br = 0; br < 3; ++br) {
      f32x4 acc[4][4];
      zero_acc(acc);
      const u16* Wb = (const u16*)(ws + (br == 0 ? O_AOUT : br == 1 ? O_RWOUT : O_NAOUT)) + ((size_t)l * 1024 + bcol) * 512;
      gemm_main(tid, (const u16*)(ws + O_YABC) + (size_t)br * NT * 512 + (size_t)brow * 512, 512, Wb, 512, 512, acc, ((tm >> 3) + (tn & 7)) & 7);
#pragma unroll
      for (int m = 0; m < 4; ++m) {
        const int tok = brow + wr * 64 + m * 16 + fr;
#pragma unroll
        for (int n = 0; n < 4; ++n) {
          const int c = bcol + wc * 64 + n * 16 + fq * 4;
          u32x2 gv = *(const u32x2*)(G + (size_t)tok * 3072 + br * 1024 + c);
          tot[m][n][0] += acc[m][n][0] * __uint_as_float(gv[0] << 16);
          tot[m][n][1] += acc[m][n][1] * __uint_as_float(gv[0] & 0xffff0000u);
          tot[m][n][2] += acc[m][n][2] * __uint_as_float(gv[1] << 16);
          tot[m][n][3] += acc[m][n][3] * __uint_as_float(gv[1] & 0xffff0000u);
        }
      }
    }
#pragma unroll
    for (int m = 0; m < 4; ++m) {
      const int tok = brow + wr * 64 + m * 16 + fr;
#pragma unroll
      for (int n = 0; n < 4; ++n) {
        const int c = bcol + wc * 64 + n * 16 + fq * 4;
        u32x2 o; o[0] = pack2(tot[m][n][0], tot[m][n][1]); o[1] = pack2(tot[m][n][2], tot[m][n][3]);
        *(u32x2*)((u16*)(ws + O_MERG) + (size_t)tok * 1024 + c) = o;
      }
    }
  }
}

__device__ void phase_wo(const Params& p, int l) {
  char* ws = opaque_ptr(p.ws);
  const int tid = opaque_tid();
  const int wid = tid >> 6, lane = tid & 63, wr = wid >> 1, wc = wid & 1, fr = lane & 15, fq = lane >> 4;
  float* X = (float*)(ws + O_X);
  for (int t = blockIdx.x; t < 64 * 8; t += gridDim.x) {
    const int tm = t & 63, tn = t >> 6;
    const int brow = tm * 128, bcol = tn * 128;
    f32x4 acc[4][4];
    zero_acc(acc);
    gemm_main(tid, (const u16*)(ws + O_MERG) + (size_t)brow * 1024, 1024, (const u16*)(ws + O_WO) + ((size_t)l * 1024 + bcol) * 1024, 1024, 1024, acc, (((tm >> 3) + (tn & 7)) * 2) & 15);
#pragma unroll
    for (int m = 0; m < 4; ++m) {
      const int tok = brow + wr * 64 + m * 16 + fr;
      const float* gate = (const float*)(ws + O_MOD) + ((size_t)l * 3 + tok_cond(tok)) * 6144 + 2 * 1024;
#pragma unroll
      for (int n = 0; n < 4; ++n) {
        const int c = bcol + wc * 64 + n * 16 + fq * 4;
        f32x4 x = *(f32x4*)(X + (size_t)tok * 1024 + c);
        f32x4 g = *(const f32x4*)(gate + c);
#pragma unroll
        for (int j = 0; j < 4; ++j) x[j] += g[j] * acc[m][n][j];
        *(f32x4*)(X + (size_t)tok * 1024 + c) = x;
      }
    }
  }
}

__device__ void phase_peq(const Params& p, int l) {
  char* ws = opaque_ptr(p.ws);
  const int tid = opaque_tid();
  const int wid = tid >> 6, lane = tid & 63, wr = wid >> 1, wc = wid & 1, fr = lane & 15, fq = lane >> 4;
  for (int t = blockIdx.x; t < 64 * 16; t += gridDim.x) {
    const int tm = t & 63, tn = t >> 6;
    const int brow = tm * 128, bcol = tn * 128;
    f32x4 acc[4][4];
    zero_acc(acc);
    gemm_main(tid, (const u16*)(ws + O_H) + (size_t)brow * 1024, 1024, (const u16*)(ws + O_PEQ) + ((size_t)l * 2048 + bcol) * 1024, 1024, 1024, acc, (((tm >> 3) + (tn & 7)) * 2) & 15);
#pragma unroll
    for (int m = 0; m < 4; ++m) {
      const int tok = brow + wr * 64 + m * 16 + fr;
#pragma unroll
      for (int n = 0; n < 4; ++n) {
        const int c = bcol + wc * 64 + n * 16 + fq * 4;
        u32x2 o; o[0] = pack2(acc[m][n][0], acc[m][n][1]); o[1] = pack2(acc[m][n][2], acc[m][n][3]);
        *(u32x2*)((u16*)(ws + O_PQ) + (size_t)tok * 2048 + c) = o;
      }
    }
  }
}

__device__ const unsigned char kCand[64] = {
    0x00, 0x01, 0x02, 0x03, 0x04, 0x05, 0x06, 0x07, 0x08, 0x09, 0x0a, 0x0b, 0x0c, 0x0d, 0x0e, 0x0f,
    0x10, 0x11, 0x12, 0x13, 0x14, 0x15, 0x16, 0x17, 0x20, 0x21, 0x22, 0x23, 0x24, 0x30, 0x31, 0x32,
    0x33, 0x40, 0x41, 0x42, 0x50, 0x51, 0x60, 0x61, 0x70, 0x71, 0x80, 0x90, 0xa0, 0xb0, 0xc0, 0xd0,
    0xe0, 0xf0, 0xff, 0xff, 0xff, 0xff, 0xff, 0xff, 0xff, 0xff, 0xff, 0xff, 0xff, 0xff, 0xff, 0xff};

DI unsigned f2key(float f) { unsigned u = __float_as_uint(f); return (u & 0x80000000u) ? ~u : (u | 0x80000000u); }
DI float key2f(unsigned k) { unsigned u = (k & 0x80000000u) ? (k & 0x7fffffffu) : ~k; return __uint_as_float(u); }
template <int CTRL> DI unsigned dppu(unsigned v) { return (unsigned)__builtin_amdgcn_update_dpp(0, (int)v, CTRL, 0xf, 0xf, true); }
DI unsigned row_max16u(unsigned v) { v = max(v, dppu<0xB1>(v)); v = max(v, dppu<0x4E>(v)); v = max(v, dppu<0x141>(v)); v = max(v, dppu<0x140>(v)); return v; }

__device__ void phase_peer_sel(const Params& p, int l) {
  char* ws = opaque_ptr(p.ws);
  const int tid = opaque_tid();
  const int wid = tid >> 6, lane = tid & 63, fr = lane & 15, fq = lane >> 4;
  const int gw = blockIdx.x * 4 + wid, GW = gridDim.x * 4;
  float* lv = (float*)(g_smem + wid * 4096);
  int* li = (int*)(g_smem + wid * 4096 + 2048);
  const u16* PQ = (const u16*)(ws + O_PQ);
  int ca[4], cb[4];
  bool cvld[4];
#pragma unroll
  for (int c = 0; c < 4; ++c) { int code = kCand[c * 16 + fr]; cvld[c] = code != 0xff; ca[c] = (code >> 4) & 15; cb[c] = code & 15; }
  for (int it = gw; it < 512 * 8; it += GW) {
    const int h = it >> 9, tg = it & 511;
    const u16* SK = (const u16*)(ws + O_SUBK) + ((size_t)(l * 8 + h) * 2) * 128 * 128;
    f32x4 sc[2][8];
#pragma unroll
    for (int z = 0; z < 2; ++z) {
      bf16x8 qf[4];
#pragma unroll
      for (int ks = 0; ks < 4; ++ks) qf[ks] = *(const bf16x8*)(PQ + (size_t)(tg * 16 + fr) * 2048 + (h * 2 + z) * 128 + ks * 32 + fq * 8);
#pragma unroll
      for (int nt = 0; nt < 8; ++nt) {
        sc[z][nt] = f32x4{0.f, 0.f, 0.f, 0.f};
#pragma unroll
        for (int ks = 0; ks < 4; ++ks) {
          bf16x8 kf = *(const bf16x8*)(SK + ((size_t)z * 128 + nt * 16 + fr) * 128 + ks * 32 + fq * 8);
          sc[z][nt] = mfma16(qf[ks], kf, sc[z][nt]);
        }
      }
    }
#pragma unroll
    for (int z = 0; z < 2; ++z) {
#pragma unroll
      for (int j = 0; j < 4; ++j) {
        unsigned key[8];
#pragma unroll
        for (int nt = 0; nt < 8; ++nt) key[nt] = (f2key(sc[z][nt][j]) & ~127u) | (unsigned)(127 - (nt * 16 + fr));
        unsigned tk = 0u;
#pragma unroll 1
        for (int k = 0; k < 16; ++k) {
          unsigned m = key[0];
#pragma unroll
          for (int nt = 1; nt < 8; ++nt) m = max(m, key[nt]);
          unsigned M = row_max16u(m);
#pragma unroll
          for (int nt = 0; nt < 8; ++nt) key[nt] = key[nt] == M ? 0u : key[nt];
          if (fr == k) tk = M;
        }
        lv[((fq * 4 + j) * 2 + z) * 16 + fr] = key2f(tk & ~127u);
        li[((fq * 4 + j) * 2 + z) * 16 + fr] = 127 - (int)(tk & 127u);
      }
    }
    __builtin_amdgcn_s_waitcnt(0xc07f);
    __builtin_amdgcn_wave_barrier();
#pragma unroll 1
    for (int j = 0; j < 4; ++j) {
      const int tl = fq * 4 + j;
      float cand[4];
#pragma unroll
      for (int c = 0; c < 4; ++c) cand[c] = cvld[c] ? lv[(tl * 2 + 0) * 16 + ca[c]] + lv[(tl * 2 + 1) * 16 + cb[c]] : -3e38f;
      unsigned ck[4];
#pragma unroll
      for (int c = 0; c < 4; ++c) ck[c] = cvld[c] ? ((f2key(cand[c]) & ~63u) | (unsigned)(63 - (c * 16 + fr))) : 0u;
      unsigned sk = 0u;
#pragma unroll 1
      for (int k = 0; k < 16; ++k) {
        unsigned m = max(max(ck[0], ck[1]), max(ck[2], ck[3]));
        unsigned M = row_max16u(m);
#pragma unroll
        for (int c = 0; c < 4; ++c) ck[c] = ck[c] == M ? 0u : ck[c];
        if (fr == k) sk = M;
      }
      const float sv = key2f(sk & ~63u);
      const int scode = 63 - (int)(sk & 63u);
      int ab = kCand[scode];
      int e = li[(tl * 2 + 0) * 16 + ((ab >> 4) & 15)] * 128 + li[(tl * 2 + 1) * 16 + (ab & 15)];
      float mx = row_max16(sv);
      float ex = __expf(sv - mx);
      float sum = row_sum16(ex);
      int tok = tg * 16 + tl;
      ((int*)(ws + O_EIDX))[(size_t)tok * 128 + h * 16 + fr] = e;
      ((float*)(ws + O_EGATE))[(size_t)tok * 128 + h * 16 + fr] = ex / sum;
    }
    __builtin_amdgcn_s_waitcnt(0xc07f);
    __builtin_amdgcn_wave_barrier();
  }
}

DI void cvt8(const bf16x8& v, float (&f)[8]) {
  u32x4 u = __builtin_bit_cast(u32x4, v);
#pragma unroll
  for (int q = 0; q < 4; ++q) { f[2 * q] = __uint_as_float(u[q] << 16); f[2 * q + 1] = __uint_as_float(u[q] & 0xffff0000u); }
}
DI void cvt16(const u32x4& q, float (&f)[16]) {
#pragma unroll
  for (int i = 0; i < 4; ++i) {
    f32x2 a = __builtin_amdgcn_cvt_pk_f32_fp8((int)q[i], false), b = __builtin_amdgcn_cvt_pk_f32_fp8((int)q[i], true);
    f[4 * i] = a[0]; f[4 * i + 1] = a[1]; f[4 * i + 2] = b[0]; f[4 * i + 3] = b[1];
  }
}

__device__ void phase_peer_gather(const Params& p, int l, bool dry = false) {
  char* ws = opaque_ptr(p.ws);
  const int tid = opaque_tid();
  const int lane = tid & 63;
  const int gw = blockIdx.x * 4 + (tid >> 6), GW = gridDim.x * 4;
  const unsigned char* U = (const unsigned char*)(ws + O_PEU) + (size_t)l * 16384 * 1024;
  const unsigned char* V = (const unsigned char*)(ws + O_PEV) + (size_t)l * 16384 * 1024;
  const float* SU = (const float*)(ws + O_SCU) + l * 16384;
  const float* SV = (const float*)(ws + O_SCV) + l * 16384;
  float* X = (float*)(ws + O_X);
  float* XW = dry ? (float*)(ws + O_YS) : X;
  u16* HW = dry ? (u16*)(ws + O_MERG) : (u16*)(ws + O_H);
  float* OW = dry ? (float*)(ws + O_PB) : p.out + OUT_Y;
  for (int tok = gw; tok < NT; tok += GW) {
    float hf[16];
    {
      const u16* hr = (const u16*)(ws + O_H) + (size_t)tok * 1024 + lane * 16;
      bf16x8 h0 = *(const bf16x8*)(hr), h1 = *(const bf16x8*)(hr + 8);
      float t0[8], t1[8];
      cvt8(h0, t0); cvt8(h1, t1);
#pragma unroll
      for (int i = 0; i < 8; ++i) { hf[i] = t0[i]; hf[8 + i] = t1[i]; }
    }
    float acc[16];
#pragma unroll
    for (int i = 0; i < 16; ++i) acc[i] = 0.f;
    const int id0 = ((const int*)(ws + O_EIDX))[(size_t)tok * 128 + lane], id1 = ((const int*)(ws + O_EIDX))[(size_t)tok * 128 + 64 + lane];
    const float g0 = ((const float*)(ws + O_EGATE))[(size_t)tok * 128 + lane], g1 = ((const float*)(ws + O_EGATE))[(size_t)tok * 128 + 64 + lane];
#define PG_LOAD(G, ids, gts, su, sv, uq, vq)                                                                      \
  do {                                                                                                            \
    _Pragma("unroll") for (int e = 0; e < 4; ++e) {                                                               \
      int k = (G) * 4 + e;                                                                                        \
      int sel = k & 63;                                                                                           \
      int a_ = __builtin_amdgcn_readlane(id0, sel), b_ = __builtin_amdgcn_readlane(id1, sel);                     \
      float ga_ = __builtin_bit_cast(float, __builtin_amdgcn_readlane(__builtin_bit_cast(int, g0), sel));         \
      float gb_ = __builtin_bit_cast(float, __builtin_amdgcn_readlane(__builtin_bit_cast(int, g1), sel));         \
      ids[e] = (G) < 16 ? a_ : b_;                                                                                 \
      gts[e] = (G) < 16 ? ga_ : gb_;                                                                               \
    }                                                                                                             \
    _Pragma("unroll") for (int e = 0; e < 4; ++e) uq[e] = *(const u32x4*)(U + (size_t)ids[e] * 1024 + lane * 16); \
    _Pragma("unroll") for (int e = 0; e < 4; ++e) vq[e] = *(const u32x4*)(V + (size_t)ids[e] * 1024 + lane * 16); \
    _Pragma("unroll") for (int e = 0; e < 4; ++e) { su[e] = SU[ids[e]]; sv[e] = SV[ids[e]]; }                     \
  } while (0)
#define PG_COMP(gts, su, sv, uq, vq)                                                                              \
  do {                                                                                                            \
    float cf[4];                                                                                                  \
    _Pragma("unroll") for (int e = 0; e < 4; ++e) {                                                               \
      float a[16];                                                                                                \
      cvt16(uq[e], a);                                                                                            \
      float d0 = 0.f, d1 = 0.f;                                                                                   \
      _Pragma("unroll") for (int i = 0; i < 16; i += 2) { d0 += a[i] * hf[i]; d1 += a[i + 1] * hf[i + 1]; }       \
      float d = wave_sum(d0 + d1) * su[e];                                                                        \
      float u3 = 0.7978845608028654f * (d + 0.044715f * d * d * d);                                               \
      float th = 1.f - 2.f * __builtin_amdgcn_rcpf(__expf(2.f * u3) + 1.f);                                                            \
      cf[e] = gts[e] * 0.5f * d * (1.f + th) * sv[e];                                                             \
    }                                                                                                             \
    _Pragma("unroll") for (int e = 0; e < 4; ++e) {                                                               \
      float a[16];                                                                                                \
      cvt16(vq[e], a);                                                                                            \
      _Pragma("unroll") for (int i = 0; i < 16; ++i) acc[i] += cf[e] * a[i];                                      \
    }                                                                                                             \
  } while (0)
    {
      int idA[4], idB[4];
      float gtA[4], gtB[4], suA[4], svA[4], suB[4], svB[4];
      u32x4 uqA[4], vqA[4], uqB[4], vqB[4];
      PG_LOAD(0, idA, gtA, suA, svA, uqA, vqA);
#pragma unroll 1
      for (int g = 0; g < 32; g += 2) {
        PG_LOAD(g + 1, idB, gtB, suB, svB, uqB, vqB);
        PG_COMP(gtA, suA, svA, uqA, vqA);
        if (g + 2 < 32) PG_LOAD(g + 2, idA, gtA, suA, svA, uqA, vqA);
        PG_COMP(gtB, suB, svB, uqB, vqB);
      }
    }
#undef PG_LOAD
#undef PG_COMP
    const float* mod = (const float*)(ws + O_MOD) + ((size_t)l * 3 + tok_cond(tok)) * 6144;
    float x[16];
    const int e0 = lane * 16;
#pragma unroll
    for (int q = 0; q < 4; ++q) {
      f32x4 a = *(const f32x4*)(X + (size_t)tok * 1024 + e0 + q * 4);
      f32x4 ga = *(const f32x4*)(mod + 5 * 1024 + e0 + q * 4);
#pragma unroll
      for (int i = 0; i < 4; ++i) { a[i] += ga[i] * acc[q * 4 + i]; x[q * 4 + i] = a[i]; }
      *(f32x4*)(XW + (size_t)tok * 1024 + e0 + q * 4) = a;
    }
    float ss = 0.f;
#pragma unroll
    for (int i = 0; i < 16; ++i) ss += x[i] * x[i];
    ss = wave_sum(ss);
    const float rstd = rsqrtf(ss * (1.f / 1024.f) + 1e-6f);
    if (l < NL - 1) {
      const float* mod2 = (const float*)(ws + O_MOD) + ((size_t)(l + 1) * 3 + tok_cond(tok)) * 6144;
      const float* g = p.in[9] + (l + 1) * 1024;
      float y[16];
#pragma unroll
      for (int q = 0; q < 4; ++q) {
        f32x4 gg = *(const f32x4*)(g + e0 + q * 4), sh = *(const f32x4*)(mod2 + e0 + q * 4), sc = *(const f32x4*)(mod2 + 1024 + e0 + q * 4);
#pragma unroll
        for (int i = 0; i < 4; ++i) y[q * 4 + i] = x[q * 4 + i] * rstd * gg[i] * (1.f + sc[i]) + sh[i];
      }
      u32x4 o0, o1;
      o0[0] = pack2(y[0], y[1]); o0[1] = pack2(y[2], y[3]); o0[2] = pack2(y[4], y[5]); o0[3] = pack2(y[6], y[7]);
      o1[0] = pack2(y[8], y[9]); o1[1] = pack2(y[10], y[11]); o1[2] = pack2(y[12], y[13]); o1[3] = pack2(y[14], y[15]);
      *(u32x4*)(HW + (size_t)tok * 1024 + e0) = o0;
      *(u32x4*)(HW + (size_t)tok * 1024 + e0 + 8) = o1;
    } else {
      const float* g = p.in[11];
#pragma unroll
      for (int q = 0; q < 4; ++q) {
        f32x4 gg = *(const f32x4*)(g + e0 + q * 4), a;
#pragma unroll
        for (int i = 0; i < 4; ++i) a[i] = x[q * 4 + i] * rstd * gg[i];
        *(f32x4*)(OW + (size_t)tok * 1024 + e0 + q * 4) = a;
      }
    }
  }
}

#define XB_TMO 128
#define XB_XCNT(j) (256 + 64 * (j))
#define XB_XSUB(j) (1280 + 64 * (j))
#define XB_XGEN(j) (2304 + 64 * (j))
#define XB_TOP 3328
#define XB_TOPGEN 3392
#define XCD_BAR_WORDS 3456
#define XB_SPIN_CAP (1u << 18)
DI unsigned xb_ld(unsigned* q) { return __hip_atomic_load(q, __ATOMIC_RELAXED, __HIP_MEMORY_SCOPE_AGENT); }
DI unsigned xb_add(unsigned* q, unsigned v) { return __hip_atomic_fetch_add(q, v, __ATOMIC_RELAXED, __HIP_MEMORY_SCOPE_AGENT); }
DI unsigned xb_xcc_id() { return (unsigned)__builtin_amdgcn_s_getreg((3 << 11) | 20) & 0xFu; }
#define XB_SPIN(cond, bar)                                                                   \
  do {                                                                                       \
    unsigned _sp = 0;                                                                        \
    while (cond) {                                                                           \
      __builtin_amdgcn_s_sleep(1);                                                           \
      if ((++_sp & 255u) == 0u) {                                                            \
        if (xb_ld(&(bar)[XB_TMO])) break;                                                    \
        if (_sp > XB_SPIN_CAP) { atomicAdd(&(bar)[XB_TMO], 1u); break; }                     \
      }                                                                                      \
    }                                                                                        \
  } while (0)
struct XB { unsigned* bar; unsigned x, nloc, nx; };
DI void xcd_barrier(const XB& b) {
  asm volatile("s_waitcnt vmcnt(0)" ::: "memory");
  __syncthreads();
  if (threadIdx.x == 0) {
    unsigned* bar = b.bar;
    __builtin_amdgcn_s_waitcnt(0);
    const unsigned nloc = b.nloc, nx = b.nx;
    const unsigned old = xb_add(&bar[XB_XSUB(b.x)], 1u);
    const unsigned gen = old / nloc;
    if (old + 1u == (gen + 1u) * nloc) {
      __builtin_amdgcn_fence(__ATOMIC_RELEASE, "agent");
      asm volatile("s_waitcnt vmcnt(0)" ::: "memory");
      const unsigned og = xb_add(&bar[XB_TOP], 1u);
      const unsigned tg = og / nx;
      if (og + 1u == (tg + 1u) * nx) xb_add(&bar[XB_TOPGEN], 1u);
      else XB_SPIN(xb_ld(&bar[XB_TOPGEN]) == tg, bar);
      __builtin_amdgcn_fence(__ATOMIC_ACQUIRE, "agent");
      xb_add(&bar[XB_XGEN(b.x)], 1u);
      asm volatile("s_waitcnt vmcnt(0)" ::: "memory");
    } else {
      XB_SPIN(xb_ld(&bar[XB_XGEN(b.x)]) == gen, bar);
      __builtin_amdgcn_fence(__ATOMIC_ACQUIRE, "agent");
      asm volatile("s_waitcnt vmcnt(0)" ::: "memory");
    }
  }
  __syncthreads();
}

__global__ void __launch_bounds__(256, 2) fwd_megakernel(Params p) {
  cg::grid_group grid = cg::this_grid();
  XB xb;
  xb.bar = (unsigned*)(p.ws + O_BAR);
  xb.x = xb_xcc_id();
  if (threadIdx.x == 0) (void)xb_add(&xb.bar[XB_XCNT(xb.x)], 1u);
  phase_prep(p);
  if (p.ws == nullptr) grid.sync();
  {
    unsigned mine = 0u, cnt = 0u, sum = 0u, sp = 0u;
    for (;;) {
      sum = 0u; cnt = 0u; mine = 0u;
#pragma unroll
      for (unsigned j = 0; j < 16; ++j) { const unsigned c = xb_ld(&xb.bar[XB_XCNT(j)]); sum += c; cnt += (c > 0u) ? 1u : 0u; mine = (j == xb.x) ? c : mine; }
      if (sum == gridDim.x) break;
      __builtin_amdgcn_s_sleep(1);
      if (++sp > XB_SPIN_CAP) break;
    }
    xb.nloc = __builtin_amdgcn_readfirstlane(mine > 0u ? mine : 1u);
    xb.nx = __builtin_amdgcn_readfirstlane(cnt > 0u ? cnt : 1u);
  }
  xcd_barrier(xb);
  phase_norm(p, 0, 0);
  xcd_barrier(xb);
  for (int l = 0; l < NL; ++l) {
    phase_gemm_in(p, l);
    xcd_barrier(xb);
    phase_rwkv_prep(p, l);
    xcd_barrier(xb);
    phase_rwkv_lora(p, l);
    xcd_barrier(xb);
    phase_mix(p, l);
    xcd_barrier(xb);
    phase_rwkv_post(p, l);
    xcd_barrier(xb);
    phase_branch(p, l);
    xcd_barrier(xb);
    phase_wo(p, l);
    xcd_barrier(xb);
    phase_norm(p, l, 1);
    xcd_barrier(xb);
    phase_peq(p, l);
    xcd_barrier(xb);
    phase_peer_sel(p, l);
    xcd_barrier(xb);
    phase_peer_gather(p, l);
    if (l + 1 < NL) xcd_barrier(xb);
  }
}

extern "C" void kernel_launch(void* const* d_in, const int* in_sizes, int n_in, void* d_out, int out_size, void* d_ws, size_t ws_size,
                              hipStream_t stream) {
  static int grid_blocks = 0;
  if (!grid_blocks) {
    int dev = 0, cus = 0, per_cu = 0;
    hipGetDevice(&dev);
    hipDeviceGetAttribute(&cus, hipDeviceAttributeMultiprocessorCount, dev);
    hipOccupancyMaxActiveBlocksPerMultiprocessor(&per_cu, fwd_megakernel, 256, 0);
    if (per_cu > 2) per_cu = 2;
    if (per_cu < 1) per_cu = 1;
    grid_blocks = cus * per_cu;
  }
  Params p{};
  for (int i = 0; i < 36; ++i) p.in[i] = (const float*)d_in[i];
  p.out = (float*)d_out;
  p.ws = (char*)d_ws;
  (void)hipMemsetAsync((char*)d_ws + O_BAR, 0, 3456 * 4, stream);
  void* args[] = {&p};
  hipError_t e = hipLaunchCooperativeKernel((void*)fwd_megakernel, dim3(grid_blocks), dim3(256), args, 0, stream);
  if (e != hipSuccess) fprintf(stderr, "cooperative launch failed: %s (grid %d)\n", hipGetErrorString(e), grid_blocks);
}
```

```cpp
#include <hip/hip_runtime.h>
#include <hip/hip_cooperative_groups.h>
#include <cstdio>
namespace cg = cooperative_groups;

#define DI __device__ __forceinline__
typedef unsigned short u16;
using bf16x8 = __attribute__((ext_vector_type(8))) short;
using bf16x4 = __attribute__((ext_vector_type(4))) short;
using f32x4 = __attribute__((ext_vector_type(4))) float;
using u32x2 = __attribute__((ext_vector_type(2))) unsigned;
using u32x4 = __attribute__((ext_vector_type(4))) unsigned;

constexpr int NT = 8192, NCTX = 4096, DM = 1024, INC = 7296, NL = 4;

constexpr size_t AL(size_t x) { return (x + 255) / 256 * 256; }
constexpr size_t O_WIN = 0;
constexpr size_t O_AOUT = O_WIN + AL(4ull * 7296 * 1024 * 2);
constexpr size_t O_RWOUT = O_AOUT + AL(4ull * 1024 * 512 * 2);
constexpr size_t O_NAOUT = O_RWOUT + AL(4ull * 1024 * 512 * 2);
constexpr size_t O_WO = O_NAOUT + AL(4ull * 1024 * 512 * 2);
constexpr size_t O_PEQ = O_WO + AL(4ull * 1024 * 1024 * 2);
constexpr size_t O_SUBK = O_PEQ + AL(4ull * 2048 * 1024 * 2);
constexpr size_t O_W2 = O_SUBK + AL(4ull * 8 * 2 * 128 * 128 * 2);
constexpr size_t O_A2 = O_W2 + AL(8ull * 512 * 64 * 2);
constexpr size_t O_G2 = O_A2 + AL(8ull * 512 * 64 * 2);
constexpr size_t O_PEU = O_G2 + AL(4ull * 512 * 128 * 2);
constexpr size_t O_PEV = O_PEU + AL(4ull * 16384 * 1024 * 2);
constexpr size_t O_CAK = O_PEV + AL(4ull * 16384 * 1024 * 2);
constexpr size_t O_CAVT = O_CAK + AL(8ull * 512 * 128 * 2);
constexpr size_t O_CCK = O_CAVT + AL(8ull * 128 * 512 * 2);
constexpr size_t O_CCVT = O_CCK + AL(8ull * 512 * 512 * 2);
constexpr size_t O_MOD = O_CCVT + AL(8ull * 512 * 512 * 2);
constexpr size_t O_ROPE = O_MOD + AL(4ull * 3 * 6144 * 4);
constexpr size_t O_CNT = O_ROPE + AL(64 * 16 * 2 * 4);
constexpr size_t O_X = O_CNT + 256;
constexpr size_t O_H = O_X + AL(8192ull * 1024 * 4);
constexpr size_t O_QA = O_H + AL(8192ull * 1024 * 2);
constexpr size_t O_KA = O_QA + AL(8192ull * 512 * 2);
constexpr size_t O_VAT = O_KA + AL(8192ull * 128 * 2);
constexpr size_t O_QC = O_VAT + AL(8192ull * 128 * 2);
constexpr size_t O_KC = O_QC + AL(8192ull * 512 * 2);
constexpr size_t O_VCT = O_KC + AL(8192ull * 512 * 2);
constexpr size_t O_PB = O_VCT + AL(8192ull * 512 * 2);
constexpr size_t O_GATE = O_PB + AL(8192ull * 1920 * 4);
constexpr size_t O_XRKV = O_GATE + AL(8192ull * 3072 * 2);
constexpr size_t O_KK = O_XRKV + AL(8192ull * 1536 * 4);
constexpr size_t O_TW = O_KK + AL(8192ull * 512 * 4);
constexpr size_t O_AD = O_TW + AL(8192ull * 128 * 2);
constexpr size_t O_SG = O_AD + AL(8192ull * 128 * 2);
constexpr size_t O_DEC = O_SG + AL(8192ull * 128 * 2);
constexpr size_t O_KD = O_DEC + AL(2ull * 8192 * 512 * 4);
constexpr size_t O_KKA = O_KD + AL(2ull * 8192 * 512 * 4);
constexpr size_t O_GG = O_KKA + AL(2ull * 8192 * 512 * 4);
constexpr size_t O_YS = O_GG + AL(8192ull * 512 * 4);
constexpr size_t O_YABC = O_YS + AL(2ull * 8192 * 512 * 4);
constexpr size_t O_MERG = O_YABC + AL(3ull * 8192 * 512 * 2);
constexpr size_t O_PQ = O_MERG + AL(8192ull * 1024 * 2);
constexpr size_t O_EIDX = O_PQ + AL(8192ull * 2048 * 2);
constexpr size_t O_EGATE = O_EIDX + AL(8192ull * 128 * 4);
constexpr size_t O_SCU = O_EGATE + AL(8192ull * 128 * 4);
constexpr size_t O_SCV = O_SCU + AL(4ull * 16384 * 4);
constexpr size_t O_BAR = O_SCV + AL(4ull * 16384 * 4);
constexpr size_t WS_TOTAL = O_BAR + AL(3456 * 4);
static_assert(WS_TOTAL < 1020ull * 1024 * 1024, "workspace too large");

constexpr size_t OUT_Y = 0;
constexpr size_t OUT_AK = 8388608;
constexpr size_t OUT_AV = 10485760;
constexpr size_t OUT_CK = 12582912;
constexpr size_t OUT_CV = 20971520;
constexpr size_t OUT_ST = 29360128;

struct Params {
  const float* in[36];
  float* out;
  char* ws;
};

__shared__ __attribute__((aligned(16))) char g_smem[65536];

DI u16 f2bf(float x) { unsigned u = __float_as_uint(x); u += 0x7fffu + ((u >> 16) & 1u); return (u16)(u >> 16); }
DI float bf2f(u16 h) { return __uint_as_float(((unsigned)h) << 16); }
typedef __bf16 bf16x2_t __attribute__((ext_vector_type(2)));
DI unsigned pack2(float a, float b) { bf16x2_t v = {(__bf16)a, (__bf16)b}; return __builtin_bit_cast(unsigned, v); }
DI float sigmoidf_(float x) { return __builtin_amdgcn_rcpf(1.f + __expf(-x)); }
template <int CTRL> DI float dppf(float v) {
  return __builtin_bit_cast(float, __builtin_amdgcn_update_dpp(0, __builtin_bit_cast(int, v), CTRL, 0xf, 0xf, true));
}
template <int CTRL> DI int dppi(int v) { return __builtin_amdgcn_update_dpp(0, v, CTRL, 0xf, 0xf, true); }
DI float row_sum16(float v) { v += dppf<0xB1>(v); v += dppf<0x4E>(v); v += dppf<0x141>(v); v += dppf<0x140>(v); return v; }
DI float row_max16(float v) { v = fmaxf(v, dppf<0xB1>(v)); v = fmaxf(v, dppf<0x4E>(v)); v = fmaxf(v, dppf<0x141>(v)); v = fmaxf(v, dppf<0x140>(v)); return v; }
DI int row_max16i(int v) { v = max(v, dppi<0xB1>(v)); v = max(v, dppi<0x4E>(v)); v = max(v, dppi<0x141>(v)); v = max(v, dppi<0x140>(v)); return v; }
DI float wave_sum(float v) { v = row_sum16(v); v += __shfl_xor(v, 16); v += __shfl_xor(v, 32); return v; }

DI int opaque_tid() { int t = threadIdx.x; asm volatile("" : "+v"(t)); return t; }
DI char* opaque_ptr(char* q) { size_t z = 0; asm volatile("" : "+s"(z)); return q + z; }
DI f32x4 mfma16(bf16x8 a, bf16x8 b, f32x4 c) { return __builtin_amdgcn_mfma_f32_16x16x32_bf16(a, b, c, 0, 0, 0); }

DI int lds_byte(int r, int c) {
  int st = (r >> 4) * 2 + (c >> 5), rr = r & 15, cc = c & 31, ob = rr * 64 + cc * 2;
  return st * 1024 + (ob ^ (((ob >> 9) & 1) << 5));
}
DI void stage_rc(int b, int& R, int& C) {
  int st = b >> 10, sb = b & 1023, swz = sb ^ (((sb >> 9) & 1) << 5);
  R = (st >> 1) * 16 + (swz >> 6);
  C = (st & 1) * 32 + ((swz & 63) >> 1);
}
DI void gemm_main(int tid, const u16* __restrict__ g0, int ld0, const u16* __restrict__ g1, int ld1, int K, f32x4 (&acc)[4][4], int koff = 0) {
  const int wid = tid >> 6, lane = tid & 63, wr = wid >> 1, wc = wid & 1, fr = lane & 15, fq = lane >> 4;
  const int nk = K >> 6;
  int R0, C0;
  stage_rc(tid * 16, R0, C0);
  const unsigned v0 = (unsigned)(R0 * ld0 + C0), v1 = (unsigned)(R0 * ld1 + C0);
  const int fa0 = lds_byte(wr * 64 + fr, fq * 8), fa1 = 16384 + lds_byte(wc * 64 + fr, fq * 8);
  const int sb = tid * 16;
#define GSTAGE(kt, buf)                                                                                          \
  do {                                                                                                           \
    _Pragma("unroll") for (int i = 0; i < 4; ++i) {                                                              \
      const u16* u0 = g0 + (size_t)(kt) * 64 + (size_t)i * 32 * ld0;                                             \
      const u16* u1 = g1 + (size_t)(kt) * 64 + (size_t)i * 32 * ld1;                                             \
      __builtin_amdgcn_global_load_lds((const unsigned*)(u0 + v0), (unsigned*)(g_smem + (buf) + i * 4096 + sb), 16, 0, 0);          \
      __builtin_amdgcn_global_load_lds((const unsigned*)(u1 + v1), (unsigned*)(g_smem + (buf) + 16384 + i * 4096 + sb), 16, 0, 0);  \
    }                                                                                                            \
  } while (0)
  int kt = koff;
  GSTAGE(kt, 0);
  for (int t = 0; t < nk; ++t) {
    asm volatile("s_waitcnt vmcnt(0)" ::: "memory");
    __syncthreads();
    const int cur = (t & 1) * 32768;
    kt = kt + 1 == nk ? 0 : kt + 1;
    if (t + 1 < nk) GSTAGE(kt, 32768 - cur);
#pragma unroll
    for (int ks = 0; ks < 2; ++ks) {
      bf16x8 f0[4], f1[4];
#pragma unroll
      for (int m = 0; m < 4; ++m) f0[m] = *(const bf16x8*)(g_smem + cur + fa0 + m * 2048 + ks * 1024);
#pragma unroll
      for (int n = 0; n < 4; ++n) f1[n] = *(const bf16x8*)(g_smem + cur + fa1 + n * 2048 + ks * 1024);
#pragma unroll
      for (int m = 0; m < 4; ++m)
#pragma unroll
        for (int n = 0; n < 4; ++n) acc[m][n] = mfma16(f1[n], f0[m], acc[m][n]);
    }
  }
#undef GSTAGE
  __syncthreads();
}
DI void zero_acc(f32x4 (&acc)[4][4]) {
#pragma unroll
  for (int m = 0; m < 4; ++m)
#pragma unroll
    for (int n = 0; n < 4; ++n) acc[m][n] = f32x4{0.f, 0.f, 0.f, 0.f};
}

struct TJob { const float* src; u16* dst; int K, N, nb; };

DI void transpose_tile(int tid, const float* __restrict__ src, u16* __restrict__ dst, int K, int N, int k0, int n0) {
  float* tile = (float*)g_smem;
  {
    const int tr = tid >> 4, tc = tid & 15;
#pragma unroll
    for (int p = 0; p < 4; ++p) {
      int r = tr + 16 * p;
      f32x4 v = __builtin_nontemporal_load((const f32x4*)(src + (size_t)(k0 + r) * N + n0 + tc * 4));
      tile[r * 65 + tc * 4 + 0] = v[0]; tile[r * 65 + tc * 4 + 1] = v[1];
      tile[r * 65 + tc * 4 + 2] = v[2]; tile[r * 65 + tc * 4 + 3] = v[3];
    }
  }
  __syncthreads();
  {
    const int tn = tid >> 3, tk = tid & 7;
#pragma unroll
    for (int p = 0; p < 2; ++p) {
      int n = tn + 32 * p;
      u32x4 o;
#pragma unroll
      for (int q = 0; q < 4; ++q) o[q] = pack2(tile[(tk * 8 + 2 * q) * 65 + n], tile[(tk * 8 + 2 * q + 1) * 65 + n]);
      *(u32x4*)(dst + (size_t)(n0 + n) * K + k0 + tk * 8) = o;
    }
  }
  __syncthreads();
}

DI void convert_chunks(int tid, const float* __restrict__ src, u16* __restrict__ dst, size_t n) {
  const size_t nch = n / 8192;
  for (size_t c = blockIdx.x; c < nch; c += gridDim.x) {
    size_t e = c * 8192 + tid * 8;
    f32x4 a[4], b[4];
#pragma unroll
    for (int q = 0; q < 4; ++q) { a[q] = __builtin_nontemporal_load((const f32x4*)(src + e + q * 2048)); b[q] = __builtin_nontemporal_load((const f32x4*)(src + e + q * 2048 + 4)); }
#pragma unroll
    for (int q = 0; q < 4; ++q) {
      u32x4 o;
      o[0] = pack2(a[q][0], a[q][1]); o[1] = pack2(a[q][2], a[q][3]); o[2] = pack2(b[q][0], b[q][1]); o[3] = pack2(b[q][2], b[q][3]);
      *(u32x4*)(dst + e + q * 2048) = o;
    }
  }
}

typedef float f32x2 __attribute__((ext_vector_type(2)));
DI void convert_rows_fp8(int tid, const float* __restrict__ src, unsigned char* __restrict__ dst, float* __restrict__ inv_scale, int nrows) {
  const int lane = tid & 63;
  const int gw = blockIdx.x * 4 + (tid >> 6), GW = gridDim.x * 4;
  for (int r0 = gw; r0 < nrows; r0 += 2 * GW) {
    int rws[2] = {r0, r0 + GW < nrows ? r0 + GW : r0};
    f32x4 v[2][4];
#pragma unroll
    for (int u = 0; u < 2; ++u)
#pragma unroll
      for (int q = 0; q < 4; ++q) v[u][q] = __builtin_nontemporal_load((const f32x4*)(src + (size_t)rws[u] * 1024 + lane * 16 + q * 4));
#pragma unroll
    for (int u = 0; u < 2; ++u) {
      float am = 0.f;
#pragma unroll
      for (int q = 0; q < 4; ++q)
#pragma unroll
        for (int j = 0; j < 4; ++j) am = fmaxf(am, fabsf(v[u][q][j]));
      am = row_max16(am);
      am = fmaxf(am, __shfl_xor(am, 16));
      am = fmaxf(am, __shfl_xor(am, 32));
      int ex = (int)((__float_as_uint(am) >> 23) & 0xff) - 127;
      int k = am > 0.f ? 7 - ex : 0;
      k = min(max(k, -100), 100);
      float sc = __uint_as_float((unsigned)(127 + k) << 23), isc = __uint_as_float((unsigned)(127 - k) << 23);
      u32x4 o;
#pragma unroll
      for (int q = 0; q < 4; ++q) {
        int w = __builtin_amdgcn_cvt_pk_fp8_f32(v[u][q][0] * sc, v[u][q][1] * sc, 0, false);
        w = __builtin_amdgcn_cvt_pk_fp8_f32(v[u][q][2] * sc, v[u][q][3] * sc, w, true);
        o[q] = (unsigned)w;
      }
      *(u32x4*)(dst + (size_t)rws[u] * 1024 + lane * 16) = o;
      if (lane == 0) inv_scale[rws[u]] = isc;
    }
  }
}

DI void convert_rows_fp8_wave(int lane, const float* __restrict__ src, unsigned char* __restrict__ dst, float* __restrict__ inv_scale, int r0, int r1) {
  for (int r = r0; r < r1; r += 2) {
    f32x4 v[2][4];
#pragma unroll
    for (int u = 0; u < 2; ++u)
#pragma unroll
      for (int q = 0; q < 4; ++q) v[u][q] = __builtin_nontemporal_load((const f32x4*)(src + (size_t)(r + u) * 1024 + lane * 16 + q * 4));
#pragma unroll
    for (int u = 0; u < 2; ++u) {
      float am = 0.f;
#pragma unroll
      for (int q = 0; q < 4; ++q)
#pragma unroll
        for (int j = 0; j < 4; ++j) am = fmaxf(am, fabsf(v[u][q][j]));
      am = row_max16(am);
      am = fmaxf(am, __shfl_xor(am, 16));
      am = fmaxf(am, __shfl_xor(am, 32));
      int ex = (int)((__float_as_uint(am) >> 23) & 0xff) - 127;
      int k = am > 0.f ? 7 - ex : 0;
      k = min(max(k, -100), 100);
      float sc = __uint_as_float((unsigned)(127 + k) << 23), isc = __uint_as_float((unsigned)(127 - k) << 23);
      u32x4 o;
#pragma unroll
      for (int q = 0; q < 4; ++q) {
        int w = __builtin_amdgcn_cvt_pk_fp8_f32(v[u][q][0] * sc, v[u][q][1] * sc, 0, false);
        w = __builtin_amdgcn_cvt_pk_fp8_f32(v[u][q][2] * sc, v[u][q][3] * sc, w, true);
        o[q] = (unsigned)w;
      }
      *(u32x4*)(dst + (size_t)(r + u) * 1024 + lane * 16) = o;
      if (lane == 0) inv_scale[r + u] = isc;
    }
  }
}

__device__ void phase_prep(const Params& p) {
  char* ws = opaque_ptr(p.ws);
  const int tid = opaque_tid(), wid = tid >> 6, lane = tid & 63;
  if (blockIdx.x == 0 && tid < 64) ((int*)(ws + O_CNT))[tid] = 0;
  if (blockIdx.x < 4) {
    int e = blockIdx.x * 256 + tid;
    int pos = e >> 4, f = e & 15;
    const float fr4[4] = {1.0f, 0.56234132519f, 0.316227766017f, 0.177827941004f};
    float sc = (f >> 2) == 0 ? 1.0f : (f >> 2) == 1 ? 0.1f : (f >> 2) == 2 ? 0.01f : 0.001f;
    float fsel = (f & 3) == 0 ? fr4[0] : (f & 3) == 1 ? fr4[1] : (f & 3) == 2 ? fr4[2] : fr4[3];
    float freq = fsel * sc;
    float ang = (float)pos * freq;
    double a = (double)ang;
    double k = rint(a * 0.15915494309189535);
    double r = a - k * 6.283185307179586;
    double r2 = r * r, ts = r, tc = 1.0, s = r, c = 1.0;
    for (int i = 1; i <= 14; ++i) {
      tc = -tc * r2 / (double)((2 * i - 1) * (2 * i));
      ts = -ts * r2 / (double)((2 * i) * (2 * i + 1));
      c += tc; s += ts;
    }
    float* rope = (float*)(ws + O_ROPE);
    rope[e * 2] = (float)c; rope[e * 2 + 1] = (float)s;
  }
  {
    float* sil = (float*)g_smem;
    float* part = (float*)(g_smem + 16384);
    const float* cvec = p.in[7];
    const float* cctx = p.in[8];
    bool have_sil = false;
    for (int it = blockIdx.x; it < 4 * 96; it += gridDim.x) {
      if (!have_sil) {
        for (int k = tid; k < 1024; k += 256) {
          float a = cctx[k], b = cvec[k], c2 = cvec[1024 + k];
          sil[k] = a * sigmoidf_(a); sil[1024 + k] = b * sigmoidf_(b); sil[2048 + k] = c2 * sigmoidf_(c2);
        }
        have_sil = true;
        __syncthreads();
      }
      int l = it / 96, n = (it % 96) * 64 + lane;
      const float* W = p.in[12] + (size_t)l * 1024 * 6144 + n;
      float a0 = 0.f, a1 = 0.f, a2 = 0.f;
      int kb = wid * 256;
#pragma unroll 8
      for (int k = 0; k < 256; ++k) {
        float w = __builtin_nontemporal_load(&W[(size_t)(kb + k) * 6144]);
        a0 += w * sil[kb + k]; a1 += w * sil[1024 + kb + k]; a2 += w * sil[2048 + kb + k];
      }
      part[(wid * 3 + 0) * 64 + lane] = a0; part[(wid * 3 + 1) * 64 + lane] = a1; part[(wid * 3 + 2) * 64 + lane] = a2;
      __syncthreads();
      if (tid < 192) {
        int c = tid >> 6, ln = tid & 63;
        float s = part[(0 * 3 + c) * 64 + ln] + part[(1 * 3 + c) * 64 + ln] + part[(2 * 3 + c) * 64 + ln] + part[(3 * 3 + c) * 64 + ln];
        int nn = (it % 96) * 64 + ln;
        ((float*)(ws + O_MOD))[((size_t)l * 3 + c) * 6144 + nn] = s + p.in[13][(size_t)l * 6144 + nn];
      }
      __syncthreads();
    }
    __syncthreads();
  }
  {
    TJob jobs[11] = {
        {p.in[14], (u16*)(ws + O_WIN), 1024, 7296, 4},
        {p.in[16], (u16*)(ws + O_AOUT), 512, 1024, 4},
        {p.in[28], (u16*)(ws + O_RWOUT), 512, 1024, 4},
        {p.in[30], (u16*)(ws + O_NAOUT), 512, 1024, 4},
        {p.in[31], (u16*)(ws + O_WO), 1024, 1024, 4},
        {p.in[32], (u16*)(ws + O_PEQ), 1024, 2048, 4},
        {p.in[19], (u16*)(ws + O_W2), 64, 512, 8},
        {p.in[21], (u16*)(ws + O_A2), 64, 512, 8},
        {p.in[22], (u16*)(ws + O_G2), 128, 512, 4},
        {p.in[3], (u16*)(ws + O_CAVT), 512, 128, 8},
        {p.in[5], (u16*)(ws + O_CCVT), 512, 512, 8},
    };
#pragma unroll
    for (int j = 0; j < 11; ++j) {
      const int tk = jobs[j].K / 64, tn = jobs[j].N / 64, per = tk * tn, tot = per * jobs[j].nb;
      for (int t = blockIdx.x; t < tot; t += gridDim.x) {
        int b = t / per, r = t % per;
        int kt = r / tn, ntile = r % tn;
        size_t off = (size_t)b * jobs[j].K * jobs[j].N;
        transpose_tile(tid, jobs[j].src + off, jobs[j].dst + off, jobs[j].K, jobs[j].N, kt * 64, ntile * 64);
      }
    }
  }
  convert_chunks(tid, p.in[33], (u16*)(ws + O_SUBK), 4ull * 8 * 2 * 128 * 128);
  convert_chunks(tid, p.in[2], (u16*)(ws + O_CAK), 8ull * 512 * 128);
  convert_chunks(tid, p.in[4], (u16*)(ws + O_CCK), 8ull * 512 * 512);
  {
    float* X = (float*)(ws + O_X);
    const size_t nch = (size_t)NT * DM / 1024;
    for (size_t c = blockIdx.x; c < nch; c += gridDim.x) {
      size_t e = c * 1024 + tid * 4;
      const float* src = e < (size_t)NCTX * DM ? p.in[0] + e : p.in[1] + (e - (size_t)NCTX * DM);
      *(f32x4*)(X + e) = *(const f32x4*)src;
    }
  }
}

DI int tok_cond(int tok) { return tok < NCTX ? 0 : 1 + ((tok - NCTX) >> 11); }

DI void norm_row_store(const float (&x)[16], const float* __restrict__ g, const float* __restrict__ shift, const float* __restrict__ scale,
                       u16* __restrict__ hrow, int lane) {
  float ss = 0.f;
#pragma unroll
  for (int i = 0; i < 16; ++i) ss += x[i] * x[i];
  ss = wave_sum(ss);
  float rstd = rsqrtf(ss * (1.f / 1024.f) + 1e-6f);
#pragma unroll
  for (int hh = 0; hh < 2; ++hh) {
    int e0 = hh * 512 + lane * 8;
    float y[8];
#pragma unroll
    for (int i = 0; i < 8; ++i) {
      float v = x[hh * 8 + i] * rstd * g[e0 + i];
      y[i] = v * (1.f + scale[e0 + i]) + shift[e0 + i];
    }
    u32x4 o;
    o[0] = pack2(y[0], y[1]); o[1] = pack2(y[2], y[3]); o[2] = pack2(y[4], y[5]); o[3] = pack2(y[6], y[7]);
    *(u32x4*)(hrow + e0) = o;
  }
}

__device__ void phase_norm(const Params& p, int l, int which) {
  char* ws = opaque_ptr(p.ws);
  const int tid = opaque_tid();
  const int lane = tid & 63;
  const int gw = blockIdx.x * 4 + (tid >> 6), GW = gridDim.x * 4;
  const float* X = (const float*)(ws + O_X);
  const float* g = (which == 0 ? p.in[9] : p.in[10]) + l * 1024;
  for (int tok = gw; tok < NT; tok += GW) {
    const float* mod = (const float*)(ws + O_MOD) + ((size_t)l * 3 + tok_cond(tok)) * 6144 + which * 3 * 1024;
    float x[16];
#pragma unroll
    for (int hh = 0; hh < 2; ++hh) {
      f32x4 a = *(const f32x4*)(X + (size_t)tok * 1024 + hh * 512 + lane * 8);
      f32x4 b = *(const f32x4*)(X + (size_t)tok * 1024 + hh * 512 + lane * 8 + 4);
#pragma unroll
      for (int i = 0; i < 4; ++i) { x[hh * 8 + i] = a[i]; x[hh * 8 + 4 + i] = b[i]; }
    }
    norm_row_store(x, g, mod, mod + 1024, (u16*)(ws + O_H) + (size_t)tok * 1024, lane);
  }
}

__device__ void phase_gemm_in(const Params& p, int l) {
  char* ws = opaque_ptr(p.ws);
  const int tid = opaque_tid();
  const int wid = tid >> 6, lane = tid & 63, wr = wid >> 1, wc = wid & 1, fr = lane & 15, fq = lane >> 4;
  const u16* H = (const u16*)(ws + O_H);
  const u16* W = (const u16*)(ws + O_WIN) + (size_t)l * INC * 1024;
  const float* rope = (const float*)(ws + O_ROPE);
  float* out = p.out;
  const int ntiles = gridDim.x == 512 ? 64 * 56 : 64 * 57;
  for (int t = blockIdx.x; t < ntiles; t += gridDim.x) {
    const int tm = t & 63, tn = t >> 6;
    const int brow = tm * 128, bcol = tn * 128;
    const bool swapped = (tn == 5) || (tn >= 29 && tn < 33);
    const bool ctx = brow < NCTX;
    f32x4 acc[4][4];
    zero_acc(acc);
    const int koff = (((tm >> 3) + (tn & 7)) * 2) & 15;
    if (!swapped) gemm_main(tid, H + (size_t)brow * 1024, 1024, W + (size_t)bcol * 1024, 1024, 1024, acc, koff);
    else gemm_main(tid, W + (size_t)bcol * 1024, 1024, H + (size_t)brow * 1024, 1024, 1024, acc, koff);
    if (!swapped) {
#pragma unroll
      for (int m = 0; m < 4; ++m) {
        const int tok = brow + wr * 64 + m * 16 + fr;
        const int cb = bcol + wc * 64 + fq * 4;
        if (tn < 5) {
          if (!ctx) {
            int tt = (tok - NCTX) & 2047;
            int pos0 = tt >> 6, pos1 = tt & 63;
#pragma unroll
            for (int ax = 0; ax < 2; ++ax) {
              int pos = ax == 0 ? pos0 : pos1;
#pragma unroll
              for (int j = 0; j < 4; ++j) {
                float c = rope[(pos * 16 + fq * 4 + j) * 2], s = rope[(pos * 16 + fq * 4 + j) * 2 + 1];
                float x1 = acc[m][2 * ax][j], x2 = acc[m][2 * ax + 1][j];
                acc[m][2 * ax][j] = x1 * c - x2 * s;
                acc[m][2 * ax + 1][j] = x2 * c + x1 * s;
              }
            }
          }
          if (tn < 4) {
#pragma unroll
            for (int n = 0; n < 4; ++n) {
              u32x2 o; o[0] = pack2(acc[m][n][0] * 0.125f, acc[m][n][1] * 0.125f); o[1] = pack2(acc[m][n][2] * 0.125f, acc[m][n][3] * 0.125f);
              *(u32x2*)((u16*)(ws + O_QA) + (size_t)tok * 512 + cb + n * 16) = o;
            }
          } else {
#pragma unroll
            for (int n = 0; n < 4; ++n) {
              int c = cb + n * 16 - 512;
              u32x2 o; o[0] = pack2(acc[m][n][0], acc[m][n][1]); o[1] = pack2(acc[m][n][2], acc[m][n][3]);
              *(u32x2*)((u16*)(ws + O_KA) + (size_t)tok * 128 + c) = o;
              if (ctx) *(f32x4*)(out + OUT_AK + ((size_t)((tok >> 8) * 4 + l) * 256 + (tok & 255)) * 128 + c) = acc[m][n];
            }
          }
        } else if (tn < 21) {
#pragma unroll
          for (int n = 0; n < 4; ++n) *(f32x4*)((float*)(ws + O_PB) + (size_t)tok * 1920 + cb + n * 16 - 768) = acc[m][n];
        } else if (tn < 25) {
#pragma unroll
          for (int n = 0; n < 4; ++n) {
            u32x2 o; o[0] = pack2(acc[m][n][0] * 0.125f, acc[m][n][1] * 0.125f); o[1] = pack2(acc[m][n][2] * 0.125f, acc[m][n][3] * 0.125f);
            *(u32x2*)((u16*)(ws + O_QC) + (size_t)tok * 512 + cb + n * 16 - 2688) = o;
          }
        } else if (tn < 29) {
#pragma unroll
          for (int n = 0; n < 4; ++n) {
            int c = cb + n * 16 - 3200;
            u32x2 o; o[0] = pack2(acc[m][n][0], acc[m][n][1]); o[1] = pack2(acc[m][n][2], acc[m][n][3]);
            *(u32x2*)((u16*)(ws + O_KC) + (size_t)tok * 512 + c) = o;
            if (ctx) *(f32x4*)(out + OUT_CK + ((size_t)((tok >> 8) * 4 + l) * 256 + (tok & 255)) * 512 + c) = acc[m][n];
          }
        } else {
#pragma unroll
          for (int n = 0; n < 4; ++n) {
            u32x2 o; o[0] = pack2(sigmoidf_(acc[m][n][0]), sigmoidf_(acc[m][n][1])); o[1] = pack2(sigmoidf_(acc[m][n][2]), sigmoidf_(acc[m][n][3]));
            *(u32x2*)((u16*)(ws + O_GATE) + (size_t)tok * 3072 + cb + n * 16 - 4224) = o;
          }
        }
      }
    } else {
      const bool isA = (tn == 5);
      u16* VT = isA ? (u16*)(ws + O_VAT) : (u16*)(ws + O_VCT);
      const int ncols = isA ? 128 : 512;
      const size_t obase = isA ? OUT_AV : OUT_CV;
#pragma unroll
      for (int m = 0; m < 4; ++m) {
        const int c = (isA ? 0 : (tn - 29) * 128) + wr * 64 + m * 16 + fr;
#pragma unroll
        for (int n = 0; n < 4; ++n) {
          const int tk = brow + wc * 64 + n * 16 + fq * 4;
          u32x2 o; o[0] = pack2(acc[m][n][0], acc[m][n][1]); o[1] = pack2(acc[m][n][2], acc[m][n][3]);
          *(u32x2*)(VT + (size_t)c * NT + tk) = o;
          if (ctx) {
#pragma unroll
            for (int j = 0; j < 4; ++j) {
              int tok = tk + j;
              out[obase + ((size_t)((tok >> 8) * 4 + l) * 256 + (tok & 255)) * ncols + c] = acc[m][n][j];
            }
          }
        }
      }
    }
  }
}

__device__ void phase_rwkv_prep(const Params& p, int l) {
  char* ws = opaque_ptr(p.ws);
  const int tid = opaque_tid();
  const int lane = tid & 63;
  const bool split = gridDim.x == 512;
  if (split && blockIdx.x < 64) {
    const int wid = tid >> 6, wr = wid >> 1, wc = wid & 1, fr = lane & 15, fq = lane >> 4;
    const int brow = blockIdx.x * 128, bcol = 56 * 128;
    f32x4 acc[4][4];
    zero_acc(acc);
    gemm_main(tid, (const u16*)(ws + O_H) + (size_t)brow * 1024, 1024, (const u16*)(ws + O_WIN) + ((size_t)l * INC + bcol) * 1024, 1024, 1024, acc);
#pragma unroll
    for (int m = 0; m < 4; ++m) {
      const int tok = brow + wr * 64 + m * 16 + fr;
      const int cb = bcol + wc * 64 + fq * 4;
#pragma unroll
      for (int n = 0; n < 4; ++n) {
        u32x2 o; o[0] = pack2(sigmoidf_(acc[m][n][0]), sigmoidf_(acc[m][n][1])); o[1] = pack2(sigmoidf_(acc[m][n][2]), sigmoidf_(acc[m][n][3]));
        *(u32x2*)((u16*)(ws + O_GATE) + (size_t)tok * 3072 + cb + n * 16 - 4224) = o;
      }
    }
    return;
  }
  const int gw = split ? ((int)blockIdx.x - 64) * 4 + (tid >> 6) : (int)blockIdx.x * 4 + (tid >> 6);
  const int GW = split ? 448 * 4 : (int)gridDim.x * 4;
  const float* PB = (const float*)(ws + O_PB);
  const float* mu = p.in[17] + l * 1920;
  const float* kkw = p.in[23] + l * 512;
  for (int tok = gw; tok < NT; tok += GW) {
    int pos, len;
    if (tok < NCTX) { pos = tok & 255; len = 256; } else { pos = (tok - NCTX) & 2047; len = 2048; }
    const bool hp = pos > 0, hn = pos < len - 1;
    const float* row = PB + (size_t)tok * 1920;
#pragma unroll
    for (int i = 0; i < 8; ++i) {
      int q = lane + 64 * i;
      if (q < 480) {
        int c = q * 4;
        f32x4 cur = *(const f32x4*)(row + c);
        f32x4 pv = hp ? *(const f32x4*)(row - 1920 + c) : f32x4{0.f, 0.f, 0.f, 0.f};
        f32x4 nv = hn ? *(const f32x4*)(row + 1920 + c) : f32x4{0.f, 0.f, 0.f, 0.f};
        f32x4 m4 = *(const f32x4*)(mu + c);
        f32x4 xb;
#pragma unroll
        for (int j = 0; j < 4; ++j) xb[j] = cur[j] + m4[j] * (0.5f * (pv[j] + nv[j]) - cur[j]);
        if (i < 6) {
          *(f32x4*)((float*)(ws + O_XRKV) + (size_t)tok * 1536 + c) = xb;
          if (i == 2 || i == 3) {
            int ck = c - 512;
            f32x4 kw = *(const f32x4*)(kkw + ck);
            f32x4 kv;
            float ss = 0.f;
#pragma unroll
            for (int j = 0; j < 4; ++j) { kv[j] = xb[j] * kw[j]; ss += kv[j] * kv[j]; }
            ss = row_sum16(ss);
            float rn = rsqrtf(ss + 1e-12f);
#pragma unroll
            for (int j = 0; j < 4; ++j) kv[j] *= rn;
            *(f32x4*)((float*)(ws + O_KK) + (size_t)tok * 512 + ck) = kv;
          }
        } else {
          u16* dst;
          int cc;
          float v[4];
          if (c < 1664) { dst = (u16*)(ws + O_TW); cc = c - 1536; for (int j = 0; j < 4; ++j) v[j] = tanhf(xb[j]); }
          else if (c < 1792) { dst = (u16*)(ws + O_AD); cc = c - 1664; for (int j = 0; j < 4; ++j) v[j] = xb[j]; }
          else { dst = (u16*)(ws + O_SG); cc = c - 1792; for (int j = 0; j < 4; ++j) v[j] = sigmoidf_(xb[j]); }
          u32x2 o; o[0] = pack2(v[0], v[1]); o[1] = pack2(v[2], v[3]);
          *(u32x2*)(dst + (size_t)tok * 128 + cc) = o;
        }
      }
    }
  }
}

__device__ void phase_rwkv_lora(const Params& p, int l) {
  char* ws = opaque_ptr(p.ws);
  const int tid = opaque_tid();
  const int wid = tid >> 6, lane = tid & 63, wr = wid >> 1, wc = wid & 1, fr = lane & 15, fq = lane >> 4;
  for (int t = blockIdx.x; t < 5 * 256; t += gridDim.x) {
    const int job = t >> 8, r = t & 255, tm = r & 63, tn = r >> 6;
    const int brow = tm * 128, bcol = tn * 128;
    f32x4 acc[4][4];
    zero_acc(acc);
    const int z = job & 1;
    if (job < 2) gemm_main(tid, (const u16*)(ws + O_TW) + (size_t)brow * 128 + z * 64, 128, (const u16*)(ws + O_W2) + ((size_t)(l * 2 + z) * 512 + bcol) * 64, 64, 64, acc);
    else if (job < 4) gemm_main(tid, (const u16*)(ws + O_AD) + (size_t)brow * 128 + z * 64, 128, (const u16*)(ws + O_A2) + ((size_t)(l * 2 + z) * 512 + bcol) * 64, 64, 64, acc);
    else gemm_main(tid, (const u16*)(ws + O_SG) + (size_t)brow * 128, 128, (const u16*)(ws + O_G2) + ((size_t)l * 512 + bcol) * 128, 128, 128, acc);
#pragma unroll
    for (int m = 0; m < 4; ++m) {
      const int tok = brow + wr * 64 + m * 16 + fr;
#pragma unroll
      for (int n = 0; n < 4; ++n) {
        const int c = bcol + wc * 64 + n * 16 + fq * 4;
        if (job < 2) {
          f32x4 w0 = *(const f32x4*)(p.in[18] + (size_t)(l * 2 + z) * 512 + c);
          f32x4 o;
#pragma unroll
          for (int j = 0; j < 4; ++j) {
            float val = w0[j] + acc[m][n][j];
            float y = -val;
            float sp = fmaxf(y, 0.f) + __logf(1.f + __expf(-fabsf(y)));
            float wlog = -sp - 0.5f;
            o[j] = __expf(-__expf(wlog));
          }
          *(f32x4*)((float*)(ws + O_DEC) + ((size_t)z * NT + tok) * 512 + c) = o;
        } else if (job < 4) {
          f32x4 a0 = *(const f32x4*)(p.in[20] + (size_t)(l * 2 + z) * 512 + c);
          f32x4 ka = *(const f32x4*)(p.in[24] + (size_t)l * 512 + c);
          f32x4 kx = *(const f32x4*)((const float*)(ws + O_XRKV) + (size_t)tok * 1536 + 512 + c);
          f32x4 kk = *(const f32x4*)((const float*)(ws + O_KK) + (size_t)tok * 512 + c);
          f32x4 okd, okka;
#pragma unroll
          for (int j = 0; j < 4; ++j) {
            float a = sigmoidf_(a0[j] + acc[m][n][j]);
            okd[j] = kx[j] * (1.f + (a - 1.f) * ka[j]);
            okka[j] = kk[j] * a;
          }
          *(f32x4*)((float*)(ws + O_KD) + ((size_t)z * NT + tok) * 512 + c) = okd;
          *(f32x4*)((float*)(ws + O_KKA) + ((size_t)z * NT + tok) * 512 + c) = okka;
        } else {
          *(f32x4*)((float*)(ws + O_GG) + (size_t)tok * 512 + c) = acc[m][n];
        }
      }
    }
  }
}

template <int JPL> struct ScanOps { float w[JPL], kd[JPL], kk[JPL], kka[JPL], r[JPL]; float v; };

template <int JPL>
DI void scan_load(ScanOps<JPL>& o, const float* __restrict__ dec, const float* __restrict__ kd, const float* __restrict__ kk,
                  const float* __restrict__ kka, const float* __restrict__ rr, const float* __restrict__ vv, int tok, int cj, int ci) {
  const size_t e = (size_t)tok * 512 + cj;
#pragma unroll
  for (int q = 0; q < JPL / 4; ++q) {
    f32x4 a = *(const f32x4*)(dec + e + q * 4), b = *(const f32x4*)(kd + e + q * 4), c = *(const f32x4*)(kk + e + q * 4),
          d = *(const f32x4*)(kka + e + q * 4), f = *(const f32x4*)(rr + (size_t)tok * 1536 + cj + q * 4);
#pragma unroll
    for (int j = 0; j < 4; ++j) { o.w[q * 4 + j] = a[j]; o.kd[q * 4 + j] = b[j]; o.kk[q * 4 + j] = c[j]; o.kka[q * 4 + j] = d[j]; o.r[q * 4 + j] = f[j]; }
  }
  o.v = vv[(size_t)tok * 1536 + 1024 + ci];
}

template <int JPL> DI float scan_red(float v) {
  v += dppf<0xB1>(v);
  v += dppf<0x4E>(v);
  if (JPL <= 8) v += dppf<0x141>(v);
  if (JPL <= 4) v += dppf<0x140>(v);
  return v;
}

template <int JPL>
DI void scan_step(float (&S)[JPL], const ScanOps<JPL>& o, float* __restrict__ y, int tok, int ci, bool wr) {
  float sa0 = 0.f, sa1 = 0.f;
#pragma unroll
  for (int j = 0; j < JPL; j += 2) { sa0 += S[j] * o.kk[j]; sa1 += S[j + 1] * o.kk[j + 1]; }
  float sa = -scan_red<JPL>(sa0 + sa1);
  float y0 = 0.f, y1 = 0.f;
#pragma unroll
  for (int j = 0; j < JPL; j += 2) {
    S[j] = S[j] * o.w[j] + (sa * o.kka[j] + o.v * o.kd[j]);
    S[j + 1] = S[j + 1] * o.w[j + 1] + (sa * o.kka[j + 1] + o.v * o.kd[j + 1]);
    y0 += S[j] * o.r[j]; y1 += S[j + 1] * o.r[j + 1];
  }
  float yv = scan_red<JPL>(y0 + y1);
  if (wr) y[(size_t)tok * 512 + ci] = yv;
}

template <int JPL, int D>
DI void scan_wave(char* ws, int lane, int z, int h, int tok0, int T, int rowbase, const float* __restrict__ s0, float* __restrict__ sout) {
  constexpr int LPR = 64 / JPL;
  const int rr = lane / LPR, pp = lane % LPR;
  const int i = rowbase + rr, j0 = pp * JPL;
  const int cj = h * 64 + j0, ci = h * 64 + i;
  const float* dec = (const float*)(ws + O_DEC) + (size_t)z * NT * 512;
  const float* kd = (const float*)(ws + O_KD) + (size_t)z * NT * 512;
  const float* kka = (const float*)(ws + O_KKA) + (size_t)z * NT * 512;
  const float* kk = (const float*)(ws + O_KK);
  const float* xr = (const float*)(ws + O_XRKV);
  float* y = (float*)(ws + O_YS) + (size_t)z * NT * 512;
  float S[JPL];
#pragma unroll
  for (int j = 0; j < JPL; ++j) S[j] = s0 ? s0[i * 64 + j0 + j] : 0.f;
  const int dir = z == 0 ? 1 : -1;
  const int first = z == 0 ? tok0 : tok0 + T - 1;
  const bool wr = pp == 0;
  ScanOps<JPL> R[D];
#pragma unroll
  for (int d = 0; d < D; ++d) scan_load<JPL>(R[d], dec, kd, kk, kka, xr, xr, first + dir * d, cj, ci);
  for (int n = 0; n < T; n += D) {
#pragma unroll
    for (int d = 0; d < D; ++d) {
      scan_step<JPL>(S, R[d], y, first + dir * (n + d), ci, wr);
      int nn = n + d + D;
      nn = nn < T ? nn : T - 1;
      scan_load<JPL>(R[d], dec, kd, kk, kka, xr, xr, first + dir * nn, cj, ci);
    }
  }
  if (sout) {
#pragma unroll
    for (int j = 0; j < JPL; ++j) sout[i * 64 + j0 + j] = S[j];
  }
}

DI void dma16(const char* gptr, unsigned ldsaddr) {
  asm volatile("s_mov_b32 m0, %0\n\ts_nop 0\n\tglobal_load_lds_dwordx4 %1, off" ::"s"(ldsaddr), "v"(gptr) : "memory");
}
template <int N> DI void wait_vm() { asm volatile("s_waitcnt vmcnt(%0)" ::"n"(N) : "memory"); }

template <int JPL> struct ScanRegs { float w[JPL], kd[JPL], kk[JPL], kka[JPL], r[JPL]; float v; };
template <int JPL> DI void scan_lds_read(ScanRegs<JPL>& o, const char* slot, int pp, int rr) {
#pragma unroll
  for (int q = 0; q < JPL / 4; ++q) {
    f32x4 a = *(const f32x4*)(slot + 0 + pp * JPL * 4 + q * 16), b = *(const f32x4*)(slot + 256 + pp * JPL * 4 + q * 16),
          c = *(const f32x4*)(slot + 512 + pp * JPL * 4 + q * 16), d = *(const f32x4*)(slot + 768 + pp * JPL * 4 + q * 16),
          f = *(const f32x4*)(slot + 1024 + pp * JPL * 4 + q * 16);
#pragma unroll
    for (int j = 0; j < 4; ++j) { o.w[q * 4 + j] = a[j]; o.kd[q * 4 + j] = b[j]; o.kk[q * 4 + j] = c[j]; o.kka[q * 4 + j] = d[j]; o.r[q * 4 + j] = f[j]; }
  }
  o.v = *(const float*)(slot + 1280 + rr * 4);
}
template <int JPL>
DI void scan_step2(float (&S)[JPL], const ScanRegs<JPL>& o, float* __restrict__ yp, bool wr) {
  float sa0 = 0.f, sa1 = 0.f;
#pragma unroll
  for (int j = 0; j < JPL; j += 2) { sa0 += S[j] * o.kk[j]; sa1 += S[j + 1] * o.kk[j + 1]; }
  float sa = -scan_red<JPL>(sa0 + sa1);
  float y0 = 0.f, y1 = 0.f;
#pragma unroll
  for (int j = 0; j < JPL; j += 2) {
    S[j] = sa * o.kka[j] + (S[j] * o.w[j] + o.v * o.kd[j]);
    S[j + 1] = sa * o.kka[j + 1] + (S[j + 1] * o.w[j + 1] + o.v * o.kd[j + 1]);
    y0 += S[j] * o.r[j]; y1 += S[j + 1] * o.r[j + 1];
  }
  float yv = scan_red<JPL>(y0 + y1);
  if (wr) *yp = yv;
}

template <int JPL, int NS>
DI void scan_wave_dma(char* ws, int lane, int ringoff, int z, int h, int tok0, int T, int rowbase, const float* __restrict__ s0,
                      float* __restrict__ sout) {
  constexpr int LPR = 64 / JPL, PD = NS - 1, WN = 3 * PD - 3;
  static_assert(WN <= 63, "vmcnt range");
  const int rr = lane / LPR, pp = lane % LPR;
  const int i = rowbase + rr, j0 = pp * JPL;
  const int dir = z == 0 ? 1 : -1;
  const int first = z == 0 ? tok0 : tok0 + T - 1;
  const bool wr = pp == 0;
  float S[JPL];
#pragma unroll
  for (int j = 0; j < JPL; ++j) S[j] = s0 ? s0[i * 64 + j0 + j] : 0.f;
  const int a = lane >> 4, c16 = lane & 15;
  const float* arr = a == 0 ? (const float*)(ws + O_DEC) + (size_t)z * NT * 512
                   : a == 1 ? (const float*)(ws + O_KD) + (size_t)z * NT * 512
                   : a == 2 ? (const float*)(ws + O_KK)
                            : (const float*)(ws + O_KKA) + (size_t)z * NT * 512;
  const char* gA = (const char*)(arr + (size_t)first * 512 + h * 64 + c16 * 4);
  const char* gB = (const char*)((const float*)(ws + O_XRKV) + (size_t)first * 1536 + (lane < 16 ? h * 64 + c16 * 4 : 1024 + h * 64 + rowbase + (lane - 16) * 4));
  const long stA = (long)dir * 2048, stB = (long)dir * 6144;
  const bool bact = lane < 16 + JPL / 4;
  ringoff = __builtin_amdgcn_readfirstlane(ringoff);
  const unsigned ring = (unsigned)(size_t)g_smem + (unsigned)ringoff;
  const char* ringp = g_smem + ringoff;
  float* yp = (float*)(ws + O_YS) + (size_t)z * NT * 512 + (size_t)first * 512 + h * 64 + i;
  const long sty = (long)dir * 512;
  float* dummy = (float*)(ws + O_MERG) + lane;
#pragma unroll 1
  for (int s = 0; s < PD; ++s) {
    unsigned slot = ring + (unsigned)(s & (NS - 1)) * 1536u;
    dma16(gA, slot);
    if (bact) dma16(gB, slot + 1024u);
    gA += stA; gB += stB;
    if (wr) dummy[s * 64] = 0.f;
  }
  ScanRegs<JPL> A, B;
  wait_vm<3 * PD - 3>();
  wait_vm<3 * (PD - 1)>();
  scan_lds_read<JPL>(A, ringp, pp, rr);
  for (int n = 0; n < T; n += 2) {
    {
      unsigned sl = (unsigned)((n + PD) & (NS - 1)) * 1536u;
      dma16(gA, ring + sl);
      if (bact) dma16(gB, ring + sl + 1024u);
      gA += stA; gB += stB;
      wait_vm<WN>();
      scan_lds_read<JPL>(B, ringp + ((n + 1) & (NS - 1)) * 1536, pp, rr);
      scan_step2<JPL>(S, A, yp, wr);
      yp += sty;
    }
    {
      unsigned sl = (unsigned)((n + 1 + PD) & (NS - 1)) * 1536u;
      dma16(gA, ring + sl);
      if (bact) dma16(gB, ring + sl + 1024u);
      gA += stA; gB += stB;
      wait_vm<WN>();
      scan_lds_read<JPL>(A, ringp + ((n + 2) & (NS - 1)) * 1536, pp, rr);
      scan_step2<JPL>(S, B, yp, wr);
      yp += sty;
    }
  }
  wait_vm<0>();
  if (sout) {
#pragma unroll
    for (int j = 0; j < JPL; ++j) sout[i * 64 + j0 + j] = S[j];
  }
}

template <int JPL>
DI void scan_dots(const float (&S)[JPL], const ScanRegs<JPL>& cur, const ScanRegs<JPL>& prv, float& d1, float& d2) {
  float a0 = 0.f, a1 = 0.f, b0 = 0.f, b1 = 0.f;
#pragma unroll
  for (int j = 0; j < JPL; j += 2) {
    a0 += S[j] * cur.kk[j]; b0 += S[j] * prv.r[j];
    a1 += S[j + 1] * cur.kk[j + 1]; b1 += S[j + 1] * prv.r[j + 1];
  }
  d1 = a0 + a1; d2 = b0 + b1;
}
template <int JPL> DI void scan_red2(float& a, float& b) {
  a += dppf<0xB1>(a); b += dppf<0xB1>(b);
  a += dppf<0x4E>(a); b += dppf<0x4E>(b);
  if (JPL <= 8) { a += dppf<0x141>(a); b += dppf<0x141>(b); }
  if (JPL <= 4) { a += dppf<0x140>(a); b += dppf<0x140>(b); }
}
template <int JPL> DI void scan_pre(float (&Tm)[JPL], const float (&S)[JPL], const ScanRegs<JPL>& o) {
#pragma unroll
  for (int j = 0; j < JPL; ++j) Tm[j] = S[j] * o.w[j] + o.v * o.kd[j];
}
template <int JPL> DI void scan_update(float (&S)[JPL], const float (&Tm)[JPL], const ScanRegs<JPL>& o, float sa) {
#pragma unroll
  for (int j = 0; j < JPL; ++j) S[j] = sa * o.kka[j] + Tm[j];
}

template <int JPL, int T>
DI void scan_latent_block(char* ws, int tid, int z, int h, int tok0, int rowblock, const float* __restrict__ s0, float* __restrict__ sout) {
  constexpr int LPR = 64 / JPL, G = 7, WNV = 6 * G - 2;
  const int wid = __builtin_amdgcn_readfirstlane(tid >> 6), lane = tid & 63;
  const int rr = lane / LPR, pp = lane % LPR;
  const int rloc = wid * JPL + rr;
  const int i = rowblock + rloc, j0 = pp * JPL;
  const int dir = z == 0 ? 1 : -1;
  const int first = z == 0 ? tok0 : tok0 + T - 1;
  const bool wr = pp == 0;
  float S[JPL];
#pragma unroll
  for (int j = 0; j < JPL; ++j) S[j] = s0 ? s0[i * 64 + j0 + j] : 0.f;
  const int a = lane >> 4, c16 = lane & 15;
  const float* arr = a == 0 ? (const float*)(ws + O_DEC) + (size_t)z * NT * 512
                   : a == 1 ? (const float*)(ws + O_KD) + (size_t)z * NT * 512
                   : a == 2 ? (const float*)(ws + O_KK)
                            : (const float*)(ws + O_KKA) + (size_t)z * NT * 512;
  const int fw = first + dir * wid;
  const char* gA = (const char*)(arr + (size_t)fw * 512 + h * 64 + c16 * 4);
  const char* gB = (const char*)((const float*)(ws + O_XRKV) + (size_t)fw * 1536 + (lane < 16 ? h * 64 + c16 * 4 : 1024 + h * 64 + rowblock + (lane - 16) * 4));
  const long stA = (long)dir * 4 * 2048, stB = (long)dir * 4 * 6144;
  const bool bact = lane < 16 + JPL;
  const unsigned ring = (unsigned)(size_t)g_smem;
  const char* ringp = g_smem;
  float* yp = (float*)(ws + O_YS) + (size_t)z * NT * 512 + (size_t)first * 512 + h * 64 + i;
  const long sty = (long)dir * 512;
  float* dummy = (float*)(ws + O_MERG) + tid;
#pragma unroll 1
  for (int g = 0; g < G; ++g) {
    unsigned slot = ring + (unsigned)((4 * g + wid) & 31) * 1536u;
    dma16(gA, slot);
    if (bact) dma16(gB, slot + 1024u);
    gA += stA; gB += stB;
    if (wr) { dummy[(g * 4 + 0) * 256] = 0.f; }
    if (wr) { dummy[(g * 4 + 1) * 256] = 0.f; }
    if (wr) { dummy[(g * 4 + 2) * 256] = 0.f; }
    if (wr) { dummy[(g * 4 + 3) * 256] = 0.f; }
    asm volatile("" ::: "memory");
  }
  ScanRegs<JPL> A, B;
#pragma unroll
  for (int j = 0; j < JPL; ++j) B.r[j] = 0.f;
  float* ypv = dummy + 28 * 256;
  wait_vm<WNV>();
  asm volatile("" ::: "memory");
  __builtin_amdgcn_s_barrier();
  asm volatile("" ::: "memory");
  scan_lds_read<JPL>(A, ringp, pp, rloc);
#pragma unroll 1
  for (int g = 0; g < T / 4; ++g) {
    wait_vm<WNV - 6>();

    asm volatile("" ::: "memory");
    __builtin_amdgcn_s_barrier();
    asm volatile("" ::: "memory");
    {
      unsigned slot = ring + (unsigned)((4 * (g + G) + wid) & 31) * 1536u;
      dma16(gA, slot);
      if (bact) dma16(gB, slot + 1024u);
      gA += stA; gB += stB;
    }
    const char* gp = ringp + ((4 * g) & 31) * 1536;
    if (JPL >= 8) {
#pragma unroll
      for (int k = 0; k < 4; ++k) {
        scan_lds_read<JPL>(A, gp + k * 1536, pp, rloc);
        scan_step2<JPL>(S, A, yp, wr);
        yp += sty;
        asm volatile("" ::: "memory");
      }
      continue;
    }
    float d1, y0, y1, y2, y3;
    float Tm[JPL];
    scan_dots<JPL>(S, A, B, d1, y0);
    scan_pre<JPL>(Tm, S, A);
    scan_lds_read<JPL>(B, gp + 1536, pp, rloc);
    scan_red2<JPL>(d1, y0);
    scan_update<JPL>(S, Tm, A, -d1);
    scan_dots<JPL>(S, B, A, d1, y1);
    scan_pre<JPL>(Tm, S, B);
    scan_lds_read<JPL>(A, gp + 2 * 1536, pp, rloc);
    scan_red2<JPL>(d1, y1);
    scan_update<JPL>(S, Tm, B, -d1);
    scan_dots<JPL>(S, A, B, d1, y2);
    scan_pre<JPL>(Tm, S, A);
    scan_lds_read<JPL>(B, gp + 3 * 1536, pp, rloc);
    scan_red2<JPL>(d1, y2);
    scan_update<JPL>(S, Tm, A, -d1);
    scan_dots<JPL>(S, B, A, d1, y3);
    scan_pre<JPL>(Tm, S, B);
    scan_lds_read<JPL>(A, ringp + ((4 * g + 4) & 31) * 1536, pp, rloc);
    scan_red2<JPL>(d1, y3);
    scan_update<JPL>(S, Tm, B, -d1);
    if (wr) {
      *ypv = y0;
      yp[0] = y1;
      yp[sty] = y2;
      yp[2 * sty] = y3;
    }
    ypv = yp + 3 * sty;
    yp += 4 * sty;
    asm volatile("" ::: "memory");
  }
  {
    float e0 = 0.f, e1 = 0.f;
#pragma unroll
    for (int j = 0; j < JPL; j += 2) { e0 += S[j] * B.r[j]; e1 += S[j + 1] * B.r[j + 1]; }
    float yv = scan_red<JPL>(e0 + e1);
    if (wr) *ypv = yv;
  }
  wait_vm<0>();
  asm volatile("" ::: "memory");
  __builtin_amdgcn_s_barrier();
  asm volatile("" ::: "memory");
  if (sout) {
#pragma unroll
    for (int j = 0; j < JPL; ++j) sout[i * 64 + j0 + j] = S[j];
  }
}

struct AttnSt { float m, l; f32x4 o[4]; };

struct AttnKVF { bf16x8 k[2][2]; bf16x8 v[4]; };
DI void attn_kvload(AttnKVF& f, const u16* __restrict__ kp, int ldk, const u16* __restrict__ vtp, int ldv, int fr, int fq) {
#pragma unroll
  for (int kt = 0; kt < 2; ++kt)
#pragma unroll
    for (int ks = 0; ks < 2; ++ks) f.k[kt][ks] = *(const bf16x8*)(kp + (size_t)(8 * (fr >> 2) + 4 * kt + (fr & 3)) * ldk + ks * 32 + fq * 8);
#pragma unroll
  for (int dt = 0; dt < 4; ++dt) f.v[dt] = *(const bf16x8*)(vtp + (size_t)(dt * 16 + fr) * ldv + fq * 8);
}
template <int MODE>
DI void attn_core(AttnSt& st, const bf16x8 (&qf)[2], const AttnKVF& f, int fr, int fq, int qpos, int kpos0, const float* __restrict__ rpbrow) {
  f32x4 s[2];
#pragma unroll
  for (int kt = 0; kt < 2; ++kt) {
    s[kt] = f32x4{0.f, 0.f, 0.f, 0.f};
#pragma unroll
    for (int ks = 0; ks < 2; ++ks) s[kt] = mfma16(f.k[kt][ks], qf[ks], s[kt]);
  }
  if (MODE != 0) {
#pragma unroll
    for (int kt = 0; kt < 2; ++kt)
#pragma unroll
      for (int j = 0; j < 4; ++j) {
        int kpos = kpos0 + 8 * fq + 4 * kt + j;
        if (MODE == 1) {
          int d = qpos - kpos;
          if (d > 128 || d < -128) s[kt][j] = -1e30f;
        } else {
          int cs = min(max(qpos - 8, 0), 48);
          int dc = min(max(kpos - qpos, -15), 15) + 15;
          float b = rpbrow[dc];
          s[kt][j] = (kpos >= cs && kpos < cs + 16) ? s[kt][j] + b : -1e30f;
        }
      }
  }
  float mx = fmaxf(fmaxf(fmaxf(s[0][0], s[0][1]), fmaxf(s[0][2], s[0][3])), fmaxf(fmaxf(s[1][0], s[1][1]), fmaxf(s[1][2], s[1][3])));
  mx = fmaxf(mx, __shfl_xor(mx, 16));
  mx = fmaxf(mx, __shfl_xor(mx, 32));
  float mn = fmaxf(st.m, mx);
  float alpha = __expf(st.m - mn);
  st.m = mn;
  float ps = 0.f;
  float pv[8];
#pragma unroll
  for (int kt = 0; kt < 2; ++kt)
#pragma unroll
    for (int j = 0; j < 4; ++j) { float e = __expf(s[kt][j] - mn); pv[kt * 4 + j] = e; ps += e; }
  st.l = st.l * alpha + ps;
  u32x4 pk;
  pk[0] = pack2(pv[0], pv[1]); pk[1] = pack2(pv[2], pv[3]); pk[2] = pack2(pv[4], pv[5]); pk[3] = pack2(pv[6], pv[7]);
  bf16x8 pf = __builtin_bit_cast(bf16x8, pk);
#pragma unroll
  for (int dt = 0; dt < 4; ++dt) {
    bf16x8 vf = f.v[dt];
#pragma unroll
    for (int j = 0; j < 4; ++j) st.o[dt][j] *= alpha;
    st.o[dt] = mfma16(vf, pf, st.o[dt]);
  }
}

DI void attn_item(const Params& p, char* ws, int lane, int l, int item) {
  const int fr = lane & 15, fq = lane >> 4;
  const int type = item >> 10, r = item & 1023;
  const int h = r & 7, qp = r >> 3;
  AttnSt st[2];
  const u16* Q;
  u16* Y;
  if (type == 0 || type == 2) { Q = (const u16*)(ws + O_QA); Y = (u16*)(ws + O_YABC); }
  else { Q = (const u16*)(ws + O_QC); Y = (u16*)(ws + O_YABC) + 2ull * NT * 512; }
  const int tok0 = (type < 2 ? NCTX : 0) + qp * 32;
  bf16x8 qf[2][2];
  const bool hasSink = (type == 0 || type == 2);
#pragma unroll
  for (int i = 0; i < 2; ++i) {
#pragma unroll
    for (int dt = 0; dt < 4; ++dt) st[i].o[dt] = f32x4{0.f, 0.f, 0.f, 0.f};
#pragma unroll
    for (int ks = 0; ks < 2; ++ks) qf[i][ks] = *(const bf16x8*)(Q + (size_t)(tok0 + i * 16 + fr) * 512 + h * 64 + ks * 32 + fq * 8);
    if (hasSink) { st[i].m = p.in[15][l * 8 + h]; st[i].l = fq == 0 ? 1.f : 0.f; }
    else { st[i].m = -1e30f; st[i].l = 0.f; }
  }
  AttnKVF f;
  if (type == 0) {
    const int qt = qp * 2;
    const int b = qt >> 7, kv = h >> 2;
    const u16* ck = (const u16*)(ws + O_CAK) + ((size_t)(b * 4 + l) * 512) * 128 + kv * 64;
    const u16* cvt = (const u16*)(ws + O_CAVT) + ((size_t)(b * 4 + l) * 128 + kv * 64) * 512;
    for (int p0 = 0; p0 < 512; p0 += 32) {
      attn_kvload(f, ck + (size_t)p0 * 128, 128, cvt + p0, 512, fr, fq);
      attn_core<0>(st[0], qf[0], f, fr, fq, 0, 0, nullptr);
      attn_core<0>(st[1], qf[1], f, fr, fq, 0, 0, nullptr);
    }
    const u16* K = (const u16*)(ws + O_KA) + (size_t)(NCTX + b * 2048) * 128 + kv * 64;
    const u16* VT = (const u16*)(ws + O_VAT) + (size_t)(kv * 64) * NT + NCTX + b * 2048;
    const int ta = (qt & 127) * 16;
    const int kb0 = max(0, ((ta - 128) >> 5) << 5), kb1 = min(2048, ta + 32 + 128);
    for (int k0 = kb0; k0 < kb1; k0 += 32) {
      attn_kvload(f, K + (size_t)k0 * 128, 128, VT + k0, NT, fr, fq);
      attn_core<1>(st[0], qf[0], f, fr, fq, ta + fr, k0, nullptr);
      attn_core<1>(st[1], qf[1], f, fr, fq, ta + 16 + fr, k0, nullptr);
    }
  } else if (type == 1) {
    const int qt = qp * 2;
    const int b = qt >> 7;
    const u16* ck = (const u16*)(ws + O_CCK) + ((size_t)(b * 4 + l) * 512) * 512 + h * 64;
    const u16* cvt = (const u16*)(ws + O_CCVT) + ((size_t)(b * 4 + l) * 512 + h * 64) * 512;
    for (int p0 = 0; p0 < 512; p0 += 32) {
      attn_kvload(f, ck + (size_t)p0 * 512, 512, cvt + p0, 512, fr, fq);
      attn_core<0>(st[0], qf[0], f, fr, fq, 0, 0, nullptr);
      attn_core<0>(st[1], qf[1], f, fr, fq, 0, 0, nullptr);
    }
    const u16* K = (const u16*)(ws + O_KC) + (size_t)(NCTX + b * 2048) * 512 + h * 64;
    const u16* VT = (const u16*)(ws + O_VCT) + (size_t)(h * 64) * NT + NCTX + b * 2048;
    const float* rpb = p.in[29] + (size_t)(l * 8 + h) * 15 * 31;
#pragma unroll
    for (int i = 0; i < 2; ++i) {
      const int t0 = ((qt + i) & 127) * 16;
      const int qrow = t0 >> 6, c0 = t0 & 63;
      const int rs = min(max(qrow - 4, 0), 24);
      const int cstart = min(max(c0 - 8, 0), 32);
      for (int a = 0; a < 8; ++a) {
        int krow = rs + a;
        int k0 = krow * 64 + cstart;
        attn_kvload(f, K + (size_t)k0 * 512, 512, VT + k0, NT, fr, fq);
        attn_core<2>(st[i], qf[i], f, fr, fq, c0 + fr, cstart, rpb + (krow - qrow + 7) * 31);
      }
    }
  } else if (type == 2) {
    const int b = (qp * 2) >> 4, kv = h >> 2;
    const u16* K = (const u16*)(ws + O_KA) + (size_t)(b * 256) * 128 + kv * 64;
    const u16* VT = (const u16*)(ws + O_VAT) + (size_t)(kv * 64) * NT + b * 256;
    for (int k0 = 0; k0 < 256; k0 += 32) {
      attn_kvload(f, K + (size_t)k0 * 128, 128, VT + k0, NT, fr, fq);
      attn_core<0>(st[0], qf[0], f, fr, fq, 0, 0, nullptr);
      attn_core<0>(st[1], qf[1], f, fr, fq, 0, 0, nullptr);
    }
  } else {
    const int b = (qp * 2) >> 4;
    const u16* K = (const u16*)(ws + O_KC) + (size_t)(b * 256) * 512 + h * 64;
    const u16* VT = (const u16*)(ws + O_VCT) + (size_t)(h * 64) * NT + b * 256;
    for (int k0 = 0; k0 < 256; k0 += 32) {
      attn_kvload(f, K + (size_t)k0 * 512, 512, VT + k0, NT, fr, fq);
      attn_core<0>(st[0], qf[0], f, fr, fq, 0, 0, nullptr);
      attn_core<0>(st[1], qf[1], f, fr, fq, 0, 0, nullptr);
    }
  }
#pragma unroll
  for (int i = 0; i < 2; ++i) {
    float lt = st[i].l;
    lt += __shfl_xor(lt, 16);
    lt += __shfl_xor(lt, 32);
    float inv = 1.f / lt;
#pragma unroll
    for (int dt = 0; dt < 4; ++dt) {
      u32x2 o; o[0] = pack2(st[i].o[dt][0] * inv, st[i].o[dt][1] * inv); o[1] = pack2(st[i].o[dt][2] * inv, st[i].o[dt][3] * inv);
      *(u32x2*)(Y + (size_t)(tok0 + i * 16 + fr) * 512 + h * 64 + dt * 16 + fq * 4) = o;
    }
  }
}


__device__ void phase_mix(const Params& p, int l) {
  char* ws = opaque_ptr(p.ws);
  const int tid = opaque_tid();
  const int wid = tid >> 6, lane = tid & 63;
  constexpr int LJPL = 4;
  constexpr int BPS = 64 / (4 * LJPL);
  const int NLB = (int)gridDim.x >= 2 * 32 * BPS ? 32 * BPS : 0;
  if ((int)blockIdx.x < NLB) {
    __builtin_amdgcn_s_setprio(3);
    const int it = blockIdx.x;
    const int sc = it / BPS, hf = it % BPS;
    const int z = sc & 1, h = (sc >> 1) & 7, b = sc >> 4;
    const float* s0 = p.in[6] + ((size_t)((b * 4 + l) * 2 + z) * 8 + h) * 4096;
    scan_latent_block<LJPL, 2048>(ws, tid, z, h, NCTX + b * 2048, hf * 4 * LJPL, s0, nullptr);
  } else {
    __builtin_amdgcn_s_setprio(1);
    if (NLB == 0) {
      for (int it = blockIdx.x * 4 + wid; it < 256; it += gridDim.x * 4) {
        int sc = it >> 3, part = it & 7;
        int z = sc & 1, h = (sc >> 1) & 7, b = sc >> 4;
        const float* s0 = p.in[6] + ((size_t)((b * 4 + l) * 2 + z) * 8 + h) * 4096;
        scan_wave_dma<8, 8>(ws, lane, wid * 12288, z, h, NCTX + b * 2048, 2048, part * 8, s0, nullptr);
      }
    }
    if (NLB > 0) {
      const int nab = (int)gridDim.x - NLB;
      for (int it = (int)blockIdx.x - NLB; it < 512; it += nab) {
        int sc = it >> 1, hf = it & 1;
        int z = sc & 1, h = (sc >> 1) & 7, b = sc >> 4;
        float* so = p.out + OUT_ST + ((size_t)((b * 4 + l) * 2 + z) * 8 + h) * 4096;
        scan_latent_block<8, 256>(ws, tid, z, h, b * 256, hf * 32, nullptr, so);
      }
    } else {
      const int nw = gridDim.x * 4;
      for (int it = (int)blockIdx.x * 4 + wid; it < 2048; it += nw) {
        int sc = it >> 3, part = it & 7;
        int z = sc & 1, h = (sc >> 1) & 7, b = sc >> 4;
        float* so = p.out + OUT_ST + ((size_t)((b * 4 + l) * 2 + z) * 8 + h) * 4096;
        scan_wave_dma<8, 8>(ws, lane, wid * 12288, z, h, b * 256, 256, part * 8, nullptr, so);
      }
    }
  }
  __builtin_amdgcn_s_setprio(0);
  int* cnt = (int*)(ws + O_CNT) + l;
  while (true) {
    int it = 0;
    if (lane == 0) it = atomicAdd(cnt, 1);
    it = __builtin_amdgcn_readfirstlane(it);
    if (it >= 4096) break;
    attn_item(p, ws, lane, l, it);
  }
  if (l == 0) {
    int* cnt2 = (int*)(ws + O_CNT) + 8;
    while (true) {
      int it = 0;
      if (lane == 0) it = atomicAdd(cnt2, 1);
      it = __builtin_amdgcn_readfirstlane(it);
      if (it >= 4096) break;
      const int tab = it >> 11, rb = (it & 2047) * 32;
      if (tab == 0) convert_rows_fp8_wave(lane, p.in[34], (unsigned char*)(ws + O_PEU), (float*)(ws + O_SCU), rb, rb + 32);
      else convert_rows_fp8_wave(lane, p.in[35], (unsigned char*)(ws + O_PEV), (float*)(ws + O_SCV), rb, rb + 32);
    }
  }
}

__device__ void phase_rwkv_post(const Params& p, int l) {
  char* ws = opaque_ptr(p.ws);
  const int tid = opaque_tid();
  const int lane = tid & 63;
  const int gw = blockIdx.x * 4 + (tid >> 6), GW = gridDim.x * 4;
  const float* Y0 = (const float*)(ws + O_YS);
  const float* Y1 = Y0 + (size_t)NT * 512;
  const float* KD0 = (const float*)(ws + O_KD);
  const float* KD1 = KD0 + (size_t)NT * 512;
  for (int tok = gw; tok < NT; tok += GW) {
#pragma unroll
    for (int i = 0; i < 2; ++i) {
      int c = (lane + 64 * i) * 4;
      size_t e = (size_t)tok * 512 + c;
      f32x4 a = *(const f32x4*)(Y0 + e), b = *(const f32x4*)(Y1 + e);
      f32x4 y;
      float s = 0.f;
#pragma unroll
      for (int j = 0; j < 4; ++j) { y[j] = a[j] + b[j]; s += y[j]; }
      float mu = row_sum16(s) * (1.f / 64.f);
      float vs = 0.f;
#pragma unroll
      for (int j = 0; j < 4; ++j) { y[j] -= mu; vs += y[j] * y[j]; }
      float var = row_sum16(vs) * (1.f / 64.f);
      float rstd = rsqrtf(var + 64e-5f);
      f32x4 g = *(const f32x4*)(p.in[26] + l * 512 + c), bb = *(const f32x4*)(p.in[27] + l * 512 + c);
      f32x4 r = *(const f32x4*)((const float*)(ws + O_XRKV) + (size_t)tok * 1536 + c);
      f32x4 v = *(const f32x4*)((const float*)(ws + O_XRKV) + (size_t)tok * 1536 + 1024 + c);
      f32x4 k0 = *(const f32x4*)(KD0 + e), k1 = *(const f32x4*)(KD1 + e);
      f32x4 rk = *(const f32x4*)(p.in[25] + l * 512 + c);
      float bs = 0.f;
#pragma unroll
      for (int j = 0; j < 4; ++j) bs += r[j] * (k0[j] + k1[j]) * rk[j];
      bs = row_sum16(bs);
      f32x4 gg = *(const f32x4*)((const float*)(ws + O_GG) + e);
      float o[4];
#pragma unroll
      for (int j = 0; j < 4; ++j) o[j] = (y[j] * rstd * g[j] + bb[j] + bs * v[j]) * gg[j];
      u32x2 ov; ov[0] = pack2(o[0], o[1]); ov[1] = pack2(o[2], o[3]);
      *(u32x2*)((u16*)(ws + O_YABC) + (size_t)NT * 512 + e) = ov;
    }
  }
}

__device__ void phase_branch(const Params& p, int l) {
  char* ws = opaque_ptr(p.ws);
  const int tid = opaque_tid();
  const int wid = tid >> 6, lane = tid & 63, wr = wid >> 1, wc = wid & 1, fr = lane & 15, fq = lane >> 4;
  const u16* G = (const u16*)(ws + O_GATE);
  for (int t = blockIdx.x; t < 64 * 8; t += gridDim.x) {
    const int tm = t & 63, tn = t >> 6;
    const int brow = tm * 128, bcol = tn * 128;
    f32x4 tot[4][4];
    zero_acc(tot);
#pragma unroll 1
    for (int br = 0; br < 3; ++br) {
      f32x4 acc[4][4];
      zero_acc(acc);
      const u16* Wb = (const u16*)(ws + (br == 0 ? O_AOUT : br == 1 ? O_RWOUT : O_NAOUT)) + ((size_t)l * 1024 + bcol) * 512;
      gemm_main(tid, (const u16*)(ws + O_YABC) + (size_t)br * NT * 512 + (size_t)brow * 512, 512, Wb, 512, 512, acc, ((tm >> 3) + (tn & 7)) & 7);
#pragma unroll
      for (int m = 0; m < 4; ++m) {
        const int tok = brow + wr * 64 + m * 16 + fr;
#pragma unroll
        for (int n = 0; n < 4; ++n) {
          const int c = bcol + wc * 64 + n * 16 + fq * 4;
          u32x2 gv = *(const u32x2*)(G + (size_t)tok * 3072 + br * 1024 + c);
          tot[m][n][0] += acc[m][n][0] * __uint_as_float(gv[0] << 16);
          tot[m][n][1] += acc[m][n][1] * __uint_as_float(gv[0] & 0xffff0000u);
          tot[m][n][2] += acc[m][n][2] * __uint_as_float(gv[1] << 16);
          tot[m][n][3] += acc[m][n][3] * __uint_as_float(gv[1] & 0xffff0000u);
        }
      }
    }
#pragma unroll
    for (int m = 0; m < 4; ++m) {
      const int tok = brow + wr * 64 + m * 16 + fr;
#pragma unroll
      for (int n = 0; n < 4; ++n) {
        const int c = bcol + wc * 64 + n * 16 + fq * 4;
        u32x2 o; o[0] = pack2(tot[m][n][0], tot[m][n][1]); o[1] = pack2(tot[m][n][2], tot[m][n][3]);
        *(u32x2*)((u16*)(ws + O_MERG) + (size_t)tok * 1024 + c) = o;
      }
    }
  }
}

__device__ void phase_wo(const Params& p, int l) {
  char* ws = opaque_ptr(p.ws);
  const int tid = opaque_tid();
  const int wid = tid >> 6, lane = tid & 63, wr = wid >> 1, wc = wid & 1, fr = lane & 15, fq = lane >> 4;
  float* X = (float*)(ws + O_X);
  for (int t = blockIdx.x; t < 64 * 8; t += gridDim.x) {
    const int tm = t & 63, tn = t >> 6;
    const int brow = tm * 128, bcol = tn * 128;
    f32x4 acc[4][4];
    zero_acc(acc);
    gemm_main(tid, (const u16*)(ws + O_MERG) + (size_t)brow * 1024, 1024, (const u16*)(ws + O_WO) + ((size_t)l * 1024 + bcol) * 1024, 1024, 1024, acc, (((tm >> 3) + (tn & 7)) * 2) & 15);
#pragma unroll
    for (int m = 0; m < 4; ++m) {
      const int tok = brow + wr * 64 + m * 16 + fr;
      const float* gate = (const float*)(ws + O_MOD) + ((size_t)l * 3 + tok_cond(tok)) * 6144 + 2 * 1024;
#pragma unroll
      for (int n = 0; n < 4; ++n) {
        const int c = bcol + wc * 64 + n * 16 + fq * 4;
        f32x4 x = *(f32x4*)(X + (size_t)tok * 1024 + c);
        f32x4 g = *(const f32x4*)(gate + c);
#pragma unroll
        for (int j = 0; j < 4; ++j) x[j] += g[j] * acc[m][n][j];
        *(f32x4*)(X + (size_t)tok * 1024 + c) = x;
      }
    }
  }
}

__device__ void phase_peq(const Params& p, int l) {
  char* ws = opaque_ptr(p.ws);
  const int tid = opaque_tid();
  const int wid = tid >> 6, lane = tid & 63, wr = wid >> 1, wc = wid & 1, fr = lane & 15, fq = lane >> 4;
  for (int t = blockIdx.x; t < 64 * 16; t += gridDim.x) {
    const int tm = t & 63, tn = t >> 6;
    const int brow = tm * 128, bcol = tn * 128;
    f32x4 acc[4][4];
    zero_acc(acc);
    gemm_main(tid, (const u16*)(ws + O_H) + (size_t)brow * 1024, 1024, (const u16*)(ws + O_PEQ) + ((size_t)l * 2048 + bcol) * 1024, 1024, 1024, acc, (((tm >> 3) + (tn & 7)) * 2) & 15);
#pragma unroll
    for (int m = 0; m < 4; ++m) {
      const int tok = brow + wr * 64 + m * 16 + fr;
#pragma unroll
      for (int n = 0; n < 4; ++n) {
        const int c = bcol + wc * 64 + n * 16 + fq * 4;
        u32x2 o; o[0] = pack2(acc[m][n][0], acc[m][n][1]); o[1] = pack2(acc[m][n][2], acc[m][n][3]);
        *(u32x2*)((u16*)(ws + O_PQ) + (size_t)tok * 2048 + c) = o;
      }
    }
  }
}

__device__ const unsigned char kCand[64] = {
    0x00, 0x01, 0x02, 0x03, 0x04, 0x05, 0x06, 0x07, 0x08, 0x09, 0x0a, 0x0b, 0x0c, 0x0d, 0x0e, 0x0f,
    0x10, 0x11, 0x12, 0x13, 0x14, 0x15, 0x16, 0x17, 0x20, 0x21, 0x22, 0x23, 0x24, 0x30, 0x31, 0x32,
    0x33, 0x40, 0x41, 0x42, 0x50, 0x51, 0x60, 0x61, 0x70, 0x71, 0x80, 0x90, 0xa0, 0xb0, 0xc0, 0xd0,
    0xe0, 0xf0, 0xff, 0xff, 0xff, 0xff, 0xff, 0xff, 0xff, 0xff, 0xff, 0xff, 0xff, 0xff, 0xff, 0xff};

DI unsigned f2key(float f) { unsigned u = __float_as_uint(f); return (u & 0x80000000u) ? ~u : (u | 0x80000000u); }
DI float key2f(unsigned k) { unsigned u = (k & 0x80000000u) ? (k & 0x7fffffffu) : ~k; return __uint_as_float(u); }
template <int CTRL> DI unsigned dppu(unsigned v) { return (unsigned)__builtin_amdgcn_update_dpp(0, (int)v, CTRL, 0xf, 0xf, true); }
DI unsigned row_max16u(unsigned v) { v = max(v, dppu<0xB1>(v)); v = max(v, dppu<0x4E>(v)); v = max(v, dppu<0x141>(v)); v = max(v, dppu<0x140>(v)); return v; }

__device__ void phase_peer_sel(const Params& p, int l) {
  char* ws = opaque_ptr(p.ws);
  const int tid = opaque_tid();
  const int wid = tid >> 6, lane = tid & 63, fr = lane & 15, fq = lane >> 4;
  const int gw = blockIdx.x * 4 + wid, GW = gridDim.x * 4;
  float* lv = (float*)(g_smem + wid * 4096);
  int* li = (int*)(g_smem + wid * 4096 + 2048);
  const u16* PQ = (const u16*)(ws + O_PQ);
  int ca[4], cb[4];
  bool cvld[4];
#pragma unroll
  for (int c = 0; c < 4; ++c) { int code = kCand[c * 16 + fr]; cvld[c] = code != 0xff; ca[c] = (code >> 4) & 15; cb[c] = code & 15; }
  for (int it = gw; it < 512 * 8; it += GW) {
    const int h = it >> 9, tg = it & 511;
    const u16* SK = (const u16*)(ws + O_SUBK) + ((size_t)(l * 8 + h) * 2) * 128 * 128;
    f32x4 sc[2][8];
#pragma unroll
    for (int z = 0; z < 2; ++z) {
      bf16x8 qf[4];
#pragma unroll
      for (int ks = 0; ks < 4; ++ks) qf[ks] = *(const bf16x8*)(PQ + (size_t)(tg * 16 + fr) * 2048 + (h * 2 + z) * 128 + ks * 32 + fq * 8);
#pragma unroll
      for (int nt = 0; nt < 8; ++nt) {
        sc[z][nt] = f32x4{0.f, 0.f, 0.f, 0.f};
#pragma unroll
        for (int ks = 0; ks < 4; ++ks) {
          bf16x8 kf = *(const bf16x8*)(SK + ((size_t)z * 128 + nt * 16 + fr) * 128 + ks * 32 + fq * 8);
          sc[z][nt] = mfma16(qf[ks], kf, sc[z][nt]);
        }
      }
    }
#pragma unroll
    for (int z = 0; z < 2; ++z) {
#pragma unroll
      for (int j = 0; j < 4; ++j) {
        unsigned key[8];
#pragma unroll
        for (int nt = 0; nt < 8; ++nt) key[nt] = (f2key(sc[z][nt][j]) & ~127u) | (unsigned)(127 - (nt * 16 + fr));
        unsigned tk = 0u;
#pragma unroll 1
        for (int k = 0; k < 16; ++k) {
          unsigned m = key[0];
#pragma unroll
          for (int nt = 1; nt < 8; ++nt) m = max(m, key[nt]);
          unsigned M = row_max16u(m);
#pragma unroll
          for (int nt = 0; nt < 8; ++nt) key[nt] = key[nt] == M ? 0u : key[nt];
          if (fr == k) tk = M;
        }
        lv[((fq * 4 + j) * 2 + z) * 16 + fr] = key2f(tk & ~127u);
        li[((fq * 4 + j) * 2 + z) * 16 + fr] = 127 - (int)(tk & 127u);
      }
    }
    __builtin_amdgcn_s_waitcnt(0xc07f);
    __builtin_amdgcn_wave_barrier();
#pragma unroll 1
    for (int j = 0; j < 4; ++j) {
      const int tl = fq * 4 + j;
      float cand[4];
#pragma unroll
      for (int c = 0; c < 4; ++c) cand[c] = cvld[c] ? lv[(tl * 2 + 0) * 16 + ca[c]] + lv[(tl * 2 + 1) * 16 + cb[c]] : -3e38f;
      unsigned ck[4];
#pragma unroll
      for (int c = 0; c < 4; ++c) ck[c] = cvld[c] ? ((f2key(cand[c]) & ~63u) | (unsigned)(63 - (c * 16 + fr))) : 0u;
      unsigned sk = 0u;
#pragma unroll 1
      for (int k = 0; k < 16; ++k) {
        unsigned m = max(max(ck[0], ck[1]), max(ck[2], ck[3]));
        unsigned M = row_max16u(m);
#pragma unroll
        for (int c = 0; c < 4; ++c) ck[c] = ck[c] == M ? 0u : ck[c];
        if (fr == k) sk = M;
      }
      const float sv = key2f(sk & ~63u);
      const int scode = 63 - (int)(sk & 63u);
      int ab = kCand[scode];
      int e = li[(tl * 2 + 0) * 16 + ((ab >> 4) & 15)] * 128 + li[(tl * 2 + 1) * 16 + (ab & 15)];
      float mx = row_max16(sv);
      float ex = __expf(sv - mx);
      float sum = row_sum16(ex);
      int tok = tg * 16 + tl;
      ((int*)(ws + O_EIDX))[(size_t)tok * 128 + h * 16 + fr] = e;
      ((float*)(ws + O_EGATE))[(size_t)tok * 128 + h * 16 + fr] = ex / sum;
    }
    __builtin_amdgcn_s_waitcnt(0xc07f);
    __builtin_amdgcn_wave_barrier();
  }
}

DI void cvt8(const bf16x8& v, float (&f)[8]) {
  u32x4 u = __builtin_bit_cast(u32x4, v);
#pragma unroll
  for (int q = 0; q < 4; ++q) { f[2 * q] = __uint_as_float(u[q] << 16); f[2 * q + 1] = __uint_as_float(u[q] & 0xffff0000u); }
}
DI void cvt16(const u32x4& q, float (&f)[16]) {
#pragma unroll
  for (int i = 0; i < 4; ++i) {
    f32x2 a = __builtin_amdgcn_cvt_pk_f32_fp8((int)q[i], false), b = __builtin_amdgcn_cvt_pk_f32_fp8((int)q[i], true);
    f[4 * i] = a[0]; f[4 * i + 1] = a[1]; f[4 * i + 2] = b[0]; f[4 * i + 3] = b[1];
  }
}

__device__ void phase_peer_gather(const Params& p, int l, bool dry = false) {
  char* ws = opaque_ptr(p.ws);
  const int tid = opaque_tid();
  const int lane = tid & 63;
  const int gw = blockIdx.x * 4 + (tid >> 6), GW = gridDim.x * 4;
  const unsigned char* U = (const unsigned char*)(ws + O_PEU) + (size_t)l * 16384 * 1024;
  const unsigned char* V = (const unsigned char*)(ws + O_PEV) + (size_t)l * 16384 * 1024;
  const float* SU = (const float*)(ws + O_SCU) + l * 16384;
  const float* SV = (const float*)(ws + O_SCV) + l * 16384;
  float* X = (float*)(ws + O_X);
  float* XW = dry ? (float*)(ws + O_YS) : X;
  u16* HW = dry ? (u16*)(ws + O_MERG) : (u16*)(ws + O_H);
  float* OW = dry ? (float*)(ws + O_PB) : p.out + OUT_Y;
  for (int tok = gw; tok < NT; tok += GW) {
    float hf[16];
    {
      const u16* hr = (const u16*)(ws + O_H) + (size_t)tok * 1024 + lane * 16;
      bf16x8 h0 = *(const bf16x8*)(hr), h1 = *(const bf16x8*)(hr + 8);
      float t0[8], t1[8];
      cvt8(h0, t0); cvt8(h1, t1);
#pragma unroll
      for (int i = 0; i < 8; ++i) { hf[i] = t0[i]; hf[8 + i] = t1[i]; }
    }
    float acc[16];
#pragma unroll
    for (int i = 0; i < 16; ++i) acc[i] = 0.f;
    const int id0 = ((const int*)(ws + O_EIDX))[(size_t)tok * 128 + lane], id1 = ((const int*)(ws + O_EIDX))[(size_t)tok * 128 + 64 + lane];
    const float g0 = ((const float*)(ws + O_EGATE))[(size_t)tok * 128 + lane], g1 = ((const float*)(ws + O_EGATE))[(size_t)tok * 128 + 64 + lane];
#define PG_LOAD(G, ids, gts, su, sv, uq, vq)                                                                      \
  do {                                                                                                            \
    _Pragma("unroll") for (int e = 0; e < 4; ++e) {                                                               \
      int k = (G) * 4 + e;                                                                                        \
      int sel = k & 63;                                                                                           \
      int a_ = __builtin_amdgcn_readlane(id0, sel), b_ = __builtin_amdgcn_readlane(id1, sel);                     \
      float ga_ = __builtin_bit_cast(float, __builtin_amdgcn_readlane(__builtin_bit_cast(int, g0), sel));         \
      float gb_ = __builtin_bit_cast(float, __builtin_amdgcn_readlane(__builtin_bit_cast(int, g1), sel));         \
      ids[e] = (G) < 16 ? a_ : b_;                                                                                 \
      gts[e] = (G) < 16 ? ga_ : gb_;                                                                               \
    }                                                                                                             \
    _Pragma("unroll") for (int e = 0; e < 4; ++e) uq[e] = *(const u32x4*)(U + (size_t)ids[e] * 1024 + lane * 16); \
    _Pragma("unroll") for (int e = 0; e < 4; ++e) vq[e] = *(const u32x4*)(V + (size_t)ids[e] * 1024 + lane * 16); \
    _Pragma("unroll") for (int e = 0; e < 4; ++e) { su[e] = SU[ids[e]]; sv[e] = SV[ids[e]]; }                     \
  } while (0)
#define PG_COMP(gts, su, sv, uq, vq)                                                                              \
  do {                                                                                                            \
    float cf[4];                                                                                                  \
    _Pragma("unroll") for (int e = 0; e < 4; ++e) {                                                               \
      float a[16];                                                                                                \
      cvt16(uq[e], a);                                                                                            \
      float d0 = 0.f, d1 = 0.f;                                                                                   \
      _Pragma("unroll") for (int i = 0; i < 16; i += 2) { d0 += a[i] * hf[i]; d1 += a[i + 1] * hf[i + 1]; }       \
      float d = wave_sum(d0 + d1) * su[e];                                                                        \
      float u3 = 0.7978845608028654f * (d + 0.044715f * d * d * d);                                               \
      float th = 1.f - 2.f * __builtin_amdgcn_rcpf(__expf(2.f * u3) + 1.f);                                                            \
      cf[e] = gts[e] * 0.5f * d * (1.f + th) * sv[e];                                                             \
    }                                                                                                             \
    _Pragma("unroll") for (int e = 0; e < 4; ++e) {                                                               \
      float a[16];                                                                                                \
      cvt16(vq[e], a);                                                                                            \
      _Pragma("unroll") for (int i = 0; i < 16; ++i) acc[i] += cf[e] * a[i];                                      \
    }                                                                                                             \
  } while (0)
    {
      int idA[4], idB[4];
      float gtA[4], gtB[4], suA[4], svA[4], suB[4], svB[4];
      u32x4 uqA[4], vqA[4], uqB[4], vqB[4];
      PG_LOAD(0, idA, gtA, suA, svA, uqA, vqA);
#pragma unroll 1
      for (int g = 0; g < 32; g += 2) {
        PG_LOAD(g + 1, idB, gtB, suB, svB, uqB, vqB);
        PG_COMP(gtA, suA, svA, uqA, vqA);
        if (g + 2 < 32) PG_LOAD(g + 2, idA, gtA, suA, svA, uqA, vqA);
        PG_COMP(gtB, suB, svB, uqB, vqB);
      }
    }
#undef PG_LOAD
#undef PG_COMP
    const float* mod = (const float*)(ws + O_MOD) + ((size_t)l * 3 + tok_cond(tok)) * 6144;
    float x[16];
    const int e0 = lane * 16;
#pragma unroll
    for (int q = 0; q < 4; ++q) {
      f32x4 a = *(const f32x4*)(X + (size_t)tok * 1024 + e0 + q * 4);
      f32x4 ga = *(const f32x4*)(mod + 5 * 1024 + e0 + q * 4);
#pragma unroll
      for (int i = 0; i < 4; ++i) { a[i] += ga[i] * acc[q * 4 + i]; x[q * 4 + i] = a[i]; }
      *(f32x4*)(XW + (size_t)tok * 1024 + e0 + q * 4) = a;
    }
    float ss = 0.f;
#pragma unroll
    for (int i = 0; i < 16; ++i) ss += x[i] * x[i];
    ss = wave_sum(ss);
    const float rstd = rsqrtf(ss * (1.f / 1024.f) + 1e-6f);
    if (l < NL - 1) {
      const float* mod2 = (const float*)(ws + O_MOD) + ((size_t)(l + 1) * 3 + tok_cond(tok)) * 6144;
      const float* g = p.in[9] + (l + 1) * 1024;
      float y[16];
#pragma unroll
      for (int q = 0; q < 4; ++q) {
        f32x4 gg = *(const f32x4*)(g + e0 + q * 4), sh = *(const f32x4*)(mod2 + e0 + q * 4), sc = *(const f32x4*)(mod2 + 1024 + e0 + q * 4);
#pragma unroll
        for (int i = 0; i < 4; ++i) y[q * 4 + i] = x[q * 4 + i] * rstd * gg[i] * (1.f + sc[i]) + sh[i];
      }
      u32x4 o0, o1;
      o0[0] = pack2(y[0], y[1]); o0[1] = pack2(y[2], y[3]); o0[2] = pack2(y[4], y[5]); o0[3] = pack2(y[6], y[7]);
      o1[0] = pack2(y[8], y[9]); o1[1] = pack2(y[10], y[11]); o1[2] = pack2(y[12], y[13]); o1[3] = pack2(y[14], y[15]);
      *(u32x4*)(HW + (size_t)tok * 1024 + e0) = o0;
      *(u32x4*)(HW + (size_t)tok * 1024 + e0 + 8) = o1;
    } else {
      const float* g = p.in[11];
#pragma unroll
      for (int q = 0; q < 4; ++q) {
        f32x4 gg = *(const f32x4*)(g + e0 + q * 4), a;
#pragma unroll
        for (int i = 0; i < 4; ++i) a[i] = x[q * 4 + i] * rstd * gg[i];
        *(f32x4*)(OW + (size_t)tok * 1024 + e0 + q * 4) = a;
      }
    }
  }
}

#define XB_TMO 128
#define XB_XCNT(j) (256 + 64 * (j))
#define XB_XSUB(j) (1280 + 64 * (j))
#define XB_XGEN(j) (2304 + 64 * (j))
#define XB_TOP 3328
#define XB_TOPGEN 3392
#define XCD_BAR_WORDS 3456
#define XB_SPIN_CAP (1u << 18)
DI unsigned xb_ld(unsigned* q) { return __hip_atomic_load(q, __ATOMIC_RELAXED, __HIP_MEMORY_SCOPE_AGENT); }
DI unsigned xb_add(unsigned* q, unsigned v) { return __hip_atomic_fetch_add(q, v, __ATOMIC_RELAXED, __HIP_MEMORY_SCOPE_AGENT); }
DI unsigned xb_xcc_id() { return (unsigned)__builtin_amdgcn_s_getreg((3 << 11) | 20) & 0xFu; }
#define XB_SPIN(cond, bar)                                                                   \
  do {                                                                                       \
    unsigned _sp = 0;                                                                        \
    while (cond) {                                                                           \
      __builtin_amdgcn_s_sleep(1);                                                           \
      if ((++_sp & 255u) == 0u) {                                                            \
        if (xb_ld(&(bar)[XB_TMO])) break;                                                    \
        if (_sp > XB_SPIN_CAP) { atomicAdd(&(bar)[XB_TMO], 1u); break; }                     \
      }                                                                                      \
    }                                                                                        \
  } while (0)
struct XB { unsigned* bar; unsigned x, nloc, nx; };
DI void xcd_barrier(const XB& b) {
  asm volatile("s_waitcnt vmcnt(0)" ::: "memory");
  __syncthreads();
  if (threadIdx.x == 0) {
    unsigned* bar = b.bar;
    __builtin_amdgcn_s_waitcnt(0);
    const unsigned nloc = b.nloc, nx = b.nx;
    const unsigned old = xb_add(&bar[XB_XSUB(b.x)], 1u);
    const unsigned gen = old / nloc;
    if (old + 1u == (gen + 1u) * nloc) {
      __builtin_amdgcn_fence(__ATOMIC_RELEASE, "agent");
      asm volatile("s_waitcnt vmcnt(0)" ::: "memory");
      const unsigned og = xb_add(&bar[XB_TOP], 1u);
      const unsigned tg = og / nx;
      if (og + 1u == (tg + 1u) * nx) xb_add(&bar[XB_TOPGEN], 1u);
      else XB_SPIN(xb_ld(&bar[XB_TOPGEN]) == tg, bar);
      __builtin_amdgcn_fence(__ATOMIC_ACQUIRE, "agent");
      xb_add(&bar[XB_XGEN(b.x)], 1u);
      asm volatile("s_waitcnt vmcnt(0)" ::: "memory");
    } else {
      XB_SPIN(xb_ld(&bar[XB_XGEN(b.x)]) == gen, bar);
      __builtin_amdgcn_fence(__ATOMIC_ACQUIRE, "agent");
      asm volatile("s_waitcnt vmcnt(0)" ::: "memory");
    }
  }
  __syncthreads();
}

__global__ void __launch_bounds__(256, 2) fwd_megakernel(Params p) {
  cg::grid_group grid = cg::this_grid();
  XB xb;
  xb.bar = (unsigned*)(p.ws + O_BAR);
  xb.x = xb_xcc_id();
  if (threadIdx.x == 0) (void)xb_add(&xb.bar[XB_XCNT(xb.x)], 1u);
  phase_prep(p);
  if (p.ws == nullptr) grid.sync();
  {
    unsigned mine = 0u, cnt = 0u, sum = 0u, sp = 0u;
    for (;;) {
      sum = 0u; cnt = 0u; mine = 0u;
#pragma unroll
      for (unsigned j = 0; j < 16; ++j) { const unsigned c = xb_ld(&xb.bar[XB_XCNT(j)]); sum += c; cnt += (c > 0u) ? 1u : 0u; mine = (j == xb.x) ? c : mine; }
      if (sum == gridDim.x) break;
      __builtin_amdgcn_s_sleep(1);
      if (++sp > XB_SPIN_CAP) break;
    }
    xb.nloc = __builtin_amdgcn_readfirstlane(mine > 0u ? mine : 1u);
    xb.nx = __builtin_amdgcn_readfirstlane(cnt > 0u ? cnt : 1u);
  }
  xcd_barrier(xb);
  phase_norm(p, 0, 0);
  xcd_barrier(xb);
  for (int l = 0; l < NL; ++l) {
    phase_gemm_in(p, l);
    xcd_barrier(xb);
    phase_rwkv_prep(p, l);
    xcd_barrier(xb);
    phase_rwkv_lora(p, l);
    xcd_barrier(xb);
    phase_mix(p, l);
    xcd_barrier(xb);
    phase_rwkv_post(p, l);
    xcd_barrier(xb);
    phase_branch(p, l);
    xcd_barrier(xb);
    phase_wo(p, l);
    xcd_barrier(xb);
    phase_norm(p, l, 1);
    xcd_barrier(xb);
    phase_peq(p, l);
    xcd_barrier(xb);
    phase_peer_sel(p, l);
    xcd_barrier(xb);
    phase_peer_gather(p, l);
    if (l + 1 < NL) xcd_barrier(xb);
  }
}

extern "C" void kernel_launch(void* const* d_in, const int* in_sizes, int n_in, void* d_out, int out_size, void* d_ws, size_t ws_size,
                              hipStream_t stream) {
  static int grid_blocks = 0;
  if (!grid_blocks) {
    int dev = 0, cus = 0, per_cu = 0;
    hipGetDevice(&dev);
    hipDeviceGetAttribute(&cus, hipDeviceAttributeMultiprocessorCount, dev);
    hipOccupancyMaxActiveBlocksPerMultiprocessor(&per_cu, fwd_megakernel, 256, 0);
    if (per_cu > 2) per_cu = 2;
    if (per_cu < 1) per_cu = 1;
    grid_blocks = cus * per_cu;
  }
  Params p{};
  for (int i = 0; i < 36; ++i) p.in[i] = (const float*)d_in[i];
  p.out = (float*)d_out;
  p.ws = (char*)d_ws;
  (void)hipMemsetAsync((char*)d_ws + O_BAR, 0, 3456 * 4, stream);
  void* args[] = {&p};
  hipError_t e = hipLaunchCooperativeKernel((void*)fwd_megakernel, dim3(grid_blocks), dim3(256), args, 0, stream);
  if (e != hipSuccess) fprintf(stderr, "cooperative launch failed: %s (grid %d)\n", hipGetErrorString(e), grid_blocks);
}
```

```cpp
#include <hip/hip_runtime.h>
#include <hip/hip_cooperative_groups.h>
#include <cstdio>
namespace cg = cooperative_groups;

#define DI __device__ __forceinline__
typedef unsigned short u16;
using bf16x8 = __attribute__((ext_vector_type(8))) short;
using bf16x4 = __attribute__((ext_vector_type(4))) short;
using f32x4 = __attribute__((ext_vector_type(4))) float;
using u32x2 = __attribute__((ext_vector_type(2))) unsigned;
using u32x4 = __attribute__((ext_vector_type(4))) unsigned;

constexpr int NT = 8192, NCTX = 4096, DM = 1024, INC = 7296, NL = 4;

constexpr size_t AL(size_t x) { return (x + 255) / 256 * 256; }
constexpr size_t O_WIN = 0;
constexpr size_t O_AOUT = O_WIN + AL(4ull * 7296 * 1024 * 2);
constexpr size_t O_RWOUT = O_AOUT + AL(4ull * 1024 * 512 * 2);
constexpr size_t O_NAOUT = O_RWOUT + AL(4ull * 1024 * 512 * 2);
constexpr size_t O_WO = O_NAOUT + AL(4ull * 1024 * 512 * 2);
constexpr size_t O_PEQ = O_WO + AL(4ull * 1024 * 1024 * 2);
constexpr size_t O_SUBK = O_PEQ + AL(4ull * 2048 * 1024 * 2);
constexpr size_t O_W2 = O_SUBK + AL(4ull * 8 * 2 * 128 * 128 * 2);
constexpr size_t O_A2 = O_W2 + AL(8ull * 512 * 64 * 2);
constexpr size_t O_G2 = O_A2 + AL(8ull * 512 * 64 * 2);
constexpr size_t O_PEU = O_G2 + AL(4ull * 512 * 128 * 2);
constexpr size_t O_PEV = O_PEU + AL(4ull * 16384 * 1024 * 2);
constexpr size_t O_CAK = O_PEV + AL(4ull * 16384 * 1024 * 2);
constexpr size_t O_CAVT = O_CAK + AL(8ull * 512 * 128 * 2);
constexpr size_t O_CCK = O_CAVT + AL(8ull * 128 * 512 * 2);
constexpr size_t O_CCVT = O_CCK + AL(8ull * 512 * 512 * 2);
constexpr size_t O_MOD = O_CCVT + AL(8ull * 512 * 512 * 2);
constexpr size_t O_ROPE = O_MOD + AL(4ull * 3 * 6144 * 4);
constexpr size_t O_CNT = O_ROPE + AL(64 * 16 * 2 * 4);
constexpr size_t O_X = O_CNT + 256;
constexpr size_t O_H = O_X + AL(8192ull * 1024 * 4);
constexpr size_t O_QA = O_H + AL(8192ull * 1024 * 2);
constexpr size_t O_KA = O_QA + AL(8192ull * 512 * 2);
constexpr size_t O_VAT = O_KA + AL(8192ull * 128 * 2);
constexpr size_t O_QC = O_VAT + AL(8192ull * 128 * 2);
constexpr size_t O_KC = O_QC + AL(8192ull * 512 * 2);
constexpr size_t O_VCT = O_KC + AL(8192ull * 512 * 2);
constexpr size_t O_PB = O_VCT + AL(8192ull * 512 * 2);
constexpr size_t O_GATE = O_PB + AL(8192ull * 1920 * 4);
constexpr size_t O_XRKV = O_GATE + AL(8192ull * 3072 * 2);
constexpr size_t O_KK = O_XRKV + AL(8192ull * 1536 * 4);
constexpr size_t O_TW = O_KK + AL(8192ull * 512 * 4);
constexpr size_t O_AD = O_TW + AL(8192ull * 128 * 2);
constexpr size_t O_SG = O_AD + AL(8192ull * 128 * 2);
constexpr size_t O_DEC = O_SG + AL(8192ull * 128 * 2);
constexpr size_t O_KD = O_DEC + AL(2ull * 8192 * 512 * 4);
constexpr size_t O_KKA = O_KD + AL(2ull * 8192 * 512 * 4);
constexpr size_t O_GG = O_KKA + AL(2ull * 8192 * 512 * 4);
constexpr size_t O_YS = O_GG + AL(8192ull * 512 * 4);
constexpr size_t O_YABC = O_YS + AL(2ull * 8192 * 512 * 4);
constexpr size_t O_MERG = O_YABC + AL(3ull * 8192 * 512 * 2);
constexpr size_t O_PQ = O_MERG + AL(8192ull * 1024 * 2);
constexpr size_t O_EIDX = O_PQ + AL(8192ull * 2048 * 2);
constexpr size_t O_EGATE = O_EIDX + AL(8192ull * 128 * 4);
constexpr size_t O_SCU = O_EGATE + AL(8192ull * 128 * 4);
constexpr size_t O_SCV = O_SCU + AL(4ull * 16384 * 4);
constexpr size_t O_BAR = O_SCV + AL(4ull * 16384 * 4);
constexpr size_t WS_TOTAL = O_BAR + AL(3456 * 4);
static_assert(WS_TOTAL < 1020ull * 1024 * 1024, "workspace too large");

constexpr size_t OUT_Y = 0;
constexpr size_t OUT_AK = 8388608;
constexpr size_t OUT_AV = 10485760;
constexpr size_t OUT_CK = 12582912;
constexpr size_t OUT_CV = 20971520;
constexpr size_t OUT_ST = 29360128;

struct Params {
  const float* in[36];
  float* out;
  char* ws;
};

__shared__ __attribute__((aligned(16))) char g_smem[65536];

DI u16 f2bf(float x) { unsigned u = __float_as_uint(x); u += 0x7fffu + ((u >> 16) & 1u); return (u16)(u >> 16); }
DI float bf2f(u16 h) { return __uint_as_float(((unsigned)h) << 16); }
typedef __bf16 bf16x2_t __attribute__((ext_vector_type(2)));
DI unsigned pack2(float a, float b) { bf16x2_t v = {(__bf16)a, (__bf16)b}; return __builtin_bit_cast(unsigned, v); }
DI float sigmoidf_(float x) { return __builtin_amdgcn_rcpf(1.f + __expf(-x)); }
template <int CTRL> DI float dppf(float v) {
  return __builtin_bit_cast(float, __builtin_amdgcn_update_dpp(0, __builtin_bit_cast(int, v), CTRL, 0xf, 0xf, true));
}
template <int CTRL> DI int dppi(int v) { return __builtin_amdgcn_update_dpp(0, v, CTRL, 0xf, 0xf, true); }
DI float row_sum16(float v) { v += dppf<0xB1>(v); v += dppf<0x4E>(v); v += dppf<0x141>(v); v += dppf<0x140>(v); return v; }
DI float row_max16(float v) { v = fmaxf(v, dppf<0xB1>(v)); v = fmaxf(v, dppf<0x4E>(v)); v = fmaxf(v, dppf<0x141>(v)); v = fmaxf(v, dppf<0x140>(v)); return v; }
DI int row_max16i(int v) { v = max(v, dppi<0xB1>(v)); v = max(v, dppi<0x4E>(v)); v = max(v, dppi<0x141>(v)); v = max(v, dppi<0x140>(v)); return v; }
DI float wave_sum(float v) {
  v = row_sum16(v);
  const int iv = __builtin_bit_cast(int, v);
  const float a = __builtin_bit_cast(float, __builtin_amdgcn_readlane(iv, 0)), b = __builtin_bit_cast(float, __builtin_amdgcn_readlane(iv, 16));
  const float c = __builtin_bit_cast(float, __builtin_amdgcn_readlane(iv, 32)), d = __builtin_bit_cast(float, __builtin_amdgcn_readlane(iv, 48));
  return (a + b) + (c + d);
}

DI int opaque_tid() { int t = threadIdx.x; asm volatile("" : "+v"(t)); return t; }
DI char* opaque_ptr(char* q) { size_t z = 0; asm volatile("" : "+s"(z)); return q + z; }
DI f32x4 mfma16(bf16x8 a, bf16x8 b, f32x4 c) { return __builtin_amdgcn_mfma_f32_16x16x32_bf16(a, b, c, 0, 0, 0); }

DI int lds_byte(int r, int c) {
  int st = (r >> 4) * 2 + (c >> 5), rr = r & 15, cc = c & 31, ob = rr * 64 + cc * 2;
  return st * 1024 + (ob ^ (((ob >> 9) & 1) << 5));
}
DI void stage_rc(int b, int& R, int& C) {
  int st = b >> 10, sb = b & 1023, swz = sb ^ (((sb >> 9) & 1) << 5);
  R = (st >> 1) * 16 + (swz >> 6);
  C = (st & 1) * 32 + ((swz & 63) >> 1);
}
DI void gemm_main(int tid, const u16* __restrict__ g0, int ld0, const u16* __restrict__ g1, int ld1, int K, f32x4 (&acc)[4][4], int koff = 0) {
  const int wid = tid >> 6, lane = tid & 63, wr = wid >> 1, wc = wid & 1, fr = lane & 15, fq = lane >> 4;
  const int nk = K >> 6;
  int R0, C0;
  stage_rc(tid * 16, R0, C0);
  const unsigned v0 = (unsigned)(R0 * ld0 + C0), v1 = (unsigned)(R0 * ld1 + C0);
  const int fa0 = lds_byte(wr * 64 + fr, fq * 8), fa1 = 16384 + lds_byte(wc * 64 + fr, fq * 8);
  const int sb = tid * 16;
#define GSTAGE(kt, buf)                                                                                          \
  do {                                                                                                           \
    _Pragma("unroll") for (int i = 0; i < 4; ++i) {                                                              \
      const u16* u0 = g0 + (size_t)(kt) * 64 + (size_t)i * 32 * ld0;                                             \
      const u16* u1 = g1 + (size_t)(kt) * 64 + (size_t)i * 32 * ld1;                                             \
      __builtin_amdgcn_global_load_lds((const unsigned*)(u0 + v0), (unsigned*)(g_smem + (buf) + i * 4096 + sb), 16, 0, 0);          \
      __builtin_amdgcn_global_load_lds((const unsigned*)(u1 + v1), (unsigned*)(g_smem + (buf) + 16384 + i * 4096 + sb), 16, 0, 0);  \
    }                                                                                                            \
  } while (0)
  int kt = koff;
  GSTAGE(kt, 0);
  for (int t = 0; t < nk; ++t) {
    asm volatile("s_waitcnt vmcnt(0)" ::: "memory");
    __syncthreads();
    const int cur = (t & 1) * 32768;
    kt = kt + 1 == nk ? 0 : kt + 1;
    if (t + 1 < nk) GSTAGE(kt, 32768 - cur);
#pragma unroll
    for (int ks = 0; ks < 2; ++ks) {
      bf16x8 f0[4], f1[4];
#pragma unroll
      for (int m = 0; m < 4; ++m) f0[m] = *(const bf16x8*)(g_smem + cur + fa0 + m * 2048 + ks * 1024);
#pragma unroll
      for (int n = 0; n < 4; ++n) f1[n] = *(const bf16x8*)(g_smem + cur + fa1 + n * 2048 + ks * 1024);
#pragma unroll
      for (int m = 0; m < 4; ++m)
#pragma unroll
        for (int n = 0; n < 4; ++n) acc[m][n] = mfma16(f1[n], f0[m], acc[m][n]);
    }
  }
#undef GSTAGE
  __syncthreads();
}
DI void zero_acc(f32x4 (&acc)[4][4]) {
#pragma unroll
  for (int m = 0; m < 4; ++m)
#pragma unroll
    for (int n = 0; n < 4; ++n) acc[m][n] = f32x4{0.f, 0.f, 0.f, 0.f};
}

struct TJob { const float* src; u16* dst; int K, N, nb; };

DI void transpose_tile(int tid, const float* __restrict__ src, u16* __restrict__ dst, int K, int N, int k0, int n0) {
  float* tile = (float*)g_smem;
  {
    const int tr = tid >> 4, tc = tid & 15;
#pragma unroll
    for (int p = 0; p < 4; ++p) {
      int r = tr + 16 * p;
      f32x4 v = __builtin_nontemporal_load((const f32x4*)(src + (size_t)(k0 + r) * N + n0 + tc * 4));
      tile[r * 65 + tc * 4 + 0] = v[0]; tile[r * 65 + tc * 4 + 1] = v[1];
      tile[r * 65 + tc * 4 + 2] = v[2]; tile[r * 65 + tc * 4 + 3] = v[3];
    }
  }
  __syncthreads();
  {
    const int tn = tid >> 3, tk = tid & 7;
#pragma unroll
    for (int p = 0; p < 2; ++p) {
      int n = tn + 32 * p;
      u32x4 o;
#pragma unroll
      for (int q = 0; q < 4; ++q) o[q] = pack2(tile[(tk * 8 + 2 * q) * 65 + n], tile[(tk * 8 + 2 * q + 1) * 65 + n]);
      *(u32x4*)(dst + (size_t)(n0 + n) * K + k0 + tk * 8) = o;
    }
  }
  __syncthreads();
}

DI void convert_chunks(int tid, const float* __restrict__ src, u16* __restrict__ dst, size_t n) {
  const size_t nch = n / 8192;
  for (size_t c = blockIdx.x; c < nch; c += gridDim.x) {
    size_t e = c * 8192 + tid * 8;
    f32x4 a[4], b[4];
#pragma unroll
    for (int q = 0; q < 4; ++q) { a[q] = __builtin_nontemporal_load((const f32x4*)(src + e + q * 2048)); b[q] = __builtin_nontemporal_load((const f32x4*)(src + e + q * 2048 + 4)); }
#pragma unroll
    for (int q = 0; q < 4; ++q) {
      u32x4 o;
      o[0] = pack2(a[q][0], a[q][1]); o[1] = pack2(a[q][2], a[q][3]); o[2] = pack2(b[q][0], b[q][1]); o[3] = pack2(b[q][2], b[q][3]);
      *(u32x4*)(dst + e + q * 2048) = o;
    }
  }
}

typedef float f32x2 __attribute__((ext_vector_type(2)));
DI void convert_rows_fp8(int tid, const float* __restrict__ src, unsigned char* __restrict__ dst, float* __restrict__ inv_scale, int nrows) {
  const int lane = tid & 63;
  const int gw = blockIdx.x * 4 + (tid >> 6), GW = gridDim.x * 4;
  for (int r0 = gw; r0 < nrows; r0 += 2 * GW) {
    int rws[2] = {r0, r0 + GW < nrows ? r0 + GW : r0};
    f32x4 v[2][4];
#pragma unroll
    for (int u = 0; u < 2; ++u)
#pragma unroll
      for (int q = 0; q < 4; ++q) v[u][q] = __builtin_nontemporal_load((const f32x4*)(src + (size_t)rws[u] * 1024 + lane * 16 + q * 4));
#pragma unroll
    for (int u = 0; u < 2; ++u) {
      float am = 0.f;
#pragma unroll
      for (int q = 0; q < 4; ++q)
#pragma unroll
        for (int j = 0; j < 4; ++j) am = fmaxf(am, fabsf(v[u][q][j]));
      am = row_max16(am);
      am = fmaxf(am, __shfl_xor(am, 16));
      am = fmaxf(am, __shfl_xor(am, 32));
      int ex = (int)((__float_as_uint(am) >> 23) & 0xff) - 127;
      int k = am > 0.f ? 7 - ex : 0;
      k = min(max(k, -100), 100);
      float sc = __uint_as_float((unsigned)(127 + k) << 23), isc = __uint_as_float((unsigned)(127 - k) << 23);
      u32x4 o;
#pragma unroll
      for (int q = 0; q < 4; ++q) {
        int w = __builtin_amdgcn_cvt_pk_fp8_f32(v[u][q][0] * sc, v[u][q][1] * sc, 0, false);
        w = __builtin_amdgcn_cvt_pk_fp8_f32(v[u][q][2] * sc, v[u][q][3] * sc, w, true);
        o[q] = (unsigned)w;
      }
      *(u32x4*)(dst + (size_t)rws[u] * 1024 + lane * 16) = o;
      if (lane == 0) inv_scale[rws[u]] = isc;
    }
  }
}

DI void convert_rows_fp8_wave(int lane, const float* __restrict__ src, unsigned char* __restrict__ dst, float* __restrict__ inv_scale, int r0, int r1) {
  for (int r = r0; r < r1; r += 2) {
    f32x4 v[2][4];
#pragma unroll
    for (int u = 0; u < 2; ++u)
#pragma unroll
      for (int q = 0; q < 4; ++q) v[u][q] = __builtin_nontemporal_load((const f32x4*)(src + (size_t)(r + u) * 1024 + lane * 16 + q * 4));
#pragma unroll
    for (int u = 0; u < 2; ++u) {
      float am = 0.f;
#pragma unroll
      for (int q = 0; q < 4; ++q)
#pragma unroll
        for (int j = 0; j < 4; ++j) am = fmaxf(am, fabsf(v[u][q][j]));
      am = row_max16(am);
      am = fmaxf(am, __shfl_xor(am, 16));
      am = fmaxf(am, __shfl_xor(am, 32));
      int ex = (int)((__float_as_uint(am) >> 23) & 0xff) - 127;
      int k = am > 0.f ? 7 - ex : 0;
      k = min(max(k, -100), 100);
      float sc = __uint_as_float((unsigned)(127 + k) << 23), isc = __uint_as_float((unsigned)(127 - k) << 23);
      u32x4 o;
#pragma unroll
      for (int q = 0; q < 4; ++q) {
        int w = __builtin_amdgcn_cvt_pk_fp8_f32(v[u][q][0] * sc, v[u][q][1] * sc, 0, false);
        w = __builtin_amdgcn_cvt_pk_fp8_f32(v[u][q][2] * sc, v[u][q][3] * sc, w, true);
        o[q] = (unsigned)w;
      }
      *(u32x4*)(dst + (size_t)(r + u) * 1024 + lane * 16) = o;
      if (lane == 0) inv_scale[r + u] = isc;
    }
  }
}

__device__ void phase_prep(const Params& p) {
  char* ws = opaque_ptr(p.ws);
  const int tid = opaque_tid(), wid = tid >> 6, lane = tid & 63;
  if (blockIdx.x == 0 && tid < 64) ((int*)(ws + O_CNT))[tid] = 0;
  if (blockIdx.x < 4) {
    int e = blockIdx.x * 256 + tid;
    int pos = e >> 4, f = e & 15;
    const float fr4[4] = {1.0f, 0.56234132519f, 0.316227766017f, 0.177827941004f};
    float sc = (f >> 2) == 0 ? 1.0f : (f >> 2) == 1 ? 0.1f : (f >> 2) == 2 ? 0.01f : 0.001f;
    float fsel = (f & 3) == 0 ? fr4[0] : (f & 3) == 1 ? fr4[1] : (f & 3) == 2 ? fr4[2] : fr4[3];
    float freq = fsel * sc;
    float ang = (float)pos * freq;
    double a = (double)ang;
    double k = rint(a * 0.15915494309189535);
    double r = a - k * 6.283185307179586;
    double r2 = r * r, ts = r, tc = 1.0, s = r, c = 1.0;
    for (int i = 1; i <= 14; ++i) {
      tc = -tc * r2 / (double)((2 * i - 1) * (2 * i));
      ts = -ts * r2 / (double)((2 * i) * (2 * i + 1));
      c += tc; s += ts;
    }
    float* rope = (float*)(ws + O_ROPE);
    rope[e * 2] = (float)c; rope[e * 2 + 1] = (float)s;
  }
  {
    float* sil = (float*)g_smem;
    float* part = (float*)(g_smem + 16384);
    const float* cvec = p.in[7];
    const float* cctx = p.in[8];
    bool have_sil = false;
    for (int it = blockIdx.x; it < 4 * 96; it += gridDim.x) {
      if (!have_sil) {
        for (int k = tid; k < 1024; k += 256) {
          float a = cctx[k], b = cvec[k], c2 = cvec[1024 + k];
          sil[k] = a * sigmoidf_(a); sil[1024 + k] = b * sigmoidf_(b); sil[2048 + k] = c2 * sigmoidf_(c2);
        }
        have_sil = true;
        __syncthreads();
      }
      int l = it / 96, n = (it % 96) * 64 + lane;
      const float* W = p.in[12] + (size_t)l * 1024 * 6144 + n;
      float a0 = 0.f, a1 = 0.f, a2 = 0.f;
      int kb = wid * 256;
#pragma unroll 8
      for (int k = 0; k < 256; ++k) {
        float w = __builtin_nontemporal_load(&W[(size_t)(kb + k) * 6144]);
        a0 += w * sil[kb + k]; a1 += w * sil[1024 + kb + k]; a2 += w * sil[2048 + kb + k];
      }
      part[(wid * 3 + 0) * 64 + lane] = a0; part[(wid * 3 + 1) * 64 + lane] = a1; part[(wid * 3 + 2) * 64 + lane] = a2;
      __syncthreads();
      if (tid < 192) {
        int c = tid >> 6, ln = tid & 63;
        float s = part[(0 * 3 + c) * 64 + ln] + part[(1 * 3 + c) * 64 + ln] + part[(2 * 3 + c) * 64 + ln] + part[(3 * 3 + c) * 64 + ln];
        int nn = (it % 96) * 64 + ln;
        ((float*)(ws + O_MOD))[((size_t)l * 3 + c) * 6144 + nn] = s + p.in[13][(size_t)l * 6144 + nn];
      }
      __syncthreads();
    }
    __syncthreads();
  }
  {
    TJob jobs[11] = {
        {p.in[14], (u16*)(ws + O_WIN), 1024, 7296, 4},
        {p.in[16], (u16*)(ws + O_AOUT), 512, 1024, 4},
        {p.in[28], (u16*)(ws + O_RWOUT), 512, 1024, 4},
        {p.in[30], (u16*)(ws + O_NAOUT), 512, 1024, 4},
        {p.in[31], (u16*)(ws + O_WO), 1024, 1024, 4},
        {p.in[32], (u16*)(ws + O_PEQ), 1024, 2048, 4},
        {p.in[19], (u16*)(ws + O_W2), 64, 512, 8},
        {p.in[21], (u16*)(ws + O_A2), 64, 512, 8},
        {p.in[22], (u16*)(ws + O_G2), 128, 512, 4},
        {p.in[3], (u16*)(ws + O_CAVT), 512, 128, 8},
        {p.in[5], (u16*)(ws + O_CCVT), 512, 512, 8},
    };
#pragma unroll
    for (int j = 0; j < 11; ++j) {
      const int tk = jobs[j].K / 64, tn = jobs[j].N / 64, per = tk * tn, tot = per * jobs[j].nb;
      for (int t = blockIdx.x; t < tot; t += gridDim.x) {
        int b = t / per, r = t % per;
        int kt = r / tn, ntile = r % tn;
        size_t off = (size_t)b * jobs[j].K * jobs[j].N;
        transpose_tile(tid, jobs[j].src + off, jobs[j].dst + off, jobs[j].K, jobs[j].N, kt * 64, ntile * 64);
      }
    }
  }
  convert_chunks(tid, p.in[33], (u16*)(ws + O_SUBK), 4ull * 8 * 2 * 128 * 128);
  convert_chunks(tid, p.in[2], (u16*)(ws + O_CAK), 8ull * 512 * 128);
  convert_chunks(tid, p.in[4], (u16*)(ws + O_CCK), 8ull * 512 * 512);
  {
    float* X = (float*)(ws + O_X);
    const size_t nch = (size_t)NT * DM / 1024;
    for (size_t c = blockIdx.x; c < nch; c += gridDim.x) {
      size_t e = c * 1024 + tid * 4;
      const float* src = e < (size_t)NCTX * DM ? p.in[0] + e : p.in[1] + (e - (size_t)NCTX * DM);
      *(f32x4*)(X + e) = *(const f32x4*)src;
    }
  }
}

DI int tok_cond(int tok) { return tok < NCTX ? 0 : 1 + ((tok - NCTX) >> 11); }

DI void norm_row_store(const float (&x)[16], const float* __restrict__ g, const float* __restrict__ shift, const float* __restrict__ scale,
                       u16* __restrict__ hrow, int lane) {
  float ss = 0.f;
#pragma unroll
  for (int i = 0; i < 16; ++i) ss += x[i] * x[i];
  ss = wave_sum(ss);
  float rstd = rsqrtf(ss * (1.f / 1024.f) + 1e-6f);
#pragma unroll
  for (int hh = 0; hh < 2; ++hh) {
    int e0 = hh * 512 + lane * 8;
    float y[8];
#pragma unroll
    for (int i = 0; i < 8; ++i) {
      float v = x[hh * 8 + i] * rstd * g[e0 + i];
      y[i] = v * (1.f + scale[e0 + i]) + shift[e0 + i];
    }
    u32x4 o;
    o[0] = pack2(y[0], y[1]); o[1] = pack2(y[2], y[3]); o[2] = pack2(y[4], y[5]); o[3] = pack2(y[6], y[7]);
    *(u32x4*)(hrow + e0) = o;
  }
}

__device__ void phase_norm(const Params& p, int l, int which) {
  char* ws = opaque_ptr(p.ws);
  const int tid = opaque_tid();
  const int lane = tid & 63;
  const int gw = blockIdx.x * 4 + (tid >> 6), GW = gridDim.x * 4;
  const float* X = (const float*)(ws + O_X);
  const float* g = (which == 0 ? p.in[9] : p.in[10]) + l * 1024;
  for (int tok = gw; tok < NT; tok += GW) {
    const float* mod = (const float*)(ws + O_MOD) + ((size_t)l * 3 + tok_cond(tok)) * 6144 + which * 3 * 1024;
    float x[16];
#pragma unroll
    for (int hh = 0; hh < 2; ++hh) {
      f32x4 a = *(const f32x4*)(X + (size_t)tok * 1024 + hh * 512 + lane * 8);
      f32x4 b = *(const f32x4*)(X + (size_t)tok * 1024 + hh * 512 + lane * 8 + 4);
#pragma unroll
      for (int i = 0; i < 4; ++i) { x[hh * 8 + i] = a[i]; x[hh * 8 + 4 + i] = b[i]; }
    }
    norm_row_store(x, g, mod, mod + 1024, (u16*)(ws + O_H) + (size_t)tok * 1024, lane);
  }
}

__device__ void phase_gemm_in(const Params& p, int l) {
  char* ws = opaque_ptr(p.ws);
  const int tid = opaque_tid();
  const int wid = tid >> 6, lane = tid & 63, wr = wid >> 1, wc = wid & 1, fr = lane & 15, fq = lane >> 4;
  const u16* H = (const u16*)(ws + O_H);
  const u16* W = (const u16*)(ws + O_WIN) + (size_t)l * INC * 1024;
  const float* rope = (const float*)(ws + O_ROPE);
  float* out = p.out;
  const int ntiles = gridDim.x == 512 ? 64 * 56 : 64 * 57;
  for (int t = blockIdx.x; t < ntiles; t += gridDim.x) {
    const int tm = t & 63, tn = t >> 6;
    const int brow = tm * 128, bcol = tn * 128;
    const bool swapped = (tn == 5) || (tn >= 29 && tn < 33);
    const bool ctx = brow < NCTX;
    f32x4 acc[4][4];
    zero_acc(acc);
    const int koff = (((tm >> 3) + (tn & 7)) * 2) & 15;
    if (!swapped) gemm_main(tid, H + (size_t)brow * 1024, 1024, W + (size_t)bcol * 1024, 1024, 1024, acc, koff);
    else gemm_main(tid, W + (size_t)bcol * 1024, 1024, H + (size_t)brow * 1024, 1024, 1024, acc, koff);
    if (!swapped) {
#pragma unroll
      for (int m = 0; m < 4; ++m) {
        const int tok = brow + wr * 64 + m * 16 + fr;
        const int cb = bcol + wc * 64 + fq * 4;
        if (tn < 5) {
          if (!ctx) {
            int tt = (tok - NCTX) & 2047;
            int pos0 = tt >> 6, pos1 = tt & 63;
#pragma unroll
            for (int ax = 0; ax < 2; ++ax) {
              int pos = ax == 0 ? pos0 : pos1;
#pragma unroll
              for (int j = 0; j < 4; ++j) {
                float c = rope[(pos * 16 + fq * 4 + j) * 2], s = rope[(pos * 16 + fq * 4 + j) * 2 + 1];
                float x1 = acc[m][2 * ax][j], x2 = acc[m][2 * ax + 1][j];
                acc[m][2 * ax][j] = x1 * c - x2 * s;
                acc[m][2 * ax + 1][j] = x2 * c + x1 * s;
              }
            }
          }
          if (tn < 4) {
#pragma unroll
            for (int n = 0; n < 4; ++n) {
              u32x2 o; o[0] = pack2(acc[m][n][0] * 0.125f, acc[m][n][1] * 0.125f); o[1] = pack2(acc[m][n][2] * 0.125f, acc[m][n][3] * 0.125f);
              *(u32x2*)((u16*)(ws + O_QA) + (size_t)tok * 512 + cb + n * 16) = o;
            }
          } else {
#pragma unroll
            for (int n = 0; n < 4; ++n) {
              int c = cb + n * 16 - 512;
              u32x2 o; o[0] = pack2(acc[m][n][0], acc[m][n][1]); o[1] = pack2(acc[m][n][2], acc[m][n][3]);
              *(u32x2*)((u16*)(ws + O_KA) + (size_t)tok * 128 + c) = o;
              if (ctx) *(f32x4*)(out + OUT_AK + ((size_t)((tok >> 8) * 4 + l) * 256 + (tok & 255)) * 128 + c) = acc[m][n];
            }
          }
        } else if (tn < 21) {
#pragma unroll
          for (int n = 0; n < 4; ++n) *(f32x4*)((float*)(ws + O_PB) + (size_t)tok * 1920 + cb + n * 16 - 768) = acc[m][n];
        } else if (tn < 25) {
#pragma unroll
          for (int n = 0; n < 4; ++n) {
            u32x2 o; o[0] = pack2(acc[m][n][0] * 0.125f, acc[m][n][1] * 0.125f); o[1] = pack2(acc[m][n][2] * 0.125f, acc[m][n][3] * 0.125f);
            *(u32x2*)((u16*)(ws + O_QC) + (size_t)tok * 512 + cb + n * 16 - 2688) = o;
          }
        } else if (tn < 29) {
#pragma unroll
          for (int n = 0; n < 4; ++n) {
            int c = cb + n * 16 - 3200;
            u32x2 o; o[0] = pack2(acc[m][n][0], acc[m][n][1]); o[1] = pack2(acc[m][n][2], acc[m][n][3]);
            *(u32x2*)((u16*)(ws + O_KC) + (size_t)tok * 512 + c) = o;
            if (ctx) *(f32x4*)(out + OUT_CK + ((size_t)((tok >> 8) * 4 + l) * 256 + (tok & 255)) * 512 + c) = acc[m][n];
          }
        } else {
#pragma unroll
          for (int n = 0; n < 4; ++n) {
            u32x2 o; o[0] = pack2(sigmoidf_(acc[m][n][0]), sigmoidf_(acc[m][n][1])); o[1] = pack2(sigmoidf_(acc[m][n][2]), sigmoidf_(acc[m][n][3]));
            *(u32x2*)((u16*)(ws + O_GATE) + (size_t)tok * 3072 + cb + n * 16 - 4224) = o;
          }
        }
      }
    } else {
      const bool isA = (tn == 5);
      u16* VT = isA ? (u16*)(ws + O_VAT) : (u16*)(ws + O_VCT);
      const int ncols = isA ? 128 : 512;
      const size_t obase = isA ? OUT_AV : OUT_CV;
#pragma unroll
      for (int m = 0; m < 4; ++m) {
        const int c = (isA ? 0 : (tn - 29) * 128) + wr * 64 + m * 16 + fr;
#pragma unroll
        for (int n = 0; n < 4; ++n) {
          const int tk = brow + wc * 64 + n * 16 + fq * 4;
          u32x2 o; o[0] = pack2(acc[m][n][0], acc[m][n][1]); o[1] = pack2(acc[m][n][2], acc[m][n][3]);
          *(u32x2*)(VT + (size_t)c * NT + tk) = o;
          if (ctx) {
#pragma unroll
            for (int j = 0; j < 4; ++j) {
              int tok = tk + j;
              out[obase + ((size_t)((tok >> 8) * 4 + l) * 256 + (tok & 255)) * ncols + c] = acc[m][n][j];
            }
          }
        }
      }
    }
  }
}

__device__ void phase_rwkv_prep(const Params& p, int l) {
  char* ws = opaque_ptr(p.ws);
  const int tid = opaque_tid();
  const int lane = tid & 63;
  const bool split = gridDim.x == 512;
  if (split && blockIdx.x < 64) {
    const int wid = tid >> 6, wr = wid >> 1, wc = wid & 1, fr = lane & 15, fq = lane >> 4;
    const int brow = blockIdx.x * 128, bcol = 56 * 128;
    f32x4 acc[4][4];
    zero_acc(acc);
    gemm_main(tid, (const u16*)(ws + O_H) + (size_t)brow * 1024, 1024, (const u16*)(ws + O_WIN) + ((size_t)l * INC + bcol) * 1024, 1024, 1024, acc);
#pragma unroll
    for (int m = 0; m < 4; ++m) {
      const int tok = brow + wr * 64 + m * 16 + fr;
      const int cb = bcol + wc * 64 + fq * 4;
#pragma unroll
      for (int n = 0; n < 4; ++n) {
        u32x2 o; o[0] = pack2(sigmoidf_(acc[m][n][0]), sigmoidf_(acc[m][n][1])); o[1] = pack2(sigmoidf_(acc[m][n][2]), sigmoidf_(acc[m][n][3]));
        *(u32x2*)((u16*)(ws + O_GATE) + (size_t)tok * 3072 + cb + n * 16 - 4224) = o;
      }
    }
    return;
  }
  const int gw = split ? ((int)blockIdx.x - 64) * 4 + (tid >> 6) : (int)blockIdx.x * 4 + (tid >> 6);
  const int GW = split ? 448 * 4 : (int)gridDim.x * 4;
  const float* PB = (const float*)(ws + O_PB);
  const float* mu = p.in[17] + l * 1920;
  const float* kkw = p.in[23] + l * 512;
  for (int tok = gw; tok < NT; tok += GW) {
    int pos, len;
    if (tok < NCTX) { pos = tok & 255; len = 256; } else { pos = (tok - NCTX) & 2047; len = 2048; }
    const bool hp = pos > 0, hn = pos < len - 1;
    const float* row = PB + (size_t)tok * 1920;
#pragma unroll
    for (int i = 0; i < 8; ++i) {
      int q = lane + 64 * i;
      if (q < 480) {
        int c = q * 4;
        f32x4 cur = *(const f32x4*)(row + c);
        f32x4 pv = hp ? *(const f32x4*)(row - 1920 + c) : f32x4{0.f, 0.f, 0.f, 0.f};
        f32x4 nv = hn ? *(const f32x4*)(row + 1920 + c) : f32x4{0.f, 0.f, 0.f, 0.f};
        f32x4 m4 = *(const f32x4*)(mu + c);
        f32x4 xb;
#pragma unroll
        for (int j = 0; j < 4; ++j) xb[j] = cur[j] + m4[j] * (0.5f * (pv[j] + nv[j]) - cur[j]);
        if (i < 6) {
          *(f32x4*)((float*)(ws + O_XRKV) + (size_t)tok * 1536 + c) = xb;
          if (i == 2 || i == 3) {
            int ck = c - 512;
            f32x4 kw = *(const f32x4*)(kkw + ck);
            f32x4 kv;
            float ss = 0.f;
#pragma unroll
            for (int j = 0; j < 4; ++j) { kv[j] = xb[j] * kw[j]; ss += kv[j] * kv[j]; }
            ss = row_sum16(ss);
            float rn = rsqrtf(ss + 1e-12f);
#pragma unroll
            for (int j = 0; j < 4; ++j) kv[j] *= rn;
            *(f32x4*)((float*)(ws + O_KK) + (size_t)tok * 512 + ck) = kv;
          }
        } else {
          u16* dst;
          int cc;
          float v[4];
          if (c < 1664) { dst = (u16*)(ws + O_TW); cc = c - 1536; for (int j = 0; j < 4; ++j) v[j] = tanhf(xb[j]); }
          else if (c < 1792) { dst = (u16*)(ws + O_AD); cc = c - 1664; for (int j = 0; j < 4; ++j) v[j] = xb[j]; }
          else { dst = (u16*)(ws + O_SG); cc = c - 1792; for (int j = 0; j < 4; ++j) v[j] = sigmoidf_(xb[j]); }
          u32x2 o; o[0] = pack2(v[0], v[1]); o[1] = pack2(v[2], v[3]);
          *(u32x2*)(dst + (size_t)tok * 128 + cc) = o;
        }
      }
    }
  }
}

__device__ void phase_rwkv_lora(const Params& p, int l) {
  char* ws = opaque_ptr(p.ws);
  const int tid = opaque_tid();
  const int wid = tid >> 6, lane = tid & 63, wr = wid >> 1, wc = wid & 1, fr = lane & 15, fq = lane >> 4;
  for (int t = blockIdx.x; t < 5 * 256; t += gridDim.x) {
    const int job = t >> 8, r = t & 255, tm = r & 63, tn = r >> 6;
    const int brow = tm * 128, bcol = tn * 128;
    f32x4 acc[4][4];
    zero_acc(acc);
    const int z = job & 1;
    if (job < 2) gemm_main(tid, (const u16*)(ws + O_TW) + (size_t)brow * 128 + z * 64, 128, (const u16*)(ws + O_W2) + ((size_t)(l * 2 + z) * 512 + bcol) * 64, 64, 64, acc);
    else if (job < 4) gemm_main(tid, (const u16*)(ws + O_AD) + (size_t)brow * 128 + z * 64, 128, (const u16*)(ws + O_A2) + ((size_t)(l * 2 + z) * 512 + bcol) * 64, 64, 64, acc);
    else gemm_main(tid, (const u16*)(ws + O_SG) + (size_t)brow * 128, 128, (const u16*)(ws + O_G2) + ((size_t)l * 512 + bcol) * 128, 128, 128, acc);
#pragma unroll
    for (int m = 0; m < 4; ++m) {
      const int tok = brow + wr * 64 + m * 16 + fr;
#pragma unroll
      for (int n = 0; n < 4; ++n) {
        const int c = bcol + wc * 64 + n * 16 + fq * 4;
        if (job < 2) {
          f32x4 w0 = *(const f32x4*)(p.in[18] + (size_t)(l * 2 + z) * 512 + c);
          f32x4 o;
#pragma unroll
          for (int j = 0; j < 4; ++j) {
            float val = w0[j] + acc[m][n][j];
            float y = -val;
            float sp = fmaxf(y, 0.f) + __logf(1.f + __expf(-fabsf(y)));
            float wlog = -sp - 0.5f;
            o[j] = __expf(-__expf(wlog));
          }
          *(f32x4*)((float*)(ws + O_DEC) + ((size_t)z * NT + tok) * 512 + c) = o;
        } else if (job < 4) {
          f32x4 a0 = *(const f32x4*)(p.in[20] + (size_t)(l * 2 + z) * 512 + c);
          f32x4 ka = *(const f32x4*)(p.in[24] + (size_t)l * 512 + c);
          f32x4 kx = *(const f32x4*)((const float*)(ws + O_XRKV) + (size_t)tok * 1536 + 512 + c);
          f32x4 kk = *(const f32x4*)((const float*)(ws + O_KK) + (size_t)tok * 512 + c);
          f32x4 okd, okka;
#pragma unroll
          for (int j = 0; j < 4; ++j) {
            float a = sigmoidf_(a0[j] + acc[m][n][j]);
            okd[j] = kx[j] * (1.f + (a - 1.f) * ka[j]);
            okka[j] = kk[j] * a;
          }
          *(f32x4*)((float*)(ws + O_KD) + ((size_t)z * NT + tok) * 512 + c) = okd;
          *(f32x4*)((float*)(ws + O_KKA) + ((size_t)z * NT + tok) * 512 + c) = okka;
        } else {
          *(f32x4*)((float*)(ws + O_GG) + (size_t)tok * 512 + c) = acc[m][n];
        }
      }
    }
  }
}

template <int JPL> struct ScanOps { float w[JPL], kd[JPL], kk[JPL], kka[JPL], r[JPL]; float v; };

template <int JPL>
DI void scan_load(ScanOps<JPL>& o, const float* __restrict__ dec, const float* __restrict__ kd, const float* __restrict__ kk,
                  const float* __restrict__ kka, const float* __restrict__ rr, const float* __restrict__ vv, int tok, int cj, int ci) {
  const size_t e = (size_t)tok * 512 + cj;
#pragma unroll
  for (int q = 0; q < JPL / 4; ++q) {
    f32x4 a = *(const f32x4*)(dec + e + q * 4), b = *(const f32x4*)(kd + e + q * 4), c = *(const f32x4*)(kk + e + q * 4),
          d = *(const f32x4*)(kka + e + q * 4), f = *(const f32x4*)(rr + (size_t)tok * 1536 + cj + q * 4);
#pragma unroll
    for (int j = 0; j < 4; ++j) { o.w[q * 4 + j] = a[j]; o.kd[q * 4 + j] = b[j]; o.kk[q * 4 + j] = c[j]; o.kka[q * 4 + j] = d[j]; o.r[q * 4 + j] = f[j]; }
  }
  o.v = vv[(size_t)tok * 1536 + 1024 + ci];
}

template <int JPL> DI float scan_red(float v) {
  v += dppf<0xB1>(v);
  v += dppf<0x4E>(v);
  if (JPL <= 8) v += dppf<0x141>(v);
  if (JPL <= 4) v += dppf<0x140>(v);
  return v;
}

template <int JPL>
DI void scan_step(float (&S)[JPL], const ScanOps<JPL>& o, float* __restrict__ y, int tok, int ci, bool wr) {
  float sa0 = 0.f, sa1 = 0.f;
#pragma unroll
  for (int j = 0; j < JPL; j += 2) { sa0 += S[j] * o.kk[j]; sa1 += S[j + 1] * o.kk[j + 1]; }
  float sa = -scan_red<JPL>(sa0 + sa1);
  float y0 = 0.f, y1 = 0.f;
#pragma unroll
  for (int j = 0; j < JPL; j += 2) {
    S[j] = S[j] * o.w[j] + (sa * o.kka[j] + o.v * o.kd[j]);
    S[j + 1] = S[j + 1] * o.w[j + 1] + (sa * o.kka[j + 1] + o.v * o.kd[j + 1]);
    y0 += S[j] * o.r[j]; y1 += S[j + 1] * o.r[j + 1];
  }
  float yv = scan_red<JPL>(y0 + y1);
  if (wr) y[(size_t)tok * 512 + ci] = yv;
}

template <int JPL, int D>
DI void scan_wave(char* ws, int lane, int z, int h, int tok0, int T, int rowbase, const float* __restrict__ s0, float* __restrict__ sout) {
  constexpr int LPR = 64 / JPL;
  const int rr = lane / LPR, pp = lane % LPR;
  const int i = rowbase + rr, j0 = pp * JPL;
  const int cj = h * 64 + j0, ci = h * 64 + i;
  const float* dec = (const float*)(ws + O_DEC) + (size_t)z * NT * 512;
  const float* kd = (const float*)(ws + O_KD) + (size_t)z * NT * 512;
  const float* kka = (const float*)(ws + O_KKA) + (size_t)z * NT * 512;
  const float* kk = (const float*)(ws + O_KK);
  const float* xr = (const float*)(ws + O_XRKV);
  float* y = (float*)(ws + O_YS) + (size_t)z * NT * 512;
  float S[JPL];
#pragma unroll
  for (int j = 0; j < JPL; ++j) S[j] = s0 ? s0[i * 64 + j0 + j] : 0.f;
  const int dir = z == 0 ? 1 : -1;
  const int first = z == 0 ? tok0 : tok0 + T - 1;
  const bool wr = pp == 0;
  ScanOps<JPL> R[D];
#pragma unroll
  for (int d = 0; d < D; ++d) scan_load<JPL>(R[d], dec, kd, kk, kka, xr, xr, first + dir * d, cj, ci);
  for (int n = 0; n < T; n += D) {
#pragma unroll
    for (int d = 0; d < D; ++d) {
      scan_step<JPL>(S, R[d], y, first + dir * (n + d), ci, wr);
      int nn = n + d + D;
      nn = nn < T ? nn : T - 1;
      scan_load<JPL>(R[d], dec, kd, kk, kka, xr, xr, first + dir * nn, cj, ci);
    }
  }
  if (sout) {
#pragma unroll
    for (int j = 0; j < JPL; ++j) sout[i * 64 + j0 + j] = S[j];
  }
}

DI void dma16(const char* gptr, unsigned ldsaddr) {
  asm volatile("s_mov_b32 m0, %0\n\ts_nop 0\n\tglobal_load_lds_dwordx4 %1, off" ::"s"(ldsaddr), "v"(gptr) : "memory");
}
template <int N> DI void wait_vm() { asm volatile("s_waitcnt vmcnt(%0)" ::"n"(N) : "memory"); }

template <int JPL> struct ScanRegs { float w[JPL], kd[JPL], kk[JPL], kka[JPL], r[JPL]; float v; };
template <int JPL> DI void scan_lds_read(ScanRegs<JPL>& o, const char* slot, int pp, int rr) {
#pragma unroll
  for (int q = 0; q < JPL / 4; ++q) {
    f32x4 a = *(const f32x4*)(slot + 0 + pp * JPL * 4 + q * 16), b = *(const f32x4*)(slot + 256 + pp * JPL * 4 + q * 16),
          c = *(const f32x4*)(slot + 512 + pp * JPL * 4 + q * 16), d = *(const f32x4*)(slot + 768 + pp * JPL * 4 + q * 16),
          f = *(const f32x4*)(slot + 1024 + pp * JPL * 4 + q * 16);
#pragma unroll
    for (int j = 0; j < 4; ++j) { o.w[q * 4 + j] = a[j]; o.kd[q * 4 + j] = b[j]; o.kk[q * 4 + j] = c[j]; o.kka[q * 4 + j] = d[j]; o.r[q * 4 + j] = f[j]; }
  }
  o.v = *(const float*)(slot + 1280 + rr * 4);
}
template <int JPL>
DI void scan_step2(float (&S)[JPL], const ScanRegs<JPL>& o, float* __restrict__ yp, bool wr) {
  float sa0 = 0.f, sa1 = 0.f;
#pragma unroll
  for (int j = 0; j < JPL; j += 2) { sa0 += S[j] * o.kk[j]; sa1 += S[j + 1] * o.kk[j + 1]; }
  float sa = -scan_red<JPL>(sa0 + sa1);
  float y0 = 0.f, y1 = 0.f;
#pragma unroll
  for (int j = 0; j < JPL; j += 2) {
    S[j] = sa * o.kka[j] + (S[j] * o.w[j] + o.v * o.kd[j]);
    S[j + 1] = sa * o.kka[j + 1] + (S[j + 1] * o.w[j + 1] + o.v * o.kd[j + 1]);
    y0 += S[j] * o.r[j]; y1 += S[j + 1] * o.r[j + 1];
  }
  float yv = scan_red<JPL>(y0 + y1);
  if (wr) *yp = yv;
}

template <int JPL, int NS>
DI void scan_wave_dma(char* ws, int lane, int ringoff, int z, int h, int tok0, int T, int rowbase, const float* __restrict__ s0,
                      float* __restrict__ sout) {
  constexpr int LPR = 64 / JPL, PD = NS - 1, WN = 3 * PD - 3;
  static_assert(WN <= 63, "vmcnt range");
  const int rr = lane / LPR, pp = lane % LPR;
  const int i = rowbase + rr, j0 = pp * JPL;
  const int dir = z == 0 ? 1 : -1;
  const int first = z == 0 ? tok0 : tok0 + T - 1;
  const bool wr = pp == 0;
  float S[JPL];
#pragma unroll
  for (int j = 0; j < JPL; ++j) S[j] = s0 ? s0[i * 64 + j0 + j] : 0.f;
  const int a = lane >> 4, c16 = lane & 15;
  const float* arr = a == 0 ? (const float*)(ws + O_DEC) + (size_t)z * NT * 512
                   : a == 1 ? (const float*)(ws + O_KD) + (size_t)z * NT * 512
                   : a == 2 ? (const float*)(ws + O_KK)
                            : (const float*)(ws + O_KKA) + (size_t)z * NT * 512;
  const char* gA = (const char*)(arr + (size_t)first * 512 + h * 64 + c16 * 4);
  const char* gB = (const char*)((const float*)(ws + O_XRKV) + (size_t)first * 1536 + (lane < 16 ? h * 64 + c16 * 4 : 1024 + h * 64 + rowbase + (lane - 16) * 4));
  const long stA = (long)dir * 2048, stB = (long)dir * 6144;
  const bool bact = lane < 16 + JPL / 4;
  ringoff = __builtin_amdgcn_readfirstlane(ringoff);
  const unsigned ring = (unsigned)(size_t)g_smem + (unsigned)ringoff;
  const char* ringp = g_smem + ringoff;
  float* yp = (float*)(ws + O_YS) + (size_t)z * NT * 512 + (size_t)first * 512 + h * 64 + i;
  const long sty = (long)dir * 512;
  float* dummy = (float*)(ws + O_MERG) + lane;
#pragma unroll 1
  for (int s = 0; s < PD; ++s) {
    unsigned slot = ring + (unsigned)(s & (NS - 1)) * 1536u;
    dma16(gA, slot);
    if (bact) dma16(gB, slot + 1024u);
    gA += stA; gB += stB;
    if (wr) dummy[s * 64] = 0.f;
  }
  ScanRegs<JPL> A, B;
  wait_vm<3 * PD - 3>();
  wait_vm<3 * (PD - 1)>();
  scan_lds_read<JPL>(A, ringp, pp, rr);
  for (int n = 0; n < T; n += 2) {
    {
      unsigned sl = (unsigned)((n + PD) & (NS - 1)) * 1536u;
      dma16(gA, ring + sl);
      if (bact) dma16(gB, ring + sl + 1024u);
      gA += stA; gB += stB;
      wait_vm<WN>();
      scan_lds_read<JPL>(B, ringp + ((n + 1) & (NS - 1)) * 1536, pp, rr);
      scan_step2<JPL>(S, A, yp, wr);
      yp += sty;
    }
    {
      unsigned sl = (unsigned)((n + 1 + PD) & (NS - 1)) * 1536u;
      dma16(gA, ring + sl);
      if (bact) dma16(gB, ring + sl + 1024u);
      gA += stA; gB += stB;
      wait_vm<WN>();
      scan_lds_read<JPL>(A, ringp + ((n + 2) & (NS - 1)) * 1536, pp, rr);
      scan_step2<JPL>(S, B, yp, wr);
      yp += sty;
    }
  }
  wait_vm<0>();
  if (sout) {
#pragma unroll
    for (int j = 0; j < JPL; ++j) sout[i * 64 + j0 + j] = S[j];
  }
}

template <int JPL>
DI void scan_dots(const float (&S)[JPL], const ScanRegs<JPL>& cur, const ScanRegs<JPL>& prv, float& d1, float& d2) {
  float a0 = 0.f, a1 = 0.f, b0 = 0.f, b1 = 0.f;
#pragma unroll
  for (int j = 0; j < JPL; j += 2) {
    a0 += S[j] * cur.kk[j]; b0 += S[j] * prv.r[j];
    a1 += S[j + 1] * cur.kk[j + 1]; b1 += S[j + 1] * prv.r[j + 1];
  }
  d1 = a0 + a1; d2 = b0 + b1;
}
template <int JPL> DI void scan_red2(float& a, float& b) {
  a += dppf<0xB1>(a); b += dppf<0xB1>(b);
  a += dppf<0x4E>(a); b += dppf<0x4E>(b);
  if (JPL <= 8) { a += dppf<0x141>(a); b += dppf<0x141>(b); }
  if (JPL <= 4) { a += dppf<0x140>(a); b += dppf<0x140>(b); }
}
template <int JPL> DI void scan_pre(float (&Tm)[JPL], const float (&S)[JPL], const ScanRegs<JPL>& o) {
#pragma unroll
  for (int j = 0; j < JPL; ++j) Tm[j] = S[j] * o.w[j] + o.v * o.kd[j];
}
template <int JPL> DI void scan_update(float (&S)[JPL], const float (&Tm)[JPL], const ScanRegs<JPL>& o, float sa) {
#pragma unroll
  for (int j = 0; j < JPL; ++j) S[j] = sa * o.kka[j] + Tm[j];
}

template <int JPL, int T>
DI void scan_latent_block(char* ws, int tid, int z, int h, int tok0, int rowblock, const float* __restrict__ s0, float* __restrict__ sout) {
  constexpr int LPR = 64 / JPL, G = 7, WNV = 6 * G - 2;
  const int wid = __builtin_amdgcn_readfirstlane(tid >> 6), lane = tid & 63;
  const int rr = lane / LPR, pp = lane % LPR;
  const int rloc = wid * JPL + rr;
  const int i = rowblock + rloc, j0 = pp * JPL;
  const int dir = z == 0 ? 1 : -1;
  const int first = z == 0 ? tok0 : tok0 + T - 1;
  const bool wr = pp == 0;
  float S[JPL];
#pragma unroll
  for (int j = 0; j < JPL; ++j) S[j] = s0 ? s0[i * 64 + j0 + j] : 0.f;
  const int a = lane >> 4, c16 = lane & 15;
  const float* arr = a == 0 ? (const float*)(ws + O_DEC) + (size_t)z * NT * 512
                   : a == 1 ? (const float*)(ws + O_KD) + (size_t)z * NT * 512
                   : a == 2 ? (const float*)(ws + O_KK)
                            : (const float*)(ws + O_KKA) + (size_t)z * NT * 512;
  const int fw = first + dir * wid;
  const char* gA = (const char*)(arr + (size_t)fw * 512 + h * 64 + c16 * 4);
  const char* gB = (const char*)((const float*)(ws + O_XRKV) + (size_t)fw * 1536 + (lane < 16 ? h * 64 + c16 * 4 : 1024 + h * 64 + rowblock + (lane - 16) * 4));
  const long stA = (long)dir * 4 * 2048, stB = (long)dir * 4 * 6144;
  const bool bact = lane < 16 + JPL;
  const unsigned ring = (unsigned)(size_t)g_smem;
  const char* ringp = g_smem;
  float* yp = (float*)(ws + O_YS) + (size_t)z * NT * 512 + (size_t)first * 512 + h * 64 + i;
  const long sty = (long)dir * 512;
  float* dummy = (float*)(ws + O_MERG) + tid;
#pragma unroll 1
  for (int g = 0; g < G; ++g) {
    unsigned slot = ring + (unsigned)((4 * g + wid) & 31) * 1536u;
    dma16(gA, slot);
    if (bact) dma16(gB, slot + 1024u);
    gA += stA; gB += stB;
    if (wr) { dummy[(g * 4 + 0) * 256] = 0.f; }
    if (wr) { dummy[(g * 4 + 1) * 256] = 0.f; }
    if (wr) { dummy[(g * 4 + 2) * 256] = 0.f; }
    if (wr) { dummy[(g * 4 + 3) * 256] = 0.f; }
    asm volatile("" ::: "memory");
  }
  ScanRegs<JPL> A, B;
#pragma unroll
  for (int j = 0; j < JPL; ++j) B.r[j] = 0.f;
  float* ypv = dummy + 28 * 256;
  wait_vm<WNV>();
  asm volatile("" ::: "memory");
  __builtin_amdgcn_s_barrier();
  asm volatile("" ::: "memory");
  scan_lds_read<JPL>(A, ringp, pp, rloc);
#pragma unroll 1
  for (int g = 0; g < T / 4; ++g) {
    wait_vm<WNV - 6>();

    asm volatile("" ::: "memory");
    __builtin_amdgcn_s_barrier();
    asm volatile("" ::: "memory");
    {
      unsigned slot = ring + (unsigned)((4 * (g + G) + wid) & 31) * 1536u;
      dma16(gA, slot);
      if (bact) dma16(gB, slot + 1024u);
      gA += stA; gB += stB;
    }
    const char* gp = ringp + ((4 * g) & 31) * 1536;
    if (JPL >= 8) {
#pragma unroll
      for (int k = 0; k < 4; ++k) {
        scan_lds_read<JPL>(A, gp + k * 1536, pp, rloc);
        scan_step2<JPL>(S, A, yp, wr);
        yp += sty;
        asm volatile("" ::: "memory");
      }
      continue;
    }
    float d1, y0, y1, y2, y3;
    float Tm[JPL];
    scan_dots<JPL>(S, A, B, d1, y0);
    scan_pre<JPL>(Tm, S, A);
    scan_lds_read<JPL>(B, gp + 1536, pp, rloc);
    scan_red2<JPL>(d1, y0);
    scan_update<JPL>(S, Tm, A, -d1);
    scan_dots<JPL>(S, B, A, d1, y1);
    scan_pre<JPL>(Tm, S, B);
    scan_lds_read<JPL>(A, gp + 2 * 1536, pp, rloc);
    scan_red2<JPL>(d1, y1);
    scan_update<JPL>(S, Tm, B, -d1);
    scan_dots<JPL>(S, A, B, d1, y2);
    scan_pre<JPL>(Tm, S, A);
    scan_lds_read<JPL>(B, gp + 3 * 1536, pp, rloc);
    scan_red2<JPL>(d1, y2);
    scan_update<JPL>(S, Tm, A, -d1);
    scan_dots<JPL>(S, B, A, d1, y3);
    scan_pre<JPL>(Tm, S, B);
    scan_lds_read<JPL>(A, ringp + ((4 * g + 4) & 31) * 1536, pp, rloc);
    scan_red2<JPL>(d1, y3);
    scan_update<JPL>(S, Tm, B, -d1);
    if (wr) {
      *ypv = y0;
      yp[0] = y1;
      yp[sty] = y2;
      yp[2 * sty] = y3;
    }
    ypv = yp + 3 * sty;
    yp += 4 * sty;
    asm volatile("" ::: "memory");
  }
  {
    float e0 = 0.f, e1 = 0.f;
#pragma unroll
    for (int j = 0; j < JPL; j += 2) { e0 += S[j] * B.r[j]; e1 += S[j + 1] * B.r[j + 1]; }
    float yv = scan_red<JPL>(e0 + e1);
    if (wr) *ypv = yv;
  }
  wait_vm<0>();
  asm volatile("" ::: "memory");
  __builtin_amdgcn_s_barrier();
  asm volatile("" ::: "memory");
  if (sout) {
#pragma unroll
    for (int j = 0; j < JPL; ++j) sout[i * 64 + j0 + j] = S[j];
  }
}

struct AttnSt { float m, l; f32x4 o[4]; };

struct AttnKVF { bf16x8 k[2][2]; bf16x8 v[4]; };
DI void attn_kvload(AttnKVF& f, const u16* __restrict__ kp, int ldk, const u16* __restrict__ vtp, int ldv, int fr, int fq) {
#pragma unroll
  for (int kt = 0; kt < 2; ++kt)
#pragma unroll
    for (int ks = 0; ks < 2; ++ks) f.k[kt][ks] = *(const bf16x8*)(kp + (size_t)(8 * (fr >> 2) + 4 * kt + (fr & 3)) * ldk + ks * 32 + fq * 8);
#pragma unroll
  for (int dt = 0; dt < 4; ++dt) f.v[dt] = *(const bf16x8*)(vtp + (size_t)(dt * 16 + fr) * ldv + fq * 8);
}
template <int MODE>
DI void attn_core(AttnSt& st, const bf16x8 (&qf)[2], const AttnKVF& f, int fr, int fq, int qpos, int kpos0, const float* __restrict__ rpbrow) {
  f32x4 s[2];
#pragma unroll
  for (int kt = 0; kt < 2; ++kt) {
    s[kt] = f32x4{0.f, 0.f, 0.f, 0.f};
#pragma unroll
    for (int ks = 0; ks < 2; ++ks) s[kt] = mfma16(f.k[kt][ks], qf[ks], s[kt]);
  }
  if (MODE != 0) {
#pragma unroll
    for (int kt = 0; kt < 2; ++kt)
#pragma unroll
      for (int j = 0; j < 4; ++j) {
        int kpos = kpos0 + 8 * fq + 4 * kt + j;
        if (MODE == 1) {
          int d = qpos - kpos;
          if (d > 128 || d < -128) s[kt][j] = -1e30f;
        } else {
          int cs = min(max(qpos - 8, 0), 48);
          int dc = min(max(kpos - qpos, -15), 15) + 15;
          float b = rpbrow[dc];
          s[kt][j] = (kpos >= cs && kpos < cs + 16) ? s[kt][j] + b : -1e30f;
        }
      }
  }
  float mx = fmaxf(fmaxf(fmaxf(s[0][0], s[0][1]), fmaxf(s[0][2], s[0][3])), fmaxf(fmaxf(s[1][0], s[1][1]), fmaxf(s[1][2], s[1][3])));
  mx = fmaxf(mx, __shfl_xor(mx, 16));
  mx = fmaxf(mx, __shfl_xor(mx, 32));
  float mn = fmaxf(st.m, mx);
  float alpha = __expf(st.m - mn);
  st.m = mn;
  float ps = 0.f;
  float pv[8];
#pragma unroll
  for (int kt = 0; kt < 2; ++kt)
#pragma unroll
    for (int j = 0; j < 4; ++j) { float e = __expf(s[kt][j] - mn); pv[kt * 4 + j] = e; ps += e; }
  st.l = st.l * alpha + ps;
  u32x4 pk;
  pk[0] = pack2(pv[0], pv[1]); pk[1] = pack2(pv[2], pv[3]); pk[2] = pack2(pv[4], pv[5]); pk[3] = pack2(pv[6], pv[7]);
  bf16x8 pf = __builtin_bit_cast(bf16x8, pk);
#pragma unroll
  for (int dt = 0; dt < 4; ++dt) {
    bf16x8 vf = f.v[dt];
#pragma unroll
    for (int j = 0; j < 4; ++j) st.o[dt][j] *= alpha;
    st.o[dt] = mfma16(vf, pf, st.o[dt]);
  }
}

DI void attn_item(const Params& p, char* ws, int lane, int l, int item) {
  const int fr = lane & 15, fq = lane >> 4;
  const int type = item >> 10, r = item & 1023;
  const int h = r & 7, qp = r >> 3;
  AttnSt st[2];
  const u16* Q;
  u16* Y;
  if (type == 0 || type == 2) { Q = (const u16*)(ws + O_QA); Y = (u16*)(ws + O_YABC); }
  else { Q = (const u16*)(ws + O_QC); Y = (u16*)(ws + O_YABC) + 2ull * NT * 512; }
  const int tok0 = (type < 2 ? NCTX : 0) + qp * 32;
  bf16x8 qf[2][2];
  const bool hasSink = (type == 0 || type == 2);
#pragma unroll
  for (int i = 0; i < 2; ++i) {
#pragma unroll
    for (int dt = 0; dt < 4; ++dt) st[i].o[dt] = f32x4{0.f, 0.f, 0.f, 0.f};
#pragma unroll
    for (int ks = 0; ks < 2; ++ks) qf[i][ks] = *(const bf16x8*)(Q + (size_t)(tok0 + i * 16 + fr) * 512 + h * 64 + ks * 32 + fq * 8);
    if (hasSink) { st[i].m = p.in[15][l * 8 + h]; st[i].l = fq == 0 ? 1.f : 0.f; }
    else { st[i].m = -1e30f; st[i].l = 0.f; }
  }
  AttnKVF f;
  if (type == 0) {
    const int qt = qp * 2;
    const int b = qt >> 7, kv = h >> 2;
    const u16* ck = (const u16*)(ws + O_CAK) + ((size_t)(b * 4 + l) * 512) * 128 + kv * 64;
    const u16* cvt = (const u16*)(ws + O_CAVT) + ((size_t)(b * 4 + l) * 128 + kv * 64) * 512;
    for (int p0 = 0; p0 < 512; p0 += 32) {
      attn_kvload(f, ck + (size_t)p0 * 128, 128, cvt + p0, 512, fr, fq);
      attn_core<0>(st[0], qf[0], f, fr, fq, 0, 0, nullptr);
      attn_core<0>(st[1], qf[1], f, fr, fq, 0, 0, nullptr);
    }
    const u16* K = (const u16*)(ws + O_KA) + (size_t)(NCTX + b * 2048) * 128 + kv * 64;
    const u16* VT = (const u16*)(ws + O_VAT) + (size_t)(kv * 64) * NT + NCTX + b * 2048;
    const int ta = (qt & 127) * 16;
    const int kb0 = max(0, ((ta - 128) >> 5) << 5), kb1 = min(2048, ta + 32 + 128);
    for (int k0 = kb0; k0 < kb1; k0 += 32) {
      attn_kvload(f, K + (size_t)k0 * 128, 128, VT + k0, NT, fr, fq);
      attn_core<1>(st[0], qf[0], f, fr, fq, ta + fr, k0, nullptr);
      attn_core<1>(st[1], qf[1], f, fr, fq, ta + 16 + fr, k0, nullptr);
    }
  } else if (type == 1) {
    const int qt = qp * 2;
    const int b = qt >> 7;
    const u16* ck = (const u16*)(ws + O_CCK) + ((size_t)(b * 4 + l) * 512) * 512 + h * 64;
    const u16* cvt = (const u16*)(ws + O_CCVT) + ((size_t)(b * 4 + l) * 512 + h * 64) * 512;
    for (int p0 = 0; p0 < 512; p0 += 32) {
      attn_kvload(f, ck + (size_t)p0 * 512, 512, cvt + p0, 512, fr, fq);
      attn_core<0>(st[0], qf[0], f, fr, fq, 0, 0, nullptr);
      attn_core<0>(st[1], qf[1], f, fr, fq, 0, 0, nullptr);
    }
    const u16* K = (const u16*)(ws + O_KC) + (size_t)(NCTX + b * 2048) * 512 + h * 64;
    const u16* VT = (const u16*)(ws + O_VCT) + (size_t)(h * 64) * NT + NCTX + b * 2048;
    const float* rpb = p.in[29] + (size_t)(l * 8 + h) * 15 * 31;
#pragma unroll
    for (int i = 0; i < 2; ++i) {
      const int t0 = ((qt + i) & 127) * 16;
      const int qrow = t0 >> 6, c0 = t0 & 63;
      const int rs = min(max(qrow - 4, 0), 24);
      const int cstart = min(max(c0 - 8, 0), 32);
      for (int a = 0; a < 8; ++a) {
        int krow = rs + a;
        int k0 = krow * 64 + cstart;
        attn_kvload(f, K + (size_t)k0 * 512, 512, VT + k0, NT, fr, fq);
        attn_core<2>(st[i], qf[i], f, fr, fq, c0 + fr, cstart, rpb + (krow - qrow + 7) * 31);
      }
    }
  } else if (type == 2) {
    const int b = (qp * 2) >> 4, kv = h >> 2;
    const u16* K = (const u16*)(ws + O_KA) + (size_t)(b * 256) * 128 + kv * 64;
    const u16* VT = (const u16*)(ws + O_VAT) + (size_t)(kv * 64) * NT + b * 256;
    for (int k0 = 0; k0 < 256; k0 += 32) {
      attn_kvload(f, K + (size_t)k0 * 128, 128, VT + k0, NT, fr, fq);
      attn_core<0>(st[0], qf[0], f, fr, fq, 0, 0, nullptr);
      attn_core<0>(st[1], qf[1], f, fr, fq, 0, 0, nullptr);
    }
  } else {
    const int b = (qp * 2) >> 4;
    const u16* K = (const u16*)(ws + O_KC) + (size_t)(b * 256) * 512 + h * 64;
    const u16* VT = (const u16*)(ws + O_VCT) + (size_t)(h * 64) * NT + b * 256;
    for (int k0 = 0; k0 < 256; k0 += 32) {
      attn_kvload(f, K + (size_t)k0 * 512, 512, VT + k0, NT, fr, fq);
      attn_core<0>(st[0], qf[0], f, fr, fq, 0, 0, nullptr);
      attn_core<0>(st[1], qf[1], f, fr, fq, 0, 0, nullptr);
    }
  }
#pragma unroll
  for (int i = 0; i < 2; ++i) {
    float lt = st[i].l;
    lt += __shfl_xor(lt, 16);
    lt += __shfl_xor(lt, 32);
    float inv = 1.f / lt;
#pragma unroll
    for (int dt = 0; dt < 4; ++dt) {
      u32x2 o; o[0] = pack2(st[i].o[dt][0] * inv, st[i].o[dt][1] * inv); o[1] = pack2(st[i].o[dt][2] * inv, st[i].o[dt][3] * inv);
      *(u32x2*)(Y + (size_t)(tok0 + i * 16 + fr) * 512 + h * 64 + dt * 16 + fq * 4) = o;
    }
  }
}


__device__ void phase_mix(const Params& p, int l) {
  char* ws = opaque_ptr(p.ws);
  const int tid = opaque_tid();
  const int wid = tid >> 6, lane = tid & 63;
  constexpr int LJPL = 4;
  constexpr int BPS = 64 / (4 * LJPL);
  const int NLB = (int)gridDim.x >= 2 * 32 * BPS ? 32 * BPS : 0;
  if ((int)blockIdx.x < NLB) {
    __builtin_amdgcn_s_setprio(3);
    const int it = blockIdx.x;
    const int sc = it / BPS, hf = it % BPS;
    const int z = sc & 1, h = (sc >> 1) & 7, b = sc >> 4;
    const float* s0 = p.in[6] + ((size_t)((b * 4 + l) * 2 + z) * 8 + h) * 4096;
    scan_latent_block<LJPL, 2048>(ws, tid, z, h, NCTX + b * 2048, hf * 4 * LJPL, s0, nullptr);
  } else {
    __builtin_amdgcn_s_setprio(1);
    if (NLB == 0) {
      for (int it = blockIdx.x * 4 + wid; it < 256; it += gridDim.x * 4) {
        int sc = it >> 3, part = it & 7;
        int z = sc & 1, h = (sc >> 1) & 7, b = sc >> 4;
        const float* s0 = p.in[6] + ((size_t)((b * 4 + l) * 2 + z) * 8 + h) * 4096;
        scan_wave_dma<8, 8>(ws, lane, wid * 12288, z, h, NCTX + b * 2048, 2048, part * 8, s0, nullptr);
      }
    }
    if (NLB > 0) {
      const int nab = (int)gridDim.x - NLB;
      for (int it = (int)blockIdx.x - NLB; it < 512; it += nab) {
        int sc = it >> 1, hf = it & 1;
        int z = sc & 1, h = (sc >> 1) & 7, b = sc >> 4;
        float* so = p.out + OUT_ST + ((size_t)((b * 4 + l) * 2 + z) * 8 + h) * 4096;
        scan_latent_block<8, 256>(ws, tid, z, h, b * 256, hf * 32, nullptr, so);
      }
    } else {
      const int nw = gridDim.x * 4;
      for (int it = (int)blockIdx.x * 4 + wid; it < 2048; it += nw) {
        int sc = it >> 3, part = it & 7;
        int z = sc & 1, h = (sc >> 1) & 7, b = sc >> 4;
        float* so = p.out + OUT_ST + ((size_t)((b * 4 + l) * 2 + z) * 8 + h) * 4096;
        scan_wave_dma<8, 8>(ws, lane, wid * 12288, z, h, b * 256, 256, part * 8, nullptr, so);
      }
    }
  }
  __builtin_amdgcn_s_setprio(0);
  int* cnt = (int*)(ws + O_CNT) + l;
  while (true) {
    int it = 0;
    if (lane == 0) it = atomicAdd(cnt, 1);
    it = __builtin_amdgcn_readfirstlane(it);
    if (it >= 4096) break;
    attn_item(p, ws, lane, l, it);
  }
  if (l == 0) {
    int* cnt2 = (int*)(ws + O_CNT) + 8;
    while (true) {
      int it = 0;
      if (lane == 0) it = atomicAdd(cnt2, 1);
      it = __builtin_amdgcn_readfirstlane(it);
      if (it >= 4096) break;
      const int tab = it >> 11, rb = (it & 2047) * 32;
      if (tab == 0) convert_rows_fp8_wave(lane, p.in[34], (unsigned char*)(ws + O_PEU), (float*)(ws + O_SCU), rb, rb + 32);
      else convert_rows_fp8_wave(lane, p.in[35], (unsigned char*)(ws + O_PEV), (float*)(ws + O_SCV), rb, rb + 32);
    }
  }
}

__device__ void phase_rwkv_post(const Params& p, int l) {
  char* ws = opaque_ptr(p.ws);
  const int tid = opaque_tid();
  const int lane = tid & 63;
  const int gw = blockIdx.x * 4 + (tid >> 6), GW = gridDim.x * 4;
  const float* Y0 = (const float*)(ws + O_YS);
  const float* Y1 = Y0 + (size_t)NT * 512;
  const float* KD0 = (const float*)(ws + O_KD);
  const float* KD1 = KD0 + (size_t)NT * 512;
  for (int tok = gw; tok < NT; tok += GW) {
#pragma unroll
    for (int i = 0; i < 2; ++i) {
      int c = (lane + 64 * i) * 4;
      size_t e = (size_t)tok * 512 + c;
      f32x4 a = *(const f32x4*)(Y0 + e), b = *(const f32x4*)(Y1 + e);
      f32x4 y;
      float s = 0.f;
#pragma unroll
      for (int j = 0; j < 4; ++j) { y[j] = a[j] + b[j]; s += y[j]; }
      float mu = row_sum16(s) * (1.f / 64.f);
      float vs = 0.f;
#pragma unroll
      for (int j = 0; j < 4; ++j) { y[j] -= mu; vs += y[j] * y[j]; }
      float var = row_sum16(vs) * (1.f / 64.f);
      float rstd = rsqrtf(var + 64e-5f);
      f32x4 g = *(const f32x4*)(p.in[26] + l * 512 + c), bb = *(const f32x4*)(p.in[27] + l * 512 + c);
      f32x4 r = *(const f32x4*)((const float*)(ws + O_XRKV) + (size_t)tok * 1536 + c);
      f32x4 v = *(const f32x4*)((const float*)(ws + O_XRKV) + (size_t)tok * 1536 + 1024 + c);
      f32x4 k0 = *(const f32x4*)(KD0 + e), k1 = *(const f32x4*)(KD1 + e);
      f32x4 rk = *(const f32x4*)(p.in[25] + l * 512 + c);
      float bs = 0.f;
#pragma unroll
      for (int j = 0; j < 4; ++j) bs += r[j] * (k0[j] + k1[j]) * rk[j];
      bs = row_sum16(bs);
      f32x4 gg = *(const f32x4*)((const float*)(ws + O_GG) + e);
      float o[4];
#pragma unroll
      for (int j = 0; j < 4; ++j) o[j] = (y[j] * rstd * g[j] + bb[j] + bs * v[j]) * gg[j];
      u32x2 ov; ov[0] = pack2(o[0], o[1]); ov[1] = pack2(o[2], o[3]);
      *(u32x2*)((u16*)(ws + O_YABC) + (size_t)NT * 512 + e) = ov;
    }
  }
}

__device__ void phase_branch(const Params& p, int l) {
  char* ws = opaque_ptr(p.ws);
  const int tid = opaque_tid();
  const int wid = tid >> 6, lane = tid & 63, wr = wid >> 1, wc = wid & 1, fr = lane & 15, fq = lane >> 4;
  const u16* G = (const u16*)(ws + O_GATE);
  for (int t = blockIdx.x; t < 64 * 8; t += gridDim.x) {
    const int tm = t & 63, tn = t >> 6;
    const int brow = tm * 128, bcol = tn * 128;
    f32x4 tot[4][4];
    zero_acc(tot);
#pragma unroll 1
    for (int br = 0; br < 3; ++br) {
      f32x4 acc[4][4];
      zero_acc(acc);
      const u16* Wb = (const u16*)(ws + (br == 0 ? O_AOUT : br == 1 ? O_RWOUT : O_NAOUT)) + ((size_t)l * 1024 + bcol) * 512;
      gemm_main(tid, (const u16*)(ws + O_YABC) + (size_t)br * NT * 512 + (size_t)brow * 512, 512, Wb, 512, 512, acc, ((tm >> 3) + (tn & 7)) & 7);
#pragma unroll
      for (int m = 0; m < 4; ++m) {
        const int tok = brow + wr * 64 + m * 16 + fr;
#pragma unroll
        for (int n = 0; n < 4; ++n) {
          const int c = bcol + wc * 64 + n * 16 + fq * 4;
          u32x2 gv = *(const u32x2*)(G + (size_t)tok * 3072 + br * 1024 + c);
          tot[m][n][0] += acc[m][n][0] * __uint_as_float(gv[0] << 16);
          tot[m][n][1] += acc[m][n][1] * __uint_as_float(gv[0] & 0xffff0000u);
          tot[m][n][2] += acc[m][n][2] * __uint_as_float(gv[1] << 16);
          tot[m][n][3] += acc[m][n][3] * __uint_as_float(gv[1] & 0xffff0000u);
        }
      }
    }
#pragma unroll
    for (int m = 0; m < 4; ++m) {
      const int tok = brow + wr * 64 + m * 16 + fr;
#pragma unroll
      for (int n = 0; n < 4; ++n) {
        const int c = bcol + wc * 64 + n * 16 + fq * 4;
        u32x2 o; o[0] = pack2(tot[m][n][0], tot[m][n][1]); o[1] = pack2(tot[m][n][2], tot[m][n][3]);
        *(u32x2*)((u16*)(ws + O_MERG) + (size_t)tok * 1024 + c) = o;
      }
    }
  }
}

__device__ void phase_wo(const Params& p, int l) {
  char* ws = opaque_ptr(p.ws);
  const int tid = opaque_tid();
  const int wid = tid >> 6, lane = tid & 63, wr = wid >> 1, wc = wid & 1, fr = lane & 15, fq = lane >> 4;
  float* X = (float*)(ws + O_X);
  for (int t = blockIdx.x; t < 64 * 8; t += gridDim.x) {
    const int tm = t & 63, tn = t >> 6;
    const int brow = tm * 128, bcol = tn * 128;
    f32x4 acc[4][4];
    zero_acc(acc);
    gemm_main(tid, (const u16*)(ws + O_MERG) + (size_t)brow * 1024, 1024, (const u16*)(ws + O_WO) + ((size_t)l * 1024 + bcol) * 1024, 1024, 1024, acc, (((tm >> 3) + (tn & 7)) * 2) & 15);
#pragma unroll
    for (int m = 0; m < 4; ++m) {
      const int tok = brow + wr * 64 + m * 16 + fr;
      const float* gate = (const float*)(ws + O_MOD) + ((size_t)l * 3 + tok_cond(tok)) * 6144 + 2 * 1024;
#pragma unroll
      for (int n = 0; n < 4; ++n) {
        const int c = bcol + wc * 64 + n * 16 + fq * 4;
        f32x4 x = *(f32x4*)(X + (size_t)tok * 1024 + c);
        f32x4 g = *(const f32x4*)(gate + c);
#pragma unroll
        for (int j = 0; j < 4; ++j) x[j] += g[j] * acc[m][n][j];
        *(f32x4*)(X + (size_t)tok * 1024 + c) = x;
      }
    }
  }
}

__device__ void phase_peq(const Params& p, int l) {
  char* ws = opaque_ptr(p.ws);
  const int tid = opaque_tid();
  const int wid = tid >> 6, lane = tid & 63, wr = wid >> 1, wc = wid & 1, fr = lane & 15, fq = lane >> 4;
  for (int t = blockIdx.x; t < 64 * 16; t += gridDim.x) {
    const int tm = t & 63, tn = t >> 6;
    const int brow = tm * 128, bcol = tn * 128;
    f32x4 acc[4][4];
    zero_acc(acc);
    gemm_main(tid, (const u16*)(ws + O_H) + (size_t)brow * 1024, 1024, (const u16*)(ws + O_PEQ) + ((size_t)l * 2048 + bcol) * 1024, 1024, 1024, acc, (((tm >> 3) + (tn & 7)) * 2) & 15);
#pragma unroll
    for (int m = 0; m < 4; ++m) {
      const int tok = brow + wr * 64 + m * 16 + fr;
#pragma unroll
      for (int n = 0; n < 4; ++n) {
        const int c = bcol + wc * 64 + n * 16 + fq * 4;
        u32x2 o; o[0] = pack2(acc[m][n][0], acc[m][n][1]); o[1] = pack2(acc[m][n][2], acc[m][n][3]);
        *(u32x2*)((u16*)(ws + O_PQ) + (size_t)tok * 2048 + c) = o;
      }
    }
  }
}

__device__ const unsigned char kCand[64] = {
    0x00, 0x01, 0x02, 0x03, 0x04, 0x05, 0x06, 0x07, 0x08, 0x09, 0x0a, 0x0b, 0x0c, 0x0d, 0x0e, 0x0f,
    0x10, 0x11, 0x12, 0x13, 0x14, 0x15, 0x16, 0x17, 0x20, 0x21, 0x22, 0x23, 0x24, 0x30, 0x31, 0x32,
    0x33, 0x40, 0x41, 0x42, 0x50, 0x51, 0x60, 0x61, 0x70, 0x71, 0x80, 0x90, 0xa0, 0xb0, 0xc0, 0xd0,
    0xe0, 0xf0, 0xff, 0xff, 0xff, 0xff, 0xff, 0xff, 0xff, 0xff, 0xff, 0xff, 0xff, 0xff, 0xff, 0xff};

DI unsigned f2key(float f) { unsigned u = __float_as_uint(f); return (u & 0x80000000u) ? ~u : (u | 0x80000000u); }
DI float key2f(unsigned k) { unsigned u = (k & 0x80000000u) ? (k & 0x7fffffffu) : ~k; return __uint_as_float(u); }
template <int CTRL> DI unsigned dppu(unsigned v) { return (unsigned)__builtin_amdgcn_update_dpp(0, (int)v, CTRL, 0xf, 0xf, true); }
DI unsigned row_max16u(unsigned v) { v = max(v, dppu<0xB1>(v)); v = max(v, dppu<0x4E>(v)); v = max(v, dppu<0x141>(v)); v = max(v, dppu<0x140>(v)); return v; }

__device__ void phase_peer_sel(const Params& p, int l) {
  char* ws = opaque_ptr(p.ws);
  const int tid = opaque_tid();
  const int wid = tid >> 6, lane = tid & 63, fr = lane & 15, fq = lane >> 4;
  const int gw = blockIdx.x * 4 + wid, GW = gridDim.x * 4;
  float* lv = (float*)(g_smem + wid * 4096);
  int* li = (int*)(g_smem + wid * 4096 + 2048);
  const u16* PQ = (const u16*)(ws + O_PQ);
  int ca[4], cb[4];
  bool cvld[4];
#pragma unroll
  for (int c = 0; c < 4; ++c) { int code = kCand[c * 16 + fr]; cvld[c] = code != 0xff; ca[c] = (code >> 4) & 15; cb[c] = code & 15; }
  for (int it = gw; it < 512 * 8; it += GW) {
    const int h = it >> 9, tg = it & 511;
    const u16* SK = (const u16*)(ws + O_SUBK) + ((size_t)(l * 8 + h) * 2) * 128 * 128;
    f32x4 sc[2][8];
#pragma unroll
    for (int z = 0; z < 2; ++z) {
      bf16x8 qf[4];
#pragma unroll
      for (int ks = 0; ks < 4; ++ks) qf[ks] = *(const bf16x8*)(PQ + (size_t)(tg * 16 + fr) * 2048 + (h * 2 + z) * 128 + ks * 32 + fq * 8);
#pragma unroll
      for (int nt = 0; nt < 8; ++nt) {
        sc[z][nt] = f32x4{0.f, 0.f, 0.f, 0.f};
#pragma unroll
        for (int ks = 0; ks < 4; ++ks) {
          bf16x8 kf = *(const bf16x8*)(SK + ((size_t)z * 128 + nt * 16 + fr) * 128 + ks * 32 + fq * 8);
          sc[z][nt] = mfma16(qf[ks], kf, sc[z][nt]);
        }
      }
    }
#pragma unroll
    for (int z = 0; z < 2; ++z) {
#pragma unroll
      for (int j = 0; j < 4; ++j) {
        unsigned key[8];
#pragma unroll
        for (int nt = 0; nt < 8; ++nt) key[nt] = (f2key(sc[z][nt][j]) & ~127u) | (unsigned)(127 - (nt * 16 + fr));
        unsigned tk = 0u;
#pragma unroll 1
        for (int k = 0; k < 16; ++k) {
          unsigned m = key[0];
#pragma unroll
          for (int nt = 1; nt < 8; ++nt) m = max(m, key[nt]);
          unsigned M = row_max16u(m);
#pragma unroll
          for (int nt = 0; nt < 8; ++nt) key[nt] = key[nt] == M ? 0u : key[nt];
          if (fr == k) tk = M;
        }
        lv[((fq * 4 + j) * 2 + z) * 16 + fr] = key2f(tk & ~127u);
        li[((fq * 4 + j) * 2 + z) * 16 + fr] = 127 - (int)(tk & 127u);
      }
    }
    __builtin_amdgcn_s_waitcnt(0xc07f);
    __builtin_amdgcn_wave_barrier();
#pragma unroll 1
    for (int j = 0; j < 4; ++j) {
      const int tl = fq * 4 + j;
      float cand[4];
#pragma unroll
      for (int c = 0; c < 4; ++c) cand[c] = cvld[c] ? lv[(tl * 2 + 0) * 16 + ca[c]] + lv[(tl * 2 + 1) * 16 + cb[c]] : -3e38f;
      unsigned ck[4];
#pragma unroll
      for (int c = 0; c < 4; ++c) ck[c] = cvld[c] ? ((f2key(cand[c]) & ~63u) | (unsigned)(63 - (c * 16 + fr))) : 0u;
      unsigned sk = 0u;
#pragma unroll 1
      for (int k = 0; k < 16; ++k) {
        unsigned m = max(max(ck[0], ck[1]), max(ck[2], ck[3]));
        unsigned M = row_max16u(m);
#pragma unroll
        for (int c = 0; c < 4; ++c) ck[c] = ck[c] == M ? 0u : ck[c];
        if (fr == k) sk = M;
      }
      const float sv = key2f(sk & ~63u);
      const int scode = 63 - (int)(sk & 63u);
      int ab = kCand[scode];
      int e = li[(tl * 2 + 0) * 16 + ((ab >> 4) & 15)] * 128 + li[(tl * 2 + 1) * 16 + (ab & 15)];
      float mx = row_max16(sv);
      float ex = __expf(sv - mx);
      float sum = row_sum16(ex);
      int tok = tg * 16 + tl;
      ((int*)(ws + O_EIDX))[(size_t)tok * 128 + h * 16 + fr] = e;
      ((float*)(ws + O_EGATE))[(size_t)tok * 128 + h * 16 + fr] = ex / sum;
    }
    __builtin_amdgcn_s_waitcnt(0xc07f);
    __builtin_amdgcn_wave_barrier();
  }
}

DI void cvt8(const bf16x8& v, float (&f)[8]) {
  u32x4 u = __builtin_bit_cast(u32x4, v);
#pragma unroll
  for (int q = 0; q < 4; ++q) { f[2 * q] = __uint_as_float(u[q] << 16); f[2 * q + 1] = __uint_as_float(u[q] & 0xffff0000u); }
}
DI void cvt16(const u32x4& q, float (&f)[16]) {
#pragma unroll
  for (int i = 0; i < 4; ++i) {
    f32x2 a = __builtin_amdgcn_cvt_pk_f32_fp8((int)q[i], false), b = __builtin_amdgcn_cvt_pk_f32_fp8((int)q[i], true);
    f[4 * i] = a[0]; f[4 * i + 1] = a[1]; f[4 * i + 2] = b[0]; f[4 * i + 3] = b[1];
  }
}

__device__ void phase_peer_gather(const Params& p, int l, bool dry = false) {
  char* ws = opaque_ptr(p.ws);
  const int tid = opaque_tid();
  const int lane = tid & 63;
  const int gw = blockIdx.x * 4 + (tid >> 6), GW = gridDim.x * 4;
  const unsigned char* U = (const unsigned char*)(ws + O_PEU) + (size_t)l * 16384 * 1024;
  const unsigned char* V = (const unsigned char*)(ws + O_PEV) + (size_t)l * 16384 * 1024;
  const float* SU = (const float*)(ws + O_SCU) + l * 16384;
  const float* SV = (const float*)(ws + O_SCV) + l * 16384;
  float* X = (float*)(ws + O_X);
  float* XW = dry ? (float*)(ws + O_YS) : X;
  u16* HW = dry ? (u16*)(ws + O_MERG) : (u16*)(ws + O_H);
  float* OW = dry ? (float*)(ws + O_PB) : p.out + OUT_Y;
  for (int tok = gw; tok < NT; tok += GW) {
    float hf[16];
    {
      const u16* hr = (const u16*)(ws + O_H) + (size_t)tok * 1024 + lane * 16;
      bf16x8 h0 = *(const bf16x8*)(hr), h1 = *(const bf16x8*)(hr + 8);
      float t0[8], t1[8];
      cvt8(h0, t0); cvt8(h1, t1);
#pragma unroll
      for (int i = 0; i < 8; ++i) { hf[i] = t0[i]; hf[8 + i] = t1[i]; }
    }
    float acc[16];
#pragma unroll
    for (int i = 0; i < 16; ++i) acc[i] = 0.f;
    const int id0 = ((const int*)(ws + O_EIDX))[(size_t)tok * 128 + lane], id1 = ((const int*)(ws + O_EIDX))[(size_t)tok * 128 + 64 + lane];
    const float g0 = ((const float*)(ws + O_EGATE))[(size_t)tok * 128 + lane], g1 = ((const float*)(ws + O_EGATE))[(size_t)tok * 128 + 64 + lane];
#define PG_LOAD(G, ids, gts, su, sv, uq, vq)                                                                      \
  do {                                                                                                            \
    _Pragma("unroll") for (int e = 0; e < 4; ++e) {                                                               \
      int k = (G) * 4 + e;                                                                                        \
      int sel = k & 63;                                                                                           \
      int a_ = __builtin_amdgcn_readlane(id0, sel), b_ = __builtin_amdgcn_readlane(id1, sel);                     \
      float ga_ = __builtin_bit_cast(float, __builtin_amdgcn_readlane(__builtin_bit_cast(int, g0), sel));         \
      float gb_ = __builtin_bit_cast(float, __builtin_amdgcn_readlane(__builtin_bit_cast(int, g1), sel));         \
      ids[e] = (G) < 16 ? a_ : b_;                                                                                 \
      gts[e] = (G) < 16 ? ga_ : gb_;                                                                               \
    }                                                                                                             \
    _Pragma("unroll") for (int e = 0; e < 4; ++e) uq[e] = *(const u32x4*)(U + (size_t)ids[e] * 1024 + lane * 16); \
    _Pragma("unroll") for (int e = 0; e < 4; ++e) vq[e] = *(const u32x4*)(V + (size_t)ids[e] * 1024 + lane * 16); \
    _Pragma("unroll") for (int e = 0; e < 4; ++e) { su[e] = SU[ids[e]]; sv[e] = SV[ids[e]]; }                     \
  } while (0)
#define PG_COMP(gts, su, sv, uq, vq)                                                                              \
  do {                                                                                                            \
    float cf[4];                                                                                                  \
    _Pragma("unroll") for (int e = 0; e < 4; ++e) {                                                               \
      float a[16];                                                                                                \
      cvt16(uq[e], a);                                                                                            \
      float d0 = 0.f, d1 = 0.f;                                                                                   \
      _Pragma("unroll") for (int i = 0; i < 16; i += 2) { d0 += a[i] * hf[i]; d1 += a[i + 1] * hf[i + 1]; }       \
      float d = wave_sum(d0 + d1) * su[e];                                                                        \
      float u3 = 0.7978845608028654f * (d + 0.044715f * d * d * d);                                               \
      float th = 1.f - 2.f * __builtin_amdgcn_rcpf(__expf(2.f * u3) + 1.f);                                                            \
      cf[e] = gts[e] * 0.5f * d * (1.f + th) * sv[e];                                                             \
    }                                                                                                             \
    _Pragma("unroll") for (int e = 0; e < 4; ++e) {                                                               \
      float a[16];                                                                                                \
      cvt16(vq[e], a);                                                                                            \
      _Pragma("unroll") for (int i = 0; i < 16; ++i) acc[i] += cf[e] * a[i];                                      \
    }                                                                                                             \
  } while (0)
    {
      int idA[4], idB[4];
      float gtA[4], gtB[4], suA[4], svA[4], suB[4], svB[4];
      u32x4 uqA[4], vqA[4], uqB[4], vqB[4];
      PG_LOAD(0, idA, gtA, suA, svA, uqA, vqA);
#pragma unroll 1
      for (int g = 0; g < 32; g += 2) {
        PG_LOAD(g + 1, idB, gtB, suB, svB, uqB, vqB);
        PG_COMP(gtA, suA, svA, uqA, vqA);
        if (g + 2 < 32) PG_LOAD(g + 2, idA, gtA, suA, svA, uqA, vqA);
        PG_COMP(gtB, suB, svB, uqB, vqB);
      }
    }
#undef PG_LOAD
#undef PG_COMP
    const float* mod = (const float*)(ws + O_MOD) + ((size_t)l * 3 + tok_cond(tok)) * 6144;
    float x[16];
    const int e0 = lane * 16;
#pragma unroll
    for (int q = 0; q < 4; ++q) {
      f32x4 a = *(const f32x4*)(X + (size_t)tok * 1024 + e0 + q * 4);
      f32x4 ga = *(const f32x4*)(mod + 5 * 1024 + e0 + q * 4);
#pragma unroll
      for (int i = 0; i < 4; ++i) { a[i] += ga[i] * acc[q * 4 + i]; x[q * 4 + i] = a[i]; }
      *(f32x4*)(XW + (size_t)tok * 1024 + e0 + q * 4) = a;
    }
    float ss = 0.f;
#pragma unroll
    for (int i = 0; i < 16; ++i) ss += x[i] * x[i];
    ss = wave_sum(ss);
    const float rstd = rsqrtf(ss * (1.f / 1024.f) + 1e-6f);
    if (l < NL - 1) {
      const float* mod2 = (const float*)(ws + O_MOD) + ((size_t)(l + 1) * 3 + tok_cond(tok)) * 6144;
      const float* g = p.in[9] + (l + 1) * 1024;
      float y[16];
#pragma unroll
      for (int q = 0; q < 4; ++q) {
        f32x4 gg = *(const f32x4*)(g + e0 + q * 4), sh = *(const f32x4*)(mod2 + e0 + q * 4), sc = *(const f32x4*)(mod2 + 1024 + e0 + q * 4);
#pragma unroll
        for (int i = 0; i < 4; ++i) y[q * 4 + i] = x[q * 4 + i] * rstd * gg[i] * (1.f + sc[i]) + sh[i];
      }
      u32x4 o0, o1;
      o0[0] = pack2(y[0], y[1]); o0[1] = pack2(y[2], y[3]); o0[2] = pack2(y[4], y[5]); o0[3] = pack2(y[6], y[7]);
      o1[0] = pack2(y[8], y[9]); o1[1] = pack2(y[10], y[11]); o1[2] = pack2(y[12], y[13]); o1[3] = pack2(y[14], y[15]);
      *(u32x4*)(HW + (size_t)tok * 1024 + e0) = o0;
      *(u32x4*)(HW + (size_t)tok * 1024 + e0 + 8) = o1;
    } else {
      const float* g = p.in[11];
#pragma unroll
      for (int q = 0; q < 4; ++q) {
        f32x4 gg = *(const f32x4*)(g + e0 + q * 4), a;
#pragma unroll
        for (int i = 0; i < 4; ++i) a[i] = x[q * 4 + i] * rstd * gg[i];
        *(f32x4*)(OW + (size_t)tok * 1024 + e0 + q * 4) = a;
      }
    }
  }
}

#define XB_TMO 128
#define XB_XCNT(j) (256 + 64 * (j))
#define XB_XSUB(j) (1280 + 64 * (j))
#define XB_XGEN(j) (2304 + 64 * (j))
#define XB_TOP 3328
#define XB_TOPGEN 3392
#define XCD_BAR_WORDS 3456
#define XB_SPIN_CAP (1u << 18)
DI unsigned xb_ld(unsigned* q) { return __hip_atomic_load(q, __ATOMIC_RELAXED, __HIP_MEMORY_SCOPE_AGENT); }
DI unsigned xb_add(unsigned* q, unsigned v) { return __hip_atomic_fetch_add(q, v, __ATOMIC_RELAXED, __HIP_MEMORY_SCOPE_AGENT); }
DI unsigned xb_xcc_id() { return (unsigned)__builtin_amdgcn_s_getreg((3 << 11) | 20) & 0xFu; }
#define XB_SPIN(cond, bar)                                                                   \
  do {                                                                                       \
    unsigned _sp = 0;                                                                        \
    while (cond) {                                                                           \
      __builtin_amdgcn_s_sleep(1);                                                           \
      if ((++_sp & 255u) == 0u) {                                                            \
        if (xb_ld(&(bar)[XB_TMO])) break;                                                    \
        if (_sp > XB_SPIN_CAP) { atomicAdd(&(bar)[XB_TMO], 1u); break; }                     \
      }                                                                                      \
    }                                                                                        \
  } while (0)
struct XB { unsigned* bar; unsigned x, nloc, nx; };
DI void xcd_barrier(const XB& b) {
  asm volatile("s_waitcnt vmcnt(0)" ::: "memory");
  __syncthreads();
  if (threadIdx.x == 0) {
    unsigned* bar = b.bar;
    __builtin_amdgcn_s_waitcnt(0);
    const unsigned nloc = b.nloc, nx = b.nx;
    const unsigned old = xb_add(&bar[XB_XSUB(b.x)], 1u);
    const unsigned gen = old / nloc;
    if (old + 1u == (gen + 1u) * nloc) {
      __builtin_amdgcn_fence(__ATOMIC_RELEASE, "agent");
      asm volatile("s_waitcnt vmcnt(0)" ::: "memory");
      const unsigned og = xb_add(&bar[XB_TOP], 1u);
      const unsigned tg = og / nx;
      if (og + 1u == (tg + 1u) * nx) xb_add(&bar[XB_TOPGEN], 1u);
      else XB_SPIN(xb_ld(&bar[XB_TOPGEN]) == tg, bar);
      __builtin_amdgcn_fence(__ATOMIC_ACQUIRE, "agent");
      xb_add(&bar[XB_XGEN(b.x)], 1u);
      asm volatile("s_waitcnt vmcnt(0)" ::: "memory");
    } else {
      XB_SPIN(xb_ld(&bar[XB_XGEN(b.x)]) == gen, bar);
      __builtin_amdgcn_fence(__ATOMIC_ACQUIRE, "agent");
      asm volatile("s_waitcnt vmcnt(0)" ::: "memory");
    }
  }
  __syncthreads();
}

__global__ void __launch_bounds__(256, 2) fwd_megakernel(Params p) {
  cg::grid_group grid = cg::this_grid();
  XB xb;
  xb.bar = (unsigned*)(p.ws + O_BAR);
  xb.x = xb_xcc_id();
  if (threadIdx.x == 0) (void)xb_add(&xb.bar[XB_XCNT(xb.x)], 1u);
  phase_prep(p);
  if (p.ws == nullptr) grid.sync();
  {
    unsigned mine = 0u, cnt = 0u, sum = 0u, sp = 0u;
    for (;;) {
      sum = 0u; cnt = 0u; mine = 0u;
#pragma unroll
      for (unsigned j = 0; j < 16; ++j) { const unsigned c = xb_ld(&xb.bar[XB_XCNT(j)]); sum += c; cnt += (c > 0u) ? 1u : 0u; mine = (j == xb.x) ? c : mine; }
      if (sum == gridDim.x) break;
      __builtin_amdgcn_s_sleep(1);
      if (++sp > XB_SPIN_CAP) break;
    }
    xb.nloc = __builtin_amdgcn_readfirstlane(mine > 0u ? mine : 1u);
    xb.nx = __builtin_amdgcn_readfirstlane(cnt > 0u ? cnt : 1u);
  }
  xcd_barrier(xb);
  phase_norm(p, 0, 0);
  xcd_barrier(xb);
  for (int l = 0; l < NL; ++l) {
    phase_gemm_in(p, l);
    xcd_barrier(xb);
    phase_rwkv_prep(p, l);
    xcd_barrier(xb);
    phase_rwkv_lora(p, l);
    xcd_barrier(xb);
    phase_mix(p, l);
    xcd_barrier(xb);
    phase_rwkv_post(p, l);
    xcd_barrier(xb);
    phase_branch(p, l);
    xcd_barrier(xb);
    phase_wo(p, l);
    xcd_barrier(xb);
    phase_norm(p, l, 1);
    xcd_barrier(xb);
    phase_peq(p, l);
    xcd_barrier(xb);
    phase_peer_sel(p, l);
    xcd_barrier(xb);
    phase_peer_gather(p, l);
    if (l + 1 < NL) xcd_barrier(xb);
  }
}

extern "C" void kernel_launch(void* const* d_in, const int* in_sizes, int n_in, void* d_out, int out_size, void* d_ws, size_t ws_size,
                              hipStream_t stream) {
  static int grid_blocks = 0;
  if (!grid_blocks) {
    int dev = 0, cus = 0, per_cu = 0;
    hipGetDevice(&dev);
    hipDeviceGetAttribute(&cus, hipDeviceAttributeMultiprocessorCount, dev);
    hipOccupancyMaxActiveBlocksPerMultiprocessor(&per_cu, fwd_megakernel, 256, 0);
    if (per_cu > 2) per_cu = 2;
    if (per_cu < 1) per_cu = 1;
    grid_blocks = cus * per_cu;
  }
  Params p{};
  for (int i = 0; i < 36; ++i) p.in[i] = (const float*)d_in[i];
  p.out = (float*)d_out;
  p.ws = (char*)d_ws;
  (void)hipMemsetAsync((char*)d_ws + O_BAR, 0, 3456 * 4, stream);
  void* args[] = {&p};
  hipError_t e = hipLaunchCooperativeKernel((void*)fwd_megakernel, dim3(grid_blocks), dim3(256), args, 0, stream);
  if (e != hipSuccess) fprintf(stderr, "cooperative launch failed: %s (grid %d)\n", hipGetErrorString(e), grid_blocks);
}
```
